# Optimizing an MI355X kernel written in HIP

```python
import jax, jax.numpy as jnp
from jax import lax
import numpy as np

D_MODEL = 1024
BATCH = 4
SEQ = 4096
DEPTH = 4

GRID_W = 64
CTX_LEN = 256
N_MOD = 6
GLA_HEADS = 4
GLA_DK = 64
GLA_DV = 128
GLA_GATE_RANK = 16
GLA_GATE_TEMP = 16.0
GLA_CHUNK = 64
MLA_HEADS = 8
MLA_Q_RANK = 384
MLA_KV_RANK = 256
MLA_NOPE = 64
MLA_ROPE = 32
MLA_DV = 64
MLA_SCALE = (MLA_NOPE + MLA_ROPE) ** -0.5
ATTN_BLOCK = 128
ROPE_BASE = 10000.0
RWKV_HEADS = 8
RWKV_HEAD = 64
RWKV_DECAY_RANK = 64
RWKV_AAA_RANK = 64
RWKV_GATE_RANK = 128
RWKV_GN_EPS = 64e-5
BRANCH_W = 512
N_BRANCH = 3
D_FF = 4 * D_MODEL
GLA_COLS = 2 * GLA_HEADS * GLA_DK + 2 * GLA_HEADS * GLA_DV + 2 * GLA_GATE_RANK
MLA_COLS = MLA_Q_RANK + MLA_KV_RANK + MLA_ROPE
RWKV_COLS = 3 * RWKV_HEADS * RWKV_HEAD + 2 * RWKV_DECAY_RANK + 2 * RWKV_AAA_RANK + RWKV_GATE_RANK
GATE_COLS = N_BRANCH * D_MODEL
N_IN = GLA_COLS + MLA_COLS + RWKV_COLS + GATE_COLS

kernel_name = "hybrid_gla_mla_rwkv7_dit_block"


def _split(z, sizes):
    idx = [int(i) for i in np.cumsum(sizes)[:-1]]
    return jnp.split(z, idx, axis=-1)


def _to_heads(a, n_heads):
    a = a.reshape(a.shape[:-1] + (n_heads, a.shape[-1] // n_heads))
    return jnp.swapaxes(a, -2, -3)


def _from_heads(a):
    a = jnp.swapaxes(a, -2, -3)
    return a.reshape(a.shape[:-2] + (-1,))


def _normalize(x, eps=1e-5):
    xf = x.astype(jnp.float32)
    mu = jnp.mean(xf, axis=-1, keepdims=True)
    var = jnp.mean(jnp.square(xf - mu), axis=-1, keepdims=True)
    return (xf - mu) * lax.rsqrt(var + eps)


def layer_norm(x, g, b):
    return (_normalize(x) * g + b).astype(x.dtype)


def modulate(x, shift, scale):
    return (_normalize(x, 1e-6) * (1.0 + scale) + shift).astype(x.dtype)


def rms_norm(x, g, eps=1e-6):
    xf = x.astype(jnp.float32)
    return (xf * lax.rsqrt(jnp.mean(xf * xf, axis=-1, keepdims=True) + eps) * g).astype(x.dtype)


def _stack_dirs(a, axis):
    return jnp.stack([a, jnp.flip(a, axis)])


def _flip_second(a2, axis):
    return jnp.stack([a2[0], jnp.flip(a2[1], axis)])


def _merge_dirs(y2, axis):
    return y2[0] + jnp.flip(y2[1], axis)


def _axial_rope(rows):
    n_axis = MLA_ROPE // 4
    inv = ROPE_BASE ** (-jnp.arange(n_axis, dtype=jnp.float32) / n_axis)
    row = jnp.repeat(jnp.arange(rows, dtype=jnp.float32), GRID_W)
    col = jnp.tile(jnp.arange(GRID_W, dtype=jnp.float32), rows)
    ang = jnp.concatenate([row[:, None] * inv, col[:, None] * inv], axis=-1)
    return jnp.cos(ang), jnp.sin(ang)


def _rope(x, cos, sin):
    x1, x2 = jnp.split(x, 2, axis=-1)
    return jnp.concatenate([x1 * cos - x2 * sin, x1 * sin + x2 * cos], axis=-1).astype(x.dtype)


def _gla_scan(q, k, v, logg, s0):
    T = q.shape[-2]
    n = T // GLA_CHUNK

    def chunk(a):
        return a.astype(jnp.float32).reshape(a.shape[:-2] + (n, GLA_CHUNK, a.shape[-1]))

    qc, kc, vc = chunk(q), chunk(k), chunk(v)
    b = jnp.cumsum(chunk(logg), axis=-2)
    b_last = b[..., -1:, :]
    q_in = qc * jnp.exp(b)
    k_in = kc * jnp.exp(-b)
    k_st = kc * jnp.exp(b_last - b)
    mask = jnp.tril(jnp.ones((GLA_CHUNK, GLA_CHUNK), dtype=bool))
    att = jnp.where(mask, jnp.einsum("...cd,...sd->...cs", q_in, k_in), 0.0)
    o_intra = jnp.einsum("...cs,...sv->...cv", att, vc)
    u = jnp.einsum("...cd,...cv->...dv", k_st, vc)
    decay = jnp.exp(b_last[..., 0, :])

    def step(s, xs):
        d, u_n = xs
        return d[..., None] * s + u_n, s

    s_fin, s_prev = lax.scan(step, s0, (jnp.moveaxis(decay, -2, 0), jnp.moveaxis(u, -3, 0)))
    o_inter = jnp.einsum("...cd,...dv->...cv", q_in, jnp.moveaxis(s_prev, 0, -3))
    o = (o_intra + o_inter).reshape(v.shape)
    return o.astype(v.dtype), s_fin


def _gla_prep(z, gk_up, gk_b):
    hk, hv, r = GLA_HEADS * GLA_DK, GLA_HEADS * GLA_DV, GLA_GATE_RANK
    q, k, v, gd_f, gd_b, og = _split(z, [hk, hk, hv, r, r, hv])
    gd = jnp.stack([gd_f, gd_b])
    logg = jax.nn.log_sigmoid((jnp.einsum("gbtr,grk->gbtk", gd, gk_up) + gk_b[:, None, None, :]).astype(jnp.float32)) / GLA_GATE_TEMP
    q = _to_heads(q, GLA_HEADS) * GLA_DK ** -0.5
    return (_stack_dirs(q, -2), _stack_dirs(_to_heads(k, GLA_HEADS), -2),
            _stack_dirs(_to_heads(v, GLA_HEADS), -2), _flip_second(_to_heads(logg, GLA_HEADS), -2), og)


def gla_branch(z, zc, gk_up, gk_b, norm_g, need_ctx):
    qc, kc, vc, gc, ogc = _gla_prep(zc, gk_up, gk_b)
    s0 = jnp.zeros((2, zc.shape[0], GLA_HEADS, GLA_DK, GLA_DV), jnp.float32)
    oc, s_ctx = _gla_scan(qc, kc, vc, gc, s0)
    q, k, v, g, og = _gla_prep(z, gk_up, gk_b)
    o, _ = _gla_scan(q, k, v, g, s_ctx)

    def post(o2, gate):
        o_h = rms_norm(_merge_dirs(o2, -2), norm_g)
        return (_from_heads(o_h) * jax.nn.silu(gate)).astype(z.dtype)

    return post(o, og), (post(oc, ogc) if need_ctx else None)


def _mla_proj(z, q_norm_g, kv_norm_g, w_uq, w_ukv):
    B, T, _ = z.shape
    qd, kvd, kr = _split(z, [MLA_Q_RANK, MLA_KV_RANK, MLA_ROPE])
    q = (rms_norm(qd, q_norm_g) @ w_uq).reshape(B, T, MLA_HEADS, MLA_NOPE + MLA_ROPE)
    kv = (rms_norm(kvd, kv_norm_g) @ w_ukv).reshape(B, T, MLA_HEADS, MLA_NOPE + MLA_DV)
    return q[..., :MLA_NOPE], q[..., MLA_NOPE:], kv[..., :MLA_NOPE], kr, kv[..., MLA_NOPE:]


def _mla_keys(k_nope, k_rope):
    B, T, H, _ = k_nope.shape
    return jnp.concatenate([k_nope, jnp.broadcast_to(k_rope[:, :, None, :], (B, T, H, MLA_ROPE))], axis=-1)


def _attend(q, k, v):
    s = jnp.einsum("bqhd,bkhd->bhqk", q, k).astype(jnp.float32) * MLA_SCALE
    p = jax.nn.softmax(s, axis=-1).astype(v.dtype)
    return jnp.einsum("bhqk,bkhv->bqhv", p, v)


def mla_branch(z, zc, q_norm_g, kv_norm_g, w_uq, w_ukv, cos, sin, need_ctx):
    B, T, _ = z.shape
    qn_c, qr_c, kn_c, kr_c, v_c = _mla_proj(zc, q_norm_g, kv_norm_g, w_uq, w_ukv)
    k_c = _mla_keys(kn_c, kr_c)
    qn, qr, kn, kr, v = _mla_proj(z, q_norm_g, kv_norm_g, w_uq, w_ukv)
    q = jnp.concatenate([qn, _rope(qr, cos[:, None, :], sin[:, None, :])], axis=-1)
    k = _mla_keys(kn, _rope(kr, cos, sin))
    k_all = jnp.concatenate([k_c, k], axis=1)
    v_all = jnp.concatenate([v_c, v], axis=1)
    nb = T // ATTN_BLOCK
    q_blocks = jnp.swapaxes(q.reshape(B, nb, ATTN_BLOCK, MLA_HEADS, MLA_NOPE + MLA_ROPE), 0, 1)
    o = lax.map(lambda qb: _attend(qb, k_all, v_all), q_blocks)
    y = jnp.swapaxes(o, 0, 1).reshape(B, T, MLA_HEADS * MLA_DV)
    yc = None
    if need_ctx:
        q_c = jnp.concatenate([qn_c, qr_c], axis=-1)
        yc = _attend(q_c, k_c, v_c).reshape(B, zc.shape[1], MLA_HEADS * MLA_DV)
    return y, yc


def _token_shift(z, mu):
    prev = jnp.pad(z[:, :-1], ((0, 0), (1, 0), (0, 0)))
    nxt = jnp.pad(z[:, 1:], ((0, 0), (0, 1), (0, 0)))
    return z + mu[0] * (prev - z) + mu[1] * (nxt - z)


def _rh(a):
    return a.reshape(a.shape[:-1] + (RWKV_HEADS, RWKV_HEAD))


def _rwkv_prep(z, shift_mu, w0, w_up, a0, a_up, g_up, k_k, k_a):
    W = RWKV_HEADS * RWKV_HEAD
    zs = _token_shift(z, shift_mu)
    r, k, v, wd_f, wd_b, ad_f, ad_b, gd = _split(
        zs, [W, W, W, RWKV_DECAY_RANK, RWKV_DECAY_RANK, RWKV_AAA_RANK, RWKV_AAA_RANK, RWKV_GATE_RANK])
    wd = jnp.stack([wd_f, wd_b])
    ad = jnp.stack([ad_f, ad_b])
    w_raw = (w0[:, None, None, :] + jnp.einsum("gbtr,grc->gbtc", jnp.tanh(wd), w_up)).astype(jnp.float32)
    decay = jnp.exp(-jnp.exp(-jax.nn.softplus(-w_raw) - 0.5))
    a = jax.nn.sigmoid(a0[:, None, None, :] + jnp.einsum("gbtr,grc->gbtc", ad, a_up))
    g = jax.nn.sigmoid(gd) @ g_up
    kk = _rh(k * k_k)
    kk = kk * lax.rsqrt(jnp.sum(kk * kk, axis=-1, keepdims=True) + 1e-12)
    k_eff = k * (1.0 + (a - 1.0) * k_a)
    return _rh(r), _rh(decay), _rh(k_eff), _rh(v), kk, _rh(a), g


def _rwkv_scan(r, w, k, v, kk, b, s0):
    xs = tuple(jnp.moveaxis(a.astype(jnp.float32), 2, 0) for a in (r, w, k, v, kk, b))

    def step(s, xt):
        r_t, w_t, k_t, v_t, kk_t, b_t = xt
        sa = -jnp.einsum("...vk,...k->...v", s, kk_t)
        s = s * w_t[..., None, :] + sa[..., :, None] * b_t[..., None, :] + v_t[..., :, None] * k_t[..., None, :]
        return s, jnp.einsum("...vk,...k->...v", s, r_t)

    s_fin, y = lax.scan(step, s0, xs)
    return jnp.moveaxis(y, 0, 2), s_fin


def rwkv_branch(z, zc, shift_mu, w0, w_up, a0, a_up, g_up, k_k, k_a, r_k, ln_g, ln_b, need_ctx):
    r_k_h = r_k.reshape(RWKV_HEADS, RWKV_HEAD)

    def run(zz, s0):
        r, w, k_eff, v, kk, a, g = _rwkv_prep(zz, shift_mu, w0, w_up, a0, a_up, g_up, k_k, k_a)
        y2, s_fin = _rwkv_scan(_stack_dirs(r, 1), _flip_second(w, 1), _flip_second(k_eff, 1),
                               _stack_dirs(v, 1), _stack_dirs(kk, 1), _flip_second(kk[None] * a, 1), s0)
        return y2, s_fin, (r, k_eff, v, g)

    def post(y2, r, k_eff, v, g):
        B, T = y2.shape[1], y2.shape[2]
        y = _merge_dirs(y2, 1)
        mu = jnp.mean(y, axis=-1, keepdims=True)
        var = jnp.mean(jnp.square(y - mu), axis=-1, keepdims=True)
        yn = ((y - mu) * lax.rsqrt(var + RWKV_GN_EPS)).reshape(B, T, -1) * ln_g + ln_b
        bonus = jnp.sum(jnp.sum(r[None] * k_eff * r_k_h, axis=-1, keepdims=True) * v[None], axis=0)
        return ((yn + bonus.reshape(B, T, -1)) * g).astype(z.dtype)

    s0 = jnp.zeros((2, zc.shape[0], RWKV_HEADS, RWKV_HEAD, RWKV_HEAD), jnp.float32)
    y2c, s_ctx, aux_c = run(zc, s0)
    y2, _, aux = run(z, s_ctx)
    return post(y2, *aux), (post(y2c, *aux_c) if need_ctx else None)


def _merge(ya, yb, yr, zg, w_branch, w_out):
    u = jnp.einsum("btnw,nwd->btnd", jnp.stack([ya, yb, yr], axis=2), w_branch)
    gates = jax.nn.sigmoid(zg.reshape(zg.shape[:-1] + (N_BRANCH, D_MODEL)))
    return jnp.sum(gates * u, axis=2) @ w_out


def _mlp(h, w1, w2):
    return jnp.square(jax.nn.relu(h @ w1)) @ w2


def setup_inputs(seed: int = 0) -> dict:
    key = jax.random.key(seed)
    ks = iter(jax.random.split(key, 40))

    def nrm(shape, scale=1.0):
        return scale * jax.random.normal(next(ks), shape, jnp.float32)

    def unif(shape, lo, hi):
        return jax.random.uniform(next(ks), shape, jnp.float32, lo, hi)

    D, L, W = D_MODEL, DEPTH, BRANCH_W
    beta = (8.0 * DEPTH) ** -0.25
    hk = GLA_HEADS * GLA_DK
    return {
        "x": nrm((BATCH, SEQ, D)),
        "c": nrm((BATCH, D)),
        "ctx": nrm((BATCH, CTX_LEN, D)),
        "c_ctx": nrm((D,)),
        "ada_w": nrm((L, D, N_MOD * D), 0.5 * D ** -0.5),
        "ada_b": nrm((L, N_MOD * D), 0.02),
        "w_in": nrm((L, D, N_IN), D ** -0.5),
        "gla_gk_up": nrm((L, 2, GLA_GATE_RANK, hk), GLA_GATE_RANK ** -0.5),
        "gla_gk_b": nrm((L, 2, hk), 0.5),
        "gla_norm_g": 1.0 + nrm((L, GLA_DV), 0.05),
        "mla_q_norm_g": 1.0 + nrm((L, MLA_Q_RANK), 0.05),
        "mla_kv_norm_g": 1.0 + nrm((L, MLA_KV_RANK), 0.05),
        "mla_w_uq": nrm((L, MLA_Q_RANK, MLA_HEADS * (MLA_NOPE + MLA_ROPE)), MLA_Q_RANK ** -0.5),
        "mla_w_ukv": nrm((L, MLA_KV_RANK, MLA_HEADS * (MLA_NOPE + MLA_DV)), MLA_KV_RANK ** -0.5),
        "rwkv_shift_mu": unif((L, 2, RWKV_COLS), 0.0, 0.5),
        "rwkv_w0": unif((L, 2, W), -4.0, 0.0),
        "rwkv_w_up": nrm((L, 2, RWKV_DECAY_RANK, W), 0.5 * RWKV_DECAY_RANK ** -0.5),
        "rwkv_a0": nrm((L, 2, W), 0.1),
        "rwkv_a_up": nrm((L, 2, RWKV_AAA_RANK, W), 0.5 * RWKV_AAA_RANK ** -0.5),
        "rwkv_g_up": nrm((L, RWKV_GATE_RANK, W), RWKV_GATE_RANK ** -0.5),
        "rwkv_k_k": 0.85 + nrm((L, W), 0.05),
        "rwkv_k_a": 1.0 + nrm((L, W), 0.05),
        "rwkv_r_k": nrm((L, W), 0.1),
        "rwkv_ln_g": 1.0 + nrm((L, W), 0.05),
        "rwkv_ln_b": nrm((L, W), 0.02),
        "w_branch": nrm((L, N_BRANCH, W, D), W ** -0.5),
        "w_out": nrm((L, D, D), beta * D ** -0.5),
        "ln1_g": 1.0 + nrm((L, D), 0.05),
        "ln1_b": nrm((L, D), 0.02),
        "mlp_w1": nrm((L, D, D_FF), D ** -0.5),
        "mlp_w2": nrm((L, D_FF, D), beta * D_FF ** -0.5),
        "ln2_g": 1.0 + nrm((L, D), 0.05),
        "ln2_b": nrm((L, D), 0.02),
    }


def reference(x, c, ctx, c_ctx, ada_w, ada_b, w_in, gla_gk_up, gla_gk_b, gla_norm_g,
              mla_q_norm_g, mla_kv_norm_g, mla_w_uq, mla_w_ukv, rwkv_shift_mu, rwkv_w0, rwkv_w_up,
              rwkv_a0, rwkv_a_up, rwkv_g_up, rwkv_k_k, rwkv_k_a, rwkv_r_k, rwkv_ln_g, rwkv_ln_b,
              w_branch, w_out, ln1_g, ln1_b, mlp_w1, mlp_w2, ln2_g, ln2_b):
    B, T, D = x.shape
    rows = T // GRID_W
    cos, sin = _axial_rope(rows)
    alpha = (2.0 * DEPTH) ** 0.25
    col_sizes = [GLA_COLS, MLA_COLS, RWKV_COLS, GATE_COLS]
    xc = ctx
    for l in range(DEPTH):
        need_ctx = l < DEPTH - 1
        mod = (jax.nn.silu(c) @ ada_w[l] + ada_b[l]).reshape(B, N_MOD, 1, D)
        modc = (jax.nn.silu(c_ctx) @ ada_w[l] + ada_b[l]).reshape(N_MOD, 1, D)
        z = modulate(x, mod[:, 0], mod[:, 1]) @ w_in[l]
        zc = modulate(xc, modc[0], modc[1]) @ w_in[l]
        za, zb, zr, zg = _split(z, col_sizes)
        zac, zbc, zrc, zgc = _split(zc, col_sizes)
        ya, yac = gla_branch(za, zac, gla_gk_up[l], gla_gk_b[l], gla_norm_g[l], need_ctx)
        yb, ybc = mla_branch(zb, zbc, mla_q_norm_g[l], mla_kv_norm_g[l], mla_w_uq[l], mla_w_ukv[l],
                             cos, sin, need_ctx)
        yr, yrc = rwkv_branch(zr, zrc, rwkv_shift_mu[l], rwkv_w0[l], rwkv_w_up[l], rwkv_a0[l],
                              rwkv_a_up[l], rwkv_g_up[l], rwkv_k_k[l], rwkv_k_a[l], rwkv_r_k[l],
                              rwkv_ln_g[l], rwkv_ln_b[l], need_ctx)
        x = layer_norm(alpha * x + mod[:, 2] * _merge(ya, yb, yr, zg, w_branch[l], w_out[l]),
                       ln1_g[l], ln1_b[l])
        x = layer_norm(alpha * x + mod[:, 5] * _mlp(modulate(x, mod[:, 3], mod[:, 4]), mlp_w1[l], mlp_w2[l]),
                       ln2_g[l], ln2_b[l])
        if need_ctx:
            xc = layer_norm(alpha * xc + modc[2] * _merge(yac, ybc, yrc, zgc, w_branch[l], w_out[l]),
                            ln1_g[l], ln1_b[l])
            xc = layer_norm(alpha * xc + modc[5] * _mlp(modulate(xc, modc[3], modc[4]), mlp_w1[l], mlp_w2[l]),
                            ln2_g[l], ln2_b[l])
    return x
```

```cpp
#include <hip/hip_runtime.h>
#include <hip/hip_cooperative_groups.h>
#include <cstdio>
#include <cstdint>
namespace cg = cooperative_groups;

typedef _Float16 h16;
typedef _Float16 h16x8 __attribute__((ext_vector_type(8)));
typedef _Float16 h16x4 __attribute__((ext_vector_type(4)));
typedef float f32x16 __attribute__((ext_vector_type(16)));
typedef float f32x4 __attribute__((ext_vector_type(4)));

#define DEVI __device__ __forceinline__
DEVI int threadIdx_x_raw() { return (int)__builtin_amdgcn_workitem_id_x(); }

constexpr int D = 1024, NB = 4, SEQ = 4096, CTX = 256, DEPTH = 4;
constexpr int SB = SEQ + CTX;
constexpr int NR = NB * SB;
constexpr int ZW = 4160;
constexpr int ZMLA = 1568, ZRW = 2240;
constexpr int NIN = 7232;
constexpr int DFF = 4096;
constexpr int LDS_BYTES = 74752;
constexpr int NSCAN_BPC = 2;
constexpr int NSCAN = 64 * NSCAN_BPC;
constexpr int NGLA = 128;
constexpr int TSTEPS = SB + 1;
constexpr int NCHUNK = (TSTEPS + 15) / 16;

struct P {
  const float *x, *c, *ctx, *c_ctx, *ada_w, *ada_b, *w_in, *gk_up, *gk_b, *gla_ng, *qn_g, *kvn_g, *w_uq, *w_ukv,
      *mu, *w0, *w_up, *a0, *a_up, *g_up, *k_k, *k_a, *r_k, *rln_g, *rln_b, *w_branch, *w_out, *ln1_g, *ln1_b,
      *w1, *w2, *ln2_g, *ln2_b;
  float *XL, *XC, *MOD, *ROPE, *INVN;
  unsigned* CTR;
  h16 *HLO, *HHI, *H, *Z, *WIN, *UQ, *UKV, *WB, *WO, *WUP, *AUP, *GUP, *LW, *AA, *G, *Y2, *Q, *K, *VT, *YA, *OFB, *W1T, *W2T, *M;
};

DEVI int tidx() { int t = threadIdx_x_raw(); asm volatile("" : "+v"(t)); return t; }
DEVI float wsum(float v) {
#pragma unroll
  for (int o = 32; o; o >>= 1) v += __shfl_xor(v, o);
  return v;
}
DEVI float sigm(float x) { return 1.f / (1.f + __expf(-x)); }
DEVI unsigned pk2(float a, float b) {
  auto h = __builtin_amdgcn_cvt_pkrtz(a, b);
  return __builtin_bit_cast(unsigned, h);
}
DEVI unsigned pk2n(float a, float b) {
  h16 x = (h16)a, y = (h16)b;
  unsigned short ux = __builtin_bit_cast(unsigned short, x), uy = __builtin_bit_cast(unsigned short, y);
  return (unsigned)ux | ((unsigned)uy << 16);
}
DEVI float h2f(unsigned short u) { return (float)__builtin_bit_cast(h16, u); }
DEVI void st4h(h16* dst, float a, float b, float c, float d) {
  uint2 u; u.x = pk2n(a, b); u.y = pk2n(c, d);
  *(uint2*)dst = u;
}
DEVI float* xrow(const P& p, int r) {
  int b = r / SB, s = r - b * SB;
  return s < CTX ? p.XC + (size_t)(b * CTX + s) * D : p.XL + (size_t)(b * SEQ + s - CTX) * D;
}
DEVI int maprow(int dir, int b, int n) {
  if (dir == 0) return b * SB + n;
  return n < CTX ? b * SB + (CTX - 1 - n) : b * SB + (SB + CTX - 1 - n);
}

DEVI void phase0(const P& p, char* smem) {
  const int tid = tidx();
  float* sc = (float*)smem;
  float* red = sc + 5 * 1024;
  for (int i = tid; i < 5 * 1024; i += 256) {
    int g = i >> 10, k = i & 1023;
    float v = g < 4 ? p.c[g * D + k] : p.c_ctx[k];
    sc[i] = v * sigm(v);
  }
  __syncthreads();
  for (int job = blockIdx.x; job < DEPTH * 96; job += gridDim.x) {
    int l = job / 96, n0 = (job % 96) * 64;
    int kq = tid >> 6, cc = tid & 63;
    const float* w = p.ada_w + ((size_t)l * D + kq * 256) * 6144 + n0 + cc;
    float a0 = 0, a1 = 0, a2 = 0, a3 = 0, a4 = 0;
#pragma unroll 8
    for (int k = 0; k < 256; ++k) {
      float wv = w[(size_t)k * 6144];
      int kk = kq * 256 + k;
      a0 += sc[kk] * wv; a1 += sc[1024 + kk] * wv; a2 += sc[2048 + kk] * wv; a3 += sc[3072 + kk] * wv; a4 += sc[4096 + kk] * wv;
    }
    red[(kq * 5 + 0) * 64 + cc] = a0; red[(kq * 5 + 1) * 64 + cc] = a1; red[(kq * 5 + 2) * 64 + cc] = a2;
    red[(kq * 5 + 3) * 64 + cc] = a3; red[(kq * 5 + 4) * 64 + cc] = a4;
    __syncthreads();
    for (int i = tid; i < 320; i += 256) {
      int g = i >> 6, c2 = i & 63;
      float s = red[(0 * 5 + g) * 64 + c2] + red[(1 * 5 + g) * 64 + c2] + red[(2 * 5 + g) * 64 + c2] + red[(3 * 5 + g) * 64 + c2];
      p.MOD[((size_t)l * 5 + g) * 6144 + n0 + c2] = s + p.ada_b[l * 6144 + n0 + c2];
    }
    __syncthreads();
  }
  for (int i = blockIdx.x * 256 + tid; i < SEQ * 16; i += gridDim.x * 256) {
    int s = i >> 4, j = i & 15;
    float pos = (float)(j < 8 ? (s >> 6) : (s & 63));
    float inv = exp2f(-(float)(j & 7) * (13.287712379549449f / 8.f));
    float ang = pos * inv;
    p.ROPE[s * 32 + j] = cosf(ang);
    p.ROPE[s * 32 + 16 + j] = sinf(ang);
  }
  if (blockIdx.x == 0 && tid < 64) p.CTR[tid] = 0;
}

struct CE { const float* src; h16* dst; const float* scale; int K, N; };
DEVI CE get_ce(const P& p, int l, int e) {
  CE c; c.scale = nullptr;
  switch (e) {
    case 0: c.src = p.w_in + (size_t)l * D * NIN; c.dst = p.WIN; c.K = D; c.N = NIN; break;
    case 1: c.src = p.w_uq + (size_t)l * 384 * 768; c.dst = p.UQ; c.K = 384; c.N = 768; c.scale = p.qn_g + l * 384; break;
    case 2: c.src = p.w_ukv + (size_t)l * 256 * 1024; c.dst = p.UKV; c.K = 256; c.N = 1024; c.scale = p.kvn_g + l * 256; break;
    case 3: case 4: case 5: c.src = p.w_branch + ((size_t)l * 3 + (e - 3)) * 512 * D; c.dst = p.WB + (size_t)(e - 3) * D * 512; c.K = 512; c.N = D; break;
    case 6: c.src = p.w_out + (size_t)l * D * D; c.dst = p.WO; c.K = D; c.N = D; break;
    case 7: case 8: c.src = p.w_up + ((size_t)l * 2 + (e - 7)) * 64 * 512; c.dst = p.WUP + (size_t)(e - 7) * 512 * 64; c.K = 64; c.N = 512; break;
    case 9: case 10: c.src = p.a_up + ((size_t)l * 2 + (e - 9)) * 64 * 512; c.dst = p.AUP + (size_t)(e - 9) * 512 * 64; c.K = 64; c.N = 512; break;
    case 11: c.src = p.g_up + (size_t)l * 128 * 512; c.dst = p.GUP; c.K = 128; c.N = 512; break;
    case 12: c.src = p.w1 + (size_t)l * D * DFF; c.dst = p.W1T; c.K = D; c.N = DFF; break;
    default: c.src = p.w2 + (size_t)l * DFF * D; c.dst = p.W2T; c.K = DFF; c.N = D; break;
  }
  return c;
}
DEVI void conv_tile(const CE& e, int tile, char* smem) {
  float* s = (float*)smem;
  const int tid = tidx();
  int ntn = e.N >> 6;
  int kt = tile / ntn, nt = tile - kt * ntn;
  {
    int r = tid >> 4, c4 = (tid & 15) * 4;
#pragma unroll
    for (int rr = 0; rr < 4; ++rr) {
      int k = r + 16 * rr;
      float4 v = *(const float4*)(e.src + (size_t)(kt * 64 + k) * e.N + nt * 64 + c4);
      float sc = e.scale ? e.scale[kt * 64 + k] : 1.f;
      s[k * 65 + c4 + 0] = v.x * sc; s[k * 65 + c4 + 1] = v.y * sc; s[k * 65 + c4 + 2] = v.z * sc; s[k * 65 + c4 + 3] = v.w * sc;
    }
  }
  __syncthreads();
  {
    int n = tid >> 2, kq = (tid & 3) * 16;
    uint4 u0, u1;
    u0.x = pk2n(s[(kq + 0) * 65 + n], s[(kq + 1) * 65 + n]); u0.y = pk2n(s[(kq + 2) * 65 + n], s[(kq + 3) * 65 + n]);
    u0.z = pk2n(s[(kq + 4) * 65 + n], s[(kq + 5) * 65 + n]); u0.w = pk2n(s[(kq + 6) * 65 + n], s[(kq + 7) * 65 + n]);
    u1.x = pk2n(s[(kq + 8) * 65 + n], s[(kq + 9) * 65 + n]); u1.y = pk2n(s[(kq + 10) * 65 + n], s[(kq + 11) * 65 + n]);
    u1.z = pk2n(s[(kq + 12) * 65 + n], s[(kq + 13) * 65 + n]); u1.w = pk2n(s[(kq + 14) * 65 + n], s[(kq + 15) * 65 + n]);
    h16* d = e.dst + (size_t)(nt * 64 + n) * e.K + kt * 64 + kq;
    *(uint4*)d = u0; *(uint4*)(d + 8) = u1;
  }
  __syncthreads();
}
DEVI void conv_phase(const P& p, int l, int e0, int e1, char* smem) {
  int total = 0;
  for (int e = e0; e < e1; ++e) { CE c = get_ce(p, l, e); total += (c.K >> 6) * (c.N >> 6); }
  for (int t = blockIdx.x; t < total; t += gridDim.x) {
    int tt = t;
    for (int e = e0; e < e1; ++e) {
      CE c = get_ce(p, l, e);
      int nt = (c.K >> 6) * (c.N >> 6);
      if (tt < nt) { conv_tile(c, tt, smem); break; }
      tt -= nt;
    }
  }
}

DEVI void ln_phase(const P& p, int l, int which) {
  const int lane = tidx() & 63;
  const int wid = blockIdx.x * 4 + (tidx() >> 6), nw = gridDim.x * 4;
  for (int r = wid; r < NR; r += nw) {
    int b = r / SB, s = r - b * SB;
    if (which == 2 && s < CTX) continue;
    int g = s < CTX ? 4 : b;
    float* xr = xrow(p, r);
    const float* src = xr;
    if (which == 0 && l == 0) src = s < CTX ? p.ctx + (size_t)(b * CTX + s) * D : p.x + (size_t)(b * SEQ + s - CTX) * D;
    float4 v[4];
#pragma unroll
    for (int i = 0; i < 4; ++i) v[i] = *(const float4*)(src + i * 256 + lane * 4);
    bool do_ln = !(which == 0 && l == 0);
    if (do_ln) {
      const float* gg = which == 1 ? p.ln1_g + l * D : p.ln2_g + (which == 2 ? 3 : l - 1) * D;
      const float* bb = which == 1 ? p.ln1_b + l * D : p.ln2_b + (which == 2 ? 3 : l - 1) * D;
      float sm = 0;
#pragma unroll
      for (int i = 0; i < 4; ++i) sm += v[i].x + v[i].y + v[i].z + v[i].w;
      float mean = wsum(sm) * (1.f / D);
      float sq = 0;
#pragma unroll
      for (int i = 0; i < 4; ++i) {
        v[i].x -= mean; v[i].y -= mean; v[i].z -= mean; v[i].w -= mean;
        sq += v[i].x * v[i].x + v[i].y * v[i].y + v[i].z * v[i].z + v[i].w * v[i].w;
      }
      float rs = rsqrtf(wsum(sq) * (1.f / D) + 1e-5f);
#pragma unroll
      for (int i = 0; i < 4; ++i) {
        float4 g4 = *(const float4*)(gg + i * 256 + lane * 4), b4 = *(const float4*)(bb + i * 256 + lane * 4);
        v[i].x = v[i].x * rs * g4.x + b4.x; v[i].y = v[i].y * rs * g4.y + b4.y;
        v[i].z = v[i].z * rs * g4.z + b4.z; v[i].w = v[i].w * rs * g4.w + b4.w;
      }
    }
#pragma unroll
    for (int i = 0; i < 4; ++i) *(float4*)(xr + i * 256 + lane * 4) = v[i];
    if (which == 2) continue;
    const float* shf = p.MOD + ((size_t)l * 5 + g) * 6144 + (which == 0 ? 0 : 3) * D;
    const float* scl = shf + D;
    float sm = 0;
#pragma unroll
    for (int i = 0; i < 4; ++i) sm += v[i].x + v[i].y + v[i].z + v[i].w;
    float mean = wsum(sm) * (1.f / D);
    float sq = 0;
#pragma unroll
    for (int i = 0; i < 4; ++i) {
      v[i].x -= mean; v[i].y -= mean; v[i].z -= mean; v[i].w -= mean;
      sq += v[i].x * v[i].x + v[i].y * v[i].y + v[i].z * v[i].z + v[i].w * v[i].w;
    }
    float rs = rsqrtf(wsum(sq) * (1.f / D) + 1e-6f);
    h16* hr = p.H + (size_t)r * D;
#pragma unroll
    for (int i = 0; i < 4; ++i) {
      float4 s4 = *(const float4*)(shf + i * 256 + lane * 4), c4 = *(const float4*)(scl + i * 256 + lane * 4);
      st4h(hr + i * 256 + lane * 4, v[i].x * rs * (1.f + c4.x) + s4.x, v[i].y * rs * (1.f + c4.y) + s4.y,
           v[i].z * rs * (1.f + c4.z) + s4.z, v[i].w * rs * (1.f + c4.w) + s4.w);
    }
  }
}

constexpr int GLD = 72;
template <bool ROWSQ, int NI = 2>
DEVI void gemm_main(const h16* __restrict__ A, int lda, const h16* __restrict__ Bt, int ldb, int K, int m0, int n0, int nmax,
                    char* smem, f32x16 (&acc)[2][NI], float* rowsq) {
  h16* As = (h16*)smem;
  h16* Bs = As + 2 * 128 * GLD;
  const int tid = tidx(), lane = tid & 63, wv = tid >> 6;
  const int wm = wv >> 1, wn = wv & 1, l31 = lane & 31, hh = lane >> 5;
  const int lrow = tid >> 3, lkc = (tid & 7) * 8;
  uint4 ga[4], gb[2 * NI];
  float sq[4] = {0.f, 0.f, 0.f, 0.f};
  const h16* Ap = A + (size_t)(m0 + lrow) * lda + lkc;
  const h16* Bp = Bt + (size_t)(n0 + lrow) * ldb + lkc;
#pragma unroll
  for (int i = 0; i < 4; ++i) ga[i] = *(const uint4*)(Ap + (size_t)(32 * i) * lda);
#pragma unroll
  for (int i = 0; i < 2 * NI; ++i)
    gb[i] = (n0 + lrow + 32 * i < nmax) ? *(const uint4*)(Bp + (size_t)(32 * i) * ldb) : make_uint4(0, 0, 0, 0);
  const int KT = K >> 6;
#pragma unroll
  for (int i = 0; i < 4; ++i) *(uint4*)(As + (lrow + 32 * i) * GLD + lkc) = ga[i];
#pragma unroll
  for (int i = 0; i < 2 * NI; ++i) *(uint4*)(Bs + (lrow + 32 * i) * GLD + lkc) = gb[i];
  __syncthreads();
  for (int kt = 0; kt < KT; ++kt) {
    const int buf = kt & 1;
    if (ROWSQ) {
#pragma unroll
      for (int i = 0; i < 4; ++i) {
        h16x8 hv = __builtin_bit_cast(h16x8, ga[i]);
#pragma unroll
        for (int j = 0; j < 8; ++j) { float f = (float)hv[j]; sq[i] += f * f; }
      }
    }
    if (kt + 1 < KT) {
#pragma unroll
      for (int i = 0; i < 4; ++i) ga[i] = *(const uint4*)(Ap + (size_t)(32 * i) * lda + (kt + 1) * 64);
#pragma unroll
      for (int i = 0; i < 2 * NI; ++i)
        gb[i] = (n0 + lrow + 32 * i < nmax) ? *(const uint4*)(Bp + (size_t)(32 * i) * ldb + (kt + 1) * 64) : make_uint4(0, 0, 0, 0);
    }
    const h16* as = As + buf * 128 * GLD + (wm * 64 + l31) * GLD + hh * 8;
    const h16* bs = Bs + buf * 128 * GLD + (wn * 32 * NI + l31) * GLD + hh * 8;
#pragma unroll
    for (int ks = 0; ks < 4; ++ks) {
      h16x8 a0 = *(const h16x8*)(as + ks * 16), a1 = *(const h16x8*)(as + 32 * GLD + ks * 16);
#pragma unroll
      for (int ni = 0; ni < NI; ++ni) {
        h16x8 b0 = *(const h16x8*)(bs + ni * 32 * GLD + ks * 16);
        acc[0][ni] = __builtin_amdgcn_mfma_f32_32x32x16_f16(b0, a0, acc[0][ni], 0, 0, 0);
        acc[1][ni] = __builtin_amdgcn_mfma_f32_32x32x16_f16(b0, a1, acc[1][ni], 0, 0, 0);
      }
    }
    if (kt + 1 < KT) {
      h16* ad = As + (buf ^ 1) * 128 * GLD;
      h16* bd = Bs + (buf ^ 1) * 128 * GLD;
#pragma unroll
      for (int i = 0; i < 4; ++i) *(uint4*)(ad + (lrow + 32 * i) * GLD + lkc) = ga[i];
#pragma unroll
      for (int i = 0; i < 2 * NI; ++i) *(uint4*)(bd + (lrow + 32 * i) * GLD + lkc) = gb[i];
    }
    __syncthreads();
  }
  if (ROWSQ) {
#pragma unroll
    for (int i = 0; i < 4; ++i) {
      float s = sq[i];
      s += __shfl_xor(s, 1); s += __shfl_xor(s, 2); s += __shfl_xor(s, 4);
      if ((tid & 7) == 0) rowsq[lrow + 32 * i] = s;
    }
    __syncthreads();
  }
}
DEVI void zero_acc(f32x16 (&acc)[2][2]) {
#pragma unroll
  for (int i = 0; i < 2; ++i)
#pragma unroll
    for (int j = 0; j < 2; ++j)
#pragma unroll
      for (int r = 0; r < 16; ++r) acc[i][j][r] = 0.f;
}
template <class F>
DEVI void epi_quads(const f32x16 (&acc)[2][2], int m0, int n0, F f) {
  const int lane = tidx() & 63, wv = tidx() >> 6;
  const int wm = wv >> 1, wn = wv & 1, l31 = lane & 31, hh = lane >> 5;
#pragma unroll
  for (int mi = 0; mi < 2; ++mi)
#pragma unroll
    for (int ni = 0; ni < 2; ++ni)
#pragma unroll
      for (int g = 0; g < 4; ++g)
        f(m0 + wm * 64 + mi * 32 + l31, n0 + wn * 64 + ni * 32 + 8 * g + 4 * hh, acc[mi][ni][4 * g], acc[mi][ni][4 * g + 1],
          acc[mi][ni][4 * g + 2], acc[mi][ni][4 * g + 3]);
}

DEVI void inproj_phase(const P& p, char* smem) {
  constexpr int MT = NR / 128, NT = (ZW + 127) / 128;
  for (int job = blockIdx.x; job < MT * NT; job += gridDim.x) {
    int nt = job / MT, mt = job - nt * MT;
    f32x16 acc[2][2]; zero_acc(acc);
    gemm_main<false>(p.H, D, p.WIN, D, D, mt * 128, nt * 128, ZW, smem, acc, nullptr);
    epi_quads(acc, mt * 128, nt * 128, [&](int m, int n, float v0, float v1, float v2, float v3) {
      if (n < ZW) {
        st4h(p.Z + (size_t)m * ZW + n, v0, v1, v2, v3);
        if (n >= ZRW) {
          if ((m & 63) == 0) st4h(p.HLO + (size_t)(m >> 6) * 1920 + n - ZRW, v0, v1, v2, v3);
          if ((m & 63) == 63) st4h(p.HHI + (size_t)(m >> 6) * 1920 + n - ZRW, v0, v1, v2, v3);
        }
      }
    });
  }
}

DEVI void shift_job(const P& p, int l, int j, char* smem) {
  h16* raw = (h16*)smem;
  const int tid = tidx(), lane = tid & 63;
  const int r0 = j * 64;
  const int s0 = r0 % SB;
  const bool first = (s0 == 0) || (s0 == CTX);
  const bool last = (s0 + 64 == CTX) || (s0 + 64 == SB);
  for (int slab = 0; slab < 8; ++slab) {
    const int c0 = slab * 256;
    const int ncols = slab == 7 ? 128 : 256;
    const int cpr = ncols >> 3;
    for (int c = tid; c < 66 * cpr; c += 256) {
      int row = c / cpr, ch = (c - row * cpr) * 8;
      uint4 v = make_uint4(0, 0, 0, 0);
      if (row == 0) { if (!first) v = *(const uint4*)(p.HHI + (size_t)(j - 1) * 1920 + c0 + ch); }
      else if (row == 65) { if (!last) v = *(const uint4*)(p.HLO + (size_t)(j + 1) * 1920 + c0 + ch); }
      else v = *(const uint4*)(p.Z + (size_t)(r0 + row - 1) * ZW + ZRW + c0 + ch);
      *(uint4*)(raw + row * 264 + ch) = v;
    }
    __syncthreads();
    if (tid < ncols) {
      const int col = c0 + tid;
      const float mup = p.mu[(size_t)l * 2 * 1920 + col], mun = p.mu[(size_t)l * 2 * 1920 + 1920 + col];
      const bool isk = (col >= 512 && col < 1024);
      const float kkp = isk ? p.k_k[l * 512 + col - 512] : 0.f;
      float prev = (float)raw[tid], cur = (float)raw[264 + tid];
      h16* zc = p.Z + (size_t)r0 * ZW + ZRW + col;
      for (int t = 0; t < 64; ++t) {
        float nxt = (float)raw[(t + 2) * 264 + tid];
        float o = cur + mup * (prev - cur) + mun * (nxt - cur);
        float ov = o;
        if (col >= 1536 && col < 1664) ov = tanhf(o);
        else if (col >= 1792) ov = sigm(o);
        zc[(size_t)t * ZW] = (h16)ov;
        if (isk) {
          float q = o * kkp;
          float ss = wsum(q * q);
          if (lane == 0) p.INVN[(size_t)(r0 + t) * 8 + ((col - 512) >> 6)] = rsqrtf(ss + 1e-12f);
        }
        prev = cur; cur = nxt;
      }
    }
    __syncthreads();
  }
}

DEVI void mla_up_job(const P& p, int job, char* smem) {
  constexpr int MT = NR / 128;
  float* rowsq = (float*)(smem + 2 * 2 * 128 * GLD * 2);
  const int tid = tidx();
  f32x16 acc[2][2]; zero_acc(acc);
  if (job < MT * 6) {
    int nt = job / MT, mt = job - nt * MT;
    gemm_main<true>(p.Z + ZMLA, ZW, p.UQ, 384, 384, mt * 128, nt * 128, 768, smem, acc, rowsq);
    const int m0 = mt * 128, n0 = nt * 128;
    const int lane = tid & 63, wv = tid >> 6, wm = wv >> 1, wn = wv & 1, l31 = lane & 31, hh = lane >> 5;
    const float qs = 0.10206207261596575f * 1.4426950408889634f;
#pragma unroll
    for (int mi = 0; mi < 2; ++mi) {
      const int ml = wm * 64 + mi * 32 + l31, m = m0 + ml;
      const float sc = rsqrtf(rowsq[ml] * (1.f / 384.f) + 1e-6f) * qs;
      const int sp = m % SB;
      const bool lat = sp >= CTX;
      const float* rp = p.ROPE + (size_t)(lat ? sp - CTX : 0) * 32;
#pragma unroll
      for (int ni = 0; ni < 2; ++ni) {
        const int nb = n0 + wn * 64 + ni * 32;
        h16* qd = p.Q + (size_t)m * 768 + nb;
        const bool ropet = (nb % 96) == 64;
        if (ropet && lat) {
#pragma unroll
          for (int g = 0; g < 2; ++g) {
            float o1[4], o2[4];
#pragma unroll
            for (int jj = 0; jj < 4; ++jj) {
              int i = 8 * g + 4 * hh + jj;
              float x1 = acc[mi][ni][4 * g + jj] * sc, x2 = acc[mi][ni][4 * (g + 2) + jj] * sc;
              float cs = rp[i], sn = rp[16 + i];
              o1[jj] = x1 * cs - x2 * sn; o2[jj] = x1 * sn + x2 * cs;
            }
            st4h(qd + 8 * g + 4 * hh, o1[0], o1[1], o1[2], o1[3]);
            st4h(qd + 16 + 8 * g + 4 * hh, o2[0], o2[1], o2[2], o2[3]);
          }
        } else {
#pragma unroll
          for (int g = 0; g < 4; ++g)
            st4h(qd + 8 * g + 4 * hh, acc[mi][ni][4 * g] * sc, acc[mi][ni][4 * g + 1] * sc, acc[mi][ni][4 * g + 2] * sc, acc[mi][ni][4 * g + 3] * sc);
        }
      }
    }
  } else {
    int j2 = job - MT * 6;
    int nt = j2 / MT, mt = j2 - nt * MT;
    gemm_main<true>(p.Z + ZMLA + 384, ZW, p.UKV, 256, 256, mt * 128, nt * 128, 1024, smem, acc, rowsq);
    const int m0 = mt * 128;
    epi_quads(acc, m0, 0, [&](int m, int n, float v0, float v1, float v2, float v3) {
      const float sc = rsqrtf(rowsq[m - m0] * (1.f / 256.f) + 1e-6f);
      if (n < 64) st4h(p.K + (size_t)m * 768 + nt * 96 + n, v0 * sc, v1 * sc, v2 * sc, v3 * sc);
      else {
        int b = m / SB, s = m - b * SB;
        h16* vt = p.VT + ((size_t)(b * 8 + nt) * 64 + (n - 64)) * SB + s;
        vt[0] = (h16)(v0 * sc); vt[SB] = (h16)(v1 * sc); vt[2 * SB] = (h16)(v2 * sc); vt[3 * SB] = (h16)(v3 * sc);
      }
    });
    {
      int row = tid >> 1, sub = tid & 1;
      int m = m0 + row;
      int sp = m % SB;
      const h16* kr = p.Z + (size_t)m * ZW + ZMLA + 640 + sub * 8;
      h16x8 x1 = *(const h16x8*)kr, x2 = *(const h16x8*)(kr + 16);
      h16* kd = p.K + (size_t)m * 768 + nt * 96 + 64 + sub * 8;
      if (sp >= CTX) {
        const float* rp = p.ROPE + (size_t)(sp - CTX) * 32 + sub * 8;
        h16x8 o1, o2;
#pragma unroll
        for (int i = 0; i < 8; ++i) {
          float a = (float)x1[i], b2 = (float)x2[i], cs = rp[i], sn = rp[16 + i];
          o1[i] = (h16)(a * cs - b2 * sn); o2[i] = (h16)(a * sn + b2 * cs);
        }
        *(h16x8*)kd = o1; *(h16x8*)(kd + 16) = o2;
      } else { *(h16x8*)kd = x1; *(h16x8*)(kd + 16) = x2; }
    }
  }
}

DEVI void lowrank_job(const P& p, int l, int job, char* smem) {
  constexpr int MT = NR / 128;
  int mat = job / (MT * 4), rem = job - mat * MT * 4;
  int nt = rem / MT, mt = rem - nt * MT;
  f32x16 acc[2][2]; zero_acc(acc);
  if (mat < 2) {
    const int dir = mat;
    gemm_main<false>(p.Z + ZRW + 1536 + dir * 64, ZW, p.WUP + (size_t)dir * 512 * 64, 64, 64, mt * 128, nt * 128, 512, smem, acc, nullptr);
    const float* w0 = p.w0 + ((size_t)l * 2 + dir) * 512;
    h16* dst = p.LW + (size_t)dir * NR * 512;
    epi_quads(acc, mt * 128, nt * 128, [&](int m, int n, float v0, float v1, float v2, float v3) {
      float4 b = *(const float4*)(w0 + n);
      const float e = 0.6065306597126334f;
      st4h(dst + (size_t)m * 512 + n, sigm(v0 + b.x) * e, sigm(v1 + b.y) * e, sigm(v2 + b.z) * e, sigm(v3 + b.w) * e);
    });
  } else if (mat < 4) {
    const int dir = mat - 2;
    gemm_main<false>(p.Z + ZRW + 1664 + dir * 64, ZW, p.AUP + (size_t)dir * 512 * 64, 64, 64, mt * 128, nt * 128, 512, smem, acc, nullptr);
    const float* a0 = p.a0 + ((size_t)l * 2 + dir) * 512;
    h16* dst = p.AA + (size_t)dir * NR * 512;
    epi_quads(acc, mt * 128, nt * 128, [&](int m, int n, float v0, float v1, float v2, float v3) {
      float4 b = *(const float4*)(a0 + n);
      st4h(dst + (size_t)m * 512 + n, sigm(v0 + b.x), sigm(v1 + b.y), sigm(v2 + b.z), sigm(v3 + b.w));
    });
  } else {
    gemm_main<false>(p.Z + ZRW + 1792, ZW, p.GUP, 128, 128, mt * 128, nt * 128, 512, smem, acc, nullptr);
    epi_quads(acc, mt * 128, nt * 128, [&](int m, int n, float v0, float v1, float v2, float v3) {
      st4h(p.G + (size_t)m * 512 + n, v0, v1, v2, v3);
    });
  }
}

DEVI void attn_job(const P& p, int job, char* smem) {
  h16* Ks = (h16*)smem;
  h16* Vs = Ks + 2 * 64 * 104;
  const int tid = tidx(), lane = tid & 63, wv = tid >> 6, l31 = lane & 31, hh = lane >> 5;
  int b, h, q0, nk;
  if (job < 1024) { b = job >> 8; h = (job >> 5) & 7; q0 = b * SB + CTX + (job & 31) * 128; nk = SB; }
  else { int j = job - 1024; b = j >> 4; h = (j >> 1) & 7; q0 = b * SB + (j & 1) * 128; nk = CTX; }
  const int NKT = nk >> 6;
  const h16* Kg = p.K + (size_t)(b * SB) * 768 + h * 96;
  const h16* Vg = p.VT + (size_t)(b * 8 + h) * 64 * SB;
  h16x8 qf[6];
  {
    const h16* qp = p.Q + (size_t)(q0 + wv * 32 + l31) * 768 + h * 96 + hh * 8;
#pragma unroll
    for (int ds = 0; ds < 6; ++ds) qf[ds] = *(const h16x8*)(qp + ds * 16);
  }
  uint4 gk[3], gv[2];
  int krow[3], kcol[3];
#pragma unroll
  for (int i = 0; i < 3; ++i) { int c = tid + 256 * i; krow[i] = c / 12; kcol[i] = (c - krow[i] * 12) * 8; }
  const int vrow = tid >> 3, vcol = (tid & 7) * 8;
#pragma unroll
  for (int i = 0; i < 3; ++i) gk[i] = *(const uint4*)(Kg + (size_t)krow[i] * 768 + kcol[i]);
#pragma unroll
  for (int i = 0; i < 2; ++i) gv[i] = *(const uint4*)(Vg + (size_t)(vrow + 32 * i) * SB + vcol);
#pragma unroll
  for (int i = 0; i < 3; ++i) *(uint4*)(Ks + krow[i] * 104 + kcol[i]) = gk[i];
#pragma unroll
  for (int i = 0; i < 2; ++i) *(uint4*)(Vs + (vrow + 32 * i) * 72 + vcol) = gv[i];
  __syncthreads();
  f32x16 o0, o1;
#pragma unroll
  for (int r = 0; r < 16; ++r) { o0[r] = 0.f; o1[r] = 0.f; }
  float mrun = -1e30f, lsum = 0.f;
  for (int kt = 0; kt < NKT; ++kt) {
    const int buf = kt & 1;
    if (kt + 1 < NKT) {
#pragma unroll
      for (int i = 0; i < 3; ++i) gk[i] = *(const uint4*)(Kg + (size_t)((kt + 1) * 64 + krow[i]) * 768 + kcol[i]);
#pragma unroll
      for (int i = 0; i < 2; ++i) gv[i] = *(const uint4*)(Vg + (size_t)(vrow + 32 * i) * SB + (kt + 1) * 64 + vcol);
    }
    const h16* ks = Ks + buf * 64 * 104 + l31 * 104 + hh * 8;
    f32x16 s0, s1;
#pragma unroll
    for (int r = 0; r < 16; ++r) { s0[r] = 0.f; s1[r] = 0.f; }
#pragma unroll
    for (int ds = 0; ds < 6; ++ds) {
      h16x8 a0 = *(const h16x8*)(ks + ds * 16), a1 = *(const h16x8*)(ks + 32 * 104 + ds * 16);
      s0 = __builtin_amdgcn_mfma_f32_32x32x16_f16(a0, qf[ds], s0, 0, 0, 0);
      s1 = __builtin_amdgcn_mfma_f32_32x32x16_f16(a1, qf[ds], s1, 0, 0, 0);
    }
    float mx = s0[0];
#pragma unroll
    for (int r = 1; r < 16; ++r) mx = fmaxf(mx, s0[r]);
#pragma unroll
    for (int r = 0; r < 16; ++r) mx = fmaxf(mx, s1[r]);
    mx = fmaxf(mx, __shfl_xor(mx, 32));
    const float mnew = fmaxf(mrun, mx);
    const float alpha = __builtin_amdgcn_exp2f(mrun - mnew);
    mrun = mnew;
    float ps = 0.f;
#pragma unroll
    for (int r = 0; r < 16; ++r) { s0[r] = __builtin_amdgcn_exp2f(s0[r] - mnew); ps += s0[r]; }
#pragma unroll
    for (int r = 0; r < 16; ++r) { s1[r] = __builtin_amdgcn_exp2f(s1[r] - mnew); ps += s1[r]; }
    lsum = lsum * alpha + ps;
#pragma unroll
    for (int r = 0; r < 16; ++r) { o0[r] *= alpha; o1[r] *= alpha; }
    const h16* vs = Vs + buf * 64 * 72 + l31 * 72 + 4 * hh;
#pragma unroll
    for (int k2 = 0; k2 < 2; ++k2) {
#pragma unroll
      for (int s2 = 0; s2 < 2; ++s2) {
        uint4 pu;
        if (k2 == 0) { pu.x = pk2(s0[8 * s2], s0[8 * s2 + 1]); pu.y = pk2(s0[8 * s2 + 2], s0[8 * s2 + 3]); pu.z = pk2(s0[8 * s2 + 4], s0[8 * s2 + 5]); pu.w = pk2(s0[8 * s2 + 6], s0[8 * s2 + 7]); }
        else { pu.x = pk2(s1[8 * s2], s1[8 * s2 + 1]); pu.y = pk2(s1[8 * s2 + 2], s1[8 * s2 + 3]); pu.z = pk2(s1[8 * s2 + 4], s1[8 * s2 + 5]); pu.w = pk2(s1[8 * s2 + 6], s1[8 * s2 + 7]); }
        h16x8 pf = __builtin_bit_cast(h16x8, pu);
        const int kb = k2 * 32 + 16 * s2;
        uint2 va = *(const uint2*)(vs + kb), vb = *(const uint2*)(vs + kb + 8);
        uint2 vc = *(const uint2*)(vs + 32 * 72 + kb), vd = *(const uint2*)(vs + 32 * 72 + kb + 8);
        h16x8 vf0 = __builtin_bit_cast(h16x8, make_uint4(va.x, va.y, vb.x, vb.y));
        h16x8 vf1 = __builtin_bit_cast(h16x8, make_uint4(vc.x, vc.y, vd.x, vd.y));
        o0 = __builtin_amdgcn_mfma_f32_32x32x16_f16(vf0, pf, o0, 0, 0, 0);
        o1 = __builtin_amdgcn_mfma_f32_32x32x16_f16(vf1, pf, o1, 0, 0, 0);
      }
    }
    if (kt + 1 < NKT) {
      h16* kd = Ks + (buf ^ 1) * 64 * 104;
      h16* vd = Vs + (buf ^ 1) * 64 * 72;
#pragma unroll
      for (int i = 0; i < 3; ++i) *(uint4*)(kd + krow[i] * 104 + kcol[i]) = gk[i];
#pragma unroll
      for (int i = 0; i < 2; ++i) *(uint4*)(vd + (vrow + 32 * i) * 72 + vcol) = gv[i];
    }
    __syncthreads();
  }
  const float ltot = lsum + __shfl_xor(lsum, 32);
  const float inv = 1.f / ltot;
  h16* yo = p.Z + (size_t)(q0 + wv * 32 + l31) * ZW + ZMLA + h * 64 + 4 * hh;
#pragma unroll
  for (int g = 0; g < 4; ++g) {
    st4h(yo + 8 * g, o0[4 * g] * inv, o0[4 * g + 1] * inv, o0[4 * g + 2] * inv, o0[4 * g + 3] * inv);
    st4h(yo + 32 + 8 * g, o1[4 * g] * inv, o1[4 * g + 1] * inv, o1[4 * g + 2] * inv, o1[4 * g + 3] * inv);
  }
}

struct Slot { float w[64], bb[64], ke[64], vv[64]; h16 ah[4][64]; };
DEVI void scan_job(const P& p, int l, int job, char* smem) {
  constexpr int RGB = 4 / NSCAN_BPC;
  Slot* sl = (Slot*)smem;
  const int tid = tidx(), lane = tid & 63, wv = tid >> 6;
  const int chain = job / NSCAN_BPC, part = job - chain * NSCAN_BPC;
  const int dir = chain >> 5, b = (chain >> 3) & 3, h = chain & 7;
  for (int i = tid; i < 32 * 128; i += 256) { int s = i >> 7, e = i & 127; sl[s].ah[2 + (e >> 6)][e & 63] = (h16)0.f; }
  const int st = tid >> 4, c4 = (tid & 15) * 4;
  const float4 kk4 = *(const float4*)(p.k_k + l * 512 + h * 64 + c4);
  const float4 ka4 = *(const float4*)(p.k_a + l * 512 + h * 64 + c4);
  const h16* LWd = p.LW + (size_t)dir * NR * 512 + h * 64 + c4;
  const h16* AAd = p.AA + (size_t)dir * NR * 512 + h * 64 + c4;
  const h16* Zr = p.Z + ZRW + h * 64 + c4;
  uint2 g_lw, g_a, g_k, g_v, g_r; float g_in;
  auto gload = [&](int ci) {
    int n = ci * 16 + st;
    g_lw = make_uint2(0, 0); g_a = make_uint2(0, 0); g_k = make_uint2(0, 0); g_v = make_uint2(0, 0); g_r = make_uint2(0, 0); g_in = 0.f;
    if (n < SB) {
      int row = maprow(dir, b, n);
      g_lw = *(const uint2*)(LWd + (size_t)row * 512);
      g_a = *(const uint2*)(AAd + (size_t)row * 512);
      g_k = *(const uint2*)(Zr + (size_t)row * ZW + 512);
      g_v = *(const uint2*)(Zr + (size_t)row * ZW + 1024);
      g_in = p.INVN[(size_t)row * 8 + h];
    }
    if (n >= 1 && n <= SB) {
      int row = maprow(dir, b, n - 1);
      g_r = *(const uint2*)(Zr + (size_t)row * ZW);
    }
  };
  auto gstore = [&](int buf) {
    Slot& s = sl[buf * 16 + st];
    h16x4 lw = __builtin_bit_cast(h16x4, g_lw), a = __builtin_bit_cast(h16x4, g_a), k = __builtin_bit_cast(h16x4, g_k), v = __builtin_bit_cast(h16x4, g_v);
    const float kkp[4] = {kk4.x, kk4.y, kk4.z, kk4.w}, kap[4] = {ka4.x, ka4.y, ka4.z, ka4.w};
    float w4[4], b4[4], e4[4], v4[4], q4[4];
#pragma unroll
    for (int i = 0; i < 4; ++i) {
      float kf = (float)k[i], af = (float)a[i];
      float kkv = kf * kkp[i] * g_in;
      w4[i] = __expf(-(float)lw[i]);
      b4[i] = kkv * af;
      e4[i] = kf * (1.f + (af - 1.f) * kap[i]);
      v4[i] = (float)v[i];
      q4[i] = kkv;
    }
    *(float4*)(s.w + c4) = make_float4(w4[0], w4[1], w4[2], w4[3]);
    *(float4*)(s.bb + c4) = make_float4(b4[0], b4[1], b4[2], b4[3]);
    *(float4*)(s.ke + c4) = make_float4(e4[0], e4[1], e4[2], e4[3]);
    *(float4*)(s.vv + c4) = make_float4(v4[0], v4[1], v4[2], v4[3]);
    uint2 u; u.x = pk2n(q4[0], q4[1]); u.y = pk2n(q4[2], q4[3]);
    *(uint2*)(&s.ah[0][c4]) = u;
    *(uint2*)(&s.ah[1][c4]) = g_r;
  };
  gload(0);
  gstore(0);
  __syncthreads();
  const int c = lane & 15, hq = lane >> 4;
  const int rg = part * RGB + wv;
  float S[16];
#pragma unroll
  for (int i = 0; i < 16; ++i) S[i] = 0.f;
  uint4 sh0 = make_uint4(0, 0, 0, 0), sh1 = make_uint4(0, 0, 0, 0);
  h16* ybase = p.Y2 + (size_t)dir * NR * 512 + h * 64 + rg * 16 + c;
  for (int ci = 0; ci < NCHUNK; ++ci) {
    const int buf = ci & 1;
    if (ci + 1 < NCHUNK) gload(ci + 1);
    if (wv < RGB) {
#pragma unroll 4
      for (int s = 0; s < 16; ++s) {
        const Slot& t = sl[buf * 16 + s];
        h16x8 A0 = *(const h16x8*)(&t.ah[c & 3][8 * hq]);
        h16x8 A1 = *(const h16x8*)(&t.ah[c & 3][32 + 8 * hq]);
        f32x4 acc = {0.f, 0.f, 0.f, 0.f};
        acc = __builtin_amdgcn_mfma_f32_16x16x32_f16(A0, __builtin_bit_cast(h16x8, sh0), acc, 0, 0, 0);
        acc = __builtin_amdgcn_mfma_f32_16x16x32_f16(A1, __builtin_bit_cast(h16x8, sh1), acc, 0, 0, 0);
        const int n = ci * 16 + s;
        if (lane < 16 && n >= 1 && n <= SB) ybase[(size_t)maprow(dir, b, n - 1) * 512] = (h16)acc[1];
        const float sa = -acc[0];
        const float vv = t.vv[rg * 16 + c];
        float4 wa = *(const float4*)(t.w + 8 * hq), wb = *(const float4*)(t.w + 8 * hq + 4), wc = *(const float4*)(t.w + 32 + 8 * hq), wd = *(const float4*)(t.w + 36 + 8 * hq);
        float4 ba = *(const float4*)(t.bb + 8 * hq), bb = *(const float4*)(t.bb + 8 * hq + 4), bc = *(const float4*)(t.bb + 32 + 8 * hq), bd = *(const float4*)(t.bb + 36 + 8 * hq);
        float4 ea = *(const float4*)(t.ke + 8 * hq), eb = *(const float4*)(t.ke + 8 * hq + 4), ec = *(const float4*)(t.ke + 32 + 8 * hq), ed = *(const float4*)(t.ke + 36 + 8 * hq);
        const float W[16] = {wa.x, wa.y, wa.z, wa.w, wb.x, wb.y, wb.z, wb.w, wc.x, wc.y, wc.z, wc.w, wd.x, wd.y, wd.z, wd.w};
        const float Bv[16] = {ba.x, ba.y, ba.z, ba.w, bb.x, bb.y, bb.z, bb.w, bc.x, bc.y, bc.z, bc.w, bd.x, bd.y, bd.z, bd.w};
        const float E[16] = {ea.x, ea.y, ea.z, ea.w, eb.x, eb.y, eb.z, eb.w, ec.x, ec.y, ec.z, ec.w, ed.x, ed.y, ed.z, ed.w};
#pragma unroll
        for (int i = 0; i < 16; ++i) S[i] = S[i] * W[i] + vv * E[i] + sa * Bv[i];
        sh0.x = pk2(S[0], S[1]); sh0.y = pk2(S[2], S[3]); sh0.z = pk2(S[4], S[5]); sh0.w = pk2(S[6], S[7]);
        sh1.x = pk2(S[8], S[9]); sh1.y = pk2(S[10], S[11]); sh1.z = pk2(S[12], S[13]); sh1.w = pk2(S[14], S[15]);
      }
    }
    if (ci + 1 < NCHUNK) gstore(buf ^ 1);
    __syncthreads();
  }
}

DEVI void gla_job(const P& p, int l, int job, char* smem) {
  float* qi = (float*)smem;
  float* ki = qi + 64 * 65;
  float* att = ki + 64 * 65;
  float* vs = att + 64 * 65;
  float* Ss = vs + 64 * 33;
  float* gku = Ss + 64 * 33;
  float* gkb = gku + 1024;
  float* tot = gkb + 64;
  const int tid = tidx();
  const int dvs = job & 3, chain = job >> 2;
  const int dir = chain >> 4, b = (chain >> 2) & 3, h = chain & 3;
  for (int i = tid; i < 64 * 33; i += 256) Ss[i] = 0.f;
  for (int i = tid; i < 1024; i += 256) gku[i] = p.gk_up[(((size_t)l * 2 + dir) * 16 + (i >> 6)) * 256 + h * 64 + (i & 63)];
  if (tid < 64) gkb[tid] = p.gk_b[((size_t)l * 2 + dir) * 256 + h * 64 + tid];
  __syncthreads();
  const int ri = tid >> 2, dq = tid & 3;
  h16* Od = p.OFB + (size_t)dir * NR * 512 + h * 128 + dvs * 32;
  for (int ci = 0; ci < SB / 64; ++ci) {
    uint4 q0, q1, k0, k1;
    {
      const int row = maprow(dir, b, ci * 64 + ri);
      const h16* zr = p.Z + (size_t)row * ZW;
      q0 = *(const uint4*)(zr + h * 64 + dq * 16); q1 = *(const uint4*)(zr + h * 64 + dq * 16 + 8);
      k0 = *(const uint4*)(zr + 256 + h * 64 + dq * 16); k1 = *(const uint4*)(zr + 256 + h * 64 + dq * 16 + 8);
      uint4 g0 = *(const uint4*)(zr + 1024 + dir * 16), g1 = *(const uint4*)(zr + 1024 + dir * 16 + 8);
      uint4 vv = *(const uint4*)(zr + 512 + h * 128 + dvs * 32 + dq * 8);
      h16x8 gh0 = __builtin_bit_cast(h16x8, g0), gh1 = __builtin_bit_cast(h16x8, g1), vh = __builtin_bit_cast(h16x8, vv);
#pragma unroll
      for (int j = 0; j < 8; ++j) vs[ri * 33 + dq * 8 + j] = (float)vh[j];
      float gd[16];
#pragma unroll
      for (int j = 0; j < 8; ++j) { gd[j] = (float)gh0[j]; gd[8 + j] = (float)gh1[j]; }
#pragma unroll 4
      for (int dd = 0; dd < 16; ++dd) {
        const int d = dq * 16 + dd;
        float xx = gkb[d];
#pragma unroll
        for (int r = 0; r < 16; ++r) xx += gd[r] * gku[r * 64 + d];
        float ls = fminf(xx, 0.f) - log1pf(__expf(-fabsf(xx)));
        att[ri * 65 + d] = ls * (1.f / 16.f);
      }
    }
    __syncthreads();
    {
      const int d = tid & 63, part = tid >> 6;
      float run = 0.f;
#pragma unroll 4
      for (int ii = 0; ii < 16; ++ii) { const int i = part * 16 + ii; run += att[i * 65 + d]; att[i * 65 + d] = run; }
      tot[part * 64 + d] = run;
    }
    __syncthreads();
    {
      h16x8 qh0 = __builtin_bit_cast(h16x8, q0), qh1 = __builtin_bit_cast(h16x8, q1), kh0 = __builtin_bit_cast(h16x8, k0), kh1 = __builtin_bit_cast(h16x8, k1);
      const int part = ri >> 4;
#pragma unroll
      for (int dd = 0; dd < 16; ++dd) {
        const int d = dq * 16 + dd;
        float off = 0.f;
        if (part > 0) off += tot[d];
        if (part > 1) off += tot[64 + d];
        if (part > 2) off += tot[128 + d];
        const float bb = att[ri * 65 + d] + off;
        const float qv = dd < 8 ? (float)qh0[dd & 7] : (float)qh1[dd & 7];
        const float kv = dd < 8 ? (float)kh0[dd & 7] : (float)kh1[dd & 7];
        qi[ri * 65 + d] = qv * __expf(bb) * 0.125f;
        ki[ri * 65 + d] = kv * __expf(-bb);
      }
    }
    __syncthreads();
    {
      const int ti = tid >> 4, tj = tid & 15;
      float a[4][4];
#pragma unroll
      for (int x = 0; x < 4; ++x)
#pragma unroll
        for (int y = 0; y < 4; ++y) a[x][y] = 0.f;
      if (tj <= ti) {
#pragma unroll 2
        for (int d = 0; d < 64; ++d) {
          float qa[4], kb[4];
#pragma unroll
          for (int x = 0; x < 4; ++x) { qa[x] = qi[(4 * ti + x) * 65 + d]; kb[x] = ki[(4 * tj + x) * 65 + d]; }
#pragma unroll
          for (int x = 0; x < 4; ++x)
#pragma unroll
            for (int y = 0; y < 4; ++y) a[x][y] += qa[x] * kb[y];
        }
      }
#pragma unroll
      for (int x = 0; x < 4; ++x)
#pragma unroll
        for (int y = 0; y < 4; ++y) att[(4 * ti + x) * 65 + 4 * tj + y] = (4 * tj + y <= 4 * ti + x) ? a[x][y] : 0.f;
    }
    __syncthreads();
    const int t2 = tid >> 3, tj = tid & 7;
    {
      float a0[4] = {0.f, 0.f, 0.f, 0.f}, a1[4] = {0.f, 0.f, 0.f, 0.f};
      const int smax = 2 * t2 + 1;
#pragma unroll 2
      for (int s = 0; s <= smax; ++s) {
        const float x0 = att[(2 * t2) * 65 + s], x1 = att[(2 * t2 + 1) * 65 + s];
#pragma unroll
        for (int y = 0; y < 4; ++y) { const float v = vs[s * 33 + 4 * tj + y]; a0[y] += x0 * v; a1[y] += x1 * v; }
      }
#pragma unroll 4
      for (int d = 0; d < 64; ++d) {
        const float x0 = qi[(2 * t2) * 65 + d], x1 = qi[(2 * t2 + 1) * 65 + d];
#pragma unroll
        for (int y = 0; y < 4; ++y) { const float v = Ss[d * 33 + 4 * tj + y]; a0[y] += x0 * v; a1[y] += x1 * v; }
      }
      const int rowa = maprow(dir, b, ci * 64 + 2 * t2), rowb = maprow(dir, b, ci * 64 + 2 * t2 + 1);
      st4h(Od + (size_t)rowa * 512 + 4 * tj, a0[0], a0[1], a0[2], a0[3]);
      st4h(Od + (size_t)rowb * 512 + 4 * tj, a1[0], a1[1], a1[2], a1[3]);
    }
    __syncthreads();
    {
      float a0[4], a1[4];
#pragma unroll
      for (int y = 0; y < 4; ++y) { a0[y] = Ss[(2 * t2) * 33 + 4 * tj + y]; a1[y] = Ss[(2 * t2 + 1) * 33 + 4 * tj + y]; }
#pragma unroll 4
      for (int s = 0; s < 64; ++s) {
        const float x0 = ki[s * 65 + 2 * t2], x1 = ki[s * 65 + 2 * t2 + 1];
#pragma unroll
        for (int y = 0; y < 4; ++y) { const float v = vs[s * 33 + 4 * tj + y]; a0[y] += x0 * v; a1[y] += x1 * v; }
      }
      const float e0 = __expf(tot[2 * t2] + tot[64 + 2 * t2] + tot[128 + 2 * t2] + tot[192 + 2 * t2]);
      const float e1 = __expf(tot[2 * t2 + 1] + tot[64 + 2 * t2 + 1] + tot[128 + 2 * t2 + 1] + tot[192 + 2 * t2 + 1]);
#pragma unroll
      for (int y = 0; y < 4; ++y) { Ss[(2 * t2) * 33 + 4 * tj + y] = a0[y] * e0; Ss[(2 * t2 + 1) * 33 + 4 * tj + y] = a1[y] * e1; }
    }
    __syncthreads();
  }
}

DEVI void mixer_phase(const P& p, int l, char* smem) {
  __shared__ int sjob;
  for (int j = blockIdx.x; j < NSCAN + NGLA; j += gridDim.x) {
    if (j < NSCAN) scan_job(p, l, j, smem);
    else gla_job(p, l, j - NSCAN, smem);
    __syncthreads();
  }
  const int njobs = (l < DEPTH - 1) ? 1024 + 64 : 1024;
  while (true) {
    if (tidx() == 0) sjob = (int)atomicAdd(p.CTR + l, 1u);
    __syncthreads();
    const int j = sjob;
    __syncthreads();
    if (j >= njobs) break;
    attn_job(p, j, smem);
  }
}

DEVI void post_phase(const P& p, int l) {
  const int lane = tidx() & 63;
  const int wid = blockIdx.x * 4 + (tidx() >> 6), nw = gridDim.x * 4;
  const int c8 = lane * 8;
  for (int r = wid; r < NR; r += nw) {
    {
      h16* zr = p.Z + (size_t)r * ZW + ZRW + c8;
      h16x8 yf = *(const h16x8*)(p.Y2 + (size_t)r * 512 + c8), yb = *(const h16x8*)(p.Y2 + (size_t)(NR + r) * 512 + c8);
      h16x8 rr = *(const h16x8*)zr, kk = *(const h16x8*)(zr + 512), vv = *(const h16x8*)(zr + 1024);
      h16x8 af = *(const h16x8*)(p.AA + (size_t)r * 512 + c8), ab = *(const h16x8*)(p.AA + (size_t)(NR + r) * 512 + c8);
      h16x8 gg = *(const h16x8*)(p.G + (size_t)r * 512 + c8);
      float y[8], sm = 0.f;
#pragma unroll
      for (int i = 0; i < 8; ++i) { y[i] = (float)yf[i] + (float)yb[i]; sm += y[i]; }
      sm += __shfl_xor(sm, 1); sm += __shfl_xor(sm, 2); sm += __shfl_xor(sm, 4);
      const float mean = sm * (1.f / 64.f);
      float sq = 0.f;
#pragma unroll
      for (int i = 0; i < 8; ++i) { y[i] -= mean; sq += y[i] * y[i]; }
      sq += __shfl_xor(sq, 1); sq += __shfl_xor(sq, 2); sq += __shfl_xor(sq, 4);
      const float rs = rsqrtf(sq * (1.f / 64.f) + 64e-5f);
      const float* ka = p.k_a + l * 512 + c8; const float* rk = p.r_k + l * 512 + c8;
      const float* lg = p.rln_g + l * 512 + c8; const float* lb = p.rln_b + l * 512 + c8;
      float bs = 0.f;
#pragma unroll
      for (int i = 0; i < 8; ++i) {
        const float kf = (float)kk[i], kav = ka[i];
        const float ke = kf * (1.f + ((float)af[i] - 1.f) * kav) + kf * (1.f + ((float)ab[i] - 1.f) * kav);
        bs += (float)rr[i] * ke * rk[i];
      }
      bs += __shfl_xor(bs, 1); bs += __shfl_xor(bs, 2); bs += __shfl_xor(bs, 4);
      float o[8];
#pragma unroll
      for (int i = 0; i < 8; ++i) o[i] = (y[i] * rs * lg[i] + lb[i] + bs * (float)vv[i]) * (float)gg[i];
      uint4 u; u.x = pk2n(o[0], o[1]); u.y = pk2n(o[2], o[3]); u.z = pk2n(o[4], o[5]); u.w = pk2n(o[6], o[7]);
      *(uint4*)zr = u;
    }
    {
      h16x8 of = *(const h16x8*)(p.OFB + (size_t)r * 512 + c8), ob = *(const h16x8*)(p.OFB + (size_t)(NR + r) * 512 + c8);
      h16x8 og = *(const h16x8*)(p.Z + (size_t)r * ZW + 1056 + c8);
      float o[8], sq = 0.f;
#pragma unroll
      for (int i = 0; i < 8; ++i) { o[i] = (float)of[i] + (float)ob[i]; sq += o[i] * o[i]; }
      sq += __shfl_xor(sq, 1); sq += __shfl_xor(sq, 2); sq += __shfl_xor(sq, 4); sq += __shfl_xor(sq, 8);
      const float rs = rsqrtf(sq * (1.f / 128.f) + 1e-6f);
      const float* ng = p.gla_ng + l * 128 + (c8 & 127);
#pragma unroll
      for (int i = 0; i < 8; ++i) { const float g = (float)og[i]; o[i] = o[i] * rs * ng[i] * (g * sigm(g)); }
      uint4 u; u.x = pk2n(o[0], o[1]); u.y = pk2n(o[2], o[3]); u.z = pk2n(o[4], o[5]); u.w = pk2n(o[6], o[7]);
      *(uint4*)(p.YA + (size_t)r * 512 + c8) = u;
    }
  }
}

DEVI void merge_phase(const P& p, char* smem) {
  constexpr int MT = NR / 128, NT = 16;
  const int lane = tidx() & 63, wv = tidx() >> 6;
  const int wm = wv >> 1, wn = wv & 1, l31 = lane & 31, hh = lane >> 5;
  for (int job = blockIdx.x; job < MT * NT; job += gridDim.x) {
    int nt = job / MT, mt = job - nt * MT;
    float out[2][16];
#pragma unroll
    for (int a = 0; a < 2; ++a)
#pragma unroll
      for (int r = 0; r < 16; ++r) out[a][r] = 0.f;
#pragma unroll 1
    for (int br = 0; br < 3; ++br) {
      const h16* Y = br == 0 ? p.YA : (br == 1 ? p.Z + ZMLA : p.Z + ZRW);
      const int ldy = br == 0 ? 512 : ZW;
      f32x16 acc[2][1];
#pragma unroll
      for (int a = 0; a < 2; ++a)
#pragma unroll
        for (int r = 0; r < 16; ++r) acc[a][0][r] = 0.f;
      gemm_main<false, 1>(Y, ldy, p.WB + (size_t)br * D * 512, 512, 512, mt * 128, nt * 64, D, smem, acc, nullptr);
      float u[2][16];
#pragma unroll
      for (int a = 0; a < 2; ++a)
#pragma unroll
        for (int r = 0; r < 16; ++r) { u[a][r] = acc[a][0][r]; acc[a][0][r] = 0.f; }
      gemm_main<false, 1>(p.H, D, p.WIN + (size_t)(ZW + br * D) * D, D, D, mt * 128, nt * 64, D, smem, acc, nullptr);
#pragma unroll
      for (int a = 0; a < 2; ++a)
#pragma unroll
        for (int r = 0; r < 16; ++r) out[a][r] += sigm(acc[a][0][r]) * u[a][r];
    }
#pragma unroll
    for (int a = 0; a < 2; ++a)
#pragma unroll
      for (int g = 0; g < 4; ++g)
        st4h(p.M + (size_t)(mt * 128 + wm * 64 + a * 32 + l31) * D + nt * 64 + wn * 32 + 8 * g + 4 * hh, out[a][4 * g], out[a][4 * g + 1],
             out[a][4 * g + 2], out[a][4 * g + 3]);
  }
}

DEVI void resid_gemm_phase(const P& p, int l, const h16* A, int K, const h16* Bt, int gate_idx, char* smem) {
  constexpr int MT = NR / 128, NT = 8;
  const float alpha = 1.6817928305074290f;
  for (int job = blockIdx.x; job < MT * NT; job += gridDim.x) {
    int nt = job / MT, mt = job - nt * MT;
    f32x16 acc[2][2]; zero_acc(acc);
    gemm_main<false>(A, K, Bt, K, K, mt * 128, nt * 128, D, smem, acc, nullptr);
    epi_quads(acc, mt * 128, nt * 128, [&](int m, int n, float v0, float v1, float v2, float v3) {
      int b = m / SB, s = m - b * SB;
      int g = s < CTX ? 4 : b;
      float4 gt = *(const float4*)(p.MOD + ((size_t)l * 5 + g) * 6144 + gate_idx * D + n);
      float* xp = xrow(p, m) + n;
      float4 xv = *(float4*)xp;
      xv.x = alpha * xv.x + gt.x * v0; xv.y = alpha * xv.y + gt.y * v1; xv.z = alpha * xv.z + gt.z * v2; xv.w = alpha * xv.w + gt.w * v3;
      *(float4*)xp = xv;
    });
  }
}
DEVI void mlp1_phase(const P& p, char* smem) {
  constexpr int MT = NR / 128, NT = DFF / 128;
  h16* HID = p.Z;
  for (int job = blockIdx.x; job < MT * NT; job += gridDim.x) {
    int nt = job / MT, mt = job - nt * MT;
    f32x16 acc[2][2]; zero_acc(acc);
    gemm_main<false>(p.H, D, p.W1T, D, D, mt * 128, nt * 128, DFF, smem, acc, nullptr);
    epi_quads(acc, mt * 128, nt * 128, [&](int m, int n, float v0, float v1, float v2, float v3) {
      v0 = fmaxf(v0, 0.f); v1 = fmaxf(v1, 0.f); v2 = fmaxf(v2, 0.f); v3 = fmaxf(v3, 0.f);
      st4h(HID + (size_t)m * DFF + n, v0 * v0, v1 * v1, v2 * v2, v3 * v3);
    });
  }
}

constexpr int PH_PER_LAYER = 11;
constexpr int NPHASES = 1 + DEPTH * PH_PER_LAYER + 1;

DEVI void run_phase(const P& p, int ph, char* smem) {
  if (ph == 0) { phase0(p, smem); return; }
  if (ph == NPHASES - 1) { ln_phase(p, DEPTH, 2); return; }
  const int l = (ph - 1) / PH_PER_LAYER, k = (ph - 1) - l * PH_PER_LAYER;
  switch (k) {
    case 0: ln_phase(p, l, 0); conv_phase(p, l, 0, 12, smem); break;
    case 1: inproj_phase(p, smem); break;
    case 2: {
      constexpr int NSH = NR / 64, NUP = (NR / 128) * 14;
      for (int j = blockIdx.x; j < NSH + NUP; j += gridDim.x) {
        if (j < NSH) shift_job(p, l, j, smem); else mla_up_job(p, j - NSH, smem);
        __syncthreads();
      }
    } break;
    case 3: for (int j = blockIdx.x; j < 5 * 4 * (NR / 128); j += gridDim.x) { lowrank_job(p, l, j, smem); __syncthreads(); } break;
    case 4: mixer_phase(p, l, smem); break;
    case 5: post_phase(p, l); break;
    case 6: merge_phase(p, smem); conv_phase(p, l, 12, 14, smem); break;
    case 7: resid_gemm_phase(p, l, p.M, D, p.WO, 2, smem); break;
    case 8: ln_phase(p, l, 1); break;
    case 9: mlp1_phase(p, smem); break;
    default: resid_gemm_phase(p, l, p.Z, DFF, p.W2T, 5, smem); break;
  }
}

__global__ void __launch_bounds__(256, 2) mega(P p, int pb, int pe) {
  extern __shared__ __attribute__((aligned(16))) char smem[];
  cg::grid_group grid = cg::this_grid();
  for (int ph = pb; ph < pe; ++ph) {
    if (ph > pb) grid.sync();
    run_phase(p, ph, smem);
  }
}

extern "C" void kernel_launch(void* const* d_in, const int* in_sizes, int n_in, void* d_out, int out_size, void* d_ws,
                              size_t ws_size, hipStream_t stream) {
  static int grid_blocks = 0;
  if (grid_blocks == 0) {
    int dev = 0, cus = 0, per_cu = 0;
    hipGetDevice(&dev);
    hipDeviceGetAttribute(&cus, hipDeviceAttributeMultiprocessorCount, dev);
    hipFuncSetAttribute((const void*)mega, hipFuncAttributeMaxDynamicSharedMemorySize, LDS_BYTES);
    hipOccupancyMaxActiveBlocksPerMultiprocessor(&per_cu, (const void*)mega, 256, LDS_BYTES);
    if (per_cu < 1) per_cu = 1;
    if (per_cu > 2) per_cu = 2;
    grid_blocks = cus * per_cu;
    fprintf(stderr, "mega: cus %d per_cu %d grid %d\n", cus, per_cu, grid_blocks);
  }
  P p{};
  const float** ins = (const float**)&p;
  for (int i = 0; i < 33; ++i) ins[i] = (const float*)d_in[i];
  char* w = (char*)d_ws;
  size_t off = 0;
  auto take = [&](size_t bytes) { char* r = w + off; off += (bytes + 255) & ~(size_t)255; return r; };
  p.XL = (float*)d_out;
  p.XC = (float*)take((size_t)NB * CTX * D * 4);
  p.MOD = (float*)take((size_t)DEPTH * 5 * 6144 * 4);
  p.ROPE = (float*)take((size_t)SEQ * 32 * 4);
  p.INVN = (float*)take((size_t)NR * 8 * 4);
  p.CTR = (unsigned*)take(256);
  p.HLO = (h16*)take((size_t)(NR / 64) * 1920 * 2);
  p.HHI = (h16*)take((size_t)(NR / 64) * 1920 * 2);
  p.H = (h16*)take((size_t)NR * D * 2);
  p.Z = (h16*)take((size_t)NR * ZW * 2);
  p.WIN = (h16*)take((size_t)NIN * D * 2);
  p.UQ = (h16*)take((size_t)768 * 384 * 2);
  p.UKV = (h16*)take((size_t)1024 * 256 * 2);
  p.WB = (h16*)take((size_t)3 * D * 512 * 2);
  p.WO = (h16*)take((size_t)D * D * 2);
  p.WUP = (h16*)take((size_t)2 * 512 * 64 * 2);
  p.AUP = (h16*)take((size_t)2 * 512 * 64 * 2);
  p.GUP = (h16*)take((size_t)512 * 128 * 2);
  p.LW = (h16*)take((size_t)2 * NR * 512 * 2);
  p.AA = (h16*)take((size_t)2 * NR * 512 * 2);
  p.W1T = p.LW;
  p.W2T = p.LW + (size_t)DFF * D;
  p.G = (h16*)take((size_t)NR * 512 * 2);
  p.Y2 = (h16*)take((size_t)2 * NR * 512 * 2);
  p.Q = (h16*)take((size_t)NR * 768 * 2);
  p.K = (h16*)take((size_t)NR * 768 * 2);
  p.M = p.Q;
  p.VT = (h16*)take((size_t)NR * 512 * 2);
  p.YA = (h16*)take((size_t)NR * 512 * 2);
  p.OFB = (h16*)take((size_t)2 * NR * 512 * 2);
  if (off > ws_size || n_in != 33) { fprintf(stderr, "mega: workspace too small (%zu > %zu) or n_in %d\n", off, ws_size, n_in); return; }
  int pb = 0, pe = NPHASES;
  void* args[] = {&p, &pb, &pe};
  hipError_t e = hipLaunchCooperativeKernel((const void*)mega, dim3(grid_blocks), dim3(256), args, LDS_BYTES, stream);
  if (e != hipSuccess) fprintf(stderr, "mega: cooperative launch failed: %s (grid %d)\n", hipGetErrorString(e), grid_blocks);
}
```

```cpp
#include <hip/hip_runtime.h>
#include <hip/hip_cooperative_groups.h>
#include <cstdio>
#include <cstdint>
namespace cg = cooperative_groups;

typedef _Float16 h16;
typedef _Float16 h16x8 __attribute__((ext_vector_type(8)));
typedef _Float16 h16x4 __attribute__((ext_vector_type(4)));
typedef float f32x16 __attribute__((ext_vector_type(16)));
typedef float f32x4 __attribute__((ext_vector_type(4)));

#define DEVI __device__ __forceinline__
DEVI int threadIdx_x_raw() { return (int)__builtin_amdgcn_workitem_id_x(); }

#define PROBE 0
constexpr int D = 1024, NB = 4, SEQ = 4096, CTX = 256, DEPTH = 4;
constexpr int SB = SEQ + CTX;
constexpr int NR = NB * SB;
constexpr int ZW = 4160;
constexpr int ZMLA = 1568, ZRW = 2240;
constexpr int NIN = 7232;
constexpr int DFF = 4096;
constexpr int LDS_BYTES = 74752;
constexpr int NSCAN_BPC = 2;
constexpr int NSCAN = 64 * NSCAN_BPC;
constexpr int NGLA = 128;
constexpr int TSTEPS = SB + 1;
constexpr int NCHUNK = (TSTEPS + 15) / 16;

struct P {
  const float *x, *c, *ctx, *c_ctx, *ada_w, *ada_b, *w_in, *gk_up, *gk_b, *gla_ng, *qn_g, *kvn_g, *w_uq, *w_ukv,
      *mu, *w0, *w_up, *a0, *a_up, *g_up, *k_k, *k_a, *r_k, *rln_g, *rln_b, *w_branch, *w_out, *ln1_g, *ln1_b,
      *w1, *w2, *ln2_g, *ln2_b;
  float *XL, *XC, *MOD, *ROPE, *INVN;
  unsigned* CTR;
  unsigned* BAR;
  h16 *HLO, *HHI, *H, *Z, *WIN, *UQ, *UKV, *WB, *WO, *WUP, *AUP, *GUP, *LW, *AA, *G, *Y2, *Q, *K, *VT, *YA, *OFB, *W1T, *W2T, *M;
};

DEVI int tidx() { int t = threadIdx_x_raw(); asm volatile("" : "+v"(t)); return t; }
DEVI float wsum(float v) {
#pragma unroll
  for (int o = 32; o; o >>= 1) v += __shfl_xor(v, o);
  return v;
}
DEVI float sigm(float x) { return 1.f / (1.f + __expf(-x)); }
DEVI unsigned pk2(float a, float b) {
  auto h = __builtin_amdgcn_cvt_pkrtz(a, b);
  return __builtin_bit_cast(unsigned, h);
}
DEVI unsigned pk2n(float a, float b) {
  h16 x = (h16)a, y = (h16)b;
  unsigned short ux = __builtin_bit_cast(unsigned short, x), uy = __builtin_bit_cast(unsigned short, y);
  return (unsigned)ux | ((unsigned)uy << 16);
}
DEVI float h2f(unsigned short u) { return (float)__builtin_bit_cast(h16, u); }
DEVI void st4h(h16* dst, float a, float b, float c, float d) {
  uint2 u; u.x = pk2n(a, b); u.y = pk2n(c, d);
  *(uint2*)dst = u;
}
DEVI float* xrow(const P& p, int r) {
  int b = r / SB, s = r - b * SB;
  return s < CTX ? p.XC + (size_t)(b * CTX + s) * D : p.XL + (size_t)(b * SEQ + s - CTX) * D;
}
DEVI int maprow(int dir, int b, int n) {
  if (dir == 0) return b * SB + n;
  return n < CTX ? b * SB + (CTX - 1 - n) : b * SB + (SB + CTX - 1 - n);
}


#define XB_TMO      128
#define XB_XCNT(j)  (256  + 64 * (j))
#define XB_XSUB(j)  (1280 + 64 * (j))
#define XB_XGEN(j)  (2304 + 64 * (j))
#define XB_TOP      3328
#define XB_TOPGEN   3392
#define XCD_BAR_WORDS 3456
#define XB_SPIN_CAP (1u << 22)
#define LAS __attribute__((address_space(3)))
DEVI unsigned xb_ld(unsigned* p) { return __hip_atomic_load(p, __ATOMIC_RELAXED, __HIP_MEMORY_SCOPE_AGENT); }
DEVI unsigned xb_add(unsigned* p, unsigned v) { return __hip_atomic_fetch_add(p, v, __ATOMIC_RELAXED, __HIP_MEMORY_SCOPE_AGENT); }
DEVI unsigned xb_xcc_id() { return (unsigned)__builtin_amdgcn_s_getreg((3 << 11) | 20) & 0xFu; }
#define XB_SPIN(cond, bar) do { unsigned _sp = 0; while (cond) { __builtin_amdgcn_s_sleep(1); \
    if ((++_sp & 255u) == 0u) { if (xb_ld(&(bar)[XB_TMO])) break; if (_sp > XB_SPIN_CAP) { atomicAdd(&(bar)[XB_TMO], 1u); break; } } } } while (0)
struct XcdBarrier { unsigned* bar; unsigned x; volatile LAS unsigned* st; };
DEVI XcdBarrier xcd_barrier_post(unsigned* bar, volatile LAS unsigned* st) {
  XcdBarrier b; b.bar = bar; b.x = xb_xcc_id(); b.st = st;
  if (threadIdx_x_raw() == 0) (void)xb_add(&bar[XB_XCNT(b.x)], 1u);
  return b;
}
DEVI void xcd_barrier_complete(unsigned* bar, unsigned x, unsigned& nloc, unsigned& nx) {
  const unsigned G = gridDim.x;
  unsigned sum, cnt, mine, sp = 0u;
  for (;;) {
    sum = 0u; cnt = 0u; mine = 0u;
#pragma unroll
    for (unsigned j = 0; j < 16; ++j) { const unsigned c = xb_ld(&bar[XB_XCNT(j)]); sum += c; cnt += (c > 0u) ? 1u : 0u; mine = (j == x) ? c : mine; }
    if (sum == G) break;
    __builtin_amdgcn_s_sleep(1);
    if ((++sp & 255u) == 0u) { if (xb_ld(&bar[XB_TMO])) break; if (sp > XB_SPIN_CAP) { atomicAdd(&bar[XB_TMO], 1u); break; } }
  }
  nloc = mine > 0u ? mine : 1u; nx = cnt > 0u ? cnt : 1u;
}
DEVI void xcd_barrier(const XcdBarrier& b) {
  asm volatile("s_waitcnt vmcnt(0)" ::: "memory");
  __syncthreads();
  if (threadIdx_x_raw() == 0) {
    unsigned* bar = b.bar;
    __builtin_amdgcn_s_waitcnt(0);
    unsigned nloc = b.st[0], nx = b.st[1];
    if (nloc == 0u) { xcd_barrier_complete(bar, b.x, nloc, nx); b.st[0] = nloc; b.st[1] = nx; }
    const unsigned old = xb_add(&bar[XB_XSUB(b.x)], 1u);
    const unsigned gen = old / nloc;
    if (old + 1u == (gen + 1u) * nloc) {
      __builtin_amdgcn_fence(__ATOMIC_RELEASE, "agent");
      asm volatile("s_waitcnt vmcnt(0)" ::: "memory");
      const unsigned og = xb_add(&bar[XB_TOP], 1u);
      const unsigned tg = og / nx;
      if (og + 1u == (tg + 1u) * nx) xb_add(&bar[XB_TOPGEN], 1u);
      else XB_SPIN(xb_ld(&bar[XB_TOPGEN]) == tg, bar);
      __builtin_amdgcn_fence(__ATOMIC_ACQUIRE, "agent");
      xb_add(&bar[XB_XGEN(b.x)], 1u);
      asm volatile("s_waitcnt vmcnt(0)" ::: "memory");
    } else {
      XB_SPIN(xb_ld(&bar[XB_XGEN(b.x)]) == gen, bar);
      __builtin_amdgcn_fence(__ATOMIC_ACQUIRE, "agent");
      asm volatile("s_waitcnt vmcnt(0)" ::: "memory");
    }
  }
  __syncthreads();
}

DEVI void phase0(const P& p, char* smem) {
  const int tid = tidx();
  float* sc = (float*)smem;
  float* red = sc + 5 * 1024;
  for (int i = tid; i < 5 * 1024; i += 256) {
    int g = i >> 10, k = i & 1023;
    float v = g < 4 ? p.c[g * D + k] : p.c_ctx[k];
    sc[i] = v * sigm(v);
  }
  __syncthreads();
  for (int job = blockIdx.x; job < DEPTH * 96; job += gridDim.x) {
    int l = job / 96, n0 = (job % 96) * 64;
    int kq = tid >> 6, cc = tid & 63;
    const float* w = p.ada_w + ((size_t)l * D + kq * 256) * 6144 + n0 + cc;
    float a0 = 0, a1 = 0, a2 = 0, a3 = 0, a4 = 0;
#pragma unroll 8
    for (int k = 0; k < 256; ++k) {
      float wv = w[(size_t)k * 6144];
      int kk = kq * 256 + k;
      a0 += sc[kk] * wv; a1 += sc[1024 + kk] * wv; a2 += sc[2048 + kk] * wv; a3 += sc[3072 + kk] * wv; a4 += sc[4096 + kk] * wv;
    }
    red[(kq * 5 + 0) * 64 + cc] = a0; red[(kq * 5 + 1) * 64 + cc] = a1; red[(kq * 5 + 2) * 64 + cc] = a2;
    red[(kq * 5 + 3) * 64 + cc] = a3; red[(kq * 5 + 4) * 64 + cc] = a4;
    __syncthreads();
    for (int i = tid; i < 320; i += 256) {
      int g = i >> 6, c2 = i & 63;
      float s = red[(0 * 5 + g) * 64 + c2] + red[(1 * 5 + g) * 64 + c2] + red[(2 * 5 + g) * 64 + c2] + red[(3 * 5 + g) * 64 + c2];
      p.MOD[((size_t)l * 5 + g) * 6144 + n0 + c2] = s + p.ada_b[l * 6144 + n0 + c2];
    }
    __syncthreads();
  }
  for (int i = blockIdx.x * 256 + tid; i < SEQ * 16; i += gridDim.x * 256) {
    int s = i >> 4, j = i & 15;
    float pos = (float)(j < 8 ? (s >> 6) : (s & 63));
    float inv = exp2f(-(float)(j & 7) * (13.287712379549449f / 8.f));
    float ang = pos * inv;
    p.ROPE[s * 32 + j] = cosf(ang);
    p.ROPE[s * 32 + 16 + j] = sinf(ang);
  }
  if (blockIdx.x == 0 && tid < 64) p.CTR[tid] = 0;
}

struct CE { const float* src; h16* dst; const float* scale; int K, N; };
DEVI CE get_ce(const P& p, int l, int e) {
  CE c; c.scale = nullptr;
  switch (e) {
    case 0: c.src = p.w_in + (size_t)l * D * NIN; c.dst = p.WIN; c.K = D; c.N = NIN; break;
    case 1: c.src = p.w_uq + (size_t)l * 384 * 768; c.dst = p.UQ; c.K = 384; c.N = 768; c.scale = p.qn_g + l * 384; break;
    case 2: c.src = p.w_ukv + (size_t)l * 256 * 1024; c.dst = p.UKV; c.K = 256; c.N = 1024; c.scale = p.kvn_g + l * 256; break;
    case 3: case 4: case 5: c.src = p.w_branch + ((size_t)l * 3 + (e - 3)) * 512 * D; c.dst = p.WB + (size_t)(e - 3) * D * 512; c.K = 512; c.N = D; break;
    case 6: c.src = p.w_out + (size_t)l * D * D; c.dst = p.WO; c.K = D; c.N = D; break;
    case 7: case 8: c.src = p.w_up + ((size_t)l * 2 + (e - 7)) * 64 * 512; c.dst = p.WUP + (size_t)(e - 7) * 512 * 64; c.K = 64; c.N = 512; break;
    case 9: case 10: c.src = p.a_up + ((size_t)l * 2 + (e - 9)) * 64 * 512; c.dst = p.AUP + (size_t)(e - 9) * 512 * 64; c.K = 64; c.N = 512; break;
    case 11: c.src = p.g_up + (size_t)l * 128 * 512; c.dst = p.GUP; c.K = 128; c.N = 512; break;
    case 12: c.src = p.w1 + (size_t)l * D * DFF; c.dst = p.W1T; c.K = D; c.N = DFF; break;
    default: c.src = p.w2 + (size_t)l * DFF * D; c.dst = p.W2T; c.K = DFF; c.N = D; break;
  }
  return c;
}
DEVI void conv_tile(const CE& e, int tile, char* smem) {
  float* s = (float*)smem;
  const int tid = tidx();
  int ntn = e.N >> 6;
  int kt = tile / ntn, nt = tile - kt * ntn;
  {
    int r = tid >> 4, c4 = (tid & 15) * 4;
#pragma unroll
    for (int rr = 0; rr < 4; ++rr) {
      int k = r + 16 * rr;
      float4 v = *(const float4*)(e.src + (size_t)(kt * 64 + k) * e.N + nt * 64 + c4);
      float sc = e.scale ? e.scale[kt * 64 + k] : 1.f;
      s[k * 65 + c4 + 0] = v.x * sc; s[k * 65 + c4 + 1] = v.y * sc; s[k * 65 + c4 + 2] = v.z * sc; s[k * 65 + c4 + 3] = v.w * sc;
    }
  }
  __syncthreads();
  {
    int n = tid >> 2, kq = (tid & 3) * 16;
    uint4 u0, u1;
    u0.x = pk2n(s[(kq + 0) * 65 + n], s[(kq + 1) * 65 + n]); u0.y = pk2n(s[(kq + 2) * 65 + n], s[(kq + 3) * 65 + n]);
    u0.z = pk2n(s[(kq + 4) * 65 + n], s[(kq + 5) * 65 + n]); u0.w = pk2n(s[(kq + 6) * 65 + n], s[(kq + 7) * 65 + n]);
    u1.x = pk2n(s[(kq + 8) * 65 + n], s[(kq + 9) * 65 + n]); u1.y = pk2n(s[(kq + 10) * 65 + n], s[(kq + 11) * 65 + n]);
    u1.z = pk2n(s[(kq + 12) * 65 + n], s[(kq + 13) * 65 + n]); u1.w = pk2n(s[(kq + 14) * 65 + n], s[(kq + 15) * 65 + n]);
    h16* d = e.dst + (size_t)(nt * 64 + n) * e.K + kt * 64 + kq;
    *(uint4*)d = u0; *(uint4*)(d + 8) = u1;
  }
  __syncthreads();
}
DEVI void conv_phase(const P& p, int l, int e0, int e1, char* smem) {
  int total = 0;
  for (int e = e0; e < e1; ++e) { CE c = get_ce(p, l, e); total += (c.K >> 6) * (c.N >> 6); }
  for (int t = blockIdx.x; t < total; t += gridDim.x) {
    int tt = t;
    for (int e = e0; e < e1; ++e) {
      CE c = get_ce(p, l, e);
      int nt = (c.K >> 6) * (c.N >> 6);
      if (tt < nt) { conv_tile(c, tt, smem); break; }
      tt -= nt;
    }
  }
}

DEVI void ln_phase(const P& p, int l, int which) {
  const int lane = tidx() & 63;
  const int wid = blockIdx.x * 4 + (tidx() >> 6), nw = gridDim.x * 4;
  for (int r = wid; r < NR; r += nw) {
    int b = r / SB, s = r - b * SB;
    if (which == 2 && s < CTX) continue;
    int g = s < CTX ? 4 : b;
    float* xr = xrow(p, r);
    const float* src = xr;
    if (which == 0 && l == 0) src = s < CTX ? p.ctx + (size_t)(b * CTX + s) * D : p.x + (size_t)(b * SEQ + s - CTX) * D;
    float4 v[4];
#pragma unroll
    for (int i = 0; i < 4; ++i) v[i] = *(const float4*)(src + i * 256 + lane * 4);
    bool do_ln = !(which == 0 && l == 0);
    if (do_ln) {
      const float* gg = which == 1 ? p.ln1_g + l * D : p.ln2_g + (which == 2 ? 3 : l - 1) * D;
      const float* bb = which == 1 ? p.ln1_b + l * D : p.ln2_b + (which == 2 ? 3 : l - 1) * D;
      float sm = 0;
#pragma unroll
      for (int i = 0; i < 4; ++i) sm += v[i].x + v[i].y + v[i].z + v[i].w;
      float mean = wsum(sm) * (1.f / D);
      float sq = 0;
#pragma unroll
      for (int i = 0; i < 4; ++i) {
        v[i].x -= mean; v[i].y -= mean; v[i].z -= mean; v[i].w -= mean;
        sq += v[i].x * v[i].x + v[i].y * v[i].y + v[i].z * v[i].z + v[i].w * v[i].w;
      }
      float rs = rsqrtf(wsum(sq) * (1.f / D) + 1e-5f);
#pragma unroll
      for (int i = 0; i < 4; ++i) {
        float4 g4 = *(const float4*)(gg + i * 256 + lane * 4), b4 = *(const float4*)(bb + i * 256 + lane * 4);
        v[i].x = v[i].x * rs * g4.x + b4.x; v[i].y = v[i].y * rs * g4.y + b4.y;
        v[i].z = v[i].z * rs * g4.z + b4.z; v[i].w = v[i].w * rs * g4.w + b4.w;
      }
    }
#pragma unroll
    for (int i = 0; i < 4; ++i) *(float4*)(xr + i * 256 + lane * 4) = v[i];
    if (which == 2) continue;
    const float* shf = p.MOD + ((size_t)l * 5 + g) * 6144 + (which == 0 ? 0 : 3) * D;
    const float* scl = shf + D;
    float sm = 0;
#pragma unroll
    for (int i = 0; i < 4; ++i) sm += v[i].x + v[i].y + v[i].z + v[i].w;
    float mean = wsum(sm) * (1.f / D);
    float sq = 0;
#pragma unroll
    for (int i = 0; i < 4; ++i) {
      v[i].x -= mean; v[i].y -= mean; v[i].z -= mean; v[i].w -= mean;
      sq += v[i].x * v[i].x + v[i].y * v[i].y + v[i].z * v[i].z + v[i].w * v[i].w;
    }
    float rs = rsqrtf(wsum(sq) * (1.f / D) + 1e-6f);
    h16* hr = p.H + (size_t)r * D;
#pragma unroll
    for (int i = 0; i < 4; ++i) {
      float4 s4 = *(const float4*)(shf + i * 256 + lane * 4), c4 = *(const float4*)(scl + i * 256 + lane * 4);
      st4h(hr + i * 256 + lane * 4, v[i].x * rs * (1.f + c4.x) + s4.x, v[i].y * rs * (1.f + c4.y) + s4.y,
           v[i].z * rs * (1.f + c4.z) + s4.z, v[i].w * rs * (1.f + c4.w) + s4.w);
    }
  }
}

constexpr int GLD = 72;
template <bool ROWSQ, int NI = 2>
DEVI void gemm_main(const h16* __restrict__ A, int lda, const h16* __restrict__ Bt, int ldb, int K, int m0, int n0, int nmax,
                    char* smem, f32x16 (&acc)[2][NI], float* rowsq) {
  h16* As = (h16*)smem;
  h16* Bs = As + 2 * 128 * GLD;
  const int tid = tidx(), lane = tid & 63, wv = tid >> 6;
  const int wm = wv >> 1, wn = wv & 1, l31 = lane & 31, hh = lane >> 5;
  const int lrow = tid >> 3, lkc = (tid & 7) * 8;
  uint4 ga[4], gb[2 * NI];
  float sq[4] = {0.f, 0.f, 0.f, 0.f};
  const h16* Ap = A + (size_t)(m0 + lrow) * lda + lkc;
  const h16* Bp = Bt + (size_t)(n0 + lrow) * ldb + lkc;
#pragma unroll
  for (int i = 0; i < 4; ++i) ga[i] = *(const uint4*)(Ap + (size_t)(32 * i) * lda);
#pragma unroll
  for (int i = 0; i < 2 * NI; ++i)
    gb[i] = (n0 + lrow + 32 * i < nmax) ? *(const uint4*)(Bp + (size_t)(32 * i) * ldb) : make_uint4(0, 0, 0, 0);
  const int KT = K >> 6;
#pragma unroll
  for (int i = 0; i < 4; ++i) *(uint4*)(As + (lrow + 32 * i) * GLD + lkc) = ga[i];
#pragma unroll
  for (int i = 0; i < 2 * NI; ++i) *(uint4*)(Bs + (lrow + 32 * i) * GLD + lkc) = gb[i];
  __syncthreads();
  for (int kt = 0; kt < KT; ++kt) {
    const int buf = kt & 1;
    if (ROWSQ) {
#pragma unroll
      for (int i = 0; i < 4; ++i) {
        h16x8 hv = __builtin_bit_cast(h16x8, ga[i]);
#pragma unroll
        for (int j = 0; j < 8; ++j) { float f = (float)hv[j]; sq[i] += f * f; }
      }
    }
    if (kt + 1 < KT) {
#pragma unroll
      for (int i = 0; i < 4; ++i) ga[i] = *(const uint4*)(Ap + (size_t)(32 * i) * lda + (kt + 1) * 64);
#pragma unroll
      for (int i = 0; i < 2 * NI; ++i)
        gb[i] = (n0 + lrow + 32 * i < nmax) ? *(const uint4*)(Bp + (size_t)(32 * i) * ldb + (kt + 1) * 64) : make_uint4(0, 0, 0, 0);
    }
    const h16* as = As + buf * 128 * GLD + (wm * 64 + l31) * GLD + hh * 8;
    const h16* bs = Bs + buf * 128 * GLD + (wn * 32 * NI + l31) * GLD + hh * 8;
#pragma unroll
    for (int ks = 0; ks < 4; ++ks) {
      h16x8 a0 = *(const h16x8*)(as + ks * 16), a1 = *(const h16x8*)(as + 32 * GLD + ks * 16);
#pragma unroll
      for (int ni = 0; ni < NI; ++ni) {
        h16x8 b0 = *(const h16x8*)(bs + ni * 32 * GLD + ks * 16);
        acc[0][ni] = __builtin_amdgcn_mfma_f32_32x32x16_f16(b0, a0, acc[0][ni], 0, 0, 0);
        acc[1][ni] = __builtin_amdgcn_mfma_f32_32x32x16_f16(b0, a1, acc[1][ni], 0, 0, 0);
      }
    }
    if (kt + 1 < KT) {
      h16* ad = As + (buf ^ 1) * 128 * GLD;
      h16* bd = Bs + (buf ^ 1) * 128 * GLD;
#pragma unroll
      for (int i = 0; i < 4; ++i) *(uint4*)(ad + (lrow + 32 * i) * GLD + lkc) = ga[i];
#pragma unroll
      for (int i = 0; i < 2 * NI; ++i) *(uint4*)(bd + (lrow + 32 * i) * GLD + lkc) = gb[i];
    }
    __syncthreads();
  }
  if (ROWSQ) {
#pragma unroll
    for (int i = 0; i < 4; ++i) {
      float s = sq[i];
      s += __shfl_xor(s, 1); s += __shfl_xor(s, 2); s += __shfl_xor(s, 4);
      if ((tid & 7) == 0) rowsq[lrow + 32 * i] = s;
    }
    __syncthreads();
  }
}
DEVI void zero_acc(f32x16 (&acc)[2][2]) {
#pragma unroll
  for (int i = 0; i < 2; ++i)
#pragma unroll
    for (int j = 0; j < 2; ++j)
#pragma unroll
      for (int r = 0; r < 16; ++r) acc[i][j][r] = 0.f;
}
template <class F>
DEVI void epi_quads(const f32x16 (&acc)[2][2], int m0, int n0, F f) {
  const int lane = tidx() & 63, wv = tidx() >> 6;
  const int wm = wv >> 1, wn = wv & 1, l31 = lane & 31, hh = lane >> 5;
#pragma unroll
  for (int mi = 0; mi < 2; ++mi)
#pragma unroll
    for (int ni = 0; ni < 2; ++ni)
#pragma unroll
      for (int g = 0; g < 4; ++g)
        f(m0 + wm * 64 + mi * 32 + l31, n0 + wn * 64 + ni * 32 + 8 * g + 4 * hh, acc[mi][ni][4 * g], acc[mi][ni][4 * g + 1],
          acc[mi][ni][4 * g + 2], acc[mi][ni][4 * g + 3]);
}

DEVI void inproj_phase(const P& p, char* smem) {
  constexpr int MT = NR / 128, NT = (ZW + 127) / 128;
  for (int job = blockIdx.x; job < MT * NT; job += gridDim.x) {
    int nt = job / MT, mt = job - nt * MT;
    f32x16 acc[2][2]; zero_acc(acc);
    gemm_main<false>(p.H, D, p.WIN, D, D, mt * 128, nt * 128, ZW, smem, acc, nullptr);
    epi_quads(acc, mt * 128, nt * 128, [&](int m, int n, float v0, float v1, float v2, float v3) {
      if (n < ZW) {
        st4h(p.Z + (size_t)m * ZW + n, v0, v1, v2, v3);
        if (n >= ZRW) {
          if ((m & 63) == 0) st4h(p.HLO + (size_t)(m >> 6) * 1920 + n - ZRW, v0, v1, v2, v3);
          if ((m & 63) == 63) st4h(p.HHI + (size_t)(m >> 6) * 1920 + n - ZRW, v0, v1, v2, v3);
        }
      }
    });
  }
}

DEVI void shift_job(const P& p, int l, int j, char* smem) {
  h16* raw = (h16*)smem;
  const int tid = tidx(), lane = tid & 63;
  const int r0 = j * 64;
  const int s0 = r0 % SB;
  const bool first = (s0 == 0) || (s0 == CTX);
  const bool last = (s0 + 64 == CTX) || (s0 + 64 == SB);
  for (int slab = 0; slab < 8; ++slab) {
    const int c0 = slab * 256;
    const int ncols = slab == 7 ? 128 : 256;
    const int cpr = ncols >> 3;
    for (int c = tid; c < 66 * cpr; c += 256) {
      int row = c / cpr, ch = (c - row * cpr) * 8;
      uint4 v = make_uint4(0, 0, 0, 0);
      if (row == 0) { if (!first) v = *(const uint4*)(p.HHI + (size_t)(j - 1) * 1920 + c0 + ch); }
      else if (row == 65) { if (!last) v = *(const uint4*)(p.HLO + (size_t)(j + 1) * 1920 + c0 + ch); }
      else v = *(const uint4*)(p.Z + (size_t)(r0 + row - 1) * ZW + ZRW + c0 + ch);
      *(uint4*)(raw + row * 264 + ch) = v;
    }
    __syncthreads();
    if (tid < ncols) {
      const int col = c0 + tid;
      const float mup = p.mu[(size_t)l * 2 * 1920 + col], mun = p.mu[(size_t)l * 2 * 1920 + 1920 + col];
      const bool isk = (col >= 512 && col < 1024);
      const float kkp = isk ? p.k_k[l * 512 + col - 512] : 0.f;
      float prev = (float)raw[tid], cur = (float)raw[264 + tid];
      h16* zc = p.Z + (size_t)r0 * ZW + ZRW + col;
      for (int t = 0; t < 64; ++t) {
        float nxt = (float)raw[(t + 2) * 264 + tid];
        float o = cur + mup * (prev - cur) + mun * (nxt - cur);
        float ov = o;
        if (col >= 1536 && col < 1664) ov = tanhf(o);
        else if (col >= 1792) ov = sigm(o);
        zc[(size_t)t * ZW] = (h16)ov;
        if (isk) {
          float q = o * kkp;
          float ss = wsum(q * q);
          if (lane == 0) p.INVN[(size_t)(r0 + t) * 8 + ((col - 512) >> 6)] = rsqrtf(ss + 1e-12f);
        }
        prev = cur; cur = nxt;
      }
    }
    __syncthreads();
  }
}

DEVI void mla_up_job(const P& p, int job, char* smem) {
  constexpr int MT = NR / 128;
  float* rowsq = (float*)(smem + 2 * 2 * 128 * GLD * 2);
  const int tid = tidx();
  f32x16 acc[2][2]; zero_acc(acc);
  if (job < MT * 6) {
    int nt = job / MT, mt = job - nt * MT;
    gemm_main<true>(p.Z + ZMLA, ZW, p.UQ, 384, 384, mt * 128, nt * 128, 768, smem, acc, rowsq);
    const int m0 = mt * 128, n0 = nt * 128;
    const int lane = tid & 63, wv = tid >> 6, wm = wv >> 1, wn = wv & 1, l31 = lane & 31, hh = lane >> 5;
    const float qs = 0.10206207261596575f * 1.4426950408889634f;
#pragma unroll
    for (int mi = 0; mi < 2; ++mi) {
      const int ml = wm * 64 + mi * 32 + l31, m = m0 + ml;
      const float sc = rsqrtf(rowsq[ml] * (1.f / 384.f) + 1e-6f) * qs;
      const int sp = m % SB;
      const bool lat = sp >= CTX;
      const float* rp = p.ROPE + (size_t)(lat ? sp - CTX : 0) * 32;
#pragma unroll
      for (int ni = 0; ni < 2; ++ni) {
        const int nb = n0 + wn * 64 + ni * 32;
        h16* qd = p.Q + (size_t)m * 768 + nb;
        const bool ropet = (nb % 96) == 64;
        if (ropet && lat) {
#pragma unroll
          for (int g = 0; g < 2; ++g) {
            float o1[4], o2[4];
#pragma unroll
            for (int jj = 0; jj < 4; ++jj) {
              int i = 8 * g + 4 * hh + jj;
              float x1 = acc[mi][ni][4 * g + jj] * sc, x2 = acc[mi][ni][4 * (g + 2) + jj] * sc;
              float cs = rp[i], sn = rp[16 + i];
              o1[jj] = x1 * cs - x2 * sn; o2[jj] = x1 * sn + x2 * cs;
            }
            st4h(qd + 8 * g + 4 * hh, o1[0], o1[1], o1[2], o1[3]);
            st4h(qd + 16 + 8 * g + 4 * hh, o2[0], o2[1], o2[2], o2[3]);
          }
        } else {
#pragma unroll
          for (int g = 0; g < 4; ++g)
            st4h(qd + 8 * g + 4 * hh, acc[mi][ni][4 * g] * sc, acc[mi][ni][4 * g + 1] * sc, acc[mi][ni][4 * g + 2] * sc, acc[mi][ni][4 * g + 3] * sc);
        }
      }
    }
  } else {
    int j2 = job - MT * 6;
    int nt = j2 / MT, mt = j2 - nt * MT;
    gemm_main<true>(p.Z + ZMLA + 384, ZW, p.UKV, 256, 256, mt * 128, nt * 128, 1024, smem, acc, rowsq);
    const int m0 = mt * 128;
    epi_quads(acc, m0, 0, [&](int m, int n, float v0, float v1, float v2, float v3) {
      const float sc = rsqrtf(rowsq[m - m0] * (1.f / 256.f) + 1e-6f);
      if (n < 64) st4h(p.K + (size_t)m * 768 + nt * 96 + n, v0 * sc, v1 * sc, v2 * sc, v3 * sc);
      else {
        int b = m / SB, s = m - b * SB;
        h16* vt = p.VT + ((size_t)(b * 8 + nt) * 64 + (n - 64)) * SB + s;
        vt[0] = (h16)(v0 * sc); vt[SB] = (h16)(v1 * sc); vt[2 * SB] = (h16)(v2 * sc); vt[3 * SB] = (h16)(v3 * sc);
      }
    });
    {
      int row = tid >> 1, sub = tid & 1;
      int m = m0 + row;
      int sp = m % SB;
      const h16* kr = p.Z + (size_t)m * ZW + ZMLA + 640 + sub * 8;
      h16x8 x1 = *(const h16x8*)kr, x2 = *(const h16x8*)(kr + 16);
      h16* kd = p.K + (size_t)m * 768 + nt * 96 + 64 + sub * 8;
      if (sp >= CTX) {
        const float* rp = p.ROPE + (size_t)(sp - CTX) * 32 + sub * 8;
        h16x8 o1, o2;
#pragma unroll
        for (int i = 0; i < 8; ++i) {
          float a = (float)x1[i], b2 = (float)x2[i], cs = rp[i], sn = rp[16 + i];
          o1[i] = (h16)(a * cs - b2 * sn); o2[i] = (h16)(a * sn + b2 * cs);
        }
        *(h16x8*)kd = o1; *(h16x8*)(kd + 16) = o2;
      } else { *(h16x8*)kd = x1; *(h16x8*)(kd + 16) = x2; }
    }
  }
}

DEVI void lowrank_job(const P& p, int l, int job, char* smem) {
  constexpr int MT = NR / 128;
  int mat = job / (MT * 4), rem = job - mat * MT * 4;
  int nt = rem / MT, mt = rem - nt * MT;
  f32x16 acc[2][2]; zero_acc(acc);
  if (mat < 2) {
    const int dir = mat;
    gemm_main<false>(p.Z + ZRW + 1536 + dir * 64, ZW, p.WUP + (size_t)dir * 512 * 64, 64, 64, mt * 128, nt * 128, 512, smem, acc, nullptr);
    const float* w0 = p.w0 + ((size_t)l * 2 + dir) * 512;
    h16* dst = p.LW + (size_t)dir * NR * 512;
    epi_quads(acc, mt * 128, nt * 128, [&](int m, int n, float v0, float v1, float v2, float v3) {
      float4 b = *(const float4*)(w0 + n);
      const float e = 0.6065306597126334f;
      st4h(dst + (size_t)m * 512 + n, sigm(v0 + b.x) * e, sigm(v1 + b.y) * e, sigm(v2 + b.z) * e, sigm(v3 + b.w) * e);
    });
  } else if (mat < 4) {
    const int dir = mat - 2;
    gemm_main<false>(p.Z + ZRW + 1664 + dir * 64, ZW, p.AUP + (size_t)dir * 512 * 64, 64, 64, mt * 128, nt * 128, 512, smem, acc, nullptr);
    const float* a0 = p.a0 + ((size_t)l * 2 + dir) * 512;
    h16* dst = p.AA + (size_t)dir * NR * 512;
    epi_quads(acc, mt * 128, nt * 128, [&](int m, int n, float v0, float v1, float v2, float v3) {
      float4 b = *(const float4*)(a0 + n);
      st4h(dst + (size_t)m * 512 + n, sigm(v0 + b.x), sigm(v1 + b.y), sigm(v2 + b.z), sigm(v3 + b.w));
    });
  } else {
    gemm_main<false>(p.Z + ZRW + 1792, ZW, p.GUP, 128, 128, mt * 128, nt * 128, 512, smem, acc, nullptr);
    epi_quads(acc, mt * 128, nt * 128, [&](int m, int n, float v0, float v1, float v2, float v3) {
      st4h(p.G + (size_t)m * 512 + n, v0, v1, v2, v3);
    });
  }
}

DEVI void attn_job(const P& p, int job, char* smem) {
  h16* Ks = (h16*)smem;
  h16* Vs = Ks + 2 * 64 * 104;
  const int tid = tidx(), lane = tid & 63, wv = tid >> 6, l31 = lane & 31, hh = lane >> 5;
  int b, h, q0, nk;
  if (job < 1024) { b = job >> 8; h = (job >> 5) & 7; q0 = b * SB + CTX + (job & 31) * 128; nk = SB; }
  else { int j = job - 1024; b = j >> 4; h = (j >> 1) & 7; q0 = b * SB + (j & 1) * 128; nk = CTX; }
  const int NKT = nk >> 6;
  const h16* Kg = p.K + (size_t)(b * SB) * 768 + h * 96;
  const h16* Vg = p.VT + (size_t)(b * 8 + h) * 64 * SB;
  h16x8 qf[6];
  {
    const h16* qp = p.Q + (size_t)(q0 + wv * 32 + l31) * 768 + h * 96 + hh * 8;
#pragma unroll
    for (int ds = 0; ds < 6; ++ds) qf[ds] = *(const h16x8*)(qp + ds * 16);
  }
  uint4 gk[3], gv[2];
  int krow[3], kcol[3];
#pragma unroll
  for (int i = 0; i < 3; ++i) { int c = tid + 256 * i; krow[i] = c / 12; kcol[i] = (c - krow[i] * 12) * 8; }
  const int vrow = tid >> 3, vcol = (tid & 7) * 8;
#pragma unroll
  for (int i = 0; i < 3; ++i) gk[i] = *(const uint4*)(Kg + (size_t)krow[i] * 768 + kcol[i]);
#pragma unroll
  for (int i = 0; i < 2; ++i) gv[i] = *(const uint4*)(Vg + (size_t)(vrow + 32 * i) * SB + vcol);
#pragma unroll
  for (int i = 0; i < 3; ++i) *(uint4*)(Ks + krow[i] * 104 + kcol[i]) = gk[i];
#pragma unroll
  for (int i = 0; i < 2; ++i) *(uint4*)(Vs + (vrow + 32 * i) * 72 + vcol) = gv[i];
  __syncthreads();
  f32x16 o0, o1;
#pragma unroll
  for (int r = 0; r < 16; ++r) { o0[r] = 0.f; o1[r] = 0.f; }
  float mrun = -1e30f, lsum = 0.f;
  for (int kt = 0; kt < NKT; ++kt) {
    const int buf = kt & 1;
    if (kt + 1 < NKT) {
#pragma unroll
      for (int i = 0; i < 3; ++i) gk[i] = *(const uint4*)(Kg + (size_t)((kt + 1) * 64 + krow[i]) * 768 + kcol[i]);
#pragma unroll
      for (int i = 0; i < 2; ++i) gv[i] = *(const uint4*)(Vg + (size_t)(vrow + 32 * i) * SB + (kt + 1) * 64 + vcol);
    }
    const h16* ks = Ks + buf * 64 * 104 + l31 * 104 + hh * 8;
    f32x16 s0, s1;
#pragma unroll
    for (int r = 0; r < 16; ++r) { s0[r] = 0.f; s1[r] = 0.f; }
#pragma unroll
    for (int ds = 0; ds < 6; ++ds) {
      h16x8 a0 = *(const h16x8*)(ks + ds * 16), a1 = *(const h16x8*)(ks + 32 * 104 + ds * 16);
      s0 = __builtin_amdgcn_mfma_f32_32x32x16_f16(a0, qf[ds], s0, 0, 0, 0);
      s1 = __builtin_amdgcn_mfma_f32_32x32x16_f16(a1, qf[ds], s1, 0, 0, 0);
    }
    float mx = s0[0];
#pragma unroll
    for (int r = 1; r < 16; ++r) mx = fmaxf(mx, s0[r]);
#pragma unroll
    for (int r = 0; r < 16; ++r) mx = fmaxf(mx, s1[r]);
    mx = fmaxf(mx, __shfl_xor(mx, 32));
    const float mnew = fmaxf(mrun, mx);
    const float alpha = __builtin_amdgcn_exp2f(mrun - mnew);
    mrun = mnew;
    float ps = 0.f;
#pragma unroll
    for (int r = 0; r < 16; ++r) { s0[r] = __builtin_amdgcn_exp2f(s0[r] - mnew); ps += s0[r]; }
#pragma unroll
    for (int r = 0; r < 16; ++r) { s1[r] = __builtin_amdgcn_exp2f(s1[r] - mnew); ps += s1[r]; }
    lsum = lsum * alpha + ps;
#pragma unroll
    for (int r = 0; r < 16; ++r) { o0[r] *= alpha; o1[r] *= alpha; }
    const h16* vs = Vs + buf * 64 * 72 + l31 * 72 + 4 * hh;
#pragma unroll
    for (int k2 = 0; k2 < 2; ++k2) {
#pragma unroll
      for (int s2 = 0; s2 < 2; ++s2) {
        uint4 pu;
        if (k2 == 0) { pu.x = pk2(s0[8 * s2], s0[8 * s2 + 1]); pu.y = pk2(s0[8 * s2 + 2], s0[8 * s2 + 3]); pu.z = pk2(s0[8 * s2 + 4], s0[8 * s2 + 5]); pu.w = pk2(s0[8 * s2 + 6], s0[8 * s2 + 7]); }
        else { pu.x = pk2(s1[8 * s2], s1[8 * s2 + 1]); pu.y = pk2(s1[8 * s2 + 2], s1[8 * s2 + 3]); pu.z = pk2(s1[8 * s2 + 4], s1[8 * s2 + 5]); pu.w = pk2(s1[8 * s2 + 6], s1[8 * s2 + 7]); }
        h16x8 pf = __builtin_bit_cast(h16x8, pu);
        const int kb = k2 * 32 + 16 * s2;
        uint2 va = *(const uint2*)(vs + kb), vb = *(const uint2*)(vs + kb + 8);
        uint2 vc = *(const uint2*)(vs + 32 * 72 + kb), vd = *(const uint2*)(vs + 32 * 72 + kb + 8);
        h16x8 vf0 = __builtin_bit_cast(h16x8, make_uint4(va.x, va.y, vb.x, vb.y));
        h16x8 vf1 = __builtin_bit_cast(h16x8, make_uint4(vc.x, vc.y, vd.x, vd.y));
        o0 = __builtin_amdgcn_mfma_f32_32x32x16_f16(vf0, pf, o0, 0, 0, 0);
        o1 = __builtin_amdgcn_mfma_f32_32x32x16_f16(vf1, pf, o1, 0, 0, 0);
      }
    }
    if (kt + 1 < NKT) {
      h16* kd = Ks + (buf ^ 1) * 64 * 104;
      h16* vd = Vs + (buf ^ 1) * 64 * 72;
#pragma unroll
      for (int i = 0; i < 3; ++i) *(uint4*)(kd + krow[i] * 104 + kcol[i]) = gk[i];
#pragma unroll
      for (int i = 0; i < 2; ++i) *(uint4*)(vd + (vrow + 32 * i) * 72 + vcol) = gv[i];
    }
    __syncthreads();
  }
  const float ltot = lsum + __shfl_xor(lsum, 32);
  const float inv = 1.f / ltot;
  h16* yo = p.Z + (size_t)(q0 + wv * 32 + l31) * ZW + ZMLA + h * 64 + 4 * hh;
#pragma unroll
  for (int g = 0; g < 4; ++g) {
    st4h(yo + 8 * g, o0[4 * g] * inv, o0[4 * g + 1] * inv, o0[4 * g + 2] * inv, o0[4 * g + 3] * inv);
    st4h(yo + 32 + 8 * g, o1[4 * g] * inv, o1[4 * g + 1] * inv, o1[4 * g + 2] * inv, o1[4 * g + 3] * inv);
  }
}

struct Slot { float w[64], bb[64], ke[64], vv[64]; h16 ah[4][64]; int yoff; int pad[3]; };
DEVI void scan_job(const P& p, int l, int job, char* smem) {
  constexpr int RGB = 4 / NSCAN_BPC;
  Slot* sl = (Slot*)smem;
  const int tid = tidx(), lane = tid & 63, wv = tid >> 6;
  const int chain = job / NSCAN_BPC, part = job - chain * NSCAN_BPC;
  const int dir = chain >> 5, b = (chain >> 3) & 3, h = chain & 7;
  for (int i = tid; i < 32 * 128; i += 256) { int s = i >> 7, e = i & 127; sl[s].ah[2 + (e >> 6)][e & 63] = (h16)0.f; }
  const int st = tid >> 4, c4 = (tid & 15) * 4;
  const float4 kk4 = *(const float4*)(p.k_k + l * 512 + h * 64 + c4);
  const float4 ka4 = *(const float4*)(p.k_a + l * 512 + h * 64 + c4);
  const h16* LWd = p.LW + (size_t)dir * NR * 512 + h * 64 + c4;
  const h16* AAd = p.AA + (size_t)dir * NR * 512 + h * 64 + c4;
  const h16* Zr = p.Z + ZRW + h * 64 + c4;
  uint2 g_lw, g_a, g_k, g_v, g_r; float g_in; int g_yoff;
  auto gload = [&](int ci) {
    int n = ci * 16 + st;
    g_lw = make_uint2(0, 0); g_a = make_uint2(0, 0); g_k = make_uint2(0, 0); g_v = make_uint2(0, 0); g_r = make_uint2(0, 0); g_in = 0.f;
    if (n < SB) {
      int row = maprow(dir, b, n);
      g_lw = *(const uint2*)(LWd + (size_t)row * 512);
      g_a = *(const uint2*)(AAd + (size_t)row * 512);
      g_k = *(const uint2*)(Zr + (size_t)row * ZW + 512);
      g_v = *(const uint2*)(Zr + (size_t)row * ZW + 1024);
      g_in = p.INVN[(size_t)row * 8 + h];
    }
    g_yoff = -1;
    if (n >= 1 && n <= SB) {
      int row = maprow(dir, b, n - 1);
      g_r = *(const uint2*)(Zr + (size_t)row * ZW);
      g_yoff = row * 512;
    }
  };
  auto gstore = [&](int buf) {
    Slot& s = sl[buf * 16 + st];
    h16x4 lw = __builtin_bit_cast(h16x4, g_lw), a = __builtin_bit_cast(h16x4, g_a), k = __builtin_bit_cast(h16x4, g_k), v = __builtin_bit_cast(h16x4, g_v);
    const float kkp[4] = {kk4.x, kk4.y, kk4.z, kk4.w}, kap[4] = {ka4.x, ka4.y, ka4.z, ka4.w};
    float w4[4], b4[4], e4[4], v4[4], q4[4];
#pragma unroll
    for (int i = 0; i < 4; ++i) {
      float kf = (float)k[i], af = (float)a[i];
      float kkv = kf * kkp[i] * g_in;
      w4[i] = __expf(-(float)lw[i]);
      b4[i] = kkv * af;
      e4[i] = kf * (1.f + (af - 1.f) * kap[i]);
      v4[i] = (float)v[i];
      q4[i] = kkv;
    }
    *(float4*)(s.w + c4) = make_float4(w4[0], w4[1], w4[2], w4[3]);
    *(float4*)(s.bb + c4) = make_float4(b4[0], b4[1], b4[2], b4[3]);
    *(float4*)(s.ke + c4) = make_float4(e4[0], e4[1], e4[2], e4[3]);
    *(float4*)(s.vv + c4) = make_float4(v4[0], v4[1], v4[2], v4[3]);
    uint2 u; u.x = pk2n(q4[0], q4[1]); u.y = pk2n(q4[2], q4[3]);
    *(uint2*)(&s.ah[0][c4]) = u;
    *(uint2*)(&s.ah[1][c4]) = g_r;
    if ((tidx() & 15) == 0) s.yoff = g_yoff;
  };
  gload(0);
  gstore(0);
  __syncthreads();
  const int c = lane & 15, hq = lane >> 4;
  const int rg = part * RGB + wv;
  typedef float f2 __attribute__((ext_vector_type(2)));
  f2 S[8];
#pragma unroll
  for (int i = 0; i < 8; ++i) S[i] = (f2){0.f, 0.f};
  uint4 sh0 = make_uint4(0, 0, 0, 0), sh1 = make_uint4(0, 0, 0, 0);
  h16* ybase = p.Y2 + (size_t)dir * NR * 512 + h * 64 + rg * 16 + c;
  if (wv < RGB) __builtin_amdgcn_s_setprio(3);
  for (int ci = 0; ci < NCHUNK; ++ci) {
    const int buf = ci & 1;
    if (ci + 1 < NCHUNK) gload(ci + 1);
    if (wv < RGB) {
#pragma unroll 4
      for (int s = 0; s < 16; ++s) {
        const Slot& t = sl[buf * 16 + s];
        h16x8 A0 = *(const h16x8*)(&t.ah[c & 3][8 * hq]);
        h16x8 A1 = *(const h16x8*)(&t.ah[c & 3][32 + 8 * hq]);
        f32x4 acc = {0.f, 0.f, 0.f, 0.f};
        acc = __builtin_amdgcn_mfma_f32_16x16x32_f16(A0, __builtin_bit_cast(h16x8, sh0), acc, 0, 0, 0);
        acc = __builtin_amdgcn_mfma_f32_16x16x32_f16(A1, __builtin_bit_cast(h16x8, sh1), acc, 0, 0, 0);
        const int yo = t.yoff;
        if (lane < 16 && yo >= 0) ybase[yo] = (h16)acc[1];
        const float sa = -acc[0];
        const float vv = t.vv[rg * 16 + c];
        const f2 sa2 = (f2){sa, sa}, vv2 = (f2){vv, vv};
        const f2* wp = (const f2*)(t.w + 8 * hq); const f2* bp = (const f2*)(t.bb + 8 * hq); const f2* ep = (const f2*)(t.ke + 8 * hq);
#pragma unroll
        for (int i = 0; i < 4; ++i) {
          S[i] = S[i] * wp[i] + vv2 * ep[i] + sa2 * bp[i];
          S[4 + i] = S[4 + i] * wp[16 + i] + vv2 * ep[16 + i] + sa2 * bp[16 + i];
        }
        sh0.x = pk2(S[0].x, S[0].y); sh0.y = pk2(S[1].x, S[1].y); sh0.z = pk2(S[2].x, S[2].y); sh0.w = pk2(S[3].x, S[3].y);
        sh1.x = pk2(S[4].x, S[4].y); sh1.y = pk2(S[5].x, S[5].y); sh1.z = pk2(S[6].x, S[6].y); sh1.w = pk2(S[7].x, S[7].y);
      }
    }
    if (ci + 1 < NCHUNK) gstore(buf ^ 1);
    __syncthreads();
  }
  __builtin_amdgcn_s_setprio(0);
}

DEVI void gla_chunk_qk(const P& p, int dir, int b, int h, int ci, float* qi, float* ki, float* lg, const float* gku, const float* gkb, float* tot) {
  const int tid = tidx();
  const int ri = tid >> 2, dq = tid & 3;
  uint4 q0, q1, k0, k1;
  {
    const int row = maprow(dir, b, ci * 64 + ri);
    const h16* zr = p.Z + (size_t)row * ZW;
    q0 = *(const uint4*)(zr + h * 64 + dq * 16); q1 = *(const uint4*)(zr + h * 64 + dq * 16 + 8);
    k0 = *(const uint4*)(zr + 256 + h * 64 + dq * 16); k1 = *(const uint4*)(zr + 256 + h * 64 + dq * 16 + 8);
    uint4 g0 = *(const uint4*)(zr + 1024 + dir * 16), g1 = *(const uint4*)(zr + 1024 + dir * 16 + 8);
    h16x8 gh0 = __builtin_bit_cast(h16x8, g0), gh1 = __builtin_bit_cast(h16x8, g1);
    float gd[16];
#pragma unroll
    for (int j = 0; j < 8; ++j) { gd[j] = (float)gh0[j]; gd[8 + j] = (float)gh1[j]; }
#pragma unroll 4
    for (int dd = 0; dd < 16; ++dd) {
      const int d = dq * 16 + dd;
      float xx = gkb[d];
#pragma unroll
      for (int r = 0; r < 16; ++r) xx += gd[r] * gku[r * 64 + d];
      float ls = fminf(xx, 0.f) - log1pf(__expf(-fabsf(xx)));
      lg[ri * 65 + d] = ls * (1.f / 16.f);
    }
  }
  __syncthreads();
  {
    const int d = tid & 63, part = tid >> 6;
    float run = 0.f;
#pragma unroll 4
    for (int ii = 0; ii < 16; ++ii) { const int i = part * 16 + ii; run += lg[i * 65 + d]; lg[i * 65 + d] = run; }
    tot[part * 64 + d] = run;
  }
  __syncthreads();
  {
    h16x8 qh0 = __builtin_bit_cast(h16x8, q0), qh1 = __builtin_bit_cast(h16x8, q1), kh0 = __builtin_bit_cast(h16x8, k0), kh1 = __builtin_bit_cast(h16x8, k1);
    const int part = ri >> 4;
#pragma unroll
    for (int dd = 0; dd < 16; ++dd) {
      const int d = dq * 16 + dd;
      float off = 0.f;
      if (part > 0) off += tot[d];
      if (part > 1) off += tot[64 + d];
      if (part > 2) off += tot[128 + d];
      const float bb = lg[ri * 65 + d] + off;
      const float qv = dd < 8 ? (float)qh0[dd & 7] : (float)qh1[dd & 7];
      const float kv = dd < 8 ? (float)kh0[dd & 7] : (float)kh1[dd & 7];
      qi[ri * 65 + d] = qv * __expf(bb) * 0.125f;
      ki[ri * 65 + d] = kv * __expf(-bb);
    }
  }
  __syncthreads();
}

DEVI void gla_pre_job(const P& p, int l, int job, char* smem) {
  float* qi = (float*)smem;
  float* ki = qi + 64 * 65;
  float* att = ki + 64 * 65;
  float* vs = att + 64 * 65;
  float* gku = vs + 64 * 65;
  float* gkb = gku + 1024;
  float* tot = gkb + 64;
  const int tid = tidx();
  const int chain = job / 68, ci = job - chain * 68;
  const int dir = chain >> 4, b = (chain >> 2) & 3, h = chain & 3;
  for (int i = tid; i < 1024; i += 256) gku[i] = p.gk_up[(((size_t)l * 2 + dir) * 16 + (i >> 6)) * 256 + h * 64 + (i & 63)];
  if (tid < 64) gkb[tid] = p.gk_b[((size_t)l * 2 + dir) * 256 + h * 64 + tid];
  __syncthreads();
  gla_chunk_qk(p, dir, b, h, ci, qi, ki, att, gku, gkb, tot);
  const int ti = tid >> 4, tj = tid & 15;
  {
    float a[4][4];
#pragma unroll
    for (int x = 0; x < 4; ++x)
#pragma unroll
      for (int y = 0; y < 4; ++y) a[x][y] = 0.f;
    if (tj <= ti) {
#pragma unroll 2
      for (int d = 0; d < 64; ++d) {
        float qa[4], kb[4];
#pragma unroll
        for (int x = 0; x < 4; ++x) { qa[x] = qi[(4 * ti + x) * 65 + d]; kb[x] = ki[(4 * tj + x) * 65 + d]; }
#pragma unroll
        for (int x = 0; x < 4; ++x)
#pragma unroll
          for (int y = 0; y < 4; ++y) a[x][y] += qa[x] * kb[y];
      }
    }
#pragma unroll
    for (int x = 0; x < 4; ++x)
#pragma unroll
      for (int y = 0; y < 4; ++y) att[(4 * ti + x) * 65 + 4 * tj + y] = (4 * tj + y <= 4 * ti + x) ? a[x][y] : 0.f;
  }
  const int ri = tid >> 2, dq = tid & 3;
  const int vrow = maprow(dir, b, ci * 64 + ri);
  h16* Od = p.OFB + (size_t)dir * NR * 512 + h * 128;
#pragma unroll 1
  for (int half = 0; half < 2; ++half) {
    {
      const h16* zv = p.Z + (size_t)vrow * ZW + 512 + h * 128 + half * 64 + dq * 16;
      h16x8 v0 = *(const h16x8*)zv, v1 = *(const h16x8*)(zv + 8);
#pragma unroll
      for (int j = 0; j < 8; ++j) { vs[ri * 65 + dq * 16 + j] = (float)v0[j]; vs[ri * 65 + dq * 16 + 8 + j] = (float)v1[j]; }
    }
    __syncthreads();
    float o[4][4];
#pragma unroll
    for (int x = 0; x < 4; ++x)
#pragma unroll
      for (int y = 0; y < 4; ++y) o[x][y] = 0.f;
    const int smax = 4 * ti + 3;
#pragma unroll 2
    for (int s2 = 0; s2 <= smax; ++s2) {
      float aa[4], vv[4];
#pragma unroll
      for (int x = 0; x < 4; ++x) { aa[x] = att[(4 * ti + x) * 65 + s2]; vv[x] = vs[s2 * 65 + 4 * tj + x]; }
#pragma unroll
      for (int x = 0; x < 4; ++x)
#pragma unroll
        for (int y = 0; y < 4; ++y) o[x][y] += aa[x] * vv[y];
    }
#pragma unroll
    for (int x = 0; x < 4; ++x) {
      const int row = maprow(dir, b, ci * 64 + 4 * ti + x);
      st4h(Od + (size_t)row * 512 + half * 64 + 4 * tj, o[x][0], o[x][1], o[x][2], o[x][3]);
    }
    __syncthreads();
  }
}

DEVI void gla_job(const P& p, int l, int job, char* smem) {
  float* qi = (float*)smem;
  float* ki = qi + 64 * 65;
  float* lg = ki + 64 * 65;
  float* vs = lg + 64 * 65;
  float* Ss = vs + 64 * 33;
  float* gku = Ss + 64 * 33;
  float* gkb = gku + 1024;
  float* tot = gkb + 64;
  const int tid = tidx();
  const int dvs = job & 3, chain = job >> 2;
  const int dir = chain >> 4, b = (chain >> 2) & 3, h = chain & 3;
  for (int i = tid; i < 64 * 33; i += 256) Ss[i] = 0.f;
  for (int i = tid; i < 1024; i += 256) gku[i] = p.gk_up[(((size_t)l * 2 + dir) * 16 + (i >> 6)) * 256 + h * 64 + (i & 63)];
  if (tid < 64) gkb[tid] = p.gk_b[((size_t)l * 2 + dir) * 256 + h * 64 + tid];
  __syncthreads();
  const int ri = tid >> 2, dq = tid & 3;
  const int t2 = tid >> 3, tj = tid & 7;
  h16* Od = p.OFB + (size_t)dir * NR * 512 + h * 128 + dvs * 32;
  for (int ci = 0; ci < SB / 64; ++ci) {
    const int rowa = maprow(dir, b, ci * 64 + 2 * t2), rowb = maprow(dir, b, ci * 64 + 2 * t2 + 1);
    const uint2 oia = *(const uint2*)(Od + (size_t)rowa * 512 + 4 * tj), oib = *(const uint2*)(Od + (size_t)rowb * 512 + 4 * tj);
    {
      const int row = maprow(dir, b, ci * 64 + ri);
      uint4 vv = *(const uint4*)(p.Z + (size_t)row * ZW + 512 + h * 128 + dvs * 32 + dq * 8);
      h16x8 vh = __builtin_bit_cast(h16x8, vv);
#pragma unroll
      for (int j = 0; j < 8; ++j) vs[ri * 33 + dq * 8 + j] = (float)vh[j];
    }
    gla_chunk_qk(p, dir, b, h, ci, qi, ki, lg, gku, gkb, tot);
    {
      h16x4 ha = __builtin_bit_cast(h16x4, oia), hb = __builtin_bit_cast(h16x4, oib);
      float a0[4], a1[4];
#pragma unroll
      for (int y = 0; y < 4; ++y) { a0[y] = (float)ha[y]; a1[y] = (float)hb[y]; }
#pragma unroll 4
      for (int d = 0; d < 64; ++d) {
        const float x0 = qi[(2 * t2) * 65 + d], x1 = qi[(2 * t2 + 1) * 65 + d];
#pragma unroll
        for (int y = 0; y < 4; ++y) { const float v = Ss[d * 33 + 4 * tj + y]; a0[y] += x0 * v; a1[y] += x1 * v; }
      }
      st4h(Od + (size_t)rowa * 512 + 4 * tj, a0[0], a0[1], a0[2], a0[3]);
      st4h(Od + (size_t)rowb * 512 + 4 * tj, a1[0], a1[1], a1[2], a1[3]);
    }
    __syncthreads();
    {
      float a0[4], a1[4];
#pragma unroll
      for (int y = 0; y < 4; ++y) { a0[y] = Ss[(2 * t2) * 33 + 4 * tj + y]; a1[y] = Ss[(2 * t2 + 1) * 33 + 4 * tj + y]; }
#pragma unroll 4
      for (int s2 = 0; s2 < 64; ++s2) {
        const float x0 = ki[s2 * 65 + 2 * t2], x1 = ki[s2 * 65 + 2 * t2 + 1];
#pragma unroll
        for (int y = 0; y < 4; ++y) { const float v = vs[s2 * 33 + 4 * tj + y]; a0[y] += x0 * v; a1[y] += x1 * v; }
      }
      const float e0 = __expf(tot[2 * t2] + tot[64 + 2 * t2] + tot[128 + 2 * t2] + tot[192 + 2 * t2]);
      const float e1 = __expf(tot[2 * t2 + 1] + tot[64 + 2 * t2 + 1] + tot[128 + 2 * t2 + 1] + tot[192 + 2 * t2 + 1]);
#pragma unroll
      for (int y = 0; y < 4; ++y) { Ss[(2 * t2) * 33 + 4 * tj + y] = a0[y] * e0; Ss[(2 * t2 + 1) * 33 + 4 * tj + y] = a1[y] * e1; }
    }
    __syncthreads();
  }
}

DEVI void mixer_phase(const P& p, int l, char* smem, int cslot) {
  __shared__ int4 sjobv;
  int& sjob = sjobv.x;
  for (int j = blockIdx.x; j < NSCAN + NGLA; j += gridDim.x) {
    if (j < NSCAN) scan_job(p, l, j, smem);
    else gla_job(p, l, j - NSCAN, smem);
    __syncthreads();
  }
  const int njobs = (l < DEPTH - 1) ? 1024 + 64 : 1024;
  while (true) {
    if (tidx() == 0) sjob = (int)atomicAdd(p.CTR + cslot, 1u);
    __syncthreads();
    const int j = sjob;
    __syncthreads();
    if (j >= njobs) break;
    attn_job(p, j, smem);
  }
}

DEVI void post_phase(const P& p, int l) {
  const int lane = tidx() & 63;
  const int wid = blockIdx.x * 4 + (tidx() >> 6), nw = gridDim.x * 4;
  const int c8 = lane * 8;
  for (int r = wid; r < NR; r += nw) {
    {
      h16* zr = p.Z + (size_t)r * ZW + ZRW + c8;
      h16x8 yf = *(const h16x8*)(p.Y2 + (size_t)r * 512 + c8), yb = *(const h16x8*)(p.Y2 + (size_t)(NR + r) * 512 + c8);
      h16x8 rr = *(const h16x8*)zr, kk = *(const h16x8*)(zr + 512), vv = *(const h16x8*)(zr + 1024);
      h16x8 af = *(const h16x8*)(p.AA + (size_t)r * 512 + c8), ab = *(const h16x8*)(p.AA + (size_t)(NR + r) * 512 + c8);
      h16x8 gg = *(const h16x8*)(p.G + (size_t)r * 512 + c8);
      float y[8], sm = 0.f;
#pragma unroll
      for (int i = 0; i < 8; ++i) { y[i] = (float)yf[i] + (float)yb[i]; sm += y[i]; }
      sm += __shfl_xor(sm, 1); sm += __shfl_xor(sm, 2); sm += __shfl_xor(sm, 4);
      const float mean = sm * (1.f / 64.f);
      float sq = 0.f;
#pragma unroll
      for (int i = 0; i < 8; ++i) { y[i] -= mean; sq += y[i] * y[i]; }
      sq += __shfl_xor(sq, 1); sq += __shfl_xor(sq, 2); sq += __shfl_xor(sq, 4);
      const float rs = rsqrtf(sq * (1.f / 64.f) + 64e-5f);
      const float* ka = p.k_a + l * 512 + c8; const float* rk = p.r_k + l * 512 + c8;
      const float* lg = p.rln_g + l * 512 + c8; const float* lb = p.rln_b + l * 512 + c8;
      float bs = 0.f;
#pragma unroll
      for (int i = 0; i < 8; ++i) {
        const float kf = (float)kk[i], kav = ka[i];
        const float ke = kf * (1.f + ((float)af[i] - 1.f) * kav) + kf * (1.f + ((float)ab[i] - 1.f) * kav);
        bs += (float)rr[i] * ke * rk[i];
      }
      bs += __shfl_xor(bs, 1); bs += __shfl_xor(bs, 2); bs += __shfl_xor(bs, 4);
      float o[8];
#pragma unroll
      for (int i = 0; i < 8; ++i) o[i] = (y[i] * rs * lg[i] + lb[i] + bs * (float)vv[i]) * (float)gg[i];
      uint4 u; u.x = pk2n(o[0], o[1]); u.y = pk2n(o[2], o[3]); u.z = pk2n(o[4], o[5]); u.w = pk2n(o[6], o[7]);
      *(uint4*)zr = u;
    }
    {
      h16x8 of = *(const h16x8*)(p.OFB + (size_t)r * 512 + c8), ob = *(const h16x8*)(p.OFB + (size_t)(NR + r) * 512 + c8);
      h16x8 og = *(const h16x8*)(p.Z + (size_t)r * ZW + 1056 + c8);
      float o[8], sq = 0.f;
#pragma unroll
      for (int i = 0; i < 8; ++i) { o[i] = (float)of[i] + (float)ob[i]; sq += o[i] * o[i]; }
      sq += __shfl_xor(sq, 1); sq += __shfl_xor(sq, 2); sq += __shfl_xor(sq, 4); sq += __shfl_xor(sq, 8);
      const float rs = rsqrtf(sq * (1.f / 128.f) + 1e-6f);
      const float* ng = p.gla_ng + l * 128 + (c8 & 127);
#pragma unroll
      for (int i = 0; i < 8; ++i) { const float g = (float)og[i]; o[i] = o[i] * rs * ng[i] * (g * sigm(g)); }
      uint4 u; u.x = pk2n(o[0], o[1]); u.y = pk2n(o[2], o[3]); u.z = pk2n(o[4], o[5]); u.w = pk2n(o[6], o[7]);
      *(uint4*)(p.YA + (size_t)r * 512 + c8) = u;
    }
  }
}

DEVI void merge_phase(const P& p, char* smem) {
  constexpr int MT = NR / 128, NT = 16;
  const int lane = tidx() & 63, wv = tidx() >> 6;
  const int wm = wv >> 1, wn = wv & 1, l31 = lane & 31, hh = lane >> 5;
  for (int job = blockIdx.x; job < MT * NT; job += gridDim.x) {
    int nt = job / MT, mt = job - nt * MT;
    float out[2][16];
#pragma unroll
    for (int a = 0; a < 2; ++a)
#pragma unroll
      for (int r = 0; r < 16; ++r) out[a][r] = 0.f;
#pragma unroll 1
    for (int br = 0; br < 3; ++br) {
      const h16* Y = br == 0 ? p.YA : (br == 1 ? p.Z + ZMLA : p.Z + ZRW);
      const int ldy = br == 0 ? 512 : ZW;
      f32x16 acc[2][1];
#pragma unroll
      for (int a = 0; a < 2; ++a)
#pragma unroll
        for (int r = 0; r < 16; ++r) acc[a][0][r] = 0.f;
      gemm_main<false, 1>(Y, ldy, p.WB + (size_t)br * D * 512, 512, 512, mt * 128, nt * 64, D, smem, acc, nullptr);
      float u[2][16];
#pragma unroll
      for (int a = 0; a < 2; ++a)
#pragma unroll
        for (int r = 0; r < 16; ++r) { u[a][r] = acc[a][0][r]; acc[a][0][r] = 0.f; }
      gemm_main<false, 1>(p.H, D, p.WIN + (size_t)(ZW + br * D) * D, D, D, mt * 128, nt * 64, D, smem, acc, nullptr);
#pragma unroll
      for (int a = 0; a < 2; ++a)
#pragma unroll
        for (int r = 0; r < 16; ++r) out[a][r] += sigm(acc[a][0][r]) * u[a][r];
    }
#pragma unroll
    for (int a = 0; a < 2; ++a)
#pragma unroll
      for (int g = 0; g < 4; ++g)
        st4h(p.M + (size_t)(mt * 128 + wm * 64 + a * 32 + l31) * D + nt * 64 + wn * 32 + 8 * g + 4 * hh, out[a][4 * g], out[a][4 * g + 1],
             out[a][4 * g + 2], out[a][4 * g + 3]);
  }
}

DEVI void resid_gemm_phase(const P& p, int l, const h16* A, int K, const h16* Bt, int gate_idx, char* smem) {
  constexpr int MT = NR / 128, NT = 8;
  const float alpha = 1.6817928305074290f;
  for (int job = blockIdx.x; job < MT * NT; job += gridDim.x) {
    int nt = job / MT, mt = job - nt * MT;
    f32x16 acc[2][2]; zero_acc(acc);
    gemm_main<false>(A, K, Bt, K, K, mt * 128, nt * 128, D, smem, acc, nullptr);
    epi_quads(acc, mt * 128, nt * 128, [&](int m, int n, float v0, float v1, float v2, float v3) {
      int b = m / SB, s = m - b * SB;
      int g = s < CTX ? 4 : b;
      float4 gt = *(const float4*)(p.MOD + ((size_t)l * 5 + g) * 6144 + gate_idx * D + n);
      float* xp = xrow(p, m) + n;
      float4 xv = *(float4*)xp;
      xv.x = alpha * xv.x + gt.x * v0; xv.y = alpha * xv.y + gt.y * v1; xv.z = alpha * xv.z + gt.z * v2; xv.w = alpha * xv.w + gt.w * v3;
      *(float4*)xp = xv;
    });
  }
}
DEVI void mlp1_phase(const P& p, char* smem) {
  constexpr int MT = NR / 128, NT = DFF / 128;
  h16* HID = p.Z;
  for (int job = blockIdx.x; job < MT * NT; job += gridDim.x) {
    int nt = job / MT, mt = job - nt * MT;
    f32x16 acc[2][2]; zero_acc(acc);
    gemm_main<false>(p.H, D, p.W1T, D, D, mt * 128, nt * 128, DFF, smem, acc, nullptr);
    epi_quads(acc, mt * 128, nt * 128, [&](int m, int n, float v0, float v1, float v2, float v3) {
      v0 = fmaxf(v0, 0.f); v1 = fmaxf(v1, 0.f); v2 = fmaxf(v2, 0.f); v3 = fmaxf(v3, 0.f);
      st4h(HID + (size_t)m * DFF + n, v0 * v0, v1 * v1, v2 * v2, v3 * v3);
    });
  }
}

constexpr int PH_PER_LAYER = 11;
constexpr int NPHASES = 1 + DEPTH * PH_PER_LAYER + 1;

DEVI void run_phase(const P& p, int ph, char* smem) {
  if (ph == 0) { phase0(p, smem); return; }
  if (ph == NPHASES - 1) { ln_phase(p, DEPTH, 2); return; }
  const int l = (ph - 1) / PH_PER_LAYER, k = (ph - 1) - l * PH_PER_LAYER;
  switch (k) {
    case 0: ln_phase(p, l, 0); conv_phase(p, l, 0, 12, smem); break;
    case 1: inproj_phase(p, smem);
#if PROBE == 2
      inproj_phase(p, smem);
#endif
      break;
    case 2: {
      constexpr int NSH = NR / 64, NUP = (NR / 128) * 14;
      for (int j = blockIdx.x; j < NSH + NUP; j += gridDim.x) {
        if (j < NSH) shift_job(p, l, j, smem); else mla_up_job(p, j - NSH, smem);
        __syncthreads();
      }
    } break;
    case 3: {
      constexpr int NPRE = 32 * 68, NLR = 5 * 4 * (NR / 128);
      for (int j = blockIdx.x; j < NPRE + NLR; j += gridDim.x) {
        if (j < NPRE) gla_pre_job(p, l, j, smem); else lowrank_job(p, l, j - NPRE, smem);
        __syncthreads();
      }
    } break;
    case 4: mixer_phase(p, l, smem, l);
#if PROBE == 1
      mixer_phase(p, l, smem, 8 + l);
#endif
      break;
    case 5: post_phase(p, l); break;
    case 6: merge_phase(p, smem); conv_phase(p, l, 12, 14, smem); break;
    case 7: resid_gemm_phase(p, l, p.M, D, p.WO, 2, smem); break;
    case 8: ln_phase(p, l, 1); break;
    case 9: mlp1_phase(p, smem);
#if PROBE == 2
      mlp1_phase(p, smem);
#endif
      break;
    default: resid_gemm_phase(p, l, p.Z, DFF, p.W2T, 5, smem); break;
  }
}

__global__ void __launch_bounds__(256, 2) mega(P p, int pb, int pe) {
  extern __shared__ __attribute__((aligned(16))) char smem[];
  cg::grid_group grid = cg::this_grid();
  __shared__ uint4 xb_words;
  if (threadIdx_x_raw() == 0) xb_words = make_uint4(0u, 0u, 0u, 0u);
  __syncthreads();
  XcdBarrier xb = xcd_barrier_post(p.BAR, (volatile LAS unsigned*)&xb_words);
  for (int ph = pb; ph < pe; ++ph) {
    if (ph > pb) { if (ph == pb + 1) grid.sync(); else xcd_barrier(xb); }
    run_phase(p, ph, smem);
  }
}

extern "C" void kernel_launch(void* const* d_in, const int* in_sizes, int n_in, void* d_out, int out_size, void* d_ws,
                              size_t ws_size, hipStream_t stream) {
  static int grid_blocks = 0;
  if (grid_blocks == 0) {
    int dev = 0, cus = 0, per_cu = 0;
    hipGetDevice(&dev);
    hipDeviceGetAttribute(&cus, hipDeviceAttributeMultiprocessorCount, dev);
    hipFuncSetAttribute((const void*)mega, hipFuncAttributeMaxDynamicSharedMemorySize, LDS_BYTES);
    hipOccupancyMaxActiveBlocksPerMultiprocessor(&per_cu, (const void*)mega, 256, LDS_BYTES);
    if (per_cu < 1) per_cu = 1;
    if (per_cu > 2) per_cu = 2;
    grid_blocks = cus * per_cu;
    fprintf(stderr, "mega: cus %d per_cu %d grid %d\n", cus, per_cu, grid_blocks);
  }
  P p{};
  const float** ins = (const float**)&p;
  for (int i = 0; i < 33; ++i) ins[i] = (const float*)d_in[i];
  char* w = (char*)d_ws;
  size_t off = 0;
  auto take = [&](size_t bytes) { char* r = w + off; off += (bytes + 255) & ~(size_t)255; return r; };
  p.XL = (float*)d_out;
  p.XC = (float*)take((size_t)NB * CTX * D * 4);
  p.MOD = (float*)take((size_t)DEPTH * 5 * 6144 * 4);
  p.ROPE = (float*)take((size_t)SEQ * 32 * 4);
  p.INVN = (float*)take((size_t)NR * 8 * 4);
  p.CTR = (unsigned*)take(256);
  p.BAR = (unsigned*)take((size_t)XCD_BAR_WORDS * 4);
  p.HLO = (h16*)take((size_t)(NR / 64) * 1920 * 2);
  p.HHI = (h16*)take((size_t)(NR / 64) * 1920 * 2);
  p.H = (h16*)take((size_t)NR * D * 2);
  p.Z = (h16*)take((size_t)NR * ZW * 2);
  p.WIN = (h16*)take((size_t)NIN * D * 2);
  p.UQ = (h16*)take((size_t)768 * 384 * 2);
  p.UKV = (h16*)take((size_t)1024 * 256 * 2);
  p.WB = (h16*)take((size_t)3 * D * 512 * 2);
  p.WO = (h16*)take((size_t)D * D * 2);
  p.WUP = (h16*)take((size_t)2 * 512 * 64 * 2);
  p.AUP = (h16*)take((size_t)2 * 512 * 64 * 2);
  p.GUP = (h16*)take((size_t)512 * 128 * 2);
  p.LW = (h16*)take((size_t)2 * NR * 512 * 2);
  p.AA = (h16*)take((size_t)2 * NR * 512 * 2);
  p.W1T = p.LW;
  p.W2T = p.LW + (size_t)DFF * D;
  p.G = (h16*)take((size_t)NR * 512 * 2);
  p.Y2 = (h16*)take((size_t)2 * NR * 512 * 2);
  p.Q = (h16*)take((size_t)NR * 768 * 2);
  p.K = (h16*)take((size_t)NR * 768 * 2);
  p.M = p.Q;
  p.VT = (h16*)take((size_t)NR * 512 * 2);
  p.YA = (h16*)take((size_t)NR * 512 * 2);
  p.OFB = (h16*)take((size_t)2 * NR * 512 * 2);
  if (off > ws_size || n_in != 33) { fprintf(stderr, "mega: workspace too small (%zu > %zu) or n_in %d\n", off, ws_size, n_in); return; }
  (void)hipMemsetAsync(p.BAR, 0, (size_t)XCD_BAR_WORDS * 4, stream);
  int pb = 0, pe = NPHASES;
  void* args[] = {&p, &pb, &pe};
  hipError_t e = hipLaunchCooperativeKernel((const void*)mega, dim3(grid_blocks), dim3(256), args, LDS_BYTES, stream);
  if (e != hipSuccess) fprintf(stderr, "mega: cooperative launch failed: %s (grid %d)\n", hipGetErrorString(e), grid_blocks);
}
```

```cpp
#include <hip/hip_runtime.h>
#include <hip/hip_cooperative_groups.h>
#include <cstdio>
#include <cstdint>
namespace cg = cooperative_groups;

typedef _Float16 h16;
typedef _Float16 h16x8 __attribute__((ext_vector_type(8)));
typedef _Float16 h16x4 __attribute__((ext_vector_type(4)));
typedef float f32x16 __attribute__((ext_vector_type(16)));
typedef float f32x4 __attribute__((ext_vector_type(4)));

#define DEVI __device__ __forceinline__
DEVI int threadIdx_x_raw() { return (int)__builtin_amdgcn_workitem_id_x(); }

#define PROBE 0
constexpr int D = 1024, NB = 4, SEQ = 4096, CTX = 256, DEPTH = 4;
constexpr int SB = SEQ + CTX;
constexpr int NR = NB * SB;
constexpr int ZW = 4160;
constexpr int ZMLA = 1568, ZRW = 2240;
constexpr int NIN = 7232;
constexpr int DFF = 4096;
constexpr int LDS_BYTES = 74752;
constexpr int NSCAN_BPC = 2;
constexpr int NSCAN = 64 * NSCAN_BPC;
constexpr int NGLA = 128;
constexpr int TSTEPS = SB + 1;
constexpr int NCHUNK = (TSTEPS + 15) / 16;

struct P {
  const float *x, *c, *ctx, *c_ctx, *ada_w, *ada_b, *w_in, *gk_up, *gk_b, *gla_ng, *qn_g, *kvn_g, *w_uq, *w_ukv,
      *mu, *w0, *w_up, *a0, *a_up, *g_up, *k_k, *k_a, *r_k, *rln_g, *rln_b, *w_branch, *w_out, *ln1_g, *ln1_b,
      *w1, *w2, *ln2_g, *ln2_b;
  float *XL, *XC, *MOD, *ROPE, *INVN;
  unsigned* CTR;
  unsigned* BAR;
  h16 *HLO, *HHI, *H, *Z, *WIN, *UQ, *UKV, *WB, *WO, *WUP, *AUP, *GUP, *LW, *AA, *G, *Y2, *Q, *K, *VT, *YA, *OFB, *W1T, *W2T, *M;
  unsigned short *QIN, *KIN;
  float* DEC;
};

DEVI int tidx() { int t = threadIdx_x_raw(); asm volatile("" : "+v"(t)); return t; }
DEVI float wsum(float v) {
#pragma unroll
  for (int o = 32; o; o >>= 1) v += __shfl_xor(v, o);
  return v;
}
DEVI float sigm(float x) { return 1.f / (1.f + __expf(-x)); }
DEVI unsigned pk2(float a, float b) {
  auto h = __builtin_amdgcn_cvt_pkrtz(a, b);
  return __builtin_bit_cast(unsigned, h);
}
DEVI unsigned pk2n(float a, float b) {
  h16 x = (h16)a, y = (h16)b;
  unsigned short ux = __builtin_bit_cast(unsigned short, x), uy = __builtin_bit_cast(unsigned short, y);
  return (unsigned)ux | ((unsigned)uy << 16);
}
DEVI unsigned f2bf(float f) { unsigned u = __builtin_bit_cast(unsigned, f); u += 0x7fffu + ((u >> 16) & 1u); return u >> 16; }
DEVI float h2f(unsigned short u) { return (float)__builtin_bit_cast(h16, u); }
DEVI void st4h(h16* dst, float a, float b, float c, float d) {
  uint2 u; u.x = pk2n(a, b); u.y = pk2n(c, d);
  *(uint2*)dst = u;
}
DEVI float* xrow(const P& p, int r) {
  int b = r / SB, s = r - b * SB;
  return s < CTX ? p.XC + (size_t)(b * CTX + s) * D : p.XL + (size_t)(b * SEQ + s - CTX) * D;
}
DEVI int maprow(int dir, int b, int n) {
  if (dir == 0) return b * SB + n;
  return n < CTX ? b * SB + (CTX - 1 - n) : b * SB + (SB + CTX - 1 - n);
}


#define XB_TMO      128
#define XB_XCNT(j)  (256  + 64 * (j))
#define XB_XSUB(j)  (1280 + 64 * (j))
#define XB_XGEN(j)  (2304 + 64 * (j))
#define XB_TOP      3328
#define XB_TOPGEN   3392
#define XCD_BAR_WORDS 3456
#define XB_SPIN_CAP (1u << 22)
#define LAS __attribute__((address_space(3)))
DEVI unsigned xb_ld(unsigned* p) { return __hip_atomic_load(p, __ATOMIC_RELAXED, __HIP_MEMORY_SCOPE_AGENT); }
DEVI unsigned xb_add(unsigned* p, unsigned v) { return __hip_atomic_fetch_add(p, v, __ATOMIC_RELAXED, __HIP_MEMORY_SCOPE_AGENT); }
DEVI unsigned xb_xcc_id() { return (unsigned)__builtin_amdgcn_s_getreg((3 << 11) | 20) & 0xFu; }
#define XB_SPIN(cond, bar) do { unsigned _sp = 0; while (cond) { __builtin_amdgcn_s_sleep(1); \
    if ((++_sp & 255u) == 0u) { if (xb_ld(&(bar)[XB_TMO])) break; if (_sp > XB_SPIN_CAP) { atomicAdd(&(bar)[XB_TMO], 1u); break; } } } } while (0)
struct XcdBarrier { unsigned* bar; unsigned x; volatile LAS unsigned* st; };
DEVI XcdBarrier xcd_barrier_post(unsigned* bar, volatile LAS unsigned* st) {
  XcdBarrier b; b.bar = bar; b.x = xb_xcc_id(); b.st = st;
  if (threadIdx_x_raw() == 0) (void)xb_add(&bar[XB_XCNT(b.x)], 1u);
  return b;
}
DEVI void xcd_barrier_complete(unsigned* bar, unsigned x, unsigned& nloc, unsigned& nx) {
  const unsigned G = gridDim.x;
  unsigned sum, cnt, mine, sp = 0u;
  for (;;) {
    sum = 0u; cnt = 0u; mine = 0u;
#pragma unroll
    for (unsigned j = 0; j < 16; ++j) { const unsigned c = xb_ld(&bar[XB_XCNT(j)]); sum += c; cnt += (c > 0u) ? 1u : 0u; mine = (j == x) ? c : mine; }
    if (sum == G) break;
    __builtin_amdgcn_s_sleep(1);
    if ((++sp & 255u) == 0u) { if (xb_ld(&bar[XB_TMO])) break; if (sp > XB_SPIN_CAP) { atomicAdd(&bar[XB_TMO], 1u); break; } }
  }
  nloc = mine > 0u ? mine : 1u; nx = cnt > 0u ? cnt : 1u;
}
DEVI void xcd_barrier(const XcdBarrier& b) {
  asm volatile("s_waitcnt vmcnt(0)" ::: "memory");
  __syncthreads();
  if (threadIdx_x_raw() == 0) {
    unsigned* bar = b.bar;
    __builtin_amdgcn_s_waitcnt(0);
    unsigned nloc = b.st[0], nx = b.st[1];
    if (nloc == 0u) { xcd_barrier_complete(bar, b.x, nloc, nx); b.st[0] = nloc; b.st[1] = nx; }
    const unsigned old = xb_add(&bar[XB_XSUB(b.x)], 1u);
    const unsigned gen = old / nloc;
    if (old + 1u == (gen + 1u) * nloc) {
      __builtin_amdgcn_fence(__ATOMIC_RELEASE, "agent");
      asm volatile("s_waitcnt vmcnt(0)" ::: "memory");
      const unsigned og = xb_add(&bar[XB_TOP], 1u);
      const unsigned tg = og / nx;
      if (og + 1u == (tg + 1u) * nx) xb_add(&bar[XB_TOPGEN], 1u);
      else XB_SPIN(xb_ld(&bar[XB_TOPGEN]) == tg, bar);
      __builtin_amdgcn_fence(__ATOMIC_ACQUIRE, "agent");
      xb_add(&bar[XB_XGEN(b.x)], 1u);
      asm volatile("s_waitcnt vmcnt(0)" ::: "memory");
    } else {
      XB_SPIN(xb_ld(&bar[XB_XGEN(b.x)]) == gen, bar);
      __builtin_amdgcn_fence(__ATOMIC_ACQUIRE, "agent");
      asm volatile("s_waitcnt vmcnt(0)" ::: "memory");
    }
  }
  __syncthreads();
}

DEVI void phase0(const P& p, char* smem) {
  const int tid = tidx();
  float* sc = (float*)smem;
  float* red = sc + 5 * 1024;
  for (int i = tid; i < 5 * 1024; i += 256) {
    int g = i >> 10, k = i & 1023;
    float v = g < 4 ? p.c[g * D + k] : p.c_ctx[k];
    sc[i] = v * sigm(v);
  }
  __syncthreads();
  for (int job = blockIdx.x; job < DEPTH * 96; job += gridDim.x) {
    int l = job / 96, n0 = (job % 96) * 64;
    int kq = tid >> 6, cc = tid & 63;
    const float* w = p.ada_w + ((size_t)l * D + kq * 256) * 6144 + n0 + cc;
    float a0 = 0, a1 = 0, a2 = 0, a3 = 0, a4 = 0;
#pragma unroll 8
    for (int k = 0; k < 256; ++k) {
      float wv = w[(size_t)k * 6144];
      int kk = kq * 256 + k;
      a0 += sc[kk] * wv; a1 += sc[1024 + kk] * wv; a2 += sc[2048 + kk] * wv; a3 += sc[3072 + kk] * wv; a4 += sc[4096 + kk] * wv;
    }
    red[(kq * 5 + 0) * 64 + cc] = a0; red[(kq * 5 + 1) * 64 + cc] = a1; red[(kq * 5 + 2) * 64 + cc] = a2;
    red[(kq * 5 + 3) * 64 + cc] = a3; red[(kq * 5 + 4) * 64 + cc] = a4;
    __syncthreads();
    for (int i = tid; i < 320; i += 256) {
      int g = i >> 6, c2 = i & 63;
      float s = red[(0 * 5 + g) * 64 + c2] + red[(1 * 5 + g) * 64 + c2] + red[(2 * 5 + g) * 64 + c2] + red[(3 * 5 + g) * 64 + c2];
      p.MOD[((size_t)l * 5 + g) * 6144 + n0 + c2] = s + p.ada_b[l * 6144 + n0 + c2];
    }
    __syncthreads();
  }
  for (int i = blockIdx.x * 256 + tid; i < SEQ * 16; i += gridDim.x * 256) {
    int s = i >> 4, j = i & 15;
    float pos = (float)(j < 8 ? (s >> 6) : (s & 63));
    float inv = exp2f(-(float)(j & 7) * (13.287712379549449f / 8.f));
    float ang = pos * inv;
    p.ROPE[s * 32 + j] = cosf(ang);
    p.ROPE[s * 32 + 16 + j] = sinf(ang);
  }
  if (blockIdx.x == 0 && tid < 64) p.CTR[tid] = 0;
}

struct CE { const float* src; h16* dst; const float* scale; int K, N; };
DEVI CE get_ce(const P& p, int l, int e) {
  CE c; c.scale = nullptr;
  switch (e) {
    case 0: c.src = p.w_in + (size_t)l * D * NIN; c.dst = p.WIN; c.K = D; c.N = NIN; break;
    case 1: c.src = p.w_uq + (size_t)l * 384 * 768; c.dst = p.UQ; c.K = 384; c.N = 768; c.scale = p.qn_g + l * 384; break;
    case 2: c.src = p.w_ukv + (size_t)l * 256 * 1024; c.dst = p.UKV; c.K = 256; c.N = 1024; c.scale = p.kvn_g + l * 256; break;
    case 3: case 4: case 5: c.src = p.w_branch + ((size_t)l * 3 + (e - 3)) * 512 * D; c.dst = p.WB + (size_t)(e - 3) * D * 512; c.K = 512; c.N = D; break;
    case 6: c.src = p.w_out + (size_t)l * D * D; c.dst = p.WO; c.K = D; c.N = D; break;
    case 7: case 8: c.src = p.w_up + ((size_t)l * 2 + (e - 7)) * 64 * 512; c.dst = p.WUP + (size_t)(e - 7) * 512 * 64; c.K = 64; c.N = 512; break;
    case 9: case 10: c.src = p.a_up + ((size_t)l * 2 + (e - 9)) * 64 * 512; c.dst = p.AUP + (size_t)(e - 9) * 512 * 64; c.K = 64; c.N = 512; break;
    case 11: c.src = p.g_up + (size_t)l * 128 * 512; c.dst = p.GUP; c.K = 128; c.N = 512; break;
    case 12: c.src = p.w1 + (size_t)l * D * DFF; c.dst = p.W1T; c.K = D; c.N = DFF; break;
    default: c.src = p.w2 + (size_t)l * DFF * D; c.dst = p.W2T; c.K = DFF; c.N = D; break;
  }
  return c;
}
DEVI void conv_tile(const CE& e, int tile, char* smem) {
  float* s = (float*)smem;
  const int tid = tidx();
  int ntn = e.N >> 6;
  int kt = tile / ntn, nt = tile - kt * ntn;
  {
    int r = tid >> 4, c4 = (tid & 15) * 4;
#pragma unroll
    for (int rr = 0; rr < 4; ++rr) {
      int k = r + 16 * rr;
      float4 v = *(const float4*)(e.src + (size_t)(kt * 64 + k) * e.N + nt * 64 + c4);
      float sc = e.scale ? e.scale[kt * 64 + k] : 1.f;
      s[k * 65 + c4 + 0] = v.x * sc; s[k * 65 + c4 + 1] = v.y * sc; s[k * 65 + c4 + 2] = v.z * sc; s[k * 65 + c4 + 3] = v.w * sc;
    }
  }
  __syncthreads();
  {
    int n = tid >> 2, kq = (tid & 3) * 16;
    uint4 u0, u1;
    u0.x = pk2n(s[(kq + 0) * 65 + n], s[(kq + 1) * 65 + n]); u0.y = pk2n(s[(kq + 2) * 65 + n], s[(kq + 3) * 65 + n]);
    u0.z = pk2n(s[(kq + 4) * 65 + n], s[(kq + 5) * 65 + n]); u0.w = pk2n(s[(kq + 6) * 65 + n], s[(kq + 7) * 65 + n]);
    u1.x = pk2n(s[(kq + 8) * 65 + n], s[(kq + 9) * 65 + n]); u1.y = pk2n(s[(kq + 10) * 65 + n], s[(kq + 11) * 65 + n]);
    u1.z = pk2n(s[(kq + 12) * 65 + n], s[(kq + 13) * 65 + n]); u1.w = pk2n(s[(kq + 14) * 65 + n], s[(kq + 15) * 65 + n]);
    h16* d = e.dst + (size_t)(nt * 64 + n) * e.K + kt * 64 + kq;
    *(uint4*)d = u0; *(uint4*)(d + 8) = u1;
  }
  __syncthreads();
}
DEVI void conv_phase(const P& p, int l, int e0, int e1, char* smem) {
  int total = 0;
  for (int e = e0; e < e1; ++e) { CE c = get_ce(p, l, e); total += (c.K >> 6) * (c.N >> 6); }
  for (int t = blockIdx.x; t < total; t += gridDim.x) {
    int tt = t;
    for (int e = e0; e < e1; ++e) {
      CE c = get_ce(p, l, e);
      int nt = (c.K >> 6) * (c.N >> 6);
      if (tt < nt) { conv_tile(c, tt, smem); break; }
      tt -= nt;
    }
  }
}

DEVI void ln_phase(const P& p, int l, int which) {
  const int lane = tidx() & 63;
  const int wid = blockIdx.x * 4 + (tidx() >> 6), nw = gridDim.x * 4;
  for (int r = wid; r < NR; r += nw) {
    int b = r / SB, s = r - b * SB;
    if (which == 2 && s < CTX) continue;
    int g = s < CTX ? 4 : b;
    float* xr = xrow(p, r);
    const float* src = xr;
    if (which == 0 && l == 0) src = s < CTX ? p.ctx + (size_t)(b * CTX + s) * D : p.x + (size_t)(b * SEQ + s - CTX) * D;
    float4 v[4];
#pragma unroll
    for (int i = 0; i < 4; ++i) v[i] = *(const float4*)(src + i * 256 + lane * 4);
    bool do_ln = !(which == 0 && l == 0);
    if (do_ln) {
      const float* gg = which == 1 ? p.ln1_g + l * D : p.ln2_g + (which == 2 ? 3 : l - 1) * D;
      const float* bb = which == 1 ? p.ln1_b + l * D : p.ln2_b + (which == 2 ? 3 : l - 1) * D;
      float sm = 0;
#pragma unroll
      for (int i = 0; i < 4; ++i) sm += v[i].x + v[i].y + v[i].z + v[i].w;
      float mean = wsum(sm) * (1.f / D);
      float sq = 0;
#pragma unroll
      for (int i = 0; i < 4; ++i) {
        v[i].x -= mean; v[i].y -= mean; v[i].z -= mean; v[i].w -= mean;
        sq += v[i].x * v[i].x + v[i].y * v[i].y + v[i].z * v[i].z + v[i].w * v[i].w;
      }
      float rs = rsqrtf(wsum(sq) * (1.f / D) + 1e-5f);
#pragma unroll
      for (int i = 0; i < 4; ++i) {
        float4 g4 = *(const float4*)(gg + i * 256 + lane * 4), b4 = *(const float4*)(bb + i * 256 + lane * 4);
        v[i].x = v[i].x * rs * g4.x + b4.x; v[i].y = v[i].y * rs * g4.y + b4.y;
        v[i].z = v[i].z * rs * g4.z + b4.z; v[i].w = v[i].w * rs * g4.w + b4.w;
      }
    }
#pragma unroll
    for (int i = 0; i < 4; ++i) *(float4*)(xr + i * 256 + lane * 4) = v[i];
    if (which == 2) continue;
    const float* shf = p.MOD + ((size_t)l * 5 + g) * 6144 + (which == 0 ? 0 : 3) * D;
    const float* scl = shf + D;
    float sm = 0;
#pragma unroll
    for (int i = 0; i < 4; ++i) sm += v[i].x + v[i].y + v[i].z + v[i].w;
    float mean = wsum(sm) * (1.f / D);
    float sq = 0;
#pragma unroll
    for (int i = 0; i < 4; ++i) {
      v[i].x -= mean; v[i].y -= mean; v[i].z -= mean; v[i].w -= mean;
      sq += v[i].x * v[i].x + v[i].y * v[i].y + v[i].z * v[i].z + v[i].w * v[i].w;
    }
    float rs = rsqrtf(wsum(sq) * (1.f / D) + 1e-6f);
    h16* hr = p.H + (size_t)r * D;
#pragma unroll
    for (int i = 0; i < 4; ++i) {
      float4 s4 = *(const float4*)(shf + i * 256 + lane * 4), c4 = *(const float4*)(scl + i * 256 + lane * 4);
      st4h(hr + i * 256 + lane * 4, v[i].x * rs * (1.f + c4.x) + s4.x, v[i].y * rs * (1.f + c4.y) + s4.y,
           v[i].z * rs * (1.f + c4.z) + s4.z, v[i].w * rs * (1.f + c4.w) + s4.w);
    }
  }
}

constexpr int GLD = 72;
template <bool ROWSQ, int NI = 2>
DEVI void gemm_main(const h16* __restrict__ A, int lda, const h16* __restrict__ Bt, int ldb, int K, int m0, int n0, int nmax,
                    char* smem, f32x16 (&acc)[2][NI], float* rowsq) {
  h16* As = (h16*)smem;
  h16* Bs = As + 2 * 128 * GLD;
  const int tid = tidx(), lane = tid & 63, wv = tid >> 6;
  const int wm = wv >> 1, wn = wv & 1, l31 = lane & 31, hh = lane >> 5;
  const int lrow = tid >> 3, lkc = (tid & 7) * 8;
  uint4 ga[4], gb[2 * NI];
  float sq[4] = {0.f, 0.f, 0.f, 0.f};
  const h16* Ap = A + (size_t)(m0 + lrow) * lda + lkc;
  const h16* Bp = Bt + (size_t)(n0 + lrow) * ldb + lkc;
#pragma unroll
  for (int i = 0; i < 4; ++i) ga[i] = *(const uint4*)(Ap + (size_t)(32 * i) * lda);
#pragma unroll
  for (int i = 0; i < 2 * NI; ++i)
    gb[i] = (n0 + lrow + 32 * i < nmax) ? *(const uint4*)(Bp + (size_t)(32 * i) * ldb) : make_uint4(0, 0, 0, 0);
  const int KT = K >> 6;
#pragma unroll
  for (int i = 0; i < 4; ++i) *(uint4*)(As + (lrow + 32 * i) * GLD + lkc) = ga[i];
#pragma unroll
  for (int i = 0; i < 2 * NI; ++i) *(uint4*)(Bs + (lrow + 32 * i) * GLD + lkc) = gb[i];
  __syncthreads();
  for (int kt = 0; kt < KT; ++kt) {
    const int buf = kt & 1;
    if (ROWSQ) {
#pragma unroll
      for (int i = 0; i < 4; ++i) {
        h16x8 hv = __builtin_bit_cast(h16x8, ga[i]);
#pragma unroll
        for (int j = 0; j < 8; ++j) { float f = (float)hv[j]; sq[i] += f * f; }
      }
    }
    if (kt + 1 < KT) {
#pragma unroll
      for (int i = 0; i < 4; ++i) ga[i] = *(const uint4*)(Ap + (size_t)(32 * i) * lda + (kt + 1) * 64);
#pragma unroll
      for (int i = 0; i < 2 * NI; ++i)
        gb[i] = (n0 + lrow + 32 * i < nmax) ? *(const uint4*)(Bp + (size_t)(32 * i) * ldb + (kt + 1) * 64) : make_uint4(0, 0, 0, 0);
    }
    const h16* as = As + buf * 128 * GLD + (wm * 64 + l31) * GLD + hh * 8;
    const h16* bs = Bs + buf * 128 * GLD + (wn * 32 * NI + l31) * GLD + hh * 8;
#pragma unroll
    for (int ks = 0; ks < 4; ++ks) {
      h16x8 a0 = *(const h16x8*)(as + ks * 16), a1 = *(const h16x8*)(as + 32 * GLD + ks * 16);
#pragma unroll
      for (int ni = 0; ni < NI; ++ni) {
        h16x8 b0 = *(const h16x8*)(bs + ni * 32 * GLD + ks * 16);
        acc[0][ni] = __builtin_amdgcn_mfma_f32_32x32x16_f16(b0, a0, acc[0][ni], 0, 0, 0);
        acc[1][ni] = __builtin_amdgcn_mfma_f32_32x32x16_f16(b0, a1, acc[1][ni], 0, 0, 0);
      }
    }
    if (kt + 1 < KT) {
      h16* ad = As + (buf ^ 1) * 128 * GLD;
      h16* bd = Bs + (buf ^ 1) * 128 * GLD;
#pragma unroll
      for (int i = 0; i < 4; ++i) *(uint4*)(ad + (lrow + 32 * i) * GLD + lkc) = ga[i];
#pragma unroll
      for (int i = 0; i < 2 * NI; ++i) *(uint4*)(bd + (lrow + 32 * i) * GLD + lkc) = gb[i];
    }
    __syncthreads();
  }
  if (ROWSQ) {
#pragma unroll
    for (int i = 0; i < 4; ++i) {
      float s = sq[i];
      s += __shfl_xor(s, 1); s += __shfl_xor(s, 2); s += __shfl_xor(s, 4);
      if ((tid & 7) == 0) rowsq[lrow + 32 * i] = s;
    }
    __syncthreads();
  }
}
DEVI void zero_acc(f32x16 (&acc)[2][2]) {
#pragma unroll
  for (int i = 0; i < 2; ++i)
#pragma unroll
    for (int j = 0; j < 2; ++j)
#pragma unroll
      for (int r = 0; r < 16; ++r) acc[i][j][r] = 0.f;
}
template <class F>
DEVI void epi_quads(const f32x16 (&acc)[2][2], int m0, int n0, F f) {
  const int lane = tidx() & 63, wv = tidx() >> 6;
  const int wm = wv >> 1, wn = wv & 1, l31 = lane & 31, hh = lane >> 5;
#pragma unroll
  for (int mi = 0; mi < 2; ++mi)
#pragma unroll
    for (int ni = 0; ni < 2; ++ni)
#pragma unroll
      for (int g = 0; g < 4; ++g)
        f(m0 + wm * 64 + mi * 32 + l31, n0 + wn * 64 + ni * 32 + 8 * g + 4 * hh, acc[mi][ni][4 * g], acc[mi][ni][4 * g + 1],
          acc[mi][ni][4 * g + 2], acc[mi][ni][4 * g + 3]);
}

DEVI void inproj_phase(const P& p, char* smem) {
  constexpr int MT = NR / 128, NT = (ZW + 127) / 128;
  for (int job = blockIdx.x; job < MT * NT; job += gridDim.x) {
    int nt = job / MT, mt = job - nt * MT;
    f32x16 acc[2][2]; zero_acc(acc);
    gemm_main<false>(p.H, D, p.WIN, D, D, mt * 128, nt * 128, ZW, smem, acc, nullptr);
    epi_quads(acc, mt * 128, nt * 128, [&](int m, int n, float v0, float v1, float v2, float v3) {
      if (n < ZW) {
        st4h(p.Z + (size_t)m * ZW + n, v0, v1, v2, v3);
        if (n >= ZRW) {
          if ((m & 63) == 0) st4h(p.HLO + (size_t)(m >> 6) * 1920 + n - ZRW, v0, v1, v2, v3);
          if ((m & 63) == 63) st4h(p.HHI + (size_t)(m >> 6) * 1920 + n - ZRW, v0, v1, v2, v3);
        }
      }
    });
  }
}

DEVI void shift_job(const P& p, int l, int j, char* smem) {
  h16* raw = (h16*)smem;
  const int tid = tidx(), lane = tid & 63;
  const int r0 = j * 64;
  const int s0 = r0 % SB;
  const bool first = (s0 == 0) || (s0 == CTX);
  const bool last = (s0 + 64 == CTX) || (s0 + 64 == SB);
  for (int slab = 0; slab < 8; ++slab) {
    const int c0 = slab * 256;
    const int ncols = slab == 7 ? 128 : 256;
    const int cpr = ncols >> 3;
    for (int c = tid; c < 66 * cpr; c += 256) {
      int row = c / cpr, ch = (c - row * cpr) * 8;
      uint4 v = make_uint4(0, 0, 0, 0);
      if (row == 0) { if (!first) v = *(const uint4*)(p.HHI + (size_t)(j - 1) * 1920 + c0 + ch); }
      else if (row == 65) { if (!last) v = *(const uint4*)(p.HLO + (size_t)(j + 1) * 1920 + c0 + ch); }
      else v = *(const uint4*)(p.Z + (size_t)(r0 + row - 1) * ZW + ZRW + c0 + ch);
      *(uint4*)(raw + row * 264 + ch) = v;
    }
    __syncthreads();
    if (tid < ncols) {
      const int col = c0 + tid;
      const float mup = p.mu[(size_t)l * 2 * 1920 + col], mun = p.mu[(size_t)l * 2 * 1920 + 1920 + col];
      const bool isk = (col >= 512 && col < 1024);
      const float kkp = isk ? p.k_k[l * 512 + col - 512] : 0.f;
      float prev = (float)raw[tid], cur = (float)raw[264 + tid];
      h16* zc = p.Z + (size_t)r0 * ZW + ZRW + col;
      for (int t = 0; t < 64; ++t) {
        float nxt = (float)raw[(t + 2) * 264 + tid];
        float o = cur + mup * (prev - cur) + mun * (nxt - cur);
        float ov = o;
        if (col >= 1536 && col < 1664) ov = tanhf(o);
        else if (col >= 1792) ov = sigm(o);
        zc[(size_t)t * ZW] = (h16)ov;
        if (isk) {
          float q = o * kkp;
          float ss = wsum(q * q);
          if (lane == 0) p.INVN[(size_t)(r0 + t) * 8 + ((col - 512) >> 6)] = rsqrtf(ss + 1e-12f);
        }
        prev = cur; cur = nxt;
      }
    }
    __syncthreads();
  }
}

DEVI void mla_up_job(const P& p, int job, char* smem) {
  constexpr int MT = NR / 128;
  float* rowsq = (float*)(smem + 2 * 2 * 128 * GLD * 2);
  const int tid = tidx();
  f32x16 acc[2][2]; zero_acc(acc);
  if (job < MT * 6) {
    int nt = job / MT, mt = job - nt * MT;
    gemm_main<true>(p.Z + ZMLA, ZW, p.UQ, 384, 384, mt * 128, nt * 128, 768, smem, acc, rowsq);
    const int m0 = mt * 128, n0 = nt * 128;
    const int lane = tid & 63, wv = tid >> 6, wm = wv >> 1, wn = wv & 1, l31 = lane & 31, hh = lane >> 5;
    const float qs = 0.10206207261596575f * 1.4426950408889634f;
#pragma unroll
    for (int mi = 0; mi < 2; ++mi) {
      const int ml = wm * 64 + mi * 32 + l31, m = m0 + ml;
      const float sc = rsqrtf(rowsq[ml] * (1.f / 384.f) + 1e-6f) * qs;
      const int sp = m % SB;
      const bool lat = sp >= CTX;
      const float* rp = p.ROPE + (size_t)(lat ? sp - CTX : 0) * 32;
#pragma unroll
      for (int ni = 0; ni < 2; ++ni) {
        const int nb = n0 + wn * 64 + ni * 32;
        h16* qd = p.Q + (size_t)m * 768 + nb;
        const bool ropet = (nb % 96) == 64;
        if (ropet && lat) {
#pragma unroll
          for (int g = 0; g < 2; ++g) {
            float o1[4], o2[4];
#pragma unroll
            for (int jj = 0; jj < 4; ++jj) {
              int i = 8 * g + 4 * hh + jj;
              float x1 = acc[mi][ni][4 * g + jj] * sc, x2 = acc[mi][ni][4 * (g + 2) + jj] * sc;
              float cs = rp[i], sn = rp[16 + i];
              o1[jj] = x1 * cs - x2 * sn; o2[jj] = x1 * sn + x2 * cs;
            }
            st4h(qd + 8 * g + 4 * hh, o1[0], o1[1], o1[2], o1[3]);
            st4h(qd + 16 + 8 * g + 4 * hh, o2[0], o2[1], o2[2], o2[3]);
          }
        } else {
#pragma unroll
          for (int g = 0; g < 4; ++g)
            st4h(qd + 8 * g + 4 * hh, acc[mi][ni][4 * g] * sc, acc[mi][ni][4 * g + 1] * sc, acc[mi][ni][4 * g + 2] * sc, acc[mi][ni][4 * g + 3] * sc);
        }
      }
    }
  } else {
    int j2 = job - MT * 6;
    int nt = j2 / MT, mt = j2 - nt * MT;
    gemm_main<true>(p.Z + ZMLA + 384, ZW, p.UKV, 256, 256, mt * 128, nt * 128, 1024, smem, acc, rowsq);
    const int m0 = mt * 128;
    epi_quads(acc, m0, 0, [&](int m, int n, float v0, float v1, float v2, float v3) {
      const float sc = rsqrtf(rowsq[m - m0] * (1.f / 256.f) + 1e-6f);
      if (n < 64) st4h(p.K + (size_t)m * 768 + nt * 96 + n, v0 * sc, v1 * sc, v2 * sc, v3 * sc);
      else {
        int b = m / SB, s = m - b * SB;
        h16* vt = p.VT + ((size_t)(b * 8 + nt) * 64 + (n - 64)) * SB + s;
        vt[0] = (h16)(v0 * sc); vt[SB] = (h16)(v1 * sc); vt[2 * SB] = (h16)(v2 * sc); vt[3 * SB] = (h16)(v3 * sc);
      }
    });
    {
      int row = tid >> 1, sub = tid & 1;
      int m = m0 + row;
      int sp = m % SB;
      const h16* kr = p.Z + (size_t)m * ZW + ZMLA + 640 + sub * 8;
      h16x8 x1 = *(const h16x8*)kr, x2 = *(const h16x8*)(kr + 16);
      h16* kd = p.K + (size_t)m * 768 + nt * 96 + 64 + sub * 8;
      if (sp >= CTX) {
        const float* rp = p.ROPE + (size_t)(sp - CTX) * 32 + sub * 8;
        h16x8 o1, o2;
#pragma unroll
        for (int i = 0; i < 8; ++i) {
          float a = (float)x1[i], b2 = (float)x2[i], cs = rp[i], sn = rp[16 + i];
          o1[i] = (h16)(a * cs - b2 * sn); o2[i] = (h16)(a * sn + b2 * cs);
        }
        *(h16x8*)kd = o1; *(h16x8*)(kd + 16) = o2;
      } else { *(h16x8*)kd = x1; *(h16x8*)(kd + 16) = x2; }
    }
  }
}

DEVI void lowrank_job(const P& p, int l, int job, char* smem) {
  constexpr int MT = NR / 128;
  int mat = job / (MT * 4), rem = job - mat * MT * 4;
  int nt = rem / MT, mt = rem - nt * MT;
  f32x16 acc[2][2]; zero_acc(acc);
  if (mat < 2) {
    const int dir = mat;
    gemm_main<false>(p.Z + ZRW + 1536 + dir * 64, ZW, p.WUP + (size_t)dir * 512 * 64, 64, 64, mt * 128, nt * 128, 512, smem, acc, nullptr);
    const float* w0 = p.w0 + ((size_t)l * 2 + dir) * 512;
    h16* dst = p.LW + (size_t)dir * NR * 512;
    epi_quads(acc, mt * 128, nt * 128, [&](int m, int n, float v0, float v1, float v2, float v3) {
      float4 b = *(const float4*)(w0 + n);
      const float e = 0.6065306597126334f;
      st4h(dst + (size_t)m * 512 + n, sigm(v0 + b.x) * e, sigm(v1 + b.y) * e, sigm(v2 + b.z) * e, sigm(v3 + b.w) * e);
    });
  } else if (mat < 4) {
    const int dir = mat - 2;
    gemm_main<false>(p.Z + ZRW + 1664 + dir * 64, ZW, p.AUP + (size_t)dir * 512 * 64, 64, 64, mt * 128, nt * 128, 512, smem, acc, nullptr);
    const float* a0 = p.a0 + ((size_t)l * 2 + dir) * 512;
    h16* dst = p.AA + (size_t)dir * NR * 512;
    epi_quads(acc, mt * 128, nt * 128, [&](int m, int n, float v0, float v1, float v2, float v3) {
      float4 b = *(const float4*)(a0 + n);
      st4h(dst + (size_t)m * 512 + n, sigm(v0 + b.x), sigm(v1 + b.y), sigm(v2 + b.z), sigm(v3 + b.w));
    });
  } else {
    gemm_main<false>(p.Z + ZRW + 1792, ZW, p.GUP, 128, 128, mt * 128, nt * 128, 512, smem, acc, nullptr);
    epi_quads(acc, mt * 128, nt * 128, [&](int m, int n, float v0, float v1, float v2, float v3) {
      st4h(p.G + (size_t)m * 512 + n, v0, v1, v2, v3);
    });
  }
}

DEVI void attn_job(const P& p, int job, char* smem) {
  h16* Ks = (h16*)smem;
  h16* Vs = Ks + 2 * 64 * 104;
  const int tid = tidx(), lane = tid & 63, wv = tid >> 6, l31 = lane & 31, hh = lane >> 5;
  int b, h, q0, nk;
  if (job < 1024) { b = job >> 8; h = (job >> 5) & 7; q0 = b * SB + CTX + (job & 31) * 128; nk = SB; }
  else { int j = job - 1024; b = j >> 4; h = (j >> 1) & 7; q0 = b * SB + (j & 1) * 128; nk = CTX; }
  const int NKT = nk >> 6;
  const h16* Kg = p.K + (size_t)(b * SB) * 768 + h * 96;
  const h16* Vg = p.VT + (size_t)(b * 8 + h) * 64 * SB;
  h16x8 qf[6];
  {
    const h16* qp = p.Q + (size_t)(q0 + wv * 32 + l31) * 768 + h * 96 + hh * 8;
#pragma unroll
    for (int ds = 0; ds < 6; ++ds) qf[ds] = *(const h16x8*)(qp + ds * 16);
  }
  uint4 gk[3], gv[2];
  int krow[3], kcol[3];
#pragma unroll
  for (int i = 0; i < 3; ++i) { int c = tid + 256 * i; krow[i] = c / 12; kcol[i] = (c - krow[i] * 12) * 8; }
  const int vrow = tid >> 3, vcol = (tid & 7) * 8;
#pragma unroll
  for (int i = 0; i < 3; ++i) gk[i] = *(const uint4*)(Kg + (size_t)krow[i] * 768 + kcol[i]);
#pragma unroll
  for (int i = 0; i < 2; ++i) gv[i] = *(const uint4*)(Vg + (size_t)(vrow + 32 * i) * SB + vcol);
#pragma unroll
  for (int i = 0; i < 3; ++i) *(uint4*)(Ks + krow[i] * 104 + kcol[i]) = gk[i];
#pragma unroll
  for (int i = 0; i < 2; ++i) *(uint4*)(Vs + (vrow + 32 * i) * 72 + vcol) = gv[i];
  __syncthreads();
  f32x16 o0, o1;
#pragma unroll
  for (int r = 0; r < 16; ++r) { o0[r] = 0.f; o1[r] = 0.f; }
  float mrun = -1e30f, lsum = 0.f;
  for (int kt = 0; kt < NKT; ++kt) {
    const int buf = kt & 1;
    if (kt + 1 < NKT) {
#pragma unroll
      for (int i = 0; i < 3; ++i) gk[i] = *(const uint4*)(Kg + (size_t)((kt + 1) * 64 + krow[i]) * 768 + kcol[i]);
#pragma unroll
      for (int i = 0; i < 2; ++i) gv[i] = *(const uint4*)(Vg + (size_t)(vrow + 32 * i) * SB + (kt + 1) * 64 + vcol);
    }
    const h16* ks = Ks + buf * 64 * 104 + l31 * 104 + hh * 8;
    f32x16 s0, s1;
#pragma unroll
    for (int r = 0; r < 16; ++r) { s0[r] = 0.f; s1[r] = 0.f; }
#pragma unroll
    for (int ds = 0; ds < 6; ++ds) {
      h16x8 a0 = *(const h16x8*)(ks + ds * 16), a1 = *(const h16x8*)(ks + 32 * 104 + ds * 16);
      s0 = __builtin_amdgcn_mfma_f32_32x32x16_f16(a0, qf[ds], s0, 0, 0, 0);
      s1 = __builtin_amdgcn_mfma_f32_32x32x16_f16(a1, qf[ds], s1, 0, 0, 0);
    }
    float mx = s0[0];
#pragma unroll
    for (int r = 1; r < 16; ++r) mx = fmaxf(mx, s0[r]);
#pragma unroll
    for (int r = 0; r < 16; ++r) mx = fmaxf(mx, s1[r]);
    mx = fmaxf(mx, __shfl_xor(mx, 32));
    const float mnew = fmaxf(mrun, mx);
    const float alpha = __builtin_amdgcn_exp2f(mrun - mnew);
    mrun = mnew;
    float ps = 0.f;
#pragma unroll
    for (int r = 0; r < 16; ++r) { s0[r] = __builtin_amdgcn_exp2f(s0[r] - mnew); ps += s0[r]; }
#pragma unroll
    for (int r = 0; r < 16; ++r) { s1[r] = __builtin_amdgcn_exp2f(s1[r] - mnew); ps += s1[r]; }
    lsum = lsum * alpha + ps;
#pragma unroll
    for (int r = 0; r < 16; ++r) { o0[r] *= alpha; o1[r] *= alpha; }
    const h16* vs = Vs + buf * 64 * 72 + l31 * 72 + 4 * hh;
#pragma unroll
    for (int k2 = 0; k2 < 2; ++k2) {
#pragma unroll
      for (int s2 = 0; s2 < 2; ++s2) {
        uint4 pu;
        if (k2 == 0) { pu.x = pk2(s0[8 * s2], s0[8 * s2 + 1]); pu.y = pk2(s0[8 * s2 + 2], s0[8 * s2 + 3]); pu.z = pk2(s0[8 * s2 + 4], s0[8 * s2 + 5]); pu.w = pk2(s0[8 * s2 + 6], s0[8 * s2 + 7]); }
        else { pu.x = pk2(s1[8 * s2], s1[8 * s2 + 1]); pu.y = pk2(s1[8 * s2 + 2], s1[8 * s2 + 3]); pu.z = pk2(s1[8 * s2 + 4], s1[8 * s2 + 5]); pu.w = pk2(s1[8 * s2 + 6], s1[8 * s2 + 7]); }
        h16x8 pf = __builtin_bit_cast(h16x8, pu);
        const int kb = k2 * 32 + 16 * s2;
        uint2 va = *(const uint2*)(vs + kb), vb = *(const uint2*)(vs + kb + 8);
        uint2 vc = *(const uint2*)(vs + 32 * 72 + kb), vd = *(const uint2*)(vs + 32 * 72 + kb + 8);
        h16x8 vf0 = __builtin_bit_cast(h16x8, make_uint4(va.x, va.y, vb.x, vb.y));
        h16x8 vf1 = __builtin_bit_cast(h16x8, make_uint4(vc.x, vc.y, vd.x, vd.y));
        o0 = __builtin_amdgcn_mfma_f32_32x32x16_f16(vf0, pf, o0, 0, 0, 0);
        o1 = __builtin_amdgcn_mfma_f32_32x32x16_f16(vf1, pf, o1, 0, 0, 0);
      }
    }
    if (kt + 1 < NKT) {
      h16* kd = Ks + (buf ^ 1) * 64 * 104;
      h16* vd = Vs + (buf ^ 1) * 64 * 72;
#pragma unroll
      for (int i = 0; i < 3; ++i) *(uint4*)(kd + krow[i] * 104 + kcol[i]) = gk[i];
#pragma unroll
      for (int i = 0; i < 2; ++i) *(uint4*)(vd + (vrow + 32 * i) * 72 + vcol) = gv[i];
    }
    __syncthreads();
  }
  const float ltot = lsum + __shfl_xor(lsum, 32);
  const float inv = 1.f / ltot;
  h16* yo = p.Z + (size_t)(q0 + wv * 32 + l31) * ZW + ZMLA + h * 64 + 4 * hh;
#pragma unroll
  for (int g = 0; g < 4; ++g) {
    st4h(yo + 8 * g, o0[4 * g] * inv, o0[4 * g + 1] * inv, o0[4 * g + 2] * inv, o0[4 * g + 3] * inv);
    st4h(yo + 32 + 8 * g, o1[4 * g] * inv, o1[4 * g + 1] * inv, o1[4 * g + 2] * inv, o1[4 * g + 3] * inv);
  }
}

struct Slot { float w[64], bb[64], ke[64], vv[64]; h16 ah[4][64]; int yoff; int pad[3]; };
struct LSet { uint4 lw, a, k, v, r; float inv; int yoff; };
DEVI void scan_job(const P& p, int l, int job, char* smem) {
  constexpr int RGB = 4 / NSCAN_BPC;
  constexpr int NLD = (4 - RGB) * 64;
  static_assert(NLD == 128, "loader mapping assumes 128 loader threads");
  typedef float f2 __attribute__((ext_vector_type(2)));
  Slot* sl = (Slot*)smem;
  const int tid = tidx(), lane = tid & 63, wv = tid >> 6;
  const int chain = job / NSCAN_BPC, part = job - chain * NSCAN_BPC;
  const int dir = chain >> 5, b = (chain >> 3) & 3, h = chain & 7;
  for (int i = tid; i < 32 * 128; i += 256) { int s = i >> 7, e = i & 127; sl[s].ah[2 + (e >> 6)][e & 63] = (h16)0.f; }
  if (wv >= RGB) {
    const int lt = tid - RGB * 64;
    const int st = lt >> 3, c8 = (lt & 7) * 8;
    const float4 kkA = *(const float4*)(p.k_k + l * 512 + h * 64 + c8), kkB = *(const float4*)(p.k_k + l * 512 + h * 64 + c8 + 4);
    const float4 kaA = *(const float4*)(p.k_a + l * 512 + h * 64 + c8), kaB = *(const float4*)(p.k_a + l * 512 + h * 64 + c8 + 4);
    const h16* LWd = p.LW + (size_t)dir * NR * 512 + h * 64 + c8;
    const h16* AAd = p.AA + (size_t)dir * NR * 512 + h * 64 + c8;
    const h16* Zr = p.Z + ZRW + h * 64 + c8;
    auto lload = [&](int ci, LSet& g) {
      const uint4 z = make_uint4(0, 0, 0, 0);
      g.lw = z; g.a = z; g.k = z; g.v = z; g.r = z; g.inv = 0.f; g.yoff = -1;
      if (ci >= NCHUNK) return;
      const int n = ci * 16 + st;
      if (n < SB) {
        const int row = maprow(dir, b, n);
        g.lw = *(const uint4*)(LWd + (size_t)row * 512);
        g.a = *(const uint4*)(AAd + (size_t)row * 512);
        g.k = *(const uint4*)(Zr + (size_t)row * ZW + 512);
        g.v = *(const uint4*)(Zr + (size_t)row * ZW + 1024);
        g.inv = p.INVN[(size_t)row * 8 + h];
      }
      if (n >= 1 && n <= SB) {
        const int row = maprow(dir, b, n - 1);
        g.r = *(const uint4*)(Zr + (size_t)row * ZW);
        g.yoff = row * 512;
      }
    };
    auto lstore = [&](const LSet& g, int buf) {
      Slot& s = sl[buf * 16 + st];
      const h16x8 lw = __builtin_bit_cast(h16x8, g.lw), a = __builtin_bit_cast(h16x8, g.a), k = __builtin_bit_cast(h16x8, g.k), v = __builtin_bit_cast(h16x8, g.v);
      const float kkp[8] = {kkA.x, kkA.y, kkA.z, kkA.w, kkB.x, kkB.y, kkB.z, kkB.w};
      const float kap[8] = {kaA.x, kaA.y, kaA.z, kaA.w, kaB.x, kaB.y, kaB.z, kaB.w};
      float w8[8], b8[8], e8[8], v8[8], q8[8];
#pragma unroll
      for (int i = 0; i < 8; ++i) {
        const float kf = (float)k[i], af = (float)a[i];
        const float kkv = kf * kkp[i] * g.inv;
        w8[i] = __expf(-(float)lw[i]);
        b8[i] = kkv * af;
        e8[i] = kf * (1.f + (af - 1.f) * kap[i]);
        v8[i] = (float)v[i];
        q8[i] = kkv;
      }
      *(float4*)(s.w + c8) = make_float4(w8[0], w8[1], w8[2], w8[3]); *(float4*)(s.w + c8 + 4) = make_float4(w8[4], w8[5], w8[6], w8[7]);
      *(float4*)(s.bb + c8) = make_float4(b8[0], b8[1], b8[2], b8[3]); *(float4*)(s.bb + c8 + 4) = make_float4(b8[4], b8[5], b8[6], b8[7]);
      *(float4*)(s.ke + c8) = make_float4(e8[0], e8[1], e8[2], e8[3]); *(float4*)(s.ke + c8 + 4) = make_float4(e8[4], e8[5], e8[6], e8[7]);
      *(float4*)(s.vv + c8) = make_float4(v8[0], v8[1], v8[2], v8[3]); *(float4*)(s.vv + c8 + 4) = make_float4(v8[4], v8[5], v8[6], v8[7]);
      uint4 u; u.x = pk2n(q8[0], q8[1]); u.y = pk2n(q8[2], q8[3]); u.z = pk2n(q8[4], q8[5]); u.w = pk2n(q8[6], q8[7]);
      *(uint4*)(&s.ah[0][c8]) = u;
      *(uint4*)(&s.ah[1][c8]) = g.r;
      if ((lt & 7) == 0) s.yoff = g.yoff;
    };
    LSet A, B;
    lload(0, A); lload(1, B);
    lstore(A, 0);
    lload(2, A);
    __syncthreads();
    for (int ci = 0; ci < NCHUNK; ci += 2) {
      if (ci + 1 < NCHUNK) lstore(B, 1);
      lload(ci + 3, B);
      __syncthreads();
      if (ci + 1 < NCHUNK) {
        if (ci + 2 < NCHUNK) lstore(A, 0);
        lload(ci + 4, A);
        __syncthreads();
      }
    }
  } else {
    const int c = lane & 15, hq = lane >> 4;
    const int rg = part * RGB + wv;
    f2 S[8];
#pragma unroll
    for (int i = 0; i < 8; ++i) S[i] = (f2){0.f, 0.f};
    uint4 sh0 = make_uint4(0, 0, 0, 0), sh1 = make_uint4(0, 0, 0, 0);
    h16* ybase = p.Y2 + (size_t)dir * NR * 512 + h * 64 + rg * 16 + c;
    __builtin_amdgcn_s_setprio(3);
    __syncthreads();
    for (int ci = 0; ci < NCHUNK; ++ci) {
      const int buf = ci & 1;
      float yv[16];
      h16x8 rA0[2], rA1[2]; float rvv[2]; f2 rw[2][8], rb[2][8], re[2][8];
      {
        const Slot& t = sl[buf * 16];
        rA0[0] = *(const h16x8*)(&t.ah[c & 3][8 * hq]); rA1[0] = *(const h16x8*)(&t.ah[c & 3][32 + 8 * hq]);
        rvv[0] = t.vv[rg * 16 + c];
        const f2* wp = (const f2*)(t.w + 8 * hq); const f2* bp = (const f2*)(t.bb + 8 * hq); const f2* ep = (const f2*)(t.ke + 8 * hq);
#pragma unroll
        for (int i = 0; i < 4; ++i) { rw[0][i] = wp[i]; rw[0][4 + i] = wp[16 + i]; rb[0][i] = bp[i]; rb[0][4 + i] = bp[16 + i]; re[0][i] = ep[i]; re[0][4 + i] = ep[16 + i]; }
      }
#pragma unroll
      for (int s = 0; s < 16; ++s) {
        const int cur = s & 1, nxt = cur ^ 1;
        const f32x4 z4 = {0.f, 0.f, 0.f, 0.f};
        f32x4 acc0 = __builtin_amdgcn_mfma_f32_16x16x32_f16(rA0[cur], __builtin_bit_cast(h16x8, sh0), z4, 0, 0, 0);
        f32x4 acc1 = __builtin_amdgcn_mfma_f32_16x16x32_f16(rA1[cur], __builtin_bit_cast(h16x8, sh1), z4, 0, 0, 0);
        if (s + 1 < 16) {
          const Slot& t = sl[buf * 16 + s + 1];
          rA0[nxt] = *(const h16x8*)(&t.ah[c & 3][8 * hq]); rA1[nxt] = *(const h16x8*)(&t.ah[c & 3][32 + 8 * hq]);
          rvv[nxt] = t.vv[rg * 16 + c];
          const f2* wp = (const f2*)(t.w + 8 * hq); const f2* bp = (const f2*)(t.bb + 8 * hq); const f2* ep = (const f2*)(t.ke + 8 * hq);
#pragma unroll
          for (int i = 0; i < 4; ++i) { rw[nxt][i] = wp[i]; rw[nxt][4 + i] = wp[16 + i]; rb[nxt][i] = bp[i]; rb[nxt][4 + i] = bp[16 + i]; re[nxt][i] = ep[i]; re[nxt][4 + i] = ep[16 + i]; }
        }
        const f2 vv2 = (f2){rvv[cur], rvv[cur]};
        f2 T[8];
#pragma unroll
        for (int i = 0; i < 8; ++i) T[i] = S[i] * rw[cur][i] + vv2 * re[cur][i];
        __builtin_amdgcn_sched_barrier(0);
        yv[s] = acc0[1] + acc1[1];
        const float sa = -(acc0[0] + acc1[0]);
        const f2 sa2 = (f2){sa, sa};
#pragma unroll
        for (int i = 0; i < 8; ++i) S[i] = T[i] + sa2 * rb[cur][i];
        sh0.x = pk2(S[0].x, S[0].y); sh0.y = pk2(S[1].x, S[1].y); sh0.z = pk2(S[2].x, S[2].y); sh0.w = pk2(S[3].x, S[3].y);
        sh1.x = pk2(S[4].x, S[4].y); sh1.y = pk2(S[5].x, S[5].y); sh1.z = pk2(S[6].x, S[6].y); sh1.w = pk2(S[7].x, S[7].y);
      }
      if (lane < 16) {
#pragma unroll
        for (int s = 0; s < 16; ++s) {
          const int yo = sl[buf * 16 + s].yoff;
          if (yo >= 0) ybase[yo] = (h16)yv[s];
        }
      }
      __syncthreads();
    }
    __builtin_amdgcn_s_setprio(0);
  }
}

DEVI void gla_chunk_qk(const P& p, int dir, int b, int h, int ci, float* qi, float* ki, float* lg, const float* gku, const float* gkb, float* tot) {
  const int tid = tidx();
  const int ri = tid >> 2, dq = tid & 3;
  uint4 q0, q1, k0, k1;
  {
    const int row = maprow(dir, b, ci * 64 + ri);
    const h16* zr = p.Z + (size_t)row * ZW;
    q0 = *(const uint4*)(zr + h * 64 + dq * 16); q1 = *(const uint4*)(zr + h * 64 + dq * 16 + 8);
    k0 = *(const uint4*)(zr + 256 + h * 64 + dq * 16); k1 = *(const uint4*)(zr + 256 + h * 64 + dq * 16 + 8);
    uint4 g0 = *(const uint4*)(zr + 1024 + dir * 16), g1 = *(const uint4*)(zr + 1024 + dir * 16 + 8);
    h16x8 gh0 = __builtin_bit_cast(h16x8, g0), gh1 = __builtin_bit_cast(h16x8, g1);
    float gd[16];
#pragma unroll
    for (int j = 0; j < 8; ++j) { gd[j] = (float)gh0[j]; gd[8 + j] = (float)gh1[j]; }
#pragma unroll 4
    for (int dd = 0; dd < 16; ++dd) {
      const int d = dq * 16 + dd;
      float xx = gkb[d];
#pragma unroll
      for (int r = 0; r < 16; ++r) xx += gd[r] * gku[r * 64 + d];
      float ls = fminf(xx, 0.f) - log1pf(__expf(-fabsf(xx)));
      lg[ri * 65 + d] = ls * (1.f / 16.f);
    }
  }
  __syncthreads();
  {
    const int d = tid & 63, part = tid >> 6;
    float run = 0.f;
#pragma unroll 4
    for (int ii = 0; ii < 16; ++ii) { const int i = part * 16 + ii; run += lg[i * 65 + d]; lg[i * 65 + d] = run; }
    tot[part * 64 + d] = run;
  }
  __syncthreads();
  {
    h16x8 qh0 = __builtin_bit_cast(h16x8, q0), qh1 = __builtin_bit_cast(h16x8, q1), kh0 = __builtin_bit_cast(h16x8, k0), kh1 = __builtin_bit_cast(h16x8, k1);
    const int part = ri >> 4;
#pragma unroll
    for (int dd = 0; dd < 16; ++dd) {
      const int d = dq * 16 + dd;
      float off = 0.f;
      if (part > 0) off += tot[d];
      if (part > 1) off += tot[64 + d];
      if (part > 2) off += tot[128 + d];
      const float bb = lg[ri * 65 + d] + off;
      const float qv = dd < 8 ? (float)qh0[dd & 7] : (float)qh1[dd & 7];
      const float kv = dd < 8 ? (float)kh0[dd & 7] : (float)kh1[dd & 7];
      qi[ri * 65 + d] = qv * __expf(bb) * 0.125f;
      ki[ri * 65 + d] = kv * __expf(-bb);
    }
  }
  __syncthreads();
}

DEVI void gla_pre_job(const P& p, int l, int job, char* smem) {
  float* qi = (float*)smem;
  float* ki = qi + 64 * 65;
  float* att = ki + 64 * 65;
  float* vs = att + 64 * 65;
  float* gku = vs + 64 * 65;
  float* gkb = gku + 1024;
  float* tot = gkb + 64;
  const int tid = tidx();
  const int chain = job / 68, ci = job - chain * 68;
  const int dir = chain >> 4, b = (chain >> 2) & 3, h = chain & 3;
  for (int i = tid; i < 1024; i += 256) gku[i] = p.gk_up[(((size_t)l * 2 + dir) * 16 + (i >> 6)) * 256 + h * 64 + (i & 63)];
  if (tid < 64) gkb[tid] = p.gk_b[((size_t)l * 2 + dir) * 256 + h * 64 + tid];
  __syncthreads();
  gla_chunk_qk(p, dir, b, h, ci, qi, ki, att, gku, gkb, tot);
  {
    const int ri2 = tid >> 2, dq2 = tid & 3;
    const int row = maprow(dir, b, ci * 64 + ri2);
    unsigned qp[8], kp[8];
#pragma unroll
    for (int j = 0; j < 8; ++j) {
      qp[j] = f2bf(qi[ri2 * 65 + dq2 * 16 + 2 * j]) | (f2bf(qi[ri2 * 65 + dq2 * 16 + 2 * j + 1]) << 16);
      kp[j] = f2bf(ki[ri2 * 65 + dq2 * 16 + 2 * j]) | (f2bf(ki[ri2 * 65 + dq2 * 16 + 2 * j + 1]) << 16);
    }
    unsigned short* qd = p.QIN + ((size_t)dir * NR + row) * 256 + h * 64 + dq2 * 16;
    unsigned short* kd = p.KIN + ((size_t)dir * NR + row) * 256 + h * 64 + dq2 * 16;
    *(uint4*)qd = make_uint4(qp[0], qp[1], qp[2], qp[3]); *(uint4*)(qd + 8) = make_uint4(qp[4], qp[5], qp[6], qp[7]);
    *(uint4*)kd = make_uint4(kp[0], kp[1], kp[2], kp[3]); *(uint4*)(kd + 8) = make_uint4(kp[4], kp[5], kp[6], kp[7]);
    if (tid < 64) p.DEC[((size_t)chain * 68 + ci) * 64 + tid] = __expf(tot[tid] + tot[64 + tid] + tot[128 + tid] + tot[192 + tid]);
  }
  const int ti = tid >> 4, tj = tid & 15;
  {
    float a[4][4];
#pragma unroll
    for (int x = 0; x < 4; ++x)
#pragma unroll
      for (int y = 0; y < 4; ++y) a[x][y] = 0.f;
    if (tj <= ti) {
#pragma unroll 2
      for (int d = 0; d < 64; ++d) {
        float qa[4], kb[4];
#pragma unroll
        for (int x = 0; x < 4; ++x) { qa[x] = qi[(4 * ti + x) * 65 + d]; kb[x] = ki[(4 * tj + x) * 65 + d]; }
#pragma unroll
        for (int x = 0; x < 4; ++x)
#pragma unroll
          for (int y = 0; y < 4; ++y) a[x][y] += qa[x] * kb[y];
      }
    }
#pragma unroll
    for (int x = 0; x < 4; ++x)
#pragma unroll
      for (int y = 0; y < 4; ++y) att[(4 * ti + x) * 65 + 4 * tj + y] = (4 * tj + y <= 4 * ti + x) ? a[x][y] : 0.f;
  }
  const int ri = tid >> 2, dq = tid & 3;
  const int vrow = maprow(dir, b, ci * 64 + ri);
  h16* Od = p.OFB + (size_t)dir * NR * 512 + h * 128;
#pragma unroll 1
  for (int half = 0; half < 2; ++half) {
    {
      const h16* zv = p.Z + (size_t)vrow * ZW + 512 + h * 128 + half * 64 + dq * 16;
      h16x8 v0 = *(const h16x8*)zv, v1 = *(const h16x8*)(zv + 8);
#pragma unroll
      for (int j = 0; j < 8; ++j) { vs[ri * 65 + dq * 16 + j] = (float)v0[j]; vs[ri * 65 + dq * 16 + 8 + j] = (float)v1[j]; }
    }
    __syncthreads();
    float o[4][4];
#pragma unroll
    for (int x = 0; x < 4; ++x)
#pragma unroll
      for (int y = 0; y < 4; ++y) o[x][y] = 0.f;
    const int smax = 4 * ti + 3;
#pragma unroll 2
    for (int s2 = 0; s2 <= smax; ++s2) {
      float aa[4], vv[4];
#pragma unroll
      for (int x = 0; x < 4; ++x) { aa[x] = att[(4 * ti + x) * 65 + s2]; vv[x] = vs[s2 * 65 + 4 * tj + x]; }
#pragma unroll
      for (int x = 0; x < 4; ++x)
#pragma unroll
        for (int y = 0; y < 4; ++y) o[x][y] += aa[x] * vv[y];
    }
#pragma unroll
    for (int x = 0; x < 4; ++x) {
      const int row = maprow(dir, b, ci * 64 + 4 * ti + x);
      st4h(Od + (size_t)row * 512 + half * 64 + 4 * tj, o[x][0], o[x][1], o[x][2], o[x][3]);
    }
    __syncthreads();
  }
}

DEVI void gla_job(const P& p, int l, int job, char* smem) {
  float* qi = (float*)smem;
  float* ki = qi + 64 * 65;
  float* vs = ki + 64 * 65;
  float* Ss = vs + 64 * 33;
  const int tid = tidx();
  const int dvs = job & 3, chain = job >> 2;
  const int dir = chain >> 4, b = (chain >> 2) & 3, h = chain & 3;
  for (int i = tid; i < 64 * 33; i += 256) Ss[i] = 0.f;
  const int ri = tid >> 2, dq = tid & 3;
  const int t2 = tid >> 3, tj = tid & 7;
  h16* Od = p.OFB + (size_t)dir * NR * 512 + h * 128 + dvs * 32;
  const unsigned short* Qg = p.QIN + (size_t)dir * NR * 256 + h * 64 + dq * 16;
  const unsigned short* Kg = p.KIN + (size_t)dir * NR * 256 + h * 64 + dq * 16;
  const float* Dg = p.DEC + (size_t)chain * 68 * 64 + 2 * t2;
  uint4 gq0, gq1, gk0, gk1, gv; uint2 goa, gob; float gd0, gd1;
  auto pre = [&](int ci) {
    const int row = maprow(dir, b, ci * 64 + ri);
    gq0 = *(const uint4*)(Qg + (size_t)row * 256); gq1 = *(const uint4*)(Qg + (size_t)row * 256 + 8);
    gk0 = *(const uint4*)(Kg + (size_t)row * 256); gk1 = *(const uint4*)(Kg + (size_t)row * 256 + 8);
    gv = *(const uint4*)(p.Z + (size_t)row * ZW + 512 + h * 128 + dvs * 32 + dq * 8);
    const int rowa = maprow(dir, b, ci * 64 + 2 * t2), rowb = maprow(dir, b, ci * 64 + 2 * t2 + 1);
    goa = *(const uint2*)(Od + (size_t)rowa * 512 + 4 * tj); gob = *(const uint2*)(Od + (size_t)rowb * 512 + 4 * tj);
    gd0 = Dg[ci * 64]; gd1 = Dg[ci * 64 + 1];
  };
  pre(0);
  __syncthreads();
  for (int ci = 0; ci < SB / 64; ++ci) {
    {
      const unsigned qa[8] = {gq0.x, gq0.y, gq0.z, gq0.w, gq1.x, gq1.y, gq1.z, gq1.w};
      const unsigned ka[8] = {gk0.x, gk0.y, gk0.z, gk0.w, gk1.x, gk1.y, gk1.z, gk1.w};
#pragma unroll
      for (int j = 0; j < 8; ++j) {
        qi[ri * 65 + dq * 16 + 2 * j] = __builtin_bit_cast(float, qa[j] << 16); qi[ri * 65 + dq * 16 + 2 * j + 1] = __builtin_bit_cast(float, qa[j] & 0xffff0000u);
        ki[ri * 65 + dq * 16 + 2 * j] = __builtin_bit_cast(float, ka[j] << 16); ki[ri * 65 + dq * 16 + 2 * j + 1] = __builtin_bit_cast(float, ka[j] & 0xffff0000u);
      }
      h16x8 vh = __builtin_bit_cast(h16x8, gv);
#pragma unroll
      for (int j = 0; j < 8; ++j) vs[ri * 33 + dq * 8 + j] = (float)vh[j];
    }
    const uint2 oia = goa, oib = gob; const float e0 = gd0, e1 = gd1;
    const int rowa = maprow(dir, b, ci * 64 + 2 * t2), rowb = maprow(dir, b, ci * 64 + 2 * t2 + 1);
    if (ci + 1 < SB / 64) pre(ci + 1);
    __syncthreads();
    {
      h16x4 ha = __builtin_bit_cast(h16x4, oia), hb = __builtin_bit_cast(h16x4, oib);
      float a0[4], a1[4];
#pragma unroll
      for (int y = 0; y < 4; ++y) { a0[y] = (float)ha[y]; a1[y] = (float)hb[y]; }
#pragma unroll 4
      for (int d = 0; d < 64; ++d) {
        const float x0 = qi[(2 * t2) * 65 + d], x1 = qi[(2 * t2 + 1) * 65 + d];
#pragma unroll
        for (int y = 0; y < 4; ++y) { const float v = Ss[d * 33 + 4 * tj + y]; a0[y] += x0 * v; a1[y] += x1 * v; }
      }
      st4h(Od + (size_t)rowa * 512 + 4 * tj, a0[0], a0[1], a0[2], a0[3]);
      st4h(Od + (size_t)rowb * 512 + 4 * tj, a1[0], a1[1], a1[2], a1[3]);
    }
    __syncthreads();
    {
      float a0[4], a1[4];
#pragma unroll
      for (int y = 0; y < 4; ++y) { a0[y] = Ss[(2 * t2) * 33 + 4 * tj + y]; a1[y] = Ss[(2 * t2 + 1) * 33 + 4 * tj + y]; }
#pragma unroll 4
      for (int s2 = 0; s2 < 64; ++s2) {
        const float x0 = ki[s2 * 65 + 2 * t2], x1 = ki[s2 * 65 + 2 * t2 + 1];
#pragma unroll
        for (int y = 0; y < 4; ++y) { const float v = vs[s2 * 33 + 4 * tj + y]; a0[y] += x0 * v; a1[y] += x1 * v; }
      }
#pragma unroll
      for (int y = 0; y < 4; ++y) { Ss[(2 * t2) * 33 + 4 * tj + y] = a0[y] * e0; Ss[(2 * t2 + 1) * 33 + 4 * tj + y] = a1[y] * e1; }
    }
    __syncthreads();
  }
}

DEVI void mixer_phase(const P& p, int l, char* smem, int cslot, int mode = 0) {
  __shared__ int4 sjobv;
  int& sjob = sjobv.x;
  for (int j = blockIdx.x; j < NSCAN + NGLA; j += gridDim.x) {
    if (mode == 1 && j >= NSCAN) break;
    if (mode == 2 && j < NSCAN) continue;
    if (j < NSCAN) {
      scan_job(p, l, j, smem);
#if PROBE == 4
      __syncthreads();
      scan_job(p, l, j, smem);
#endif
    }
    else gla_job(p, l, j - NSCAN, smem);
    __syncthreads();
  }
  if (mode == 1) return;
  const int njobs = (l < DEPTH - 1) ? 1024 + 64 : 1024;
  while (true) {
    if (tidx() == 0) sjob = (int)atomicAdd(p.CTR + cslot, 1u);
    __syncthreads();
    const int j = sjob;
    __syncthreads();
    if (j >= njobs) break;
    attn_job(p, j, smem);
  }
}

DEVI void post_phase(const P& p, int l) {
  const int lane = tidx() & 63;
  const int wid = blockIdx.x * 4 + (tidx() >> 6), nw = gridDim.x * 4;
  const int c8 = lane * 8;
  for (int r = wid; r < NR; r += nw) {
    {
      h16* zr = p.Z + (size_t)r * ZW + ZRW + c8;
      h16x8 yf = *(const h16x8*)(p.Y2 + (size_t)r * 512 + c8), yb = *(const h16x8*)(p.Y2 + (size_t)(NR + r) * 512 + c8);
      h16x8 rr = *(const h16x8*)zr, kk = *(const h16x8*)(zr + 512), vv = *(const h16x8*)(zr + 1024);
      h16x8 af = *(const h16x8*)(p.AA + (size_t)r * 512 + c8), ab = *(const h16x8*)(p.AA + (size_t)(NR + r) * 512 + c8);
      h16x8 gg = *(const h16x8*)(p.G + (size_t)r * 512 + c8);
      float y[8], sm = 0.f;
#pragma unroll
      for (int i = 0; i < 8; ++i) { y[i] = (float)yf[i] + (float)yb[i]; sm += y[i]; }
      sm += __shfl_xor(sm, 1); sm += __shfl_xor(sm, 2); sm += __shfl_xor(sm, 4);
      const float mean = sm * (1.f / 64.f);
      float sq = 0.f;
#pragma unroll
      for (int i = 0; i < 8; ++i) { y[i] -= mean; sq += y[i] * y[i]; }
      sq += __shfl_xor(sq, 1); sq += __shfl_xor(sq, 2); sq += __shfl_xor(sq, 4);
      const float rs = rsqrtf(sq * (1.f / 64.f) + 64e-5f);
      const float* ka = p.k_a + l * 512 + c8; const float* rk = p.r_k + l * 512 + c8;
      const float* lg = p.rln_g + l * 512 + c8; const float* lb = p.rln_b + l * 512 + c8;
      float bs = 0.f;
#pragma unroll
      for (int i = 0; i < 8; ++i) {
        const float kf = (float)kk[i], kav = ka[i];
        const float ke = kf * (1.f + ((float)af[i] - 1.f) * kav) + kf * (1.f + ((float)ab[i] - 1.f) * kav);
        bs += (float)rr[i] * ke * rk[i];
      }
      bs += __shfl_xor(bs, 1); bs += __shfl_xor(bs, 2); bs += __shfl_xor(bs, 4);
      float o[8];
#pragma unroll
      for (int i = 0; i < 8; ++i) o[i] = (y[i] * rs * lg[i] + lb[i] + bs * (float)vv[i]) * (float)gg[i];
      uint4 u; u.x = pk2n(o[0], o[1]); u.y = pk2n(o[2], o[3]); u.z = pk2n(o[4], o[5]); u.w = pk2n(o[6], o[7]);
      *(uint4*)zr = u;
    }
    {
      h16x8 of = *(const h16x8*)(p.OFB + (size_t)r * 512 + c8), ob = *(const h16x8*)(p.OFB + (size_t)(NR + r) * 512 + c8);
      h16x8 og = *(const h16x8*)(p.Z + (size_t)r * ZW + 1056 + c8);
      float o[8], sq = 0.f;
#pragma unroll
      for (int i = 0; i < 8; ++i) { o[i] = (float)of[i] + (float)ob[i]; sq += o[i] * o[i]; }
      sq += __shfl_xor(sq, 1); sq += __shfl_xor(sq, 2); sq += __shfl_xor(sq, 4); sq += __shfl_xor(sq, 8);
      const float rs = rsqrtf(sq * (1.f / 128.f) + 1e-6f);
      const float* ng = p.gla_ng + l * 128 + (c8 & 127);
#pragma unroll
      for (int i = 0; i < 8; ++i) { const float g = (float)og[i]; o[i] = o[i] * rs * ng[i] * (g * sigm(g)); }
      uint4 u; u.x = pk2n(o[0], o[1]); u.y = pk2n(o[2], o[3]); u.z = pk2n(o[4], o[5]); u.w = pk2n(o[6], o[7]);
      *(uint4*)(p.YA + (size_t)r * ZW + c8) = u;
    }
  }
}

DEVI void merge_phase(const P& p, char* smem) {
  constexpr int MT = NR / 128, NT = 16;
  const int lane = tidx() & 63, wv = tidx() >> 6;
  const int wm = wv >> 1, wn = wv & 1, l31 = lane & 31, hh = lane >> 5;
  for (int job = blockIdx.x; job < MT * NT; job += gridDim.x) {
    int nt = job / MT, mt = job - nt * MT;
    float out[2][16];
#pragma unroll
    for (int a = 0; a < 2; ++a)
#pragma unroll
      for (int r = 0; r < 16; ++r) out[a][r] = 0.f;
#pragma unroll 1
    for (int br = 0; br < 3; ++br) {
      const h16* Y = br == 0 ? p.YA : (br == 1 ? p.Z + ZMLA : p.Z + ZRW);
      const int ldy = ZW;
      f32x16 acc[2][1];
#pragma unroll
      for (int a = 0; a < 2; ++a)
#pragma unroll
        for (int r = 0; r < 16; ++r) acc[a][0][r] = 0.f;
      gemm_main<false, 1>(Y, ldy, p.WB + (size_t)br * D * 512, 512, 512, mt * 128, nt * 64, D, smem, acc, nullptr);
      float u[2][16];
#pragma unroll
      for (int a = 0; a < 2; ++a)
#pragma unroll
        for (int r = 0; r < 16; ++r) { u[a][r] = acc[a][0][r]; acc[a][0][r] = 0.f; }
      gemm_main<false, 1>(p.H, D, p.WIN + (size_t)(ZW + br * D) * D, D, D, mt * 128, nt * 64, D, smem, acc, nullptr);
#pragma unroll
      for (int a = 0; a < 2; ++a)
#pragma unroll
        for (int r = 0; r < 16; ++r) out[a][r] += sigm(acc[a][0][r]) * u[a][r];
    }
#pragma unroll
    for (int a = 0; a < 2; ++a)
#pragma unroll
      for (int g = 0; g < 4; ++g)
        st4h(p.M + (size_t)(mt * 128 + wm * 64 + a * 32 + l31) * D + nt * 64 + wn * 32 + 8 * g + 4 * hh, out[a][4 * g], out[a][4 * g + 1],
             out[a][4 * g + 2], out[a][4 * g + 3]);
  }
}

DEVI void resid_gemm_phase(const P& p, int l, const h16* A, int K, const h16* Bt, int gate_idx, char* smem) {
  constexpr int MT = NR / 128, NT = 8;
  const float alpha = 1.6817928305074290f;
  for (int job = blockIdx.x; job < MT * NT; job += gridDim.x) {
    int nt = job / MT, mt = job - nt * MT;
    f32x16 acc[2][2]; zero_acc(acc);
    gemm_main<false>(A, K, Bt, K, K, mt * 128, nt * 128, D, smem, acc, nullptr);
    epi_quads(acc, mt * 128, nt * 128, [&](int m, int n, float v0, float v1, float v2, float v3) {
      int b = m / SB, s = m - b * SB;
      int g = s < CTX ? 4 : b;
      float4 gt = *(const float4*)(p.MOD + ((size_t)l * 5 + g) * 6144 + gate_idx * D + n);
      float* xp = xrow(p, m) + n;
      float4 xv = *(float4*)xp;
      xv.x = alpha * xv.x + gt.x * v0; xv.y = alpha * xv.y + gt.y * v1; xv.z = alpha * xv.z + gt.z * v2; xv.w = alpha * xv.w + gt.w * v3;
      *(float4*)xp = xv;
    });
  }
}
DEVI void mlp1_phase(const P& p, char* smem) {
  constexpr int MT = NR / 128, NT = DFF / 128;
  h16* HID = p.Z;
  for (int job = blockIdx.x; job < MT * NT; job += gridDim.x) {
    int nt = job / MT, mt = job - nt * MT;
    f32x16 acc[2][2]; zero_acc(acc);
    gemm_main<false>(p.H, D, p.W1T, D, D, mt * 128, nt * 128, DFF, smem, acc, nullptr);
    epi_quads(acc, mt * 128, nt * 128, [&](int m, int n, float v0, float v1, float v2, float v3) {
      v0 = fmaxf(v0, 0.f); v1 = fmaxf(v1, 0.f); v2 = fmaxf(v2, 0.f); v3 = fmaxf(v3, 0.f);
      st4h(HID + (size_t)m * DFF + n, v0 * v0, v1 * v1, v2 * v2, v3 * v3);
    });
  }
}

constexpr int PH_PER_LAYER = 11;
constexpr int NPHASES = 1 + DEPTH * PH_PER_LAYER + 1;

DEVI void run_phase(const P& p, int ph, char* smem) {
  if (ph == 0) { phase0(p, smem); return; }
  if (ph == NPHASES - 1) { ln_phase(p, DEPTH, 2); return; }
  const int l = (ph - 1) / PH_PER_LAYER, k = (ph - 1) - l * PH_PER_LAYER;
  switch (k) {
    case 0: ln_phase(p, l, 0); conv_phase(p, l, 0, 12, smem); break;
    case 1: inproj_phase(p, smem);
#if PROBE == 2
      inproj_phase(p, smem);
#endif
      break;
    case 2: {
      constexpr int NSH = NR / 64, NUP = (NR / 128) * 14;
      for (int j = blockIdx.x; j < NSH + NUP; j += gridDim.x) {
        if (j < NSH) shift_job(p, l, j, smem); else mla_up_job(p, j - NSH, smem);
        __syncthreads();
      }
    } break;
    case 3: {
      constexpr int NPRE = 32 * 68, NLR = 5 * 4 * (NR / 128);
      for (int j = blockIdx.x; j < NPRE + NLR; j += gridDim.x) {
        if (j < NPRE) gla_pre_job(p, l, j, smem); else lowrank_job(p, l, j - NPRE, smem);
        __syncthreads();
      }
    } break;
    case 4: mixer_phase(p, l, smem, l);
#if PROBE == 1
      mixer_phase(p, l, smem, 8 + l);
#endif
      break;
    case 5: post_phase(p, l); break;
    case 6: merge_phase(p, smem); conv_phase(p, l, 12, 14, smem); break;
    case 7: resid_gemm_phase(p, l, p.M, D, p.WO, 2, smem); break;
    case 8: ln_phase(p, l, 1); break;
    case 9: mlp1_phase(p, smem);
#if PROBE == 2
      mlp1_phase(p, smem);
#endif
      break;
    default: resid_gemm_phase(p, l, p.Z, DFF, p.W2T, 5, smem); break;
  }
}

__global__ void __launch_bounds__(256, 2) mega(P p, int pb, int pe) {
  extern __shared__ __attribute__((aligned(16))) char smem[];
  cg::grid_group grid = cg::this_grid();
  __shared__ uint4 xb_words;
  if (threadIdx_x_raw() == 0) xb_words = make_uint4(0u, 0u, 0u, 0u);
  __syncthreads();
  XcdBarrier xb = xcd_barrier_post(p.BAR, (volatile LAS unsigned*)&xb_words);
  for (int ph = pb; ph < pe; ++ph) {
    if (ph > pb) { if (ph == pb + 1) grid.sync(); else xcd_barrier(xb); }
#if PROBE == 6
    if (ph >= 1 && ph < NPHASES - 1 && ((ph - 1) % PH_PER_LAYER) == 4) {
      const int l = (ph - 1) / PH_PER_LAYER;
      mixer_phase(p, l, smem, l, 1);
      xcd_barrier(xb);
      mixer_phase(p, l, smem, l, 1);
      xcd_barrier(xb);
      mixer_phase(p, l, smem, l, 2);
      continue;
    }
#endif
    run_phase(p, ph, smem);
  }
}

extern "C" void kernel_launch(void* const* d_in, const int* in_sizes, int n_in, void* d_out, int out_size, void* d_ws,
                              size_t ws_size, hipStream_t stream) {
  static int grid_blocks = 0;
  if (grid_blocks == 0) {
    int dev = 0, cus = 0, per_cu = 0;
    hipGetDevice(&dev);
    hipDeviceGetAttribute(&cus, hipDeviceAttributeMultiprocessorCount, dev);
    hipFuncSetAttribute((const void*)mega, hipFuncAttributeMaxDynamicSharedMemorySize, LDS_BYTES);
    hipOccupancyMaxActiveBlocksPerMultiprocessor(&per_cu, (const void*)mega, 256, LDS_BYTES);
    if (per_cu < 1) per_cu = 1;
    if (per_cu > 2) per_cu = 2;
    grid_blocks = cus * per_cu;
    fprintf(stderr, "mega: cus %d per_cu %d grid %d\n", cus, per_cu, grid_blocks);
  }
  P p{};
  const float** ins = (const float**)&p;
  for (int i = 0; i < 33; ++i) ins[i] = (const float*)d_in[i];
  char* w = (char*)d_ws;
  size_t off = 0;
  auto take = [&](size_t bytes) { char* r = w + off; off += (bytes + 255) & ~(size_t)255; return r; };
  p.XL = (float*)d_out;
  p.XC = (float*)take((size_t)NB * CTX * D * 4);
  p.MOD = (float*)take((size_t)DEPTH * 5 * 6144 * 4);
  p.ROPE = (float*)take((size_t)SEQ * 32 * 4);
  p.INVN = (float*)take((size_t)NR * 8 * 4);
  p.CTR = (unsigned*)take(256);
  p.BAR = (unsigned*)take((size_t)XCD_BAR_WORDS * 4);
  p.HLO = (h16*)take((size_t)(NR / 64) * 1920 * 2);
  p.HHI = (h16*)take((size_t)(NR / 64) * 1920 * 2);
  p.H = (h16*)take((size_t)NR * D * 2);
  p.Z = (h16*)take((size_t)NR * ZW * 2);
  p.WIN = (h16*)take((size_t)NIN * D * 2);
  p.UQ = (h16*)take((size_t)768 * 384 * 2);
  p.UKV = (h16*)take((size_t)1024 * 256 * 2);
  p.WB = (h16*)take((size_t)3 * D * 512 * 2);
  p.WO = (h16*)take((size_t)D * D * 2);
  p.WUP = (h16*)take((size_t)2 * 512 * 64 * 2);
  p.AUP = (h16*)take((size_t)2 * 512 * 64 * 2);
  p.GUP = (h16*)take((size_t)512 * 128 * 2);
  p.LW = (h16*)take((size_t)2 * NR * 512 * 2);
  p.AA = (h16*)take((size_t)2 * NR * 512 * 2);
  p.W1T = p.LW;
  p.W2T = p.LW + (size_t)DFF * D;
  p.G = (h16*)take((size_t)NR * 512 * 2);
  p.Y2 = (h16*)take((size_t)2 * NR * 512 * 2);
  p.Q = (h16*)take((size_t)NR * 768 * 2);
  p.K = (h16*)take((size_t)NR * 768 * 2);
  p.M = p.Q;
  p.VT = (h16*)take((size_t)NR * 512 * 2);
  p.YA = p.Z + 1056;
  p.QIN = (unsigned short*)take((size_t)2 * NR * 256 * 2);
  p.KIN = (unsigned short*)take((size_t)2 * NR * 256 * 2);
  p.DEC = (float*)take((size_t)32 * 68 * 64 * 4);
  p.OFB = (h16*)take((size_t)2 * NR * 512 * 2);
  if (off > ws_size || n_in != 33) { fprintf(stderr, "mega: workspace too small (%zu > %zu) or n_in %d\n", off, ws_size, n_in); return; }
  (void)hipMemsetAsync(p.BAR, 0, (size_t)XCD_BAR_WORDS * 4, stream);
  int pb = 0, pe = NPHASES;
  void* args[] = {&p, &pb, &pe};
  hipError_t e = hipLaunchCooperativeKernel((const void*)mega, dim3(grid_blocks), dim3(256), args, LDS_BYTES, stream);
  if (e != hipSuccess) fprintf(stderr, "mega: cooperative launch failed: %s (grid %d)\n", hipGetErrorString(e), grid_blocks);
}
```

```cpp
#include <hip/hip_runtime.h>
#include <hip/hip_cooperative_groups.h>
#include <cstdio>
#include <cstdint>
namespace cg = cooperative_groups;

typedef _Float16 h16;
typedef _Float16 h16x8 __attribute__((ext_vector_type(8)));
typedef _Float16 h16x4 __attribute__((ext_vector_type(4)));
typedef float f32x16 __attribute__((ext_vector_type(16)));
typedef float f32x4 __attribute__((ext_vector_type(4)));

#define DEVI __device__ __forceinline__
DEVI int threadIdx_x_raw() { return (int)__builtin_amdgcn_workitem_id_x(); }

#define PROBE 0
constexpr int D = 1024, NB = 4, SEQ = 4096, CTX = 256, DEPTH = 4;
constexpr int SB = SEQ + CTX;
constexpr int NR = NB * SB;
constexpr int ZW = 4160;
constexpr int ZMLA = 1568, ZRW = 2240;
constexpr int NIN = 7232;
constexpr int DFF = 4096;
constexpr int LDS_BYTES = 74752;
constexpr int NSCAN_BPC = 2;
constexpr int NSCAN = 64 * NSCAN_BPC;
constexpr int NGLA = 128;
constexpr int TSTEPS = SB + 1;
constexpr int NCHUNK = (TSTEPS + 15) / 16;

constexpr size_t al256(size_t x) { return (x + 255) & ~(size_t)255; }
constexpr size_t OFF_XC = 0;
constexpr size_t OFF_MOD = OFF_XC + al256((size_t)NB * CTX * D * 4);
constexpr size_t OFF_ROPE = OFF_MOD + al256((size_t)DEPTH * 5 * 6144 * 4);
constexpr size_t OFF_INVN = OFF_ROPE + al256((size_t)SEQ * 32 * 4);
constexpr size_t OFF_CTR = OFF_INVN + al256((size_t)NR * 8 * 4);
constexpr size_t OFF_BAR = OFF_CTR + al256(256);
constexpr size_t OFF_HLO = OFF_BAR + al256((size_t)3456 * 4);
constexpr size_t OFF_HHI = OFF_HLO + al256((size_t)(NR / 64) * 1920 * 2);
constexpr size_t OFF_H = OFF_HHI + al256((size_t)(NR / 64) * 1920 * 2);
constexpr size_t OFF_Z = OFF_H + al256((size_t)NR * D * 2);
constexpr size_t OFF_WIN = OFF_Z + al256((size_t)NR * ZW * 2);
constexpr size_t OFF_UQ = OFF_WIN + al256((size_t)NIN * D * 2);
constexpr size_t OFF_UKV = OFF_UQ + al256((size_t)768 * 384 * 2);
constexpr size_t OFF_WB = OFF_UKV + al256((size_t)1024 * 256 * 2);
constexpr size_t OFF_WO = OFF_WB + al256((size_t)3 * D * 512 * 2);
constexpr size_t OFF_WUP = OFF_WO + al256((size_t)D * D * 2);
constexpr size_t OFF_AUP = OFF_WUP + al256((size_t)2 * 512 * 64 * 2);
constexpr size_t OFF_GUP = OFF_AUP + al256((size_t)2 * 512 * 64 * 2);
constexpr size_t OFF_LW = OFF_GUP + al256((size_t)512 * 128 * 2);
constexpr size_t OFF_AA = OFF_LW + al256((size_t)2 * NR * 512 * 2);
constexpr size_t OFF_G = OFF_AA + al256((size_t)2 * NR * 512 * 2);
constexpr size_t OFF_Y2 = OFF_G + al256((size_t)NR * 512 * 2);
constexpr size_t OFF_Q = OFF_Y2 + al256((size_t)2 * NR * 512 * 2);
constexpr size_t OFF_K = OFF_Q + al256((size_t)NR * 768 * 2);
constexpr size_t OFF_VT = OFF_K + al256((size_t)NR * 768 * 2);
constexpr size_t OFF_QIN = OFF_VT + al256((size_t)NR * 512 * 2);
constexpr size_t OFF_KIN = OFF_QIN + al256((size_t)2 * NR * 256 * 2);
constexpr size_t OFF_DEC = OFF_KIN + al256((size_t)2 * NR * 256 * 2);
constexpr size_t OFF_OFB = OFF_DEC + al256((size_t)32 * 68 * 64 * 4);
constexpr size_t WS_TOTAL = OFF_OFB + al256((size_t)2 * NR * 512 * 2);
struct P {
  const float *x, *c, *ctx, *c_ctx, *ada_w, *ada_b, *w_in, *gk_up, *gk_b, *gla_ng, *qn_g, *kvn_g, *w_uq, *w_ukv,
      *mu, *w0, *w_up, *a0, *a_up, *g_up, *k_k, *k_a, *r_k, *rln_g, *rln_b, *w_branch, *w_out, *ln1_g, *ln1_b,
      *w1, *w2, *ln2_g, *ln2_b;
  float* XL;
  char* ws;
  DEVI float* XC() const { return (float*)(ws + OFF_XC); }
  DEVI float* MOD() const { return (float*)(ws + OFF_MOD); }
  DEVI float* ROPE() const { return (float*)(ws + OFF_ROPE); }
  DEVI float* INVN() const { return (float*)(ws + OFF_INVN); }
  DEVI unsigned* CTR() const { return (unsigned*)(ws + OFF_CTR); }
  DEVI unsigned* BAR() const { return (unsigned*)(ws + OFF_BAR); }
  DEVI h16* HLO() const { return (h16*)(ws + OFF_HLO); }
  DEVI h16* HHI() const { return (h16*)(ws + OFF_HHI); }
  DEVI h16* H() const { return (h16*)(ws + OFF_H); }
  DEVI h16* Z() const { return (h16*)(ws + OFF_Z); }
  DEVI h16* WIN() const { return (h16*)(ws + OFF_WIN); }
  DEVI h16* UQ() const { return (h16*)(ws + OFF_UQ); }
  DEVI h16* UKV() const { return (h16*)(ws + OFF_UKV); }
  DEVI h16* WB() const { return (h16*)(ws + OFF_WB); }
  DEVI h16* WO() const { return (h16*)(ws + OFF_WO); }
  DEVI h16* WUP() const { return (h16*)(ws + OFF_WUP); }
  DEVI h16* AUP() const { return (h16*)(ws + OFF_AUP); }
  DEVI h16* GUP() const { return (h16*)(ws + OFF_GUP); }
  DEVI h16* LW() const { return (h16*)(ws + OFF_LW); }
  DEVI h16* AA() const { return (h16*)(ws + OFF_AA); }
  DEVI h16* G() const { return (h16*)(ws + OFF_G); }
  DEVI h16* Y2() const { return (h16*)(ws + OFF_Y2); }
  DEVI h16* Q() const { return (h16*)(ws + OFF_Q); }
  DEVI h16* K() const { return (h16*)(ws + OFF_K); }
  DEVI h16* VT() const { return (h16*)(ws + OFF_VT); }
  DEVI unsigned short* QIN() const { return (unsigned short*)(ws + OFF_QIN); }
  DEVI unsigned short* KIN() const { return (unsigned short*)(ws + OFF_KIN); }
  DEVI float* DEC() const { return (float*)(ws + OFF_DEC); }
  DEVI h16* OFB() const { return (h16*)(ws + OFF_OFB); }
  DEVI h16* W1T() const { return (h16*)(ws + OFF_LW); }
  DEVI h16* W2T() const { return (h16*)(ws + OFF_LW + (size_t)DFF * D * 2); }
  DEVI h16* M() const { return (h16*)(ws + OFF_Q); }
  DEVI h16* YA() const { return (h16*)(ws + OFF_Z + 1056 * 2); }
};

DEVI int tidx() { int t = threadIdx_x_raw(); asm volatile("" : "+v"(t)); return t; }
DEVI float wsum(float v) {
#pragma unroll
  for (int o = 32; o; o >>= 1) v += __shfl_xor(v, o);
  return v;
}
DEVI float sigm(float x) { return 1.f / (1.f + __expf(-x)); }
DEVI unsigned pk2(float a, float b) {
  auto h = __builtin_amdgcn_cvt_pkrtz(a, b);
  return __builtin_bit_cast(unsigned, h);
}
DEVI unsigned pk2n(float a, float b) {
  h16 x = (h16)a, y = (h16)b;
  unsigned short ux = __builtin_bit_cast(unsigned short, x), uy = __builtin_bit_cast(unsigned short, y);
  return (unsigned)ux | ((unsigned)uy << 16);
}
DEVI unsigned f2bf(float f) { unsigned u = __builtin_bit_cast(unsigned, f); u += 0x7fffu + ((u >> 16) & 1u); return u >> 16; }
DEVI float h2f(unsigned short u) { return (float)__builtin_bit_cast(h16, u); }
DEVI void st4h(h16* dst, float a, float b, float c, float d) {
  uint2 u; u.x = pk2n(a, b); u.y = pk2n(c, d);
  *(uint2*)dst = u;
}
DEVI float* xrow(const P& p, int r) {
  int b = r / SB, s = r - b * SB;
  return s < CTX ? p.XC() + (size_t)(b * CTX + s) * D : p.XL + (size_t)(b * SEQ + s - CTX) * D;
}
DEVI int maprow(int dir, int b, int n) {
  if (dir == 0) return b * SB + n;
  return n < CTX ? b * SB + (CTX - 1 - n) : b * SB + (SB + CTX - 1 - n);
}


#define XB_TMO      128
#define XB_XCNT(j)  (256  + 64 * (j))
#define XB_XSUB(j)  (1280 + 64 * (j))
#define XB_XGEN(j)  (2304 + 64 * (j))
#define XB_TOP      3328
#define XB_TOPGEN   3392
#define XCD_BAR_WORDS 3456
#define XB_SPIN_CAP (1u << 22)
#define LAS __attribute__((address_space(3)))
DEVI unsigned xb_ld(unsigned* p) { return __hip_atomic_load(p, __ATOMIC_RELAXED, __HIP_MEMORY_SCOPE_AGENT); }
DEVI unsigned xb_add(unsigned* p, unsigned v) { return __hip_atomic_fetch_add(p, v, __ATOMIC_RELAXED, __HIP_MEMORY_SCOPE_AGENT); }
DEVI unsigned xb_xcc_id() { return (unsigned)__builtin_amdgcn_s_getreg((3 << 11) | 20) & 0xFu; }
#define XB_SPIN(cond, bar) do { unsigned _sp = 0; while (cond) { __builtin_amdgcn_s_sleep(1); \
    if ((++_sp & 255u) == 0u) { if (xb_ld(&(bar)[XB_TMO])) break; if (_sp > XB_SPIN_CAP) { atomicAdd(&(bar)[XB_TMO], 1u); break; } } } } while (0)
struct XcdBarrier { unsigned* bar; unsigned x; volatile LAS unsigned* st; };
DEVI XcdBarrier xcd_barrier_post(unsigned* bar, volatile LAS unsigned* st) {
  XcdBarrier b; b.bar = bar; b.x = xb_xcc_id(); b.st = st;
  if (threadIdx_x_raw() == 0) (void)xb_add(&bar[XB_XCNT(b.x)], 1u);
  return b;
}
DEVI void xcd_barrier_complete(unsigned* bar, unsigned x, unsigned& nloc, unsigned& nx) {
  const unsigned G = gridDim.x;
  unsigned sum, cnt, mine, sp = 0u;
  for (;;) {
    sum = 0u; cnt = 0u; mine = 0u;
#pragma unroll
    for (unsigned j = 0; j < 16; ++j) { const unsigned c = xb_ld(&bar[XB_XCNT(j)]); sum += c; cnt += (c > 0u) ? 1u : 0u; mine = (j == x) ? c : mine; }
    if (sum == G) break;
    __builtin_amdgcn_s_sleep(1);
    if ((++sp & 255u) == 0u) { if (xb_ld(&bar[XB_TMO])) break; if (sp > XB_SPIN_CAP) { atomicAdd(&bar[XB_TMO], 1u); break; } }
  }
  nloc = mine > 0u ? mine : 1u; nx = cnt > 0u ? cnt : 1u;
}
DEVI void xcd_barrier(const XcdBarrier& b) {
  asm volatile("s_waitcnt vmcnt(0)" ::: "memory");
  __syncthreads();
  if (threadIdx_x_raw() == 0) {
    unsigned* bar = b.bar;
    __builtin_amdgcn_s_waitcnt(0);
    unsigned nloc = b.st[0], nx = b.st[1];
    if (nloc == 0u) { xcd_barrier_complete(bar, b.x, nloc, nx); b.st[0] = nloc; b.st[1] = nx; }
    const unsigned old = xb_add(&bar[XB_XSUB(b.x)], 1u);
    const unsigned gen = old / nloc;
    if (old + 1u == (gen + 1u) * nloc) {
      __builtin_amdgcn_fence(__ATOMIC_RELEASE, "agent");
      asm volatile("s_waitcnt vmcnt(0)" ::: "memory");
      const unsigned og = xb_add(&bar[XB_TOP], 1u);
      const unsigned tg = og / nx;
      if (og + 1u == (tg + 1u) * nx) xb_add(&bar[XB_TOPGEN], 1u);
      else XB_SPIN(xb_ld(&bar[XB_TOPGEN]) == tg, bar);
      __builtin_amdgcn_fence(__ATOMIC_ACQUIRE, "agent");
      xb_add(&bar[XB_XGEN(b.x)], 1u);
      asm volatile("s_waitcnt vmcnt(0)" ::: "memory");
    } else {
      XB_SPIN(xb_ld(&bar[XB_XGEN(b.x)]) == gen, bar);
      __builtin_amdgcn_fence(__ATOMIC_ACQUIRE, "agent");
      asm volatile("s_waitcnt vmcnt(0)" ::: "memory");
    }
  }
  __syncthreads();
}

DEVI void phase0(const P& p, char* smem) {
  const int tid = tidx();
  float* sc = (float*)smem;
  float* red = sc + 5 * 1024;
  for (int i = tid; i < 5 * 1024; i += 256) {
    int g = i >> 10, k = i & 1023;
    float v = g < 4 ? p.c[g * D + k] : p.c_ctx[k];
    sc[i] = v * sigm(v);
  }
  __syncthreads();
  for (int job = blockIdx.x; job < DEPTH * 96; job += gridDim.x) {
    int l = job / 96, n0 = (job % 96) * 64;
    int kq = tid >> 6, cc = tid & 63;
    const float* w = p.ada_w + ((size_t)l * D + kq * 256) * 6144 + n0 + cc;
    float a0 = 0, a1 = 0, a2 = 0, a3 = 0, a4 = 0;
#pragma unroll 8
    for (int k = 0; k < 256; ++k) {
      float wv = w[(size_t)k * 6144];
      int kk = kq * 256 + k;
      a0 += sc[kk] * wv; a1 += sc[1024 + kk] * wv; a2 += sc[2048 + kk] * wv; a3 += sc[3072 + kk] * wv; a4 += sc[4096 + kk] * wv;
    }
    red[(kq * 5 + 0) * 64 + cc] = a0; red[(kq * 5 + 1) * 64 + cc] = a1; red[(kq * 5 + 2) * 64 + cc] = a2;
    red[(kq * 5 + 3) * 64 + cc] = a3; red[(kq * 5 + 4) * 64 + cc] = a4;
    __syncthreads();
    for (int i = tid; i < 320; i += 256) {
      int g = i >> 6, c2 = i & 63;
      float s = red[(0 * 5 + g) * 64 + c2] + red[(1 * 5 + g) * 64 + c2] + red[(2 * 5 + g) * 64 + c2] + red[(3 * 5 + g) * 64 + c2];
      p.MOD()[((size_t)l * 5 + g) * 6144 + n0 + c2] = s + p.ada_b[l * 6144 + n0 + c2];
    }
    __syncthreads();
  }
  for (int i = blockIdx.x * 256 + tid; i < SEQ * 16; i += gridDim.x * 256) {
    int s = i >> 4, j = i & 15;
    float pos = (float)(j < 8 ? (s >> 6) : (s & 63));
    float inv = exp2f(-(float)(j & 7) * (13.287712379549449f / 8.f));
    float ang = pos * inv;
    p.ROPE()[s * 32 + j] = cosf(ang);
    p.ROPE()[s * 32 + 16 + j] = sinf(ang);
  }
  if (blockIdx.x == 0 && tid < 64) p.CTR()[tid] = 0;
}

struct CE { const float* src; h16* dst; const float* scale; int K, N; };
DEVI CE get_ce(const P& p, int l, int e) {
  CE c; c.scale = nullptr;
  switch (e) {
    case 0: c.src = p.w_in + (size_t)l * D * NIN; c.dst = p.WIN(); c.K = D; c.N = NIN; break;
    case 1: c.src = p.w_uq + (size_t)l * 384 * 768; c.dst = p.UQ(); c.K = 384; c.N = 768; c.scale = p.qn_g + l * 384; break;
    case 2: c.src = p.w_ukv + (size_t)l * 256 * 1024; c.dst = p.UKV(); c.K = 256; c.N = 1024; c.scale = p.kvn_g + l * 256; break;
    case 3: case 4: case 5: c.src = p.w_branch + ((size_t)l * 3 + (e - 3)) * 512 * D; c.dst = p.WB() + (size_t)(e - 3) * D * 512; c.K = 512; c.N = D; break;
    case 6: c.src = p.w_out + (size_t)l * D * D; c.dst = p.WO(); c.K = D; c.N = D; break;
    case 7: case 8: c.src = p.w_up + ((size_t)l * 2 + (e - 7)) * 64 * 512; c.dst = p.WUP() + (size_t)(e - 7) * 512 * 64; c.K = 64; c.N = 512; break;
    case 9: case 10: c.src = p.a_up + ((size_t)l * 2 + (e - 9)) * 64 * 512; c.dst = p.AUP() + (size_t)(e - 9) * 512 * 64; c.K = 64; c.N = 512; break;
    case 11: c.src = p.g_up + (size_t)l * 128 * 512; c.dst = p.GUP(); c.K = 128; c.N = 512; break;
    case 12: c.src = p.w1 + (size_t)l * D * DFF; c.dst = p.W1T(); c.K = D; c.N = DFF; break;
    default: c.src = p.w2 + (size_t)l * DFF * D; c.dst = p.W2T(); c.K = DFF; c.N = D; break;
  }
  return c;
}
DEVI void conv_tile(const CE& e, int tile, char* smem) {
  float* s = (float*)smem;
  const int tid = tidx();
  int ntn = e.N >> 6;
  int kt = tile / ntn, nt = tile - kt * ntn;
  {
    int r = tid >> 4, c4 = (tid & 15) * 4;
#pragma unroll
    for (int rr = 0; rr < 4; ++rr) {
      int k = r + 16 * rr;
      float4 v = *(const float4*)(e.src + (size_t)(kt * 64 + k) * e.N + nt * 64 + c4);
      float sc = e.scale ? e.scale[kt * 64 + k] : 1.f;
      s[k * 65 + c4 + 0] = v.x * sc; s[k * 65 + c4 + 1] = v.y * sc; s[k * 65 + c4 + 2] = v.z * sc; s[k * 65 + c4 + 3] = v.w * sc;
    }
  }
  __syncthreads();
  {
    int n = tid >> 2, kq = (tid & 3) * 16;
    uint4 u0, u1;
    u0.x = pk2n(s[(kq + 0) * 65 + n], s[(kq + 1) * 65 + n]); u0.y = pk2n(s[(kq + 2) * 65 + n], s[(kq + 3) * 65 + n]);
    u0.z = pk2n(s[(kq + 4) * 65 + n], s[(kq + 5) * 65 + n]); u0.w = pk2n(s[(kq + 6) * 65 + n], s[(kq + 7) * 65 + n]);
    u1.x = pk2n(s[(kq + 8) * 65 + n], s[(kq + 9) * 65 + n]); u1.y = pk2n(s[(kq + 10) * 65 + n], s[(kq + 11) * 65 + n]);
    u1.z = pk2n(s[(kq + 12) * 65 + n], s[(kq + 13) * 65 + n]); u1.w = pk2n(s[(kq + 14) * 65 + n], s[(kq + 15) * 65 + n]);
    h16* d = e.dst + (size_t)(nt * 64 + n) * e.K + kt * 64 + kq;
    *(uint4*)d = u0; *(uint4*)(d + 8) = u1;
  }
  __syncthreads();
}
DEVI void conv_phase(const P& p, int l, int e0, int e1, char* smem) {
  int total = 0;
  for (int e = e0; e < e1; ++e) { CE c = get_ce(p, l, e); total += (c.K >> 6) * (c.N >> 6); }
  for (int t = blockIdx.x; t < total; t += gridDim.x) {
    int tt = t;
    for (int e = e0; e < e1; ++e) {
      CE c = get_ce(p, l, e);
      int nt = (c.K >> 6) * (c.N >> 6);
      if (tt < nt) { conv_tile(c, tt, smem); break; }
      tt -= nt;
    }
  }
}

DEVI void ln_phase(const P& p, int l, int which) {
  const int lane = tidx() & 63;
  const int wid = blockIdx.x * 4 + (tidx() >> 6), nw = gridDim.x * 4;
  for (int r = wid; r < NR; r += nw) {
    int b = r / SB, s = r - b * SB;
    if (which == 2 && s < CTX) continue;
    int g = s < CTX ? 4 : b;
    float* xr = xrow(p, r);
    const float* src = xr;
    if (which == 0 && l == 0) src = s < CTX ? p.ctx + (size_t)(b * CTX + s) * D : p.x + (size_t)(b * SEQ + s - CTX) * D;
    float4 v[4];
#pragma unroll
    for (int i = 0; i < 4; ++i) v[i] = *(const float4*)(src + i * 256 + lane * 4);
    bool do_ln = !(which == 0 && l == 0);
    if (do_ln) {
      const float* gg = which == 1 ? p.ln1_g + l * D : p.ln2_g + (which == 2 ? 3 : l - 1) * D;
      const float* bb = which == 1 ? p.ln1_b + l * D : p.ln2_b + (which == 2 ? 3 : l - 1) * D;
      float sm = 0;
#pragma unroll
      for (int i = 0; i < 4; ++i) sm += v[i].x + v[i].y + v[i].z + v[i].w;
      float mean = wsum(sm) * (1.f / D);
      float sq = 0;
#pragma unroll
      for (int i = 0; i < 4; ++i) {
        v[i].x -= mean; v[i].y -= mean; v[i].z -= mean; v[i].w -= mean;
        sq += v[i].x * v[i].x + v[i].y * v[i].y + v[i].z * v[i].z + v[i].w * v[i].w;
      }
      float rs = rsqrtf(wsum(sq) * (1.f / D) + 1e-5f);
#pragma unroll
      for (int i = 0; i < 4; ++i) {
        float4 g4 = *(const float4*)(gg + i * 256 + lane * 4), b4 = *(const float4*)(bb + i * 256 + lane * 4);
        v[i].x = v[i].x * rs * g4.x + b4.x; v[i].y = v[i].y * rs * g4.y + b4.y;
        v[i].z = v[i].z * rs * g4.z + b4.z; v[i].w = v[i].w * rs * g4.w + b4.w;
      }
    }
#pragma unroll
    for (int i = 0; i < 4; ++i) *(float4*)(xr + i * 256 + lane * 4) = v[i];
    if (which == 2) continue;
    const float* shf = p.MOD() + ((size_t)l * 5 + g) * 6144 + (which == 0 ? 0 : 3) * D;
    const float* scl = shf + D;
    float sm = 0;
#pragma unroll
    for (int i = 0; i < 4; ++i) sm += v[i].x + v[i].y + v[i].z + v[i].w;
    float mean = wsum(sm) * (1.f / D);
    float sq = 0;
#pragma unroll
    for (int i = 0; i < 4; ++i) {
      v[i].x -= mean; v[i].y -= mean; v[i].z -= mean; v[i].w -= mean;
      sq += v[i].x * v[i].x + v[i].y * v[i].y + v[i].z * v[i].z + v[i].w * v[i].w;
    }
    float rs = rsqrtf(wsum(sq) * (1.f / D) + 1e-6f);
    h16* hr = p.H() + (size_t)r * D;
#pragma unroll
    for (int i = 0; i < 4; ++i) {
      float4 s4 = *(const float4*)(shf + i * 256 + lane * 4), c4 = *(const float4*)(scl + i * 256 + lane * 4);
      st4h(hr + i * 256 + lane * 4, v[i].x * rs * (1.f + c4.x) + s4.x, v[i].y * rs * (1.f + c4.y) + s4.y,
           v[i].z * rs * (1.f + c4.z) + s4.z, v[i].w * rs * (1.f + c4.w) + s4.w);
    }
  }
}

constexpr int GLD = 72;
template <bool ROWSQ, int NI = 2>
DEVI void gemm_main(const h16* __restrict__ A, int lda, const h16* __restrict__ Bt, int ldb, int K, int m0, int n0, int nmax,
                    char* smem, f32x16 (&acc)[2][NI], float* rowsq) {
  h16* As = (h16*)smem;
  h16* Bs = As + 2 * 128 * GLD;
  const int tid = tidx(), lane = tid & 63, wv = tid >> 6;
  const int wm = wv >> 1, wn = wv & 1, l31 = lane & 31, hh = lane >> 5;
  const int lrow = tid >> 3, lkc = (tid & 7) * 8;
  uint4 ga[4], gb[2 * NI];
  float sq[4] = {0.f, 0.f, 0.f, 0.f};
  const h16* Ap = A + (size_t)(m0 + lrow) * lda + lkc;
  const h16* Bp = Bt + (size_t)(n0 + lrow) * ldb + lkc;
#pragma unroll
  for (int i = 0; i < 4; ++i) ga[i] = *(const uint4*)(Ap + (size_t)(32 * i) * lda);
#pragma unroll
  for (int i = 0; i < 2 * NI; ++i)
    gb[i] = (n0 + lrow + 32 * i < nmax) ? *(const uint4*)(Bp + (size_t)(32 * i) * ldb) : make_uint4(0, 0, 0, 0);
  const int KT = K >> 6;
#pragma unroll
  for (int i = 0; i < 4; ++i) *(uint4*)(As + (lrow + 32 * i) * GLD + lkc) = ga[i];
#pragma unroll
  for (int i = 0; i < 2 * NI; ++i) *(uint4*)(Bs + (lrow + 32 * i) * GLD + lkc) = gb[i];
  __syncthreads();
  for (int kt = 0; kt < KT; ++kt) {
    const int buf = kt & 1;
    if (ROWSQ) {
#pragma unroll
      for (int i = 0; i < 4; ++i) {
        h16x8 hv = __builtin_bit_cast(h16x8, ga[i]);
#pragma unroll
        for (int j = 0; j < 8; ++j) { float f = (float)hv[j]; sq[i] += f * f; }
      }
    }
    if (kt + 1 < KT) {
#pragma unroll
      for (int i = 0; i < 4; ++i) ga[i] = *(const uint4*)(Ap + (size_t)(32 * i) * lda + (kt + 1) * 64);
#pragma unroll
      for (int i = 0; i < 2 * NI; ++i)
        gb[i] = (n0 + lrow + 32 * i < nmax) ? *(const uint4*)(Bp + (size_t)(32 * i) * ldb + (kt + 1) * 64) : make_uint4(0, 0, 0, 0);
    }
    const h16* as = As + buf * 128 * GLD + (wm * 64 + l31) * GLD + hh * 8;
    const h16* bs = Bs + buf * 128 * GLD + (wn * 32 * NI + l31) * GLD + hh * 8;
#pragma unroll
    for (int ks = 0; ks < 4; ++ks) {
      h16x8 a0 = *(const h16x8*)(as + ks * 16), a1 = *(const h16x8*)(as + 32 * GLD + ks * 16);
#pragma unroll
      for (int ni = 0; ni < NI; ++ni) {
        h16x8 b0 = *(const h16x8*)(bs + ni * 32 * GLD + ks * 16);
        acc[0][ni] = __builtin_amdgcn_mfma_f32_32x32x16_f16(b0, a0, acc[0][ni], 0, 0, 0);
        acc[1][ni] = __builtin_amdgcn_mfma_f32_32x32x16_f16(b0, a1, acc[1][ni], 0, 0, 0);
      }
    }
    if (kt + 1 < KT) {
      h16* ad = As + (buf ^ 1) * 128 * GLD;
      h16* bd = Bs + (buf ^ 1) * 128 * GLD;
#pragma unroll
      for (int i = 0; i < 4; ++i) *(uint4*)(ad + (lrow + 32 * i) * GLD + lkc) = ga[i];
#pragma unroll
      for (int i = 0; i < 2 * NI; ++i) *(uint4*)(bd + (lrow + 32 * i) * GLD + lkc) = gb[i];
    }
    __syncthreads();
  }
  if (ROWSQ) {
#pragma unroll
    for (int i = 0; i < 4; ++i) {
      float s = sq[i];
      s += __shfl_xor(s, 1); s += __shfl_xor(s, 2); s += __shfl_xor(s, 4);
      if ((tid & 7) == 0) rowsq[lrow + 32 * i] = s;
    }
    __syncthreads();
  }
}
template <int NI = 2>
DEVI void gemm_deep(const h16* __restrict__ A, int lda, const h16* __restrict__ Bt, int ldb, int K, int m0, int n0, int nmax,
                    char* smem, f32x16 (&acc)[2][NI]) {
  h16* As = (h16*)smem;
  h16* Bs = As + 2 * 128 * GLD;
  const int tid = tidx(), lane = tid & 63, wv = tid >> 6;
  const int wm = wv >> 1, wn = wv & 1, l31 = lane & 31, hh = lane >> 5;
  const int lrow = tid >> 3, lkc = (tid & 7) * 8;
  uint4 pa0, pa1, pa2, pa3, pb0, pb1, pb2, pb3;
  uint4 qa0, qa1, qa2, qa3, qb0, qb1, qb2, qb3;
  const h16* Ap = A + (size_t)(m0 + lrow) * lda + lkc;
  const int KT = K >> 6;
  const uint4 zz = make_uint4(0, 0, 0, 0);
  const h16* Bq0 = Bt + (size_t)min(n0 + lrow, nmax - 1) * ldb + lkc;
  const h16* Bq1 = Bt + (size_t)min(n0 + lrow + 32, nmax - 1) * ldb + lkc;
  const h16* Bq2 = Bt + (size_t)min(n0 + lrow + 64, nmax - 1) * ldb + lkc;
  const h16* Bq3 = Bt + (size_t)min(n0 + lrow + 96, nmax - 1) * ldb + lkc;
#define GLOAD(S, kt_)                                                                   \
  {                                                                                     \
    const h16* ap_ = Ap + (kt_) * 64;                                                   \
    S##a0 = *(const uint4*)(ap_); S##a1 = *(const uint4*)(ap_ + (size_t)32 * lda);      \
    S##a2 = *(const uint4*)(ap_ + (size_t)64 * lda); S##a3 = *(const uint4*)(ap_ + (size_t)96 * lda); \
    S##b0 = *(const uint4*)(Bq0 + (kt_) * 64); S##b1 = *(const uint4*)(Bq1 + (kt_) * 64); \
    if (NI == 2) { S##b2 = *(const uint4*)(Bq2 + (kt_) * 64); S##b3 = *(const uint4*)(Bq3 + (kt_) * 64); } \
  }
#define LSTORE(S, buf_)                                                                 \
  {                                                                                     \
    h16* ad = As + (buf_) * 128 * GLD + lrow * GLD + lkc;                               \
    h16* bd = Bs + (buf_) * 128 * GLD + lrow * GLD + lkc;                               \
    *(uint4*)(ad) = S##a0; *(uint4*)(ad + 32 * GLD) = S##a1; *(uint4*)(ad + 64 * GLD) = S##a2; *(uint4*)(ad + 96 * GLD) = S##a3; \
    *(uint4*)(bd) = S##b0; *(uint4*)(bd + 32 * GLD) = S##b1;                            \
    if (NI == 2) { *(uint4*)(bd + 64 * GLD) = S##b2; *(uint4*)(bd + 96 * GLD) = S##b3; } \
  }
#define COMPUTE(buf_)                                                                                              \
  {                                                                                                                \
    const h16* as = As + (buf_) * 128 * GLD + (wm * 64 + l31) * GLD + hh * 8;                                      \
    const h16* bs = Bs + (buf_) * 128 * GLD + (wn * 32 * NI + l31) * GLD + hh * 8;                                 \
    _Pragma("unroll") for (int ks = 0; ks < 4; ++ks) {                                                             \
      h16x8 a0 = *(const h16x8*)(as + ks * 16), a1 = *(const h16x8*)(as + 32 * GLD + ks * 16);                     \
      _Pragma("unroll") for (int ni = 0; ni < NI; ++ni) {                                                          \
        h16x8 b0 = *(const h16x8*)(bs + ni * 32 * GLD + ks * 16);                                                  \
        acc[0][ni] = __builtin_amdgcn_mfma_f32_32x32x16_f16(b0, a0, acc[0][ni], 0, 0, 0);                          \
        acc[1][ni] = __builtin_amdgcn_mfma_f32_32x32x16_f16(b0, a1, acc[1][ni], 0, 0, 0);                          \
      }                                                                                                            \
    }                                                                                                              \
  }
  pb2 = zz; pb3 = zz; qb2 = zz; qb3 = zz;
  GLOAD(p, 0);
  GLOAD(q, 1);
  LSTORE(p, 0);
  if (KT > 2) GLOAD(p, 2);
  __syncthreads();
  for (int kt = 0; kt < KT; kt += 2) {
    COMPUTE(0);
    if (kt + 1 < KT) LSTORE(q, 1);
    if (kt + 3 < KT) GLOAD(q, kt + 3);
    __syncthreads();
    if (kt + 1 < KT) {
      COMPUTE(1);
      if (kt + 2 < KT) LSTORE(p, 0);
      if (kt + 4 < KT) GLOAD(p, kt + 4);
      __syncthreads();
    }
  }
#undef GLOAD
#undef LSTORE
#undef COMPUTE
}
DEVI void zero_acc(f32x16 (&acc)[2][2]) {
#pragma unroll
  for (int i = 0; i < 2; ++i)
#pragma unroll
    for (int j = 0; j < 2; ++j)
#pragma unroll
      for (int r = 0; r < 16; ++r) acc[i][j][r] = 0.f;
}
template <class F>
DEVI void epi_quads(const f32x16 (&acc)[2][2], int m0, int n0, F f) {
  const int lane = tidx() & 63, wv = tidx() >> 6;
  const int wm = wv >> 1, wn = wv & 1, l31 = lane & 31, hh = lane >> 5;
#pragma unroll
  for (int mi = 0; mi < 2; ++mi)
#pragma unroll
    for (int ni = 0; ni < 2; ++ni)
#pragma unroll
      for (int g = 0; g < 4; ++g)
        f(m0 + wm * 64 + mi * 32 + l31, n0 + wn * 64 + ni * 32 + 8 * g + 4 * hh, acc[mi][ni][4 * g], acc[mi][ni][4 * g + 1],
          acc[mi][ni][4 * g + 2], acc[mi][ni][4 * g + 3]);
}

DEVI void inproj_phase(const P& p, char* smem) {
  constexpr int MT = NR / 128, NT = (ZW + 127) / 128;
  for (int job = blockIdx.x; job < MT * NT; job += gridDim.x) {
    int nt = job / MT, mt = job - nt * MT;
    f32x16 acc[2][2]; zero_acc(acc);
    gemm_deep<2>(p.H(), D, p.WIN(), D, D, mt * 128, nt * 128, ZW, smem, acc);
    epi_quads(acc, mt * 128, nt * 128, [&](int m, int n, float v0, float v1, float v2, float v3) {
      if (n < ZW) {
        st4h(p.Z() + (size_t)m * ZW + n, v0, v1, v2, v3);
        if (n >= ZRW) {
          if ((m & 63) == 0) st4h(p.HLO() + (size_t)(m >> 6) * 1920 + n - ZRW, v0, v1, v2, v3);
          if ((m & 63) == 63) st4h(p.HHI() + (size_t)(m >> 6) * 1920 + n - ZRW, v0, v1, v2, v3);
        }
      }
    });
  }
}

DEVI void shift_job(const P& p, int l, int j, char* smem) {
  h16* raw = (h16*)smem;
  const int tid = tidx(), lane = tid & 63;
  const int r0 = j * 64;
  const int s0 = r0 % SB;
  const bool first = (s0 == 0) || (s0 == CTX);
  const bool last = (s0 + 64 == CTX) || (s0 + 64 == SB);
  for (int slab = 0; slab < 8; ++slab) {
    const int c0 = slab * 256;
    const int ncols = slab == 7 ? 128 : 256;
    const int cpr = ncols >> 3;
    for (int c = tid; c < 66 * cpr; c += 256) {
      int row = c / cpr, ch = (c - row * cpr) * 8;
      uint4 v = make_uint4(0, 0, 0, 0);
      if (row == 0) { if (!first) v = *(const uint4*)(p.HHI() + (size_t)(j - 1) * 1920 + c0 + ch); }
      else if (row == 65) { if (!last) v = *(const uint4*)(p.HLO() + (size_t)(j + 1) * 1920 + c0 + ch); }
      else v = *(const uint4*)(p.Z() + (size_t)(r0 + row - 1) * ZW + ZRW + c0 + ch);
      *(uint4*)(raw + row * 264 + ch) = v;
    }
    __syncthreads();
    if (tid < ncols) {
      const int col = c0 + tid;
      const float mup = p.mu[(size_t)l * 2 * 1920 + col], mun = p.mu[(size_t)l * 2 * 1920 + 1920 + col];
      const bool isk = (col >= 512 && col < 1024);
      const float kkp = isk ? p.k_k[l * 512 + col - 512] : 0.f;
      float prev = (float)raw[tid], cur = (float)raw[264 + tid];
      h16* zc = p.Z() + (size_t)r0 * ZW + ZRW + col;
      for (int t = 0; t < 64; ++t) {
        float nxt = (float)raw[(t + 2) * 264 + tid];
        float o = cur + mup * (prev - cur) + mun * (nxt - cur);
        float ov = o;
        if (col >= 1536 && col < 1664) ov = tanhf(o);
        else if (col >= 1792) ov = sigm(o);
        zc[(size_t)t * ZW] = (h16)ov;
        if (isk) {
          float q = o * kkp;
          float ss = wsum(q * q);
          if (lane == 0) p.INVN()[(size_t)(r0 + t) * 8 + ((col - 512) >> 6)] = rsqrtf(ss + 1e-12f);
        }
        prev = cur; cur = nxt;
      }
    }
    __syncthreads();
  }
}

DEVI void mla_up_job(const P& p, int job, char* smem) {
  constexpr int MT = NR / 128;
  float* rowsq = (float*)(smem + 2 * 2 * 128 * GLD * 2);
  const int tid = tidx();
  f32x16 acc[2][2]; zero_acc(acc);
  if (job < MT * 6) {
    int nt = job / MT, mt = job - nt * MT;
    gemm_main<true>(p.Z() + ZMLA, ZW, p.UQ(), 384, 384, mt * 128, nt * 128, 768, smem, acc, rowsq);
    const int m0 = mt * 128, n0 = nt * 128;
    const int lane = tid & 63, wv = tid >> 6, wm = wv >> 1, wn = wv & 1, l31 = lane & 31, hh = lane >> 5;
    const float qs = 0.10206207261596575f * 1.4426950408889634f;
#pragma unroll
    for (int mi = 0; mi < 2; ++mi) {
      const int ml = wm * 64 + mi * 32 + l31, m = m0 + ml;
      const float sc = rsqrtf(rowsq[ml] * (1.f / 384.f) + 1e-6f) * qs;
      const int sp = m % SB;
      const bool lat = sp >= CTX;
      const float* rp = p.ROPE() + (size_t)(lat ? sp - CTX : 0) * 32;
#pragma unroll
      for (int ni = 0; ni < 2; ++ni) {
        const int nb = n0 + wn * 64 + ni * 32;
        h16* qd = p.Q() + (size_t)m * 768 + nb;
        const bool ropet = (nb % 96) == 64;
        if (ropet && lat) {
#pragma unroll
          for (int g = 0; g < 2; ++g) {
            float o1[4], o2[4];
#pragma unroll
            for (int jj = 0; jj < 4; ++jj) {
              int i = 8 * g + 4 * hh + jj;
              float x1 = acc[mi][ni][4 * g + jj] * sc, x2 = acc[mi][ni][4 * (g + 2) + jj] * sc;
              float cs = rp[i], sn = rp[16 + i];
              o1[jj] = x1 * cs - x2 * sn; o2[jj] = x1 * sn + x2 * cs;
            }
            st4h(qd + 8 * g + 4 * hh, o1[0], o1[1], o1[2], o1[3]);
            st4h(qd + 16 + 8 * g + 4 * hh, o2[0], o2[1], o2[2], o2[3]);
          }
        } else {
#pragma unroll
          for (int g = 0; g < 4; ++g)
            st4h(qd + 8 * g + 4 * hh, acc[mi][ni][4 * g] * sc, acc[mi][ni][4 * g + 1] * sc, acc[mi][ni][4 * g + 2] * sc, acc[mi][ni][4 * g + 3] * sc);
        }
      }
    }
  } else {
    int j2 = job - MT * 6;
    int nt = j2 / MT, mt = j2 - nt * MT;
    gemm_main<true>(p.Z() + ZMLA + 384, ZW, p.UKV(), 256, 256, mt * 128, nt * 128, 1024, smem, acc, rowsq);
    const int m0 = mt * 128;
    epi_quads(acc, m0, 0, [&](int m, int n, float v0, float v1, float v2, float v3) {
      const float sc = rsqrtf(rowsq[m - m0] * (1.f / 256.f) + 1e-6f);
      if (n < 64) st4h(p.K() + (size_t)m * 768 + nt * 96 + n, v0 * sc, v1 * sc, v2 * sc, v3 * sc);
      else {
        int b = m / SB, s = m - b * SB;
        h16* vt = p.VT() + ((size_t)(b * 8 + nt) * 64 + (n - 64)) * SB + s;
        vt[0] = (h16)(v0 * sc); vt[SB] = (h16)(v1 * sc); vt[2 * SB] = (h16)(v2 * sc); vt[3 * SB] = (h16)(v3 * sc);
      }
    });
    {
      int row = tid >> 1, sub = tid & 1;
      int m = m0 + row;
      int sp = m % SB;
      const h16* kr = p.Z() + (size_t)m * ZW + ZMLA + 640 + sub * 8;
      h16x8 x1 = *(const h16x8*)kr, x2 = *(const h16x8*)(kr + 16);
      h16* kd = p.K() + (size_t)m * 768 + nt * 96 + 64 + sub * 8;
      if (sp >= CTX) {
        const float* rp = p.ROPE() + (size_t)(sp - CTX) * 32 + sub * 8;
        h16x8 o1, o2;
#pragma unroll
        for (int i = 0; i < 8; ++i) {
          float a = (float)x1[i], b2 = (float)x2[i], cs = rp[i], sn = rp[16 + i];
          o1[i] = (h16)(a * cs - b2 * sn); o2[i] = (h16)(a * sn + b2 * cs);
        }
        *(h16x8*)kd = o1; *(h16x8*)(kd + 16) = o2;
      } else { *(h16x8*)kd = x1; *(h16x8*)(kd + 16) = x2; }
    }
  }
}

DEVI void lowrank_job(const P& p, int l, int job, char* smem) {
  constexpr int MT = NR / 128;
  int mat = job / (MT * 4), rem = job - mat * MT * 4;
  int nt = rem / MT, mt = rem - nt * MT;
  f32x16 acc[2][2]; zero_acc(acc);
  if (mat < 2) {
    const int dir = mat;
    gemm_main<false>(p.Z() + ZRW + 1536 + dir * 64, ZW, p.WUP() + (size_t)dir * 512 * 64, 64, 64, mt * 128, nt * 128, 512, smem, acc, nullptr);
    const float* w0 = p.w0 + ((size_t)l * 2 + dir) * 512;
    h16* dst = p.LW() + (size_t)dir * NR * 512;
    epi_quads(acc, mt * 128, nt * 128, [&](int m, int n, float v0, float v1, float v2, float v3) {
      float4 b = *(const float4*)(w0 + n);
      const float e = 0.6065306597126334f;
      st4h(dst + (size_t)m * 512 + n, sigm(v0 + b.x) * e, sigm(v1 + b.y) * e, sigm(v2 + b.z) * e, sigm(v3 + b.w) * e);
    });
  } else if (mat < 4) {
    const int dir = mat - 2;
    gemm_main<false>(p.Z() + ZRW + 1664 + dir * 64, ZW, p.AUP() + (size_t)dir * 512 * 64, 64, 64, mt * 128, nt * 128, 512, smem, acc, nullptr);
    const float* a0 = p.a0 + ((size_t)l * 2 + dir) * 512;
    h16* dst = p.AA() + (size_t)dir * NR * 512;
    epi_quads(acc, mt * 128, nt * 128, [&](int m, int n, float v0, float v1, float v2, float v3) {
      float4 b = *(const float4*)(a0 + n);
      st4h(dst + (size_t)m * 512 + n, sigm(v0 + b.x), sigm(v1 + b.y), sigm(v2 + b.z), sigm(v3 + b.w));
    });
  } else {
    gemm_main<false>(p.Z() + ZRW + 1792, ZW, p.GUP(), 128, 128, mt * 128, nt * 128, 512, smem, acc, nullptr);
    epi_quads(acc, mt * 128, nt * 128, [&](int m, int n, float v0, float v1, float v2, float v3) {
      st4h(p.G() + (size_t)m * 512 + n, v0, v1, v2, v3);
    });
  }
}

DEVI void attn_job(const P& p, int job, char* smem) {
  h16* Ks = (h16*)smem;
  h16* Vs = Ks + 2 * 64 * 104;
  const int tid = tidx(), lane = tid & 63, wv = tid >> 6, l31 = lane & 31, hh = lane >> 5;
  int b, h, q0, nk;
  if (job < 1024) { b = job >> 8; h = (job >> 5) & 7; q0 = b * SB + CTX + (job & 31) * 128; nk = SB; }
  else { int j = job - 1024; b = j >> 4; h = (j >> 1) & 7; q0 = b * SB + (j & 1) * 128; nk = CTX; }
  const int NKT = nk >> 6;
  const h16* Kg = p.K() + (size_t)(b * SB) * 768 + h * 96;
  const h16* Vg = p.VT() + (size_t)(b * 8 + h) * 64 * SB;
  h16x8 qf[6];
  {
    const h16* qp = p.Q() + (size_t)(q0 + wv * 32 + l31) * 768 + h * 96 + hh * 8;
#pragma unroll
    for (int ds = 0; ds < 6; ++ds) qf[ds] = *(const h16x8*)(qp + ds * 16);
  }
  uint4 gk[3], gv[2];
  int krow[3], kcol[3];
#pragma unroll
  for (int i = 0; i < 3; ++i) { int c = tid + 256 * i; krow[i] = c / 12; kcol[i] = (c - krow[i] * 12) * 8; }
  const int vrow = tid >> 3, vcol = (tid & 7) * 8;
#pragma unroll
  for (int i = 0; i < 3; ++i) gk[i] = *(const uint4*)(Kg + (size_t)krow[i] * 768 + kcol[i]);
#pragma unroll
  for (int i = 0; i < 2; ++i) gv[i] = *(const uint4*)(Vg + (size_t)(vrow + 32 * i) * SB + vcol);
#pragma unroll
  for (int i = 0; i < 3; ++i) *(uint4*)(Ks + krow[i] * 104 + kcol[i]) = gk[i];
#pragma unroll
  for (int i = 0; i < 2; ++i) *(uint4*)(Vs + (vrow + 32 * i) * 72 + vcol) = gv[i];
  __syncthreads();
  f32x16 o0, o1;
#pragma unroll
  for (int r = 0; r < 16; ++r) { o0[r] = 0.f; o1[r] = 0.f; }
  float mrun = -1e30f, lsum = 0.f;
  for (int kt = 0; kt < NKT; ++kt) {
    const int buf = kt & 1;
    if (kt + 1 < NKT) {
#pragma unroll
      for (int i = 0; i < 3; ++i) gk[i] = *(const uint4*)(Kg + (size_t)((kt + 1) * 64 + krow[i]) * 768 + kcol[i]);
#pragma unroll
      for (int i = 0; i < 2; ++i) gv[i] = *(const uint4*)(Vg + (size_t)(vrow + 32 * i) * SB + (kt + 1) * 64 + vcol);
    }
    const h16* ks = Ks + buf * 64 * 104 + l31 * 104 + hh * 8;
    f32x16 s0, s1;
#pragma unroll
    for (int r = 0; r < 16; ++r) { s0[r] = 0.f; s1[r] = 0.f; }
#pragma unroll
    for (int ds = 0; ds < 6; ++ds) {
      h16x8 a0 = *(const h16x8*)(ks + ds * 16), a1 = *(const h16x8*)(ks + 32 * 104 + ds * 16);
      s0 = __builtin_amdgcn_mfma_f32_32x32x16_f16(a0, qf[ds], s0, 0, 0, 0);
      s1 = __builtin_amdgcn_mfma_f32_32x32x16_f16(a1, qf[ds], s1, 0, 0, 0);
    }
    float mx = s0[0];
#pragma unroll
    for (int r = 1; r < 16; ++r) mx = fmaxf(mx, s0[r]);
#pragma unroll
    for (int r = 0; r < 16; ++r) mx = fmaxf(mx, s1[r]);
    mx = fmaxf(mx, __shfl_xor(mx, 32));
    const float mnew = fmaxf(mrun, mx);
    const float alpha = __builtin_amdgcn_exp2f(mrun - mnew);
    mrun = mnew;
    float ps = 0.f;
#pragma unroll
    for (int r = 0; r < 16; ++r) { s0[r] = __builtin_amdgcn_exp2f(s0[r] - mnew); ps += s0[r]; }
#pragma unroll
    for (int r = 0; r < 16; ++r) { s1[r] = __builtin_amdgcn_exp2f(s1[r] - mnew); ps += s1[r]; }
    lsum = lsum * alpha + ps;
#pragma unroll
    for (int r = 0; r < 16; ++r) { o0[r] *= alpha; o1[r] *= alpha; }
    const h16* vs = Vs + buf * 64 * 72 + l31 * 72 + 4 * hh;
#pragma unroll
    for (int k2 = 0; k2 < 2; ++k2) {
#pragma unroll
      for (int s2 = 0; s2 < 2; ++s2) {
        uint4 pu;
        if (k2 == 0) { pu.x = pk2(s0[8 * s2], s0[8 * s2 + 1]); pu.y = pk2(s0[8 * s2 + 2], s0[8 * s2 + 3]); pu.z = pk2(s0[8 * s2 + 4], s0[8 * s2 + 5]); pu.w = pk2(s0[8 * s2 + 6], s0[8 * s2 + 7]); }
        else { pu.x = pk2(s1[8 * s2], s1[8 * s2 + 1]); pu.y = pk2(s1[8 * s2 + 2], s1[8 * s2 + 3]); pu.z = pk2(s1[8 * s2 + 4], s1[8 * s2 + 5]); pu.w = pk2(s1[8 * s2 + 6], s1[8 * s2 + 7]); }
        h16x8 pf = __builtin_bit_cast(h16x8, pu);
        const int kb = k2 * 32 + 16 * s2;
        uint2 va = *(const uint2*)(vs + kb), vb = *(const uint2*)(vs + kb + 8);
        uint2 vc = *(const uint2*)(vs + 32 * 72 + kb), vd = *(const uint2*)(vs + 32 * 72 + kb + 8);
        h16x8 vf0 = __builtin_bit_cast(h16x8, make_uint4(va.x, va.y, vb.x, vb.y));
        h16x8 vf1 = __builtin_bit_cast(h16x8, make_uint4(vc.x, vc.y, vd.x, vd.y));
        o0 = __builtin_amdgcn_mfma_f32_32x32x16_f16(vf0, pf, o0, 0, 0, 0);
        o1 = __builtin_amdgcn_mfma_f32_32x32x16_f16(vf1, pf, o1, 0, 0, 0);
      }
    }
    if (kt + 1 < NKT) {
      h16* kd = Ks + (buf ^ 1) * 64 * 104;
      h16* vd = Vs + (buf ^ 1) * 64 * 72;
#pragma unroll
      for (int i = 0; i < 3; ++i) *(uint4*)(kd + krow[i] * 104 + kcol[i]) = gk[i];
#pragma unroll
      for (int i = 0; i < 2; ++i) *(uint4*)(vd + (vrow + 32 * i) * 72 + vcol) = gv[i];
    }
    __syncthreads();
  }
  const float ltot = lsum + __shfl_xor(lsum, 32);
  const float inv = 1.f / ltot;
  h16* yo = p.Z() + (size_t)(q0 + wv * 32 + l31) * ZW + ZMLA + h * 64 + 4 * hh;
#pragma unroll
  for (int g = 0; g < 4; ++g) {
    st4h(yo + 8 * g, o0[4 * g] * inv, o0[4 * g + 1] * inv, o0[4 * g + 2] * inv, o0[4 * g + 3] * inv);
    st4h(yo + 32 + 8 * g, o1[4 * g] * inv, o1[4 * g + 1] * inv, o1[4 * g + 2] * inv, o1[4 * g + 3] * inv);
  }
}

struct Slot { float w[64], bb[64], ke[64], vv[64]; h16 ah[4][64]; int yoff; int pad[3]; };
struct LSet { uint4 lw, a, k, v, r; float inv; int yoff; };
DEVI void scan_job(const P& p, int l, int job, char* smem) {
  constexpr int RGB = 4 / NSCAN_BPC;
  constexpr int NLD = (4 - RGB) * 64;
  static_assert(NLD == 128, "loader mapping assumes 128 loader threads");
  typedef float f2 __attribute__((ext_vector_type(2)));
  Slot* sl = (Slot*)smem;
  const int tid = tidx(), lane = tid & 63, wv = tid >> 6;
  const int chain = job / NSCAN_BPC, part = job - chain * NSCAN_BPC;
  const int dir = chain >> 5, b = (chain >> 3) & 3, h = chain & 7;
  for (int i = tid; i < 32 * 128; i += 256) { int s = i >> 7, e = i & 127; sl[s].ah[2 + (e >> 6)][e & 63] = (h16)0.f; }
  if (wv >= RGB) {
    const int lt = tid - RGB * 64;
    const int st = lt >> 3, c8 = (lt & 7) * 8;
    const float4 kkA = *(const float4*)(p.k_k + l * 512 + h * 64 + c8), kkB = *(const float4*)(p.k_k + l * 512 + h * 64 + c8 + 4);
    const float4 kaA = *(const float4*)(p.k_a + l * 512 + h * 64 + c8), kaB = *(const float4*)(p.k_a + l * 512 + h * 64 + c8 + 4);
    const h16* LWd = p.LW() + (size_t)dir * NR * 512 + h * 64 + c8;
    const h16* AAd = p.AA() + (size_t)dir * NR * 512 + h * 64 + c8;
    const h16* Zr = p.Z() + ZRW + h * 64 + c8;
    auto lload = [&](int ci, LSet& g) {
      const uint4 z = make_uint4(0, 0, 0, 0);
      g.lw = z; g.a = z; g.k = z; g.v = z; g.r = z; g.inv = 0.f; g.yoff = -1;
      if (ci >= NCHUNK) return;
      const int n = ci * 16 + st;
      if (n < SB) {
        const int row = maprow(dir, b, n);
        g.lw = *(const uint4*)(LWd + (size_t)row * 512);
        g.a = *(const uint4*)(AAd + (size_t)row * 512);
        g.k = *(const uint4*)(Zr + (size_t)row * ZW + 512);
        g.v = *(const uint4*)(Zr + (size_t)row * ZW + 1024);
        g.inv = p.INVN()[(size_t)row * 8 + h];
      }
      if (n >= 1 && n <= SB) {
        const int row = maprow(dir, b, n - 1);
        g.r = *(const uint4*)(Zr + (size_t)row * ZW);
        g.yoff = row * 512;
      }
    };
    auto lstore = [&](const LSet& g, int buf) {
      Slot& s = sl[buf * 16 + st];
      const h16x8 lw = __builtin_bit_cast(h16x8, g.lw), a = __builtin_bit_cast(h16x8, g.a), k = __builtin_bit_cast(h16x8, g.k), v = __builtin_bit_cast(h16x8, g.v);
      const float kkp[8] = {kkA.x, kkA.y, kkA.z, kkA.w, kkB.x, kkB.y, kkB.z, kkB.w};
      const float kap[8] = {kaA.x, kaA.y, kaA.z, kaA.w, kaB.x, kaB.y, kaB.z, kaB.w};
      float w8[8], b8[8], e8[8], v8[8], q8[8];
#pragma unroll
      for (int i = 0; i < 8; ++i) {
        const float kf = (float)k[i], af = (float)a[i];
        const float kkv = kf * kkp[i] * g.inv;
        w8[i] = __expf(-(float)lw[i]);
        b8[i] = kkv * af;
        e8[i] = kf * (1.f + (af - 1.f) * kap[i]);
        v8[i] = (float)v[i];
        q8[i] = kkv;
      }
      *(float4*)(s.w + c8) = make_float4(w8[0], w8[1], w8[2], w8[3]); *(float4*)(s.w + c8 + 4) = make_float4(w8[4], w8[5], w8[6], w8[7]);
      *(float4*)(s.bb + c8) = make_float4(b8[0], b8[1], b8[2], b8[3]); *(float4*)(s.bb + c8 + 4) = make_float4(b8[4], b8[5], b8[6], b8[7]);
      *(float4*)(s.ke + c8) = make_float4(e8[0], e8[1], e8[2], e8[3]); *(float4*)(s.ke + c8 + 4) = make_float4(e8[4], e8[5], e8[6], e8[7]);
      *(float4*)(s.vv + c8) = make_float4(v8[0], v8[1], v8[2], v8[3]); *(float4*)(s.vv + c8 + 4) = make_float4(v8[4], v8[5], v8[6], v8[7]);
      uint4 u; u.x = pk2n(q8[0], q8[1]); u.y = pk2n(q8[2], q8[3]); u.z = pk2n(q8[4], q8[5]); u.w = pk2n(q8[6], q8[7]);
      *(uint4*)(&s.ah[0][c8]) = u;
      *(uint4*)(&s.ah[1][c8]) = g.r;
      if ((lt & 7) == 0) s.yoff = g.yoff;
    };
    LSet A, B;
    lload(0, A); lload(1, B);
    lstore(A, 0);
    lload(2, A);
    __syncthreads();
    for (int ci = 0; ci < NCHUNK; ci += 2) {
      if (ci + 1 < NCHUNK) lstore(B, 1);
      lload(ci + 3, B);
      __syncthreads();
      if (ci + 1 < NCHUNK) {
        if (ci + 2 < NCHUNK) lstore(A, 0);
        lload(ci + 4, A);
        __syncthreads();
      }
    }
  } else {
    const int c = lane & 15, hq = lane >> 4;
    const int rg = part * RGB + wv;
    f2 S[8];
#pragma unroll
    for (int i = 0; i < 8; ++i) S[i] = (f2){0.f, 0.f};
    uint4 sh0 = make_uint4(0, 0, 0, 0), sh1 = make_uint4(0, 0, 0, 0);
    h16* ybase = p.Y2() + (size_t)dir * NR * 512 + h * 64 + rg * 16 + c;
    __builtin_amdgcn_s_setprio(3);
    __syncthreads();
    for (int ci = 0; ci < NCHUNK; ++ci) {
      const int buf = ci & 1;
      float yv[16];
      h16x8 rA0[2], rA1[2]; float rvv[2]; f2 rw[2][8], rb[2][8], re[2][8];
      {
        const Slot& t = sl[buf * 16];
        rA0[0] = *(const h16x8*)(&t.ah[c & 3][8 * hq]); rA1[0] = *(const h16x8*)(&t.ah[c & 3][32 + 8 * hq]);
        rvv[0] = t.vv[rg * 16 + c];
        const f2* wp = (const f2*)(t.w + 8 * hq); const f2* bp = (const f2*)(t.bb + 8 * hq); const f2* ep = (const f2*)(t.ke + 8 * hq);
#pragma unroll
        for (int i = 0; i < 4; ++i) { rw[0][i] = wp[i]; rw[0][4 + i] = wp[16 + i]; rb[0][i] = bp[i]; rb[0][4 + i] = bp[16 + i]; re[0][i] = ep[i]; re[0][4 + i] = ep[16 + i]; }
      }
#pragma unroll
      for (int s = 0; s < 16; ++s) {
        const int cur = s & 1, nxt = cur ^ 1;
        const f32x4 z4 = {0.f, 0.f, 0.f, 0.f};
        f32x4 acc0 = __builtin_amdgcn_mfma_f32_16x16x32_f16(rA0[cur], __builtin_bit_cast(h16x8, sh0), z4, 0, 0, 0);
        f32x4 acc1 = __builtin_amdgcn_mfma_f32_16x16x32_f16(rA1[cur], __builtin_bit_cast(h16x8, sh1), z4, 0, 0, 0);
        if (s + 1 < 16) {
          const Slot& t = sl[buf * 16 + s + 1];
          rA0[nxt] = *(const h16x8*)(&t.ah[c & 3][8 * hq]); rA1[nxt] = *(const h16x8*)(&t.ah[c & 3][32 + 8 * hq]);
          rvv[nxt] = t.vv[rg * 16 + c];
          const f2* wp = (const f2*)(t.w + 8 * hq); const f2* bp = (const f2*)(t.bb + 8 * hq); const f2* ep = (const f2*)(t.ke + 8 * hq);
#pragma unroll
          for (int i = 0; i < 4; ++i) { rw[nxt][i] = wp[i]; rw[nxt][4 + i] = wp[16 + i]; rb[nxt][i] = bp[i]; rb[nxt][4 + i] = bp[16 + i]; re[nxt][i] = ep[i]; re[nxt][4 + i] = ep[16 + i]; }
        }
        const f2 vv2 = (f2){rvv[cur], rvv[cur]};
        f2 T[8];
#pragma unroll
        for (int i = 0; i < 8; ++i) T[i] = S[i] * rw[cur][i] + vv2 * re[cur][i];
        __builtin_amdgcn_sched_barrier(0);
        yv[s] = acc0[1] + acc1[1];
        const float sa = -(acc0[0] + acc1[0]);
        const f2 sa2 = (f2){sa, sa};
#pragma unroll
        for (int i = 0; i < 8; ++i) S[i] = T[i] + sa2 * rb[cur][i];
        sh0.x = pk2(S[0].x, S[0].y); sh0.y = pk2(S[1].x, S[1].y); sh0.z = pk2(S[2].x, S[2].y); sh0.w = pk2(S[3].x, S[3].y);
        sh1.x = pk2(S[4].x, S[4].y); sh1.y = pk2(S[5].x, S[5].y); sh1.z = pk2(S[6].x, S[6].y); sh1.w = pk2(S[7].x, S[7].y);
      }
      if (lane < 16) {
#pragma unroll
        for (int s = 0; s < 16; ++s) {
          const int yo = sl[buf * 16 + s].yoff;
          if (yo >= 0) ybase[yo] = (h16)yv[s];
        }
      }
      __syncthreads();
    }
    __builtin_amdgcn_s_setprio(0);
  }
}

DEVI void gla_chunk_qk(const P& p, int dir, int b, int h, int ci, float* qi, float* ki, float* lg, const float* gku, const float* gkb, float* tot) {
  const int tid = tidx();
  const int ri = tid >> 2, dq = tid & 3;
  uint4 q0, q1, k0, k1;
  {
    const int row = maprow(dir, b, ci * 64 + ri);
    const h16* zr = p.Z() + (size_t)row * ZW;
    q0 = *(const uint4*)(zr + h * 64 + dq * 16); q1 = *(const uint4*)(zr + h * 64 + dq * 16 + 8);
    k0 = *(const uint4*)(zr + 256 + h * 64 + dq * 16); k1 = *(const uint4*)(zr + 256 + h * 64 + dq * 16 + 8);
    uint4 g0 = *(const uint4*)(zr + 1024 + dir * 16), g1 = *(const uint4*)(zr + 1024 + dir * 16 + 8);
    h16x8 gh0 = __builtin_bit_cast(h16x8, g0), gh1 = __builtin_bit_cast(h16x8, g1);
    float gd[16];
#pragma unroll
    for (int j = 0; j < 8; ++j) { gd[j] = (float)gh0[j]; gd[8 + j] = (float)gh1[j]; }
#pragma unroll 4
    for (int dd = 0; dd < 16; ++dd) {
      const int d = dq * 16 + dd;
      float xx = gkb[d];
#pragma unroll
      for (int r = 0; r < 16; ++r) xx += gd[r] * gku[r * 64 + d];
      float ls = fminf(xx, 0.f) - log1pf(__expf(-fabsf(xx)));
      lg[ri * 65 + d] = ls * (1.f / 16.f);
    }
  }
  __syncthreads();
  {
    const int d = tid & 63, part = tid >> 6;
    float run = 0.f;
#pragma unroll 4
    for (int ii = 0; ii < 16; ++ii) { const int i = part * 16 + ii; run += lg[i * 65 + d]; lg[i * 65 + d] = run; }
    tot[part * 64 + d] = run;
  }
  __syncthreads();
  {
    h16x8 qh0 = __builtin_bit_cast(h16x8, q0), qh1 = __builtin_bit_cast(h16x8, q1), kh0 = __builtin_bit_cast(h16x8, k0), kh1 = __builtin_bit_cast(h16x8, k1);
    const int part = ri >> 4;
#pragma unroll
    for (int dd = 0; dd < 16; ++dd) {
      const int d = dq * 16 + dd;
      float off = 0.f;
      if (part > 0) off += tot[d];
      if (part > 1) off += tot[64 + d];
      if (part > 2) off += tot[128 + d];
      const float bb = lg[ri * 65 + d] + off;
      const float qv = dd < 8 ? (float)qh0[dd & 7] : (float)qh1[dd & 7];
      const float kv = dd < 8 ? (float)kh0[dd & 7] : (float)kh1[dd & 7];
      qi[ri * 65 + d] = qv * __expf(bb) * 0.125f;
      ki[ri * 65 + d] = kv * __expf(-bb);
    }
  }
  __syncthreads();
}

DEVI void gla_pre_job(const P& p, int l, int job, char* smem) {
  float* qi = (float*)smem;
  float* ki = qi + 64 * 65;
  float* att = ki + 64 * 65;
  float* vs = att + 64 * 65;
  float* gku = vs + 64 * 65;
  float* gkb = gku + 1024;
  float* tot = gkb + 64;
  const int tid = tidx();
  const int chain = job / 68, ci = job - chain * 68;
  const int dir = chain >> 4, b = (chain >> 2) & 3, h = chain & 3;
  for (int i = tid; i < 1024; i += 256) gku[i] = p.gk_up[(((size_t)l * 2 + dir) * 16 + (i >> 6)) * 256 + h * 64 + (i & 63)];
  if (tid < 64) gkb[tid] = p.gk_b[((size_t)l * 2 + dir) * 256 + h * 64 + tid];
  __syncthreads();
  gla_chunk_qk(p, dir, b, h, ci, qi, ki, att, gku, gkb, tot);
  {
    const int ri2 = tid >> 2, dq2 = tid & 3;
    const int row = maprow(dir, b, ci * 64 + ri2);
    unsigned qp[8], kp[8];
#pragma unroll
    for (int j = 0; j < 8; ++j) {
      qp[j] = f2bf(qi[ri2 * 65 + dq2 * 16 + 2 * j]) | (f2bf(qi[ri2 * 65 + dq2 * 16 + 2 * j + 1]) << 16);
      kp[j] = f2bf(ki[ri2 * 65 + dq2 * 16 + 2 * j]) | (f2bf(ki[ri2 * 65 + dq2 * 16 + 2 * j + 1]) << 16);
    }
    unsigned short* qd = p.QIN() + ((size_t)dir * NR + row) * 256 + h * 64 + dq2 * 16;
    unsigned short* kd = p.KIN() + ((size_t)dir * NR + row) * 256 + h * 64 + dq2 * 16;
    *(uint4*)qd = make_uint4(qp[0], qp[1], qp[2], qp[3]); *(uint4*)(qd + 8) = make_uint4(qp[4], qp[5], qp[6], qp[7]);
    *(uint4*)kd = make_uint4(kp[0], kp[1], kp[2], kp[3]); *(uint4*)(kd + 8) = make_uint4(kp[4], kp[5], kp[6], kp[7]);
    if (tid < 64) p.DEC()[((size_t)chain * 68 + ci) * 64 + tid] = __expf(tot[tid] + tot[64 + tid] + tot[128 + tid] + tot[192 + tid]);
  }
  const int ti = tid >> 4, tj = tid & 15;
  {
    float a[4][4];
#pragma unroll
    for (int x = 0; x < 4; ++x)
#pragma unroll
      for (int y = 0; y < 4; ++y) a[x][y] = 0.f;
    if (tj <= ti) {
#pragma unroll 2
      for (int d = 0; d < 64; ++d) {
        float qa[4], kb[4];
#pragma unroll
        for (int x = 0; x < 4; ++x) { qa[x] = qi[(4 * ti + x) * 65 + d]; kb[x] = ki[(4 * tj + x) * 65 + d]; }
#pragma unroll
        for (int x = 0; x < 4; ++x)
#pragma unroll
          for (int y = 0; y < 4; ++y) a[x][y] += qa[x] * kb[y];
      }
    }
#pragma unroll
    for (int x = 0; x < 4; ++x)
#pragma unroll
      for (int y = 0; y < 4; ++y) att[(4 * ti + x) * 65 + 4 * tj + y] = (4 * tj + y <= 4 * ti + x) ? a[x][y] : 0.f;
  }
  const int ri = tid >> 2, dq = tid & 3;
  const int vrow = maprow(dir, b, ci * 64 + ri);
  h16* Od = p.OFB() + (size_t)dir * NR * 512 + h * 128;
#pragma unroll 1
  for (int half = 0; half < 2; ++half) {
    {
      const h16* zv = p.Z() + (size_t)vrow * ZW + 512 + h * 128 + half * 64 + dq * 16;
      h16x8 v0 = *(const h16x8*)zv, v1 = *(const h16x8*)(zv + 8);
#pragma unroll
      for (int j = 0; j < 8; ++j) { vs[ri * 65 + dq * 16 + j] = (float)v0[j]; vs[ri * 65 + dq * 16 + 8 + j] = (float)v1[j]; }
    }
    __syncthreads();
    float o[4][4];
#pragma unroll
    for (int x = 0; x < 4; ++x)
#pragma unroll
      for (int y = 0; y < 4; ++y) o[x][y] = 0.f;
    const int smax = 4 * ti + 3;
#pragma unroll 2
    for (int s2 = 0; s2 <= smax; ++s2) {
      float aa[4], vv[4];
#pragma unroll
      for (int x = 0; x < 4; ++x) { aa[x] = att[(4 * ti + x) * 65 + s2]; vv[x] = vs[s2 * 65 + 4 * tj + x]; }
#pragma unroll
      for (int x = 0; x < 4; ++x)
#pragma unroll
        for (int y = 0; y < 4; ++y) o[x][y] += aa[x] * vv[y];
    }
#pragma unroll
    for (int x = 0; x < 4; ++x) {
      const int row = maprow(dir, b, ci * 64 + 4 * ti + x);
      st4h(Od + (size_t)row * 512 + half * 64 + 4 * tj, o[x][0], o[x][1], o[x][2], o[x][3]);
    }
    __syncthreads();
  }
}

DEVI void gla_job(const P& p, int l, int job, char* smem) {
  float* qi = (float*)smem;
  float* ki = qi + 64 * 65;
  float* vs = ki + 64 * 65;
  float* Ss = vs + 64 * 33;
  const int tid = tidx();
  const int dvs = job & 3, chain = job >> 2;
  const int dir = chain >> 4, b = (chain >> 2) & 3, h = chain & 3;
  for (int i = tid; i < 64 * 33; i += 256) Ss[i] = 0.f;
  const int ri = tid >> 2, dq = tid & 3;
  const int t2 = tid >> 3, tj = tid & 7;
  h16* Od = p.OFB() + (size_t)dir * NR * 512 + h * 128 + dvs * 32;
  const unsigned short* Qg = p.QIN() + (size_t)dir * NR * 256 + h * 64 + dq * 16;
  const unsigned short* Kg = p.KIN() + (size_t)dir * NR * 256 + h * 64 + dq * 16;
  const float* Dg = p.DEC() + (size_t)chain * 68 * 64 + 2 * t2;
  uint4 gq0, gq1, gk0, gk1, gv; uint2 goa, gob; float gd0, gd1;
  auto pre = [&](int ci) {
    const int row = maprow(dir, b, ci * 64 + ri);
    gq0 = *(const uint4*)(Qg + (size_t)row * 256); gq1 = *(const uint4*)(Qg + (size_t)row * 256 + 8);
    gk0 = *(const uint4*)(Kg + (size_t)row * 256); gk1 = *(const uint4*)(Kg + (size_t)row * 256 + 8);
    gv = *(const uint4*)(p.Z() + (size_t)row * ZW + 512 + h * 128 + dvs * 32 + dq * 8);
    const int rowa = maprow(dir, b, ci * 64 + 2 * t2), rowb = maprow(dir, b, ci * 64 + 2 * t2 + 1);
    goa = *(const uint2*)(Od + (size_t)rowa * 512 + 4 * tj); gob = *(const uint2*)(Od + (size_t)rowb * 512 + 4 * tj);
    gd0 = Dg[ci * 64]; gd1 = Dg[ci * 64 + 1];
  };
  pre(0);
  __syncthreads();
  for (int ci = 0; ci < SB / 64; ++ci) {
    {
      const unsigned qa[8] = {gq0.x, gq0.y, gq0.z, gq0.w, gq1.x, gq1.y, gq1.z, gq1.w};
      const unsigned ka[8] = {gk0.x, gk0.y, gk0.z, gk0.w, gk1.x, gk1.y, gk1.z, gk1.w};
#pragma unroll
      for (int j = 0; j < 8; ++j) {
        qi[ri * 65 + dq * 16 + 2 * j] = __builtin_bit_cast(float, qa[j] << 16); qi[ri * 65 + dq * 16 + 2 * j + 1] = __builtin_bit_cast(float, qa[j] & 0xffff0000u);
        ki[ri * 65 + dq * 16 + 2 * j] = __builtin_bit_cast(float, ka[j] << 16); ki[ri * 65 + dq * 16 + 2 * j + 1] = __builtin_bit_cast(float, ka[j] & 0xffff0000u);
      }
      h16x8 vh = __builtin_bit_cast(h16x8, gv);
#pragma unroll
      for (int j = 0; j < 8; ++j) vs[ri * 33 + dq * 8 + j] = (float)vh[j];
    }
    const uint2 oia = goa, oib = gob; const float e0 = gd0, e1 = gd1;
    const int rowa = maprow(dir, b, ci * 64 + 2 * t2), rowb = maprow(dir, b, ci * 64 + 2 * t2 + 1);
    if (ci + 1 < SB / 64) pre(ci + 1);
    __syncthreads();
    {
      h16x4 ha = __builtin_bit_cast(h16x4, oia), hb = __builtin_bit_cast(h16x4, oib);
      float a0[4], a1[4];
#pragma unroll
      for (int y = 0; y < 4; ++y) { a0[y] = (float)ha[y]; a1[y] = (float)hb[y]; }
#pragma unroll 4
      for (int d = 0; d < 64; ++d) {
        const float x0 = qi[(2 * t2) * 65 + d], x1 = qi[(2 * t2 + 1) * 65 + d];
#pragma unroll
        for (int y = 0; y < 4; ++y) { const float v = Ss[d * 33 + 4 * tj + y]; a0[y] += x0 * v; a1[y] += x1 * v; }
      }
      st4h(Od + (size_t)rowa * 512 + 4 * tj, a0[0], a0[1], a0[2], a0[3]);
      st4h(Od + (size_t)rowb * 512 + 4 * tj, a1[0], a1[1], a1[2], a1[3]);
    }
    __syncthreads();
    {
      float a0[4], a1[4];
#pragma unroll
      for (int y = 0; y < 4; ++y) { a0[y] = Ss[(2 * t2) * 33 + 4 * tj + y]; a1[y] = Ss[(2 * t2 + 1) * 33 + 4 * tj + y]; }
#pragma unroll 4
      for (int s2 = 0; s2 < 64; ++s2) {
        const float x0 = ki[s2 * 65 + 2 * t2], x1 = ki[s2 * 65 + 2 * t2 + 1];
#pragma unroll
        for (int y = 0; y < 4; ++y) { const float v = vs[s2 * 33 + 4 * tj + y]; a0[y] += x0 * v; a1[y] += x1 * v; }
      }
#pragma unroll
      for (int y = 0; y < 4; ++y) { Ss[(2 * t2) * 33 + 4 * tj + y] = a0[y] * e0; Ss[(2 * t2 + 1) * 33 + 4 * tj + y] = a1[y] * e1; }
    }
    __syncthreads();
  }
}

DEVI void mixer_phase(const P& p, int l, char* smem, int cslot, int mode = 0) {
  __shared__ int4 sjobv;
  int& sjob = sjobv.x;
  for (int j = blockIdx.x; j < NSCAN + NGLA; j += gridDim.x) {
    if (mode == 1 && j >= NSCAN) break;
    if (mode == 2 && j < NSCAN) continue;
    if (j < NSCAN) {
      scan_job(p, l, j, smem);
#if PROBE == 4
      __syncthreads();
      scan_job(p, l, j, smem);
#endif
    }
    else gla_job(p, l, j - NSCAN, smem);
    __syncthreads();
  }
  if (mode == 1) return;
  const int njobs = (l < DEPTH - 1) ? 1024 + 64 : 1024;
  while (true) {
    if (tidx() == 0) sjob = (int)atomicAdd(p.CTR() + cslot, 1u);
    __syncthreads();
    const int j = sjob;
    __syncthreads();
    if (j >= njobs) break;
    attn_job(p, j, smem);
  }
}

DEVI void post_phase(const P& p, int l) {
  const int lane = tidx() & 63;
  const int wid = blockIdx.x * 4 + (tidx() >> 6), nw = gridDim.x * 4;
  const int c8 = lane * 8;
  for (int r = wid; r < NR; r += nw) {
    {
      h16* zr = p.Z() + (size_t)r * ZW + ZRW + c8;
      h16x8 yf = *(const h16x8*)(p.Y2() + (size_t)r * 512 + c8), yb = *(const h16x8*)(p.Y2() + (size_t)(NR + r) * 512 + c8);
      h16x8 rr = *(const h16x8*)zr, kk = *(const h16x8*)(zr + 512), vv = *(const h16x8*)(zr + 1024);
      h16x8 af = *(const h16x8*)(p.AA() + (size_t)r * 512 + c8), ab = *(const h16x8*)(p.AA() + (size_t)(NR + r) * 512 + c8);
      h16x8 gg = *(const h16x8*)(p.G() + (size_t)r * 512 + c8);
      float y[8], sm = 0.f;
#pragma unroll
      for (int i = 0; i < 8; ++i) { y[i] = (float)yf[i] + (float)yb[i]; sm += y[i]; }
      sm += __shfl_xor(sm, 1); sm += __shfl_xor(sm, 2); sm += __shfl_xor(sm, 4);
      const float mean = sm * (1.f / 64.f);
      float sq = 0.f;
#pragma unroll
      for (int i = 0; i < 8; ++i) { y[i] -= mean; sq += y[i] * y[i]; }
      sq += __shfl_xor(sq, 1); sq += __shfl_xor(sq, 2); sq += __shfl_xor(sq, 4);
      const float rs = rsqrtf(sq * (1.f / 64.f) + 64e-5f);
      const float* ka = p.k_a + l * 512 + c8; const float* rk = p.r_k + l * 512 + c8;
      const float* lg = p.rln_g + l * 512 + c8; const float* lb = p.rln_b + l * 512 + c8;
      float bs = 0.f;
#pragma unroll
      for (int i = 0; i < 8; ++i) {
        const float kf = (float)kk[i], kav = ka[i];
        const float ke = kf * (1.f + ((float)af[i] - 1.f) * kav) + kf * (1.f + ((float)ab[i] - 1.f) * kav);
        bs += (float)rr[i] * ke * rk[i];
      }
      bs += __shfl_xor(bs, 1); bs += __shfl_xor(bs, 2); bs += __shfl_xor(bs, 4);
      float o[8];
#pragma unroll
      for (int i = 0; i < 8; ++i) o[i] = (y[i] * rs * lg[i] + lb[i] + bs * (float)vv[i]) * (float)gg[i];
      uint4 u; u.x = pk2n(o[0], o[1]); u.y = pk2n(o[2], o[3]); u.z = pk2n(o[4], o[5]); u.w = pk2n(o[6], o[7]);
      *(uint4*)zr = u;
    }
    {
      h16x8 of = *(const h16x8*)(p.OFB() + (size_t)r * 512 + c8), ob = *(const h16x8*)(p.OFB() + (size_t)(NR + r) * 512 + c8);
      h16x8 og = *(const h16x8*)(p.Z() + (size_t)r * ZW + 1056 + c8);
      float o[8], sq = 0.f;
#pragma unroll
      for (int i = 0; i < 8; ++i) { o[i] = (float)of[i] + (float)ob[i]; sq += o[i] * o[i]; }
      sq += __shfl_xor(sq, 1); sq += __shfl_xor(sq, 2); sq += __shfl_xor(sq, 4); sq += __shfl_xor(sq, 8);
      const float rs = rsqrtf(sq * (1.f / 128.f) + 1e-6f);
      const float* ng = p.gla_ng + l * 128 + (c8 & 127);
#pragma unroll
      for (int i = 0; i < 8; ++i) { const float g = (float)og[i]; o[i] = o[i] * rs * ng[i] * (g * sigm(g)); }
      uint4 u; u.x = pk2n(o[0], o[1]); u.y = pk2n(o[2], o[3]); u.z = pk2n(o[4], o[5]); u.w = pk2n(o[6], o[7]);
      *(uint4*)(p.YA() + (size_t)r * ZW + c8) = u;
    }
  }
}

DEVI void merge_phase(const P& p, char* smem) {
  constexpr int MT = NR / 128, NT = 16;
  const int lane = tidx() & 63, wv = tidx() >> 6;
  const int wm = wv >> 1, wn = wv & 1, l31 = lane & 31, hh = lane >> 5;
  for (int job = blockIdx.x; job < MT * NT; job += gridDim.x) {
    int nt = job / MT, mt = job - nt * MT;
    float out[2][16];
#pragma unroll
    for (int a = 0; a < 2; ++a)
#pragma unroll
      for (int r = 0; r < 16; ++r) out[a][r] = 0.f;
#pragma unroll 1
    for (int br = 0; br < 3; ++br) {
      const h16* Y = br == 0 ? p.YA() : (br == 1 ? p.Z() + ZMLA : p.Z() + ZRW);
      const int ldy = ZW;
      f32x16 acc[2][1];
#pragma unroll
      for (int a = 0; a < 2; ++a)
#pragma unroll
        for (int r = 0; r < 16; ++r) acc[a][0][r] = 0.f;
      gemm_deep<1>(Y, ldy, p.WB() + (size_t)br * D * 512, 512, 512, mt * 128, nt * 64, D, smem, acc);
      float u[2][16];
#pragma unroll
      for (int a = 0; a < 2; ++a)
#pragma unroll
        for (int r = 0; r < 16; ++r) { u[a][r] = acc[a][0][r]; acc[a][0][r] = 0.f; }
      gemm_deep<1>(p.H(), D, p.WIN() + (size_t)(ZW + br * D) * D, D, D, mt * 128, nt * 64, D, smem, acc);
#pragma unroll
      for (int a = 0; a < 2; ++a)
#pragma unroll
        for (int r = 0; r < 16; ++r) out[a][r] += sigm(acc[a][0][r]) * u[a][r];
    }
#pragma unroll
    for (int a = 0; a < 2; ++a)
#pragma unroll
      for (int g = 0; g < 4; ++g)
        st4h(p.M() + (size_t)(mt * 128 + wm * 64 + a * 32 + l31) * D + nt * 64 + wn * 32 + 8 * g + 4 * hh, out[a][4 * g], out[a][4 * g + 1],
             out[a][4 * g + 2], out[a][4 * g + 3]);
  }
}

DEVI void resid_gemm_phase(const P& p, int l, const h16* A, int K, const h16* Bt, int gate_idx, char* smem) {
  constexpr int MT = NR / 128, NT = 8;
  const float alpha = 1.6817928305074290f;
  for (int job = blockIdx.x; job < MT * NT; job += gridDim.x) {
    int nt = job / MT, mt = job - nt * MT;
    f32x16 acc[2][2]; zero_acc(acc);
    gemm_deep<2>(A, K, Bt, K, K, mt * 128, nt * 128, D, smem, acc);
    epi_quads(acc, mt * 128, nt * 128, [&](int m, int n, float v0, float v1, float v2, float v3) {
      int b = m / SB, s = m - b * SB;
      int g = s < CTX ? 4 : b;
      float4 gt = *(const float4*)(p.MOD() + ((size_t)l * 5 + g) * 6144 + gate_idx * D + n);
      float* xp = xrow(p, m) + n;
      float4 xv = *(float4*)xp;
      xv.x = alpha * xv.x + gt.x * v0; xv.y = alpha * xv.y + gt.y * v1; xv.z = alpha * xv.z + gt.z * v2; xv.w = alpha * xv.w + gt.w * v3;
      *(float4*)xp = xv;
    });
  }
}
DEVI void mlp1_phase(const P& p, char* smem) {
  constexpr int MT = NR / 128, NT = DFF / 128;
  h16* HID = p.Z();
  for (int job = blockIdx.x; job < MT * NT; job += gridDim.x) {
    int nt = job / MT, mt = job - nt * MT;
    f32x16 acc[2][2]; zero_acc(acc);
    gemm_deep<2>(p.H(), D, p.W1T(), D, D, mt * 128, nt * 128, DFF, smem, acc);
    epi_quads(acc, mt * 128, nt * 128, [&](int m, int n, float v0, float v1, float v2, float v3) {
      v0 = fmaxf(v0, 0.f); v1 = fmaxf(v1, 0.f); v2 = fmaxf(v2, 0.f); v3 = fmaxf(v3, 0.f);
      st4h(HID + (size_t)m * DFF + n, v0 * v0, v1 * v1, v2 * v2, v3 * v3);
    });
  }
}

constexpr int PH_PER_LAYER = 11;
constexpr int NPHASES = 1 + DEPTH * PH_PER_LAYER + 1;

DEVI void run_phase(const P& p, int ph, char* smem) {
  if (ph == 0) { phase0(p, smem); return; }
  if (ph == NPHASES - 1) { ln_phase(p, DEPTH, 2); return; }
  const int l = (ph - 1) / PH_PER_LAYER, k = (ph - 1) - l * PH_PER_LAYER;
  switch (k) {
    case 0: ln_phase(p, l, 0); conv_phase(p, l, 0, 12, smem); break;
    case 1: inproj_phase(p, smem);
#if PROBE == 2
      inproj_phase(p, smem);
#endif
      break;
    case 2: {
      constexpr int NSH = NR / 64, NUP = (NR / 128) * 14;
      for (int j = blockIdx.x; j < NSH + NUP; j += gridDim.x) {
        if (j < NSH) shift_job(p, l, j, smem); else mla_up_job(p, j - NSH, smem);
        __syncthreads();
      }
    } break;
    case 3: {
      constexpr int NPRE = 32 * 68, NLR = 5 * 4 * (NR / 128);
      for (int j = blockIdx.x; j < NPRE + NLR; j += gridDim.x) {
        if (j < NPRE) gla_pre_job(p, l, j, smem); else lowrank_job(p, l, j - NPRE, smem);
        __syncthreads();
      }
    } break;
    case 4: mixer_phase(p, l, smem, l);
#if PROBE == 1
      mixer_phase(p, l, smem, 8 + l);
#endif
      break;
    case 5: post_phase(p, l); break;
    case 6: merge_phase(p, smem); conv_phase(p, l, 12, 14, smem); break;
    case 7: resid_gemm_phase(p, l, p.M(), D, p.WO(), 2, smem); break;
    case 8: ln_phase(p, l, 1); break;
    case 9: mlp1_phase(p, smem);
#if PROBE == 2
      mlp1_phase(p, smem);
#endif
      break;
    default: resid_gemm_phase(p, l, p.Z(), DFF, p.W2T(), 5, smem); break;
  }
}

__global__ void __launch_bounds__(256, 2) mega(P p, int pb, int pe) {
  extern __shared__ __attribute__((aligned(16))) char smem[];
  cg::grid_group grid = cg::this_grid();
  __shared__ uint4 xb_words;
  if (threadIdx_x_raw() == 0) xb_words = make_uint4(0u, 0u, 0u, 0u);
  __syncthreads();
  XcdBarrier xb = xcd_barrier_post(p.BAR(), (volatile LAS unsigned*)&xb_words);
  for (int ph = pb; ph < pe; ++ph) {
    if (ph > pb) { if (ph == pb + 1) grid.sync(); else xcd_barrier(xb); }
#if PROBE == 6
    if (ph >= 1 && ph < NPHASES - 1 && ((ph - 1) % PH_PER_LAYER) == 4) {
      const int l = (ph - 1) / PH_PER_LAYER;
      mixer_phase(p, l, smem, l, 1);
      xcd_barrier(xb);
      mixer_phase(p, l, smem, l, 1);
      xcd_barrier(xb);
      mixer_phase(p, l, smem, l, 2);
      continue;
    }
#endif
    run_phase(p, ph, smem);
  }
}

extern "C" void kernel_launch(void* const* d_in, const int* in_sizes, int n_in, void* d_out, int out_size, void* d_ws,
                              size_t ws_size, hipStream_t stream) {
  static int grid_blocks = 0;
  if (grid_blocks == 0) {
    int dev = 0, cus = 0, per_cu = 0;
    hipGetDevice(&dev);
    hipDeviceGetAttribute(&cus, hipDeviceAttributeMultiprocessorCount, dev);
    hipFuncSetAttribute((const void*)mega, hipFuncAttributeMaxDynamicSharedMemorySize, LDS_BYTES);
    hipOccupancyMaxActiveBlocksPerMultiprocessor(&per_cu, (const void*)mega, 256, LDS_BYTES);
    if (per_cu < 1) per_cu = 1;
    if (per_cu > 2) per_cu = 2;
    grid_blocks = cus * per_cu;
    fprintf(stderr, "mega: cus %d per_cu %d grid %d\n", cus, per_cu, grid_blocks);
  }
  P p{};
  const float** ins = (const float**)&p;
  for (int i = 0; i < 33; ++i) ins[i] = (const float*)d_in[i];
  p.XL = (float*)d_out;
  p.ws = (char*)d_ws;
  const size_t off = WS_TOTAL;
  if (off > ws_size || n_in != 33) { fprintf(stderr, "mega: workspace too small (%zu > %zu) or n_in %d\n", off, ws_size, n_in); return; }
  (void)hipMemsetAsync((char*)d_ws + OFF_BAR, 0, (size_t)XCD_BAR_WORDS * 4, stream);
  int pb = 0, pe = NPHASES;
  void* args[] = {&p, &pb, &pe};
  hipError_t e = hipLaunchCooperativeKernel((const void*)mega, dim3(grid_blocks), dim3(256), args, LDS_BYTES, stream);
  if (e != hipSuccess) fprintf(stderr, "mega: cooperative launch failed: %s (grid %d)\n", hipGetErrorString(e), grid_blocks);
}
```

```cpp
#include <hip/hip_runtime.h>
#include <hip/hip_cooperative_groups.h>
#include <cstdio>
#include <cstdint>
namespace cg = cooperative_groups;

typedef _Float16 h16;
typedef _Float16 h16x8 __attribute__((ext_vector_type(8)));
typedef _Float16 h16x4 __attribute__((ext_vector_type(4)));
typedef float f32x16 __attribute__((ext_vector_type(16)));
typedef float f32x4 __attribute__((ext_vector_type(4)));

#define DEVI __device__ __forceinline__
DEVI int threadIdx_x_raw() { return (int)__builtin_amdgcn_workitem_id_x(); }

#define PROBE 0
constexpr int D = 1024, NB = 4, SEQ = 4096, CTX = 256, DEPTH = 4;
constexpr int SB = SEQ + CTX;
constexpr int NR = NB * SB;
constexpr int ZW = 4160;
constexpr int ZMLA = 1568, ZRW = 2240;
constexpr int NIN = 7232;
constexpr int DFF = 4096;
constexpr int LDS_BYTES = 74752;
constexpr int NSCAN_BPC = 2;
constexpr int NSCAN = 64 * NSCAN_BPC;
constexpr int NGLA = 128;
constexpr int TSTEPS = SB + 1;
constexpr int NCHUNK = (TSTEPS + 15) / 16;

constexpr size_t al256(size_t x) { return (x + 255) & ~(size_t)255; }
constexpr size_t OFF_XC = 0;
constexpr size_t OFF_MOD = OFF_XC + al256((size_t)NB * CTX * D * 4);
constexpr size_t OFF_ROPE = OFF_MOD + al256((size_t)DEPTH * 5 * 6144 * 4);
constexpr size_t OFF_INVN = OFF_ROPE + al256((size_t)SEQ * 32 * 4);
constexpr size_t OFF_CTR = OFF_INVN + al256((size_t)NR * 8 * 4);
constexpr size_t OFF_BAR = OFF_CTR + al256(256);
constexpr size_t BAR_BYTES = (size_t)(3584 + 4096 + 4096 + 64) * 4;
constexpr size_t OFF_HLO = OFF_BAR + al256(BAR_BYTES);
constexpr size_t OFF_HHI = OFF_HLO + al256((size_t)(NR / 64) * 1920 * 2);
constexpr size_t OFF_H = OFF_HHI + al256((size_t)(NR / 64) * 1920 * 2);
constexpr size_t OFF_Z = OFF_H + al256((size_t)NR * D * 2);
constexpr size_t OFF_WIN = OFF_Z + al256((size_t)NR * ZW * 2);
constexpr size_t OFF_UQ = OFF_WIN + al256((size_t)NIN * D * 2);
constexpr size_t OFF_UKV = OFF_UQ + al256((size_t)768 * 384 * 2);
constexpr size_t OFF_WB = OFF_UKV + al256((size_t)1024 * 256 * 2);
constexpr size_t OFF_WO = OFF_WB + al256((size_t)3 * D * 512 * 2);
constexpr size_t OFF_WUP = OFF_WO + al256((size_t)D * D * 2);
constexpr size_t OFF_AUP = OFF_WUP + al256((size_t)2 * 512 * 64 * 2);
constexpr size_t OFF_GUP = OFF_AUP + al256((size_t)2 * 512 * 64 * 2);
constexpr size_t OFF_LW = OFF_GUP + al256((size_t)512 * 128 * 2);
constexpr size_t OFF_AA = OFF_LW + al256((size_t)2 * NR * 512 * 2);
constexpr size_t OFF_G = OFF_AA + al256((size_t)2 * NR * 512 * 2);
constexpr size_t OFF_Y2 = OFF_G + al256((size_t)NR * 512 * 2);
constexpr size_t OFF_Q = OFF_Y2 + al256((size_t)2 * NR * 512 * 2);
constexpr size_t OFF_K = OFF_Q + al256((size_t)NR * 768 * 2);
constexpr size_t OFF_VT = OFF_K + al256((size_t)NR * 768 * 2);
constexpr size_t OFF_QIN = OFF_VT + al256((size_t)NR * 512 * 2);
constexpr size_t OFF_KIN = OFF_QIN + al256((size_t)2 * NR * 256 * 2);
constexpr size_t OFF_DEC = OFF_KIN + al256((size_t)2 * NR * 256 * 2);
constexpr size_t OFF_OFB = OFF_DEC + al256((size_t)32 * 68 * 64 * 4);
constexpr size_t WS_TOTAL = OFF_OFB + al256((size_t)2 * NR * 512 * 2);
struct P {
  const float *x, *c, *ctx, *c_ctx, *ada_w, *ada_b, *w_in, *gk_up, *gk_b, *gla_ng, *qn_g, *kvn_g, *w_uq, *w_ukv,
      *mu, *w0, *w_up, *a0, *a_up, *g_up, *k_k, *k_a, *r_k, *rln_g, *rln_b, *w_branch, *w_out, *ln1_g, *ln1_b,
      *w1, *w2, *ln2_g, *ln2_b;
  float* XL;
  char* ws;
  DEVI float* XC() const { return (float*)(ws + OFF_XC); }
  DEVI float* MOD() const { return (float*)(ws + OFF_MOD); }
  DEVI float* ROPE() const { return (float*)(ws + OFF_ROPE); }
  DEVI float* INVN() const { return (float*)(ws + OFF_INVN); }
  DEVI unsigned* CTR() const { return (unsigned*)(ws + OFF_CTR); }
  DEVI unsigned* BAR() const { return (unsigned*)(ws + OFF_BAR); }
  DEVI h16* HLO() const { return (h16*)(ws + OFF_HLO); }
  DEVI h16* HHI() const { return (h16*)(ws + OFF_HHI); }
  DEVI h16* H() const { return (h16*)(ws + OFF_H); }
  DEVI h16* Z() const { return (h16*)(ws + OFF_Z); }
  DEVI h16* WIN() const { return (h16*)(ws + OFF_WIN); }
  DEVI h16* UQ() const { return (h16*)(ws + OFF_UQ); }
  DEVI h16* UKV() const { return (h16*)(ws + OFF_UKV); }
  DEVI h16* WB() const { return (h16*)(ws + OFF_WB); }
  DEVI h16* WO() const { return (h16*)(ws + OFF_WO); }
  DEVI h16* WUP() const { return (h16*)(ws + OFF_WUP); }
  DEVI h16* AUP() const { return (h16*)(ws + OFF_AUP); }
  DEVI h16* GUP() const { return (h16*)(ws + OFF_GUP); }
  DEVI h16* LW() const { return (h16*)(ws + OFF_LW); }
  DEVI h16* AA() const { return (h16*)(ws + OFF_AA); }
  DEVI h16* G() const { return (h16*)(ws + OFF_G); }
  DEVI h16* Y2() const { return (h16*)(ws + OFF_Y2); }
  DEVI h16* Q() const { return (h16*)(ws + OFF_Q); }
  DEVI h16* K() const { return (h16*)(ws + OFF_K); }
  DEVI h16* VT() const { return (h16*)(ws + OFF_VT); }
  DEVI unsigned short* QIN() const { return (unsigned short*)(ws + OFF_QIN); }
  DEVI unsigned short* KIN() const { return (unsigned short*)(ws + OFF_KIN); }
  DEVI float* DEC() const { return (float*)(ws + OFF_DEC); }
  DEVI h16* OFB() const { return (h16*)(ws + OFF_OFB); }
  DEVI h16* W1T() const { return (h16*)(ws + OFF_LW); }
  DEVI h16* W2T() const { return (h16*)(ws + OFF_LW + (size_t)DFF * D * 2); }
  DEVI h16* M() const { return (h16*)(ws + OFF_Q); }
  DEVI h16* YA() const { return (h16*)(ws + OFF_Z + 1056 * 2); }
};

DEVI int tidx() { int t = threadIdx_x_raw(); asm volatile("" : "+v"(t)); return t; }
DEVI float wsum(float v) {
#pragma unroll
  for (int o = 32; o; o >>= 1) v += __shfl_xor(v, o);
  return v;
}
DEVI float sigm(float x) { return 1.f / (1.f + __expf(-x)); }
DEVI unsigned pk2(float a, float b) {
  auto h = __builtin_amdgcn_cvt_pkrtz(a, b);
  return __builtin_bit_cast(unsigned, h);
}
DEVI unsigned pk2n(float a, float b) {
  h16 x = (h16)a, y = (h16)b;
  unsigned short ux = __builtin_bit_cast(unsigned short, x), uy = __builtin_bit_cast(unsigned short, y);
  return (unsigned)ux | ((unsigned)uy << 16);
}
DEVI unsigned f2bf(float f) { unsigned u = __builtin_bit_cast(unsigned, f); u += 0x7fffu + ((u >> 16) & 1u); return u >> 16; }
DEVI float h2f(unsigned short u) { return (float)__builtin_bit_cast(h16, u); }
DEVI void st4h(h16* dst, float a, float b, float c, float d) {
  uint2 u; u.x = pk2n(a, b); u.y = pk2n(c, d);
  *(uint2*)dst = u;
}
DEVI float* xrow(const P& p, int r) {
  int b = r / SB, s = r - b * SB;
  return s < CTX ? p.XC() + (size_t)(b * CTX + s) * D : p.XL + (size_t)(b * SEQ + s - CTX) * D;
}
DEVI int maprow(int dir, int b, int n) {
  if (dir == 0) return b * SB + n;
  return n < CTX ? b * SB + (CTX - 1 - n) : b * SB + (SB + CTX - 1 - n);
}


#define XB_TMO      128
#define XB_XCNT(j)  (256  + 64 * (j))
#define XB_XSUB(j)  (1280 + 64 * (j))
#define XB_XGEN(j)  (2304 + 64 * (j))
#define XB_TOP      3328
#define XB_TOPGEN   3392
#define XCD_BAR_WORDS 3456
#define XB_SPIN_CAP (1u << 22)
#define LAS __attribute__((address_space(3)))
DEVI unsigned xb_ld(unsigned* p) { return __hip_atomic_load(p, __ATOMIC_RELAXED, __HIP_MEMORY_SCOPE_AGENT); }
DEVI unsigned xb_add(unsigned* p, unsigned v) { return __hip_atomic_fetch_add(p, v, __ATOMIC_RELAXED, __HIP_MEMORY_SCOPE_AGENT); }
DEVI unsigned xb_xcc_id() { return (unsigned)__builtin_amdgcn_s_getreg((3 << 11) | 20) & 0xFu; }
#define XB_SPIN(cond, bar) do { unsigned _sp = 0; while (cond) { __builtin_amdgcn_s_sleep(1); \
    if ((++_sp & 255u) == 0u) { if (xb_ld(&(bar)[XB_TMO])) break; if (_sp > XB_SPIN_CAP) { atomicAdd(&(bar)[XB_TMO], 1u); break; } } } } while (0)
struct XcdBarrier { unsigned* bar; unsigned x; volatile LAS unsigned* st; };
DEVI XcdBarrier xcd_barrier_post(unsigned* bar, volatile LAS unsigned* st) {
  XcdBarrier b; b.bar = bar; b.x = xb_xcc_id(); b.st = st;
  if (threadIdx_x_raw() == 0) (void)xb_add(&bar[XB_XCNT(b.x)], 1u);
  return b;
}
DEVI void xcd_barrier_complete(unsigned* bar, unsigned x, unsigned& nloc, unsigned& nx) {
  const unsigned G = gridDim.x;
  unsigned sum, cnt, mine, sp = 0u;
  for (;;) {
    sum = 0u; cnt = 0u; mine = 0u;
#pragma unroll
    for (unsigned j = 0; j < 16; ++j) { const unsigned c = xb_ld(&bar[XB_XCNT(j)]); sum += c; cnt += (c > 0u) ? 1u : 0u; mine = (j == x) ? c : mine; }
    if (sum == G) break;
    __builtin_amdgcn_s_sleep(1);
    if ((++sp & 255u) == 0u) { if (xb_ld(&bar[XB_TMO])) break; if (sp > XB_SPIN_CAP) { atomicAdd(&bar[XB_TMO], 1u); break; } }
  }
  nloc = mine > 0u ? mine : 1u; nx = cnt > 0u ? cnt : 1u;
}
DEVI void xcd_barrier(const XcdBarrier& b) {
  asm volatile("s_waitcnt vmcnt(0)" ::: "memory");
  __syncthreads();
  if (threadIdx_x_raw() == 0) {
    unsigned* bar = b.bar;
    __builtin_amdgcn_s_waitcnt(0);
    unsigned nloc = b.st[0], nx = b.st[1];
    if (nloc == 0u) { xcd_barrier_complete(bar, b.x, nloc, nx); b.st[0] = nloc; b.st[1] = nx; }
    const unsigned old = xb_add(&bar[XB_XSUB(b.x)], 1u);
    const unsigned gen = old / nloc;
    if (old + 1u == (gen + 1u) * nloc) {
      __builtin_amdgcn_fence(__ATOMIC_RELEASE, "agent");
      asm volatile("s_waitcnt vmcnt(0)" ::: "memory");
      const unsigned og = xb_add(&bar[XB_TOP], 1u);
      const unsigned tg = og / nx;
      if (og + 1u == (tg + 1u) * nx) xb_add(&bar[XB_TOPGEN], 1u);
      else XB_SPIN(xb_ld(&bar[XB_TOPGEN]) == tg, bar);
      __builtin_amdgcn_fence(__ATOMIC_ACQUIRE, "agent");
      xb_add(&bar[XB_XGEN(b.x)], 1u);
      asm volatile("s_waitcnt vmcnt(0)" ::: "memory");
    } else {
      XB_SPIN(xb_ld(&bar[XB_XGEN(b.x)]) == gen, bar);
      __builtin_amdgcn_fence(__ATOMIC_ACQUIRE, "agent");
      asm volatile("s_waitcnt vmcnt(0)" ::: "memory");
    }
  }
  __syncthreads();
}

DEVI void phase0(const P& p, char* smem) {
  const int tid = tidx();
  float* sc = (float*)smem;
  float* red = sc + 5 * 1024;
  for (int i = tid; i < 5 * 1024; i += 256) {
    int g = i >> 10, k = i & 1023;
    float v = g < 4 ? p.c[g * D + k] : p.c_ctx[k];
    sc[i] = v * sigm(v);
  }
  __syncthreads();
  for (int job = blockIdx.x; job < DEPTH * 96; job += gridDim.x) {
    int l = job / 96, n0 = (job % 96) * 64;
    int kq = tid >> 6, cc = tid & 63;
    const float* w = p.ada_w + ((size_t)l * D + kq * 256) * 6144 + n0 + cc;
    float a0 = 0, a1 = 0, a2 = 0, a3 = 0, a4 = 0;
#pragma unroll 8
    for (int k = 0; k < 256; ++k) {
      float wv = w[(size_t)k * 6144];
      int kk = kq * 256 + k;
      a0 += sc[kk] * wv; a1 += sc[1024 + kk] * wv; a2 += sc[2048 + kk] * wv; a3 += sc[3072 + kk] * wv; a4 += sc[4096 + kk] * wv;
    }
    red[(kq * 5 + 0) * 64 + cc] = a0; red[(kq * 5 + 1) * 64 + cc] = a1; red[(kq * 5 + 2) * 64 + cc] = a2;
    red[(kq * 5 + 3) * 64 + cc] = a3; red[(kq * 5 + 4) * 64 + cc] = a4;
    __syncthreads();
    for (int i = tid; i < 320; i += 256) {
      int g = i >> 6, c2 = i & 63;
      float s = red[(0 * 5 + g) * 64 + c2] + red[(1 * 5 + g) * 64 + c2] + red[(2 * 5 + g) * 64 + c2] + red[(3 * 5 + g) * 64 + c2];
      p.MOD()[((size_t)l * 5 + g) * 6144 + n0 + c2] = s + p.ada_b[l * 6144 + n0 + c2];
    }
    __syncthreads();
  }
  for (int i = blockIdx.x * 256 + tid; i < SEQ * 16; i += gridDim.x * 256) {
    int s = i >> 4, j = i & 15;
    float pos = (float)(j < 8 ? (s >> 6) : (s & 63));
    float inv = exp2f(-(float)(j & 7) * (13.287712379549449f / 8.f));
    float ang = pos * inv;
    p.ROPE()[s * 32 + j] = cosf(ang);
    p.ROPE()[s * 32 + 16 + j] = sinf(ang);
  }
  if (blockIdx.x == 0 && tid < 64) p.CTR()[tid] = 0;
}

struct CE { const float* src; h16* dst; const float* scale; int K, N; };
DEVI CE get_ce(const P& p, int l, int e) {
  CE c; c.scale = nullptr;
  switch (e) {
    case 0: c.src = p.w_in + (size_t)l * D * NIN; c.dst = p.WIN(); c.K = D; c.N = NIN; break;
    case 1: c.src = p.w_uq + (size_t)l * 384 * 768; c.dst = p.UQ(); c.K = 384; c.N = 768; c.scale = p.qn_g + l * 384; break;
    case 2: c.src = p.w_ukv + (size_t)l * 256 * 1024; c.dst = p.UKV(); c.K = 256; c.N = 1024; c.scale = p.kvn_g + l * 256; break;
    case 3: case 4: case 5: c.src = p.w_branch + ((size_t)l * 3 + (e - 3)) * 512 * D; c.dst = p.WB() + (size_t)(e - 3) * D * 512; c.K = 512; c.N = D; break;
    case 6: c.src = p.w_out + (size_t)l * D * D; c.dst = p.WO(); c.K = D; c.N = D; break;
    case 7: case 8: c.src = p.w_up + ((size_t)l * 2 + (e - 7)) * 64 * 512; c.dst = p.WUP() + (size_t)(e - 7) * 512 * 64; c.K = 64; c.N = 512; break;
    case 9: case 10: c.src = p.a_up + ((size_t)l * 2 + (e - 9)) * 64 * 512; c.dst = p.AUP() + (size_t)(e - 9) * 512 * 64; c.K = 64; c.N = 512; break;
    case 11: c.src = p.g_up + (size_t)l * 128 * 512; c.dst = p.GUP(); c.K = 128; c.N = 512; break;
    case 12: c.src = p.w1 + (size_t)l * D * DFF; c.dst = p.W1T(); c.K = D; c.N = DFF; break;
    default: c.src = p.w2 + (size_t)l * DFF * D; c.dst = p.W2T(); c.K = DFF; c.N = D; break;
  }
  return c;
}
DEVI void conv_tile(const CE& e, int tile, char* smem) {
  float* s = (float*)smem;
  const int tid = tidx();
  int ntn = e.N >> 6;
  int kt = tile / ntn, nt = tile - kt * ntn;
  {
    int r = tid >> 4, c4 = (tid & 15) * 4;
#pragma unroll
    for (int rr = 0; rr < 4; ++rr) {
      int k = r + 16 * rr;
      float4 v = *(const float4*)(e.src + (size_t)(kt * 64 + k) * e.N + nt * 64 + c4);
      float sc = e.scale ? e.scale[kt * 64 + k] : 1.f;
      s[k * 65 + c4 + 0] = v.x * sc; s[k * 65 + c4 + 1] = v.y * sc; s[k * 65 + c4 + 2] = v.z * sc; s[k * 65 + c4 + 3] = v.w * sc;
    }
  }
  __syncthreads();
  {
    int n = tid >> 2, kq = (tid & 3) * 16;
    uint4 u0, u1;
    u0.x = pk2n(s[(kq + 0) * 65 + n], s[(kq + 1) * 65 + n]); u0.y = pk2n(s[(kq + 2) * 65 + n], s[(kq + 3) * 65 + n]);
    u0.z = pk2n(s[(kq + 4) * 65 + n], s[(kq + 5) * 65 + n]); u0.w = pk2n(s[(kq + 6) * 65 + n], s[(kq + 7) * 65 + n]);
    u1.x = pk2n(s[(kq + 8) * 65 + n], s[(kq + 9) * 65 + n]); u1.y = pk2n(s[(kq + 10) * 65 + n], s[(kq + 11) * 65 + n]);
    u1.z = pk2n(s[(kq + 12) * 65 + n], s[(kq + 13) * 65 + n]); u1.w = pk2n(s[(kq + 14) * 65 + n], s[(kq + 15) * 65 + n]);
    h16* d = e.dst + (size_t)(nt * 64 + n) * e.K + kt * 64 + kq;
    *(uint4*)d = u0; *(uint4*)(d + 8) = u1;
  }
  __syncthreads();
}
DEVI void conv_phase(const P& p, int l, int e0, int e1, char* smem) {
  int total = 0;
  for (int e = e0; e < e1; ++e) { CE c = get_ce(p, l, e); total += (c.K >> 6) * (c.N >> 6); }
  for (int t = blockIdx.x; t < total; t += gridDim.x) {
    int tt = t;
    for (int e = e0; e < e1; ++e) {
      CE c = get_ce(p, l, e);
      int nt = (c.K >> 6) * (c.N >> 6);
      if (tt < nt) { conv_tile(c, tt, smem); break; }
      tt -= nt;
    }
  }
}

DEVI void ln_phase(const P& p, int l, int which) {
  const int lane = tidx() & 63;
  const int wid = blockIdx.x * 4 + (tidx() >> 6), nw = gridDim.x * 4;
  for (int r = wid; r < NR; r += nw) {
    int b = r / SB, s = r - b * SB;
    if (which == 2 && s < CTX) continue;
    int g = s < CTX ? 4 : b;
    float* xr = xrow(p, r);
    const float* src = xr;
    if (which == 0 && l == 0) src = s < CTX ? p.ctx + (size_t)(b * CTX + s) * D : p.x + (size_t)(b * SEQ + s - CTX) * D;
    float4 v[4];
#pragma unroll
    for (int i = 0; i < 4; ++i) v[i] = *(const float4*)(src + i * 256 + lane * 4);
    bool do_ln = !(which == 0 && l == 0);
    if (do_ln) {
      const float* gg = which == 1 ? p.ln1_g + l * D : p.ln2_g + (which == 2 ? 3 : l - 1) * D;
      const float* bb = which == 1 ? p.ln1_b + l * D : p.ln2_b + (which == 2 ? 3 : l - 1) * D;
      float sm = 0;
#pragma unroll
      for (int i = 0; i < 4; ++i) sm += v[i].x + v[i].y + v[i].z + v[i].w;
      float mean = wsum(sm) * (1.f / D);
      float sq = 0;
#pragma unroll
      for (int i = 0; i < 4; ++i) {
        v[i].x -= mean; v[i].y -= mean; v[i].z -= mean; v[i].w -= mean;
        sq += v[i].x * v[i].x + v[i].y * v[i].y + v[i].z * v[i].z + v[i].w * v[i].w;
      }
      float rs = rsqrtf(wsum(sq) * (1.f / D) + 1e-5f);
#pragma unroll
      for (int i = 0; i < 4; ++i) {
        float4 g4 = *(const float4*)(gg + i * 256 + lane * 4), b4 = *(const float4*)(bb + i * 256 + lane * 4);
        v[i].x = v[i].x * rs * g4.x + b4.x; v[i].y = v[i].y * rs * g4.y + b4.y;
        v[i].z = v[i].z * rs * g4.z + b4.z; v[i].w = v[i].w * rs * g4.w + b4.w;
      }
    }
#pragma unroll
    for (int i = 0; i < 4; ++i) *(float4*)(xr + i * 256 + lane * 4) = v[i];
    if (which == 2) continue;
    const float* shf = p.MOD() + ((size_t)l * 5 + g) * 6144 + (which == 0 ? 0 : 3) * D;
    const float* scl = shf + D;
    float sm = 0;
#pragma unroll
    for (int i = 0; i < 4; ++i) sm += v[i].x + v[i].y + v[i].z + v[i].w;
    float mean = wsum(sm) * (1.f / D);
    float sq = 0;
#pragma unroll
    for (int i = 0; i < 4; ++i) {
      v[i].x -= mean; v[i].y -= mean; v[i].z -= mean; v[i].w -= mean;
      sq += v[i].x * v[i].x + v[i].y * v[i].y + v[i].z * v[i].z + v[i].w * v[i].w;
    }
    float rs = rsqrtf(wsum(sq) * (1.f / D) + 1e-6f);
    h16* hr = p.H() + (size_t)r * D;
#pragma unroll
    for (int i = 0; i < 4; ++i) {
      float4 s4 = *(const float4*)(shf + i * 256 + lane * 4), c4 = *(const float4*)(scl + i * 256 + lane * 4);
      st4h(hr + i * 256 + lane * 4, v[i].x * rs * (1.f + c4.x) + s4.x, v[i].y * rs * (1.f + c4.y) + s4.y,
           v[i].z * rs * (1.f + c4.z) + s4.z, v[i].w * rs * (1.f + c4.w) + s4.w);
    }
  }
}

constexpr int GLD = 72;
template <bool ROWSQ, int NI = 2>
DEVI void gemm_main(const h16* __restrict__ A, int lda, const h16* __restrict__ Bt, int ldb, int K, int m0, int n0, int nmax,
                    char* smem, f32x16 (&acc)[2][NI], float* rowsq) {
  h16* As = (h16*)smem;
  h16* Bs = As + 2 * 128 * GLD;
  const int tid = tidx(), lane = tid & 63, wv = tid >> 6;
  const int wm = wv >> 1, wn = wv & 1, l31 = lane & 31, hh = lane >> 5;
  const int lrow = tid >> 3, lkc = (tid & 7) * 8;
  uint4 ga[4], gb[2 * NI];
  float sq[4] = {0.f, 0.f, 0.f, 0.f};
  const h16* Ap = A + (size_t)(m0 + lrow) * lda + lkc;
  const h16* Bp = Bt + (size_t)(n0 + lrow) * ldb + lkc;
#pragma unroll
  for (int i = 0; i < 4; ++i) ga[i] = *(const uint4*)(Ap + (size_t)(32 * i) * lda);
#pragma unroll
  for (int i = 0; i < 2 * NI; ++i)
    gb[i] = (n0 + lrow + 32 * i < nmax) ? *(const uint4*)(Bp + (size_t)(32 * i) * ldb) : make_uint4(0, 0, 0, 0);
  const int KT = K >> 6;
#pragma unroll
  for (int i = 0; i < 4; ++i) *(uint4*)(As + (lrow + 32 * i) * GLD + lkc) = ga[i];
#pragma unroll
  for (int i = 0; i < 2 * NI; ++i) *(uint4*)(Bs + (lrow + 32 * i) * GLD + lkc) = gb[i];
  __syncthreads();
  for (int kt = 0; kt < KT; ++kt) {
    const int buf = kt & 1;
    if (ROWSQ) {
#pragma unroll
      for (int i = 0; i < 4; ++i) {
        h16x8 hv = __builtin_bit_cast(h16x8, ga[i]);
#pragma unroll
        for (int j = 0; j < 8; ++j) { float f = (float)hv[j]; sq[i] += f * f; }
      }
    }
    if (kt + 1 < KT) {
#pragma unroll
      for (int i = 0; i < 4; ++i) ga[i] = *(const uint4*)(Ap + (size_t)(32 * i) * lda + (kt + 1) * 64);
#pragma unroll
      for (int i = 0; i < 2 * NI; ++i)
        gb[i] = (n0 + lrow + 32 * i < nmax) ? *(const uint4*)(Bp + (size_t)(32 * i) * ldb + (kt + 1) * 64) : make_uint4(0, 0, 0, 0);
    }
    const h16* as = As + buf * 128 * GLD + (wm * 64 + l31) * GLD + hh * 8;
    const h16* bs = Bs + buf * 128 * GLD + (wn * 32 * NI + l31) * GLD + hh * 8;
#pragma unroll
    for (int ks = 0; ks < 4; ++ks) {
      h16x8 a0 = *(const h16x8*)(as + ks * 16), a1 = *(const h16x8*)(as + 32 * GLD + ks * 16);
#pragma unroll
      for (int ni = 0; ni < NI; ++ni) {
        h16x8 b0 = *(const h16x8*)(bs + ni * 32 * GLD + ks * 16);
        acc[0][ni] = __builtin_amdgcn_mfma_f32_32x32x16_f16(b0, a0, acc[0][ni], 0, 0, 0);
        acc[1][ni] = __builtin_amdgcn_mfma_f32_32x32x16_f16(b0, a1, acc[1][ni], 0, 0, 0);
      }
    }
    if (kt + 1 < KT) {
      h16* ad = As + (buf ^ 1) * 128 * GLD;
      h16* bd = Bs + (buf ^ 1) * 128 * GLD;
#pragma unroll
      for (int i = 0; i < 4; ++i) *(uint4*)(ad + (lrow + 32 * i) * GLD + lkc) = ga[i];
#pragma unroll
      for (int i = 0; i < 2 * NI; ++i) *(uint4*)(bd + (lrow + 32 * i) * GLD + lkc) = gb[i];
    }
    __syncthreads();
  }
  if (ROWSQ) {
#pragma unroll
    for (int i = 0; i < 4; ++i) {
      float s = sq[i];
      s += __shfl_xor(s, 1); s += __shfl_xor(s, 2); s += __shfl_xor(s, 4);
      if ((tid & 7) == 0) rowsq[lrow + 32 * i] = s;
    }
    __syncthreads();
  }
}
template <int NI = 2>
DEVI void gemm_deep(const h16* __restrict__ A, int lda, const h16* __restrict__ Bt, int ldb, int K, int m0, int n0, int nmax,
                    char* smem, f32x16 (&acc)[2][NI]) {
  h16* As = (h16*)smem;
  h16* Bs = As + 2 * 128 * GLD;
  const int tid = tidx(), lane = tid & 63, wv = tid >> 6;
  const int wm = wv >> 1, wn = wv & 1, l31 = lane & 31, hh = lane >> 5;
  const int lrow = tid >> 3, lkc = (tid & 7) * 8;
  uint4 pa0, pa1, pa2, pa3, pb0, pb1, pb2, pb3;
  uint4 qa0, qa1, qa2, qa3, qb0, qb1, qb2, qb3;
  const h16* Ap = A + (size_t)(m0 + lrow) * lda + lkc;
  const int KT = K >> 6;
  const uint4 zz = make_uint4(0, 0, 0, 0);
  const h16* Bq0 = Bt + (size_t)min(n0 + lrow, nmax - 1) * ldb + lkc;
  const h16* Bq1 = Bt + (size_t)min(n0 + lrow + 32, nmax - 1) * ldb + lkc;
  const h16* Bq2 = Bt + (size_t)min(n0 + lrow + 64, nmax - 1) * ldb + lkc;
  const h16* Bq3 = Bt + (size_t)min(n0 + lrow + 96, nmax - 1) * ldb + lkc;
#define GLOAD(S, kt_)                                                                   \
  {                                                                                     \
    const h16* ap_ = Ap + (kt_) * 64;                                                   \
    S##a0 = *(const uint4*)(ap_); S##a1 = *(const uint4*)(ap_ + (size_t)32 * lda);      \
    S##a2 = *(const uint4*)(ap_ + (size_t)64 * lda); S##a3 = *(const uint4*)(ap_ + (size_t)96 * lda); \
    S##b0 = *(const uint4*)(Bq0 + (kt_) * 64); S##b1 = *(const uint4*)(Bq1 + (kt_) * 64); \
    if (NI == 2) { S##b2 = *(const uint4*)(Bq2 + (kt_) * 64); S##b3 = *(const uint4*)(Bq3 + (kt_) * 64); } \
  }
#define LSTORE(S, buf_)                                                                 \
  {                                                                                     \
    h16* ad = As + (buf_) * 128 * GLD + lrow * GLD + lkc;                               \
    h16* bd = Bs + (buf_) * 128 * GLD + lrow * GLD + lkc;                               \
    *(uint4*)(ad) = S##a0; *(uint4*)(ad + 32 * GLD) = S##a1; *(uint4*)(ad + 64 * GLD) = S##a2; *(uint4*)(ad + 96 * GLD) = S##a3; \
    *(uint4*)(bd) = S##b0; *(uint4*)(bd + 32 * GLD) = S##b1;                            \
    if (NI == 2) { *(uint4*)(bd + 64 * GLD) = S##b2; *(uint4*)(bd + 96 * GLD) = S##b3; } \
  }
#define COMPUTE(buf_)                                                                                              \
  {                                                                                                                \
    const h16* as = As + (buf_) * 128 * GLD + (wm * 64 + l31) * GLD + hh * 8;                                      \
    const h16* bs = Bs + (buf_) * 128 * GLD + (wn * 32 * NI + l31) * GLD + hh * 8;                                 \
    _Pragma("unroll") for (int ks = 0; ks < 4; ++ks) {                                                             \
      h16x8 a0 = *(const h16x8*)(as + ks * 16), a1 = *(const h16x8*)(as + 32 * GLD + ks * 16);                     \
      _Pragma("unroll") for (int ni = 0; ni < NI; ++ni) {                                                          \
        h16x8 b0 = *(const h16x8*)(bs + ni * 32 * GLD + ks * 16);                                                  \
        acc[0][ni] = __builtin_amdgcn_mfma_f32_32x32x16_f16(b0, a0, acc[0][ni], 0, 0, 0);                          \
        acc[1][ni] = __builtin_amdgcn_mfma_f32_32x32x16_f16(b0, a1, acc[1][ni], 0, 0, 0);                          \
      }                                                                                                            \
    }                                                                                                              \
  }
  pb2 = zz; pb3 = zz; qb2 = zz; qb3 = zz;
  GLOAD(p, 0);
  GLOAD(q, 1);
  LSTORE(p, 0);
  if (KT > 2) GLOAD(p, 2);
  __syncthreads();
  for (int kt = 0; kt < KT; kt += 2) {
    COMPUTE(0);
    if (kt + 1 < KT) LSTORE(q, 1);
    if (kt + 3 < KT) GLOAD(q, kt + 3);
    __syncthreads();
    if (kt + 1 < KT) {
      COMPUTE(1);
      if (kt + 2 < KT) LSTORE(p, 0);
      if (kt + 4 < KT) GLOAD(p, kt + 4);
      __syncthreads();
    }
  }
#undef GLOAD
#undef LSTORE
#undef COMPUTE
}
DEVI void zero_acc(f32x16 (&acc)[2][2]) {
#pragma unroll
  for (int i = 0; i < 2; ++i)
#pragma unroll
    for (int j = 0; j < 2; ++j)
#pragma unroll
      for (int r = 0; r < 16; ++r) acc[i][j][r] = 0.f;
}
template <class F>
DEVI void epi_quads(const f32x16 (&acc)[2][2], int m0, int n0, F f) {
  const int lane = tidx() & 63, wv = tidx() >> 6;
  const int wm = wv >> 1, wn = wv & 1, l31 = lane & 31, hh = lane >> 5;
#pragma unroll
  for (int mi = 0; mi < 2; ++mi)
#pragma unroll
    for (int ni = 0; ni < 2; ++ni)
#pragma unroll
      for (int g = 0; g < 4; ++g)
        f(m0 + wm * 64 + mi * 32 + l31, n0 + wn * 64 + ni * 32 + 8 * g + 4 * hh, acc[mi][ni][4 * g], acc[mi][ni][4 * g + 1],
          acc[mi][ni][4 * g + 2], acc[mi][ni][4 * g + 3]);
}

DEVI void inproj_phase(const P& p, char* smem) {
  constexpr int MT = NR / 128, NT = (ZW + 127) / 128;
  for (int job = blockIdx.x; job < MT * NT; job += gridDim.x) {
    int nt = job / MT, mt = job - nt * MT;
    f32x16 acc[2][2]; zero_acc(acc);
    gemm_deep<2>(p.H(), D, p.WIN(), D, D, mt * 128, nt * 128, ZW, smem, acc);
    epi_quads(acc, mt * 128, nt * 128, [&](int m, int n, float v0, float v1, float v2, float v3) {
      if (n < ZW) {
        st4h(p.Z() + (size_t)m * ZW + n, v0, v1, v2, v3);
        if (n >= ZRW) {
          if ((m & 63) == 0) st4h(p.HLO() + (size_t)(m >> 6) * 1920 + n - ZRW, v0, v1, v2, v3);
          if ((m & 63) == 63) st4h(p.HHI() + (size_t)(m >> 6) * 1920 + n - ZRW, v0, v1, v2, v3);
        }
      }
    });
  }
}

DEVI void shift_job(const P& p, int l, int jj, char* smem) {
  const int j = jj >> 3, slab0 = jj & 7;
  h16* raw = (h16*)smem;
  const int tid = tidx(), lane = tid & 63;
  const int r0 = j * 64;
  const int s0 = r0 % SB;
  const bool first = (s0 == 0) || (s0 == CTX);
  const bool last = (s0 + 64 == CTX) || (s0 + 64 == SB);
  for (int slab = slab0; slab <= slab0; ++slab) {
    const int c0 = slab * 256;
    const int ncols = slab == 7 ? 128 : 256;
    const int cpr = ncols >> 3;
    for (int c = tid; c < 66 * cpr; c += 256) {
      int row = c / cpr, ch = (c - row * cpr) * 8;
      uint4 v = make_uint4(0, 0, 0, 0);
      if (row == 0) { if (!first) v = *(const uint4*)(p.HHI() + (size_t)(j - 1) * 1920 + c0 + ch); }
      else if (row == 65) { if (!last) v = *(const uint4*)(p.HLO() + (size_t)(j + 1) * 1920 + c0 + ch); }
      else v = *(const uint4*)(p.Z() + (size_t)(r0 + row - 1) * ZW + ZRW + c0 + ch);
      *(uint4*)(raw + row * 264 + ch) = v;
    }
    __syncthreads();
    if (tid < ncols) {
      const int col = c0 + tid;
      const float mup = p.mu[(size_t)l * 2 * 1920 + col], mun = p.mu[(size_t)l * 2 * 1920 + 1920 + col];
      const bool isk = (col >= 512 && col < 1024);
      const float kkp = isk ? p.k_k[l * 512 + col - 512] : 0.f;
      float prev = (float)raw[tid], cur = (float)raw[264 + tid];
      h16* zc = p.Z() + (size_t)r0 * ZW + ZRW + col;
      for (int t = 0; t < 64; ++t) {
        float nxt = (float)raw[(t + 2) * 264 + tid];
        float o = cur + mup * (prev - cur) + mun * (nxt - cur);
        float ov = o;
        if (col >= 1536 && col < 1664) ov = tanhf(o);
        else if (col >= 1792) ov = sigm(o);
        zc[(size_t)t * ZW] = (h16)ov;
        if (isk) {
          float q = o * kkp;
          float ss = wsum(q * q);
          if (lane == 0) p.INVN()[(size_t)(r0 + t) * 8 + ((col - 512) >> 6)] = rsqrtf(ss + 1e-12f);
        }
        prev = cur; cur = nxt;
      }
    }
    __syncthreads();
  }
}

DEVI void mla_up_job(const P& p, int job, char* smem) {
  constexpr int MT = NR / 128;
  float* rowsq = (float*)(smem + 2 * 2 * 128 * GLD * 2);
  const int tid = tidx();
  f32x16 acc[2][2]; zero_acc(acc);
  if (job < MT * 6) {
    int nt = job / MT, mt = job - nt * MT;
    gemm_main<true>(p.Z() + ZMLA, ZW, p.UQ(), 384, 384, mt * 128, nt * 128, 768, smem, acc, rowsq);
    const int m0 = mt * 128, n0 = nt * 128;
    const int lane = tid & 63, wv = tid >> 6, wm = wv >> 1, wn = wv & 1, l31 = lane & 31, hh = lane >> 5;
    const float qs = 0.10206207261596575f * 1.4426950408889634f;
#pragma unroll
    for (int mi = 0; mi < 2; ++mi) {
      const int ml = wm * 64 + mi * 32 + l31, m = m0 + ml;
      const float sc = rsqrtf(rowsq[ml] * (1.f / 384.f) + 1e-6f) * qs;
      const int sp = m % SB;
      const bool lat = sp >= CTX;
      const float* rp = p.ROPE() + (size_t)(lat ? sp - CTX : 0) * 32;
#pragma unroll
      for (int ni = 0; ni < 2; ++ni) {
        const int nb = n0 + wn * 64 + ni * 32;
        h16* qd = p.Q() + (size_t)m * 768 + nb;
        const bool ropet = (nb % 96) == 64;
        if (ropet && lat) {
#pragma unroll
          for (int g = 0; g < 2; ++g) {
            float o1[4], o2[4];
#pragma unroll
            for (int jj = 0; jj < 4; ++jj) {
              int i = 8 * g + 4 * hh + jj;
              float x1 = acc[mi][ni][4 * g + jj] * sc, x2 = acc[mi][ni][4 * (g + 2) + jj] * sc;
              float cs = rp[i], sn = rp[16 + i];
              o1[jj] = x1 * cs - x2 * sn; o2[jj] = x1 * sn + x2 * cs;
            }
            st4h(qd + 8 * g + 4 * hh, o1[0], o1[1], o1[2], o1[3]);
            st4h(qd + 16 + 8 * g + 4 * hh, o2[0], o2[1], o2[2], o2[3]);
          }
        } else {
#pragma unroll
          for (int g = 0; g < 4; ++g)
            st4h(qd + 8 * g + 4 * hh, acc[mi][ni][4 * g] * sc, acc[mi][ni][4 * g + 1] * sc, acc[mi][ni][4 * g + 2] * sc, acc[mi][ni][4 * g + 3] * sc);
        }
      }
    }
  } else {
    int j2 = job - MT * 6;
    int nt = j2 / MT, mt = j2 - nt * MT;
    gemm_main<true>(p.Z() + ZMLA + 384, ZW, p.UKV(), 256, 256, mt * 128, nt * 128, 1024, smem, acc, rowsq);
    const int m0 = mt * 128;
    epi_quads(acc, m0, 0, [&](int m, int n, float v0, float v1, float v2, float v3) {
      const float sc = rsqrtf(rowsq[m - m0] * (1.f / 256.f) + 1e-6f);
      if (n < 64) st4h(p.K() + (size_t)m * 768 + nt * 96 + n, v0 * sc, v1 * sc, v2 * sc, v3 * sc);
      else {
        int b = m / SB, s = m - b * SB;
        h16* vt = p.VT() + ((size_t)(b * 8 + nt) * 64 + (n - 64)) * SB + s;
        vt[0] = (h16)(v0 * sc); vt[SB] = (h16)(v1 * sc); vt[2 * SB] = (h16)(v2 * sc); vt[3 * SB] = (h16)(v3 * sc);
      }
    });
    {
      int row = tid >> 1, sub = tid & 1;
      int m = m0 + row;
      int sp = m % SB;
      const h16* kr = p.Z() + (size_t)m * ZW + ZMLA + 640 + sub * 8;
      h16x8 x1 = *(const h16x8*)kr, x2 = *(const h16x8*)(kr + 16);
      h16* kd = p.K() + (size_t)m * 768 + nt * 96 + 64 + sub * 8;
      if (sp >= CTX) {
        const float* rp = p.ROPE() + (size_t)(sp - CTX) * 32 + sub * 8;
        h16x8 o1, o2;
#pragma unroll
        for (int i = 0; i < 8; ++i) {
          float a = (float)x1[i], b2 = (float)x2[i], cs = rp[i], sn = rp[16 + i];
          o1[i] = (h16)(a * cs - b2 * sn); o2[i] = (h16)(a * sn + b2 * cs);
        }
        *(h16x8*)kd = o1; *(h16x8*)(kd + 16) = o2;
      } else { *(h16x8*)kd = x1; *(h16x8*)(kd + 16) = x2; }
    }
  }
}

DEVI void lowrank_job(const P& p, int l, int job, char* smem) {
  constexpr int MT = NR / 128;
  int mat = job / (MT * 4), rem = job - mat * MT * 4;
  int nt = rem / MT, mt = rem - nt * MT;
  f32x16 acc[2][2]; zero_acc(acc);
  if (mat < 2) {
    const int dir = mat;
    gemm_main<false>(p.Z() + ZRW + 1536 + dir * 64, ZW, p.WUP() + (size_t)dir * 512 * 64, 64, 64, mt * 128, nt * 128, 512, smem, acc, nullptr);
    const float* w0 = p.w0 + ((size_t)l * 2 + dir) * 512;
    h16* dst = p.LW() + (size_t)dir * NR * 512;
    epi_quads(acc, mt * 128, nt * 128, [&](int m, int n, float v0, float v1, float v2, float v3) {
      float4 b = *(const float4*)(w0 + n);
      const float e = 0.6065306597126334f;
      st4h(dst + (size_t)m * 512 + n, sigm(v0 + b.x) * e, sigm(v1 + b.y) * e, sigm(v2 + b.z) * e, sigm(v3 + b.w) * e);
    });
  } else if (mat < 4) {
    const int dir = mat - 2;
    gemm_main<false>(p.Z() + ZRW + 1664 + dir * 64, ZW, p.AUP() + (size_t)dir * 512 * 64, 64, 64, mt * 128, nt * 128, 512, smem, acc, nullptr);
    const float* a0 = p.a0 + ((size_t)l * 2 + dir) * 512;
    h16* dst = p.AA() + (size_t)dir * NR * 512;
    epi_quads(acc, mt * 128, nt * 128, [&](int m, int n, float v0, float v1, float v2, float v3) {
      float4 b = *(const float4*)(a0 + n);
      st4h(dst + (size_t)m * 512 + n, sigm(v0 + b.x), sigm(v1 + b.y), sigm(v2 + b.z), sigm(v3 + b.w));
    });
  } else {
    gemm_main<false>(p.Z() + ZRW + 1792, ZW, p.GUP(), 128, 128, mt * 128, nt * 128, 512, smem, acc, nullptr);
    epi_quads(acc, mt * 128, nt * 128, [&](int m, int n, float v0, float v1, float v2, float v3) {
      st4h(p.G() + (size_t)m * 512 + n, v0, v1, v2, v3);
    });
  }
}

DEVI void attn_job(const P& p, int job, char* smem) {
  h16* Ks = (h16*)smem;
  h16* Vs = Ks + 2 * 64 * 104;
  const int tid = tidx(), lane = tid & 63, wv = tid >> 6, l31 = lane & 31, hh = lane >> 5;
  int b, h, q0, nk;
  if (job < 1024) { b = job >> 8; h = (job >> 5) & 7; q0 = b * SB + CTX + (job & 31) * 128; nk = SB; }
  else { int j = job - 1024; b = j >> 4; h = (j >> 1) & 7; q0 = b * SB + (j & 1) * 128; nk = CTX; }
  const int NKT = nk >> 6;
  const h16* Kg = p.K() + (size_t)(b * SB) * 768 + h * 96;
  const h16* Vg = p.VT() + (size_t)(b * 8 + h) * 64 * SB;
  h16x8 qf[6];
  {
    const h16* qp = p.Q() + (size_t)(q0 + wv * 32 + l31) * 768 + h * 96 + hh * 8;
#pragma unroll
    for (int ds = 0; ds < 6; ++ds) qf[ds] = *(const h16x8*)(qp + ds * 16);
  }
  uint4 pk0, pk1, pk2_, pv0, pv1, qk0, qk1, qk2_, qv0, qv1;
  int krow[3], kcol[3];
#pragma unroll
  for (int i = 0; i < 3; ++i) { int c = tid + 256 * i; krow[i] = c / 12; kcol[i] = (c - krow[i] * 12) * 8; }
  const int vrow = tid >> 3, vcol = (tid & 7) * 8;
  const h16* kp0 = Kg + (size_t)krow[0] * 768 + kcol[0];
  const h16* kp1 = Kg + (size_t)krow[1] * 768 + kcol[1];
  const h16* kp2 = Kg + (size_t)krow[2] * 768 + kcol[2];
  const h16* vp0 = Vg + (size_t)vrow * SB + vcol;
  const h16* vp1 = Vg + (size_t)(vrow + 32) * SB + vcol;
#define ALOAD(S, kt_) { S##k0 = *(const uint4*)(kp0 + (size_t)(kt_) * 64 * 768); S##k1 = *(const uint4*)(kp1 + (size_t)(kt_) * 64 * 768); \
    S##k2_ = *(const uint4*)(kp2 + (size_t)(kt_) * 64 * 768); S##v0 = *(const uint4*)(vp0 + (kt_) * 64); S##v1 = *(const uint4*)(vp1 + (kt_) * 64); }
#define ASTORE(S, buf_) { h16* kd = Ks + (buf_) * 64 * 104; h16* vd = Vs + (buf_) * 64 * 72; \
    *(uint4*)(kd + krow[0] * 104 + kcol[0]) = S##k0; *(uint4*)(kd + krow[1] * 104 + kcol[1]) = S##k1; *(uint4*)(kd + krow[2] * 104 + kcol[2]) = S##k2_; \
    *(uint4*)(vd + vrow * 72 + vcol) = S##v0; *(uint4*)(vd + (vrow + 32) * 72 + vcol) = S##v1; }
  f32x16 o0, o1;
#pragma unroll
  for (int r = 0; r < 16; ++r) { o0[r] = 0.f; o1[r] = 0.f; }
  float mrun = -1e30f, lsum = 0.f;
  auto compute = [&](int buf) {
    const h16* ks = Ks + buf * 64 * 104 + l31 * 104 + hh * 8;
    f32x16 s0, s1;
#pragma unroll
    for (int r = 0; r < 16; ++r) { s0[r] = 0.f; s1[r] = 0.f; }
#pragma unroll
    for (int ds = 0; ds < 6; ++ds) {
      h16x8 a0 = *(const h16x8*)(ks + ds * 16), a1 = *(const h16x8*)(ks + 32 * 104 + ds * 16);
      s0 = __builtin_amdgcn_mfma_f32_32x32x16_f16(a0, qf[ds], s0, 0, 0, 0);
      s1 = __builtin_amdgcn_mfma_f32_32x32x16_f16(a1, qf[ds], s1, 0, 0, 0);
    }
    float mx = s0[0];
#pragma unroll
    for (int r = 1; r < 16; ++r) mx = fmaxf(mx, s0[r]);
#pragma unroll
    for (int r = 0; r < 16; ++r) mx = fmaxf(mx, s1[r]);
    mx = fmaxf(mx, __shfl_xor(mx, 32));
    const float mnew = fmaxf(mrun, mx);
    const float alpha = __builtin_amdgcn_exp2f(mrun - mnew);
    mrun = mnew;
    float ps = 0.f;
#pragma unroll
    for (int r = 0; r < 16; ++r) { s0[r] = __builtin_amdgcn_exp2f(s0[r] - mnew); ps += s0[r]; }
#pragma unroll
    for (int r = 0; r < 16; ++r) { s1[r] = __builtin_amdgcn_exp2f(s1[r] - mnew); ps += s1[r]; }
    lsum = lsum * alpha + ps;
#pragma unroll
    for (int r = 0; r < 16; ++r) { o0[r] *= alpha; o1[r] *= alpha; }
    const h16* vs = Vs + buf * 64 * 72 + l31 * 72 + 4 * hh;
#pragma unroll
    for (int k2 = 0; k2 < 2; ++k2) {
#pragma unroll
      for (int s2 = 0; s2 < 2; ++s2) {
        uint4 pu;
        if (k2 == 0) { pu.x = pk2(s0[8 * s2], s0[8 * s2 + 1]); pu.y = pk2(s0[8 * s2 + 2], s0[8 * s2 + 3]); pu.z = pk2(s0[8 * s2 + 4], s0[8 * s2 + 5]); pu.w = pk2(s0[8 * s2 + 6], s0[8 * s2 + 7]); }
        else { pu.x = pk2(s1[8 * s2], s1[8 * s2 + 1]); pu.y = pk2(s1[8 * s2 + 2], s1[8 * s2 + 3]); pu.z = pk2(s1[8 * s2 + 4], s1[8 * s2 + 5]); pu.w = pk2(s1[8 * s2 + 6], s1[8 * s2 + 7]); }
        h16x8 pf = __builtin_bit_cast(h16x8, pu);
        const int kb = k2 * 32 + 16 * s2;
        uint2 va = *(const uint2*)(vs + kb), vb = *(const uint2*)(vs + kb + 8);
        uint2 vc = *(const uint2*)(vs + 32 * 72 + kb), vd = *(const uint2*)(vs + 32 * 72 + kb + 8);
        h16x8 vf0 = __builtin_bit_cast(h16x8, make_uint4(va.x, va.y, vb.x, vb.y));
        h16x8 vf1 = __builtin_bit_cast(h16x8, make_uint4(vc.x, vc.y, vd.x, vd.y));
        o0 = __builtin_amdgcn_mfma_f32_32x32x16_f16(vf0, pf, o0, 0, 0, 0);
        o1 = __builtin_amdgcn_mfma_f32_32x32x16_f16(vf1, pf, o1, 0, 0, 0);
      }
    }
  };
  ALOAD(p, 0);
  if (NKT > 1) ALOAD(q, 1);
  ASTORE(p, 0);
  if (NKT > 2) ALOAD(p, 2);
  __syncthreads();
  for (int kt = 0; kt < NKT; kt += 2) {
    compute(0);
    if (kt + 1 < NKT) ASTORE(q, 1);
    if (kt + 3 < NKT) ALOAD(q, kt + 3);
    __syncthreads();
    if (kt + 1 < NKT) {
      compute(1);
      if (kt + 2 < NKT) ASTORE(p, 0);
      if (kt + 4 < NKT) ALOAD(p, kt + 4);
      __syncthreads();
    }
  }
#undef ALOAD
#undef ASTORE
  const float ltot = lsum + __shfl_xor(lsum, 32);
  const float inv = 1.f / ltot;
  h16* yo = p.Z() + (size_t)(q0 + wv * 32 + l31) * ZW + ZMLA + h * 64 + 4 * hh;
#pragma unroll
  for (int g = 0; g < 4; ++g) {
    st4h(yo + 8 * g, o0[4 * g] * inv, o0[4 * g + 1] * inv, o0[4 * g + 2] * inv, o0[4 * g + 3] * inv);
    st4h(yo + 32 + 8 * g, o1[4 * g] * inv, o1[4 * g + 1] * inv, o1[4 * g + 2] * inv, o1[4 * g + 3] * inv);
  }
}

#if PROBE >= 200
__device__ unsigned long long g_tacc[4];
#endif
struct Slot { float w[64]; unsigned bke[64]; float vv[64]; h16 ah[4][64]; int yoff; int pad[3]; };
struct LSet { uint4 lw, a, k, v, r; float inv; int yoff; int vm; };
DEVI void scan_job(const P& p, int l, int job, char* smem, int rank) {
  constexpr int RGB = 4 / NSCAN_BPC;
  constexpr int NLD = (4 - RGB) * 64;
  static_assert(NLD == 128, "loader mapping assumes 128 loader threads");
  Slot* sl = (Slot*)smem;
  h16* ybuf = (h16*)(smem + 2 * 16 * sizeof(Slot));
  const int tid = tidx(), lane = tid & 63, wv = rank ? ((tid >> 6) ^ 2) : (tid >> 6);
  const int chain = job / NSCAN_BPC, part = job - chain * NSCAN_BPC;
  const int dir = chain >> 5, b = (chain >> 3) & 3, h = chain & 7;
  for (int i = tid; i < 32 * 128; i += 256) { int s = i >> 7, e = i & 127; sl[s].ah[2 + (e >> 6)][e & 63] = (h16)0.f; }
  if (wv >= RGB) {
    const int lt = (wv - RGB) * 64 + lane;
    const int st = lt >> 3, ca = lt & 7, c8 = ca * 8;
    const int pp0 = (ca >> 2) * 32 + (2 * (ca & 1)) * 8 + ((ca & 3) >> 1) * 4;
    const int pp1 = pp0 + 8;
    const float4 kkA = *(const float4*)(p.k_k + l * 512 + h * 64 + c8), kkB = *(const float4*)(p.k_k + l * 512 + h * 64 + c8 + 4);
    const float4 kaA = *(const float4*)(p.k_a + l * 512 + h * 64 + c8), kaB = *(const float4*)(p.k_a + l * 512 + h * 64 + c8 + 4);
    const h16* LWd = p.LW() + (size_t)dir * NR * 512 + h * 64 + c8;
    const h16* AAd = p.AA() + (size_t)dir * NR * 512 + h * 64 + c8;
    const h16* Zr = p.Z() + ZRW + h * 64 + c8;
#define LLOAD(ci_, g)                                                                                         \
    {                                                                                                         \
      const int n_ = (ci_) * 16 + st;                                                                         \
      const int rowm_ = maprow(dir, b, min(n_, SB - 1));                                                      \
      const int rowr_ = maprow(dir, b, min(max(n_ - 1, 0), SB - 1));                                          \
      g##_yoff = (n_ >= 1 && n_ <= SB) ? rowr_ * 512 : -1;                                                      \
      g##_vm = (n_ < SB) ? 1 : 0;                                                                               \
      const h16* p0_ = LWd + (size_t)rowm_ * 512; const h16* p1_ = AAd + (size_t)rowm_ * 512;                 \
      const h16* p2_ = Zr + (size_t)rowm_ * ZW + 512; const h16* p3_ = Zr + (size_t)rowm_ * ZW + 1024;        \
      const h16* p4_ = Zr + (size_t)rowr_ * ZW; const float* p5_ = p.INVN() + (size_t)rowm_ * 8 + h;          \
      asm volatile("global_load_dwordx4 %0, %1, off" : "=v"(g##_lw) : "v"(p0_) : "memory");                     \
      asm volatile("global_load_dwordx4 %0, %1, off" : "=v"(g##_a) : "v"(p1_) : "memory");                      \
      asm volatile("global_load_dwordx4 %0, %1, off" : "=v"(g##_k) : "v"(p2_) : "memory");                      \
      asm volatile("global_load_dwordx4 %0, %1, off" : "=v"(g##_v) : "v"(p3_) : "memory");                      \
      asm volatile("global_load_dwordx4 %0, %1, off" : "=v"(g##_r) : "v"(p4_) : "memory");                      \
      asm volatile("global_load_dword %0, %1, off" : "=v"(g##_inv) : "v"(p5_) : "memory");                      \
    }
#define LWAIT(g) asm volatile("s_waitcnt vmcnt(18)" : "+v"(g##_lw), "+v"(g##_a), "+v"(g##_k), "+v"(g##_v), "+v"(g##_r), "+v"(g##_inv) : : "memory")
    auto lstore = [&](uint4 g_lw, uint4 g_a, uint4 g_k, uint4 g_v, uint4 g_r, float g_inv, int g_yoff, int g_vm, int buf) {
      Slot& s = sl[buf * 16 + st];
      const h16x8 lw = __builtin_bit_cast(h16x8, g_lw), a = __builtin_bit_cast(h16x8, g_a), k = __builtin_bit_cast(h16x8, g_k), v = __builtin_bit_cast(h16x8, g_v);
      const float kkp[8] = {kkA.x, kkA.y, kkA.z, kkA.w, kkB.x, kkB.y, kkB.z, kkB.w};
      const float kap[8] = {kaA.x, kaA.y, kaA.z, kaA.w, kaB.x, kaB.y, kaB.z, kaB.w};
      const float vmf = g_vm ? 1.f : 0.f;
      const float inv = g_inv * vmf;
      float w8[8], v8[8], q8[8]; unsigned be8[8];
#pragma unroll
      for (int i = 0; i < 8; ++i) {
        const float kf = (float)k[i] * vmf, af = (float)a[i];
        const float kkv = kf * kkp[i] * inv;
        w8[i] = __expf(-(float)lw[i] * vmf);
        be8[i] = pk2n(kkv * af, kf * (1.f + (af - 1.f) * kap[i]));
        v8[i] = (float)v[i] * vmf;
        q8[i] = kkv;
      }
      const uint4 rr = (g_yoff >= 0) ? g_r : make_uint4(0, 0, 0, 0);
      *(float4*)(s.w + c8) = make_float4(w8[0], w8[1], w8[2], w8[3]); *(float4*)(s.w + c8 + 4) = make_float4(w8[4], w8[5], w8[6], w8[7]);
      *(uint4*)(s.bke + c8) = make_uint4(be8[0], be8[1], be8[2], be8[3]); *(uint4*)(s.bke + c8 + 4) = make_uint4(be8[4], be8[5], be8[6], be8[7]);
      *(float4*)(s.vv + c8) = make_float4(v8[0], v8[1], v8[2], v8[3]); *(float4*)(s.vv + c8 + 4) = make_float4(v8[4], v8[5], v8[6], v8[7]);
      *(uint2*)(&s.ah[0][pp0]) = make_uint2(pk2n(q8[0], q8[1]), pk2n(q8[2], q8[3]));
      *(uint2*)(&s.ah[0][pp1]) = make_uint2(pk2n(q8[4], q8[5]), pk2n(q8[6], q8[7]));
      *(uint2*)(&s.ah[1][pp0]) = make_uint2(rr.x, rr.y);
      *(uint2*)(&s.ah[1][pp1]) = make_uint2(rr.z, rr.w);
      if (ca == 0) s.yoff = g_yoff;
    };
    typedef unsigned u32x4 __attribute__((ext_vector_type(4)));
    u32x4 R0_lw, R0_a, R0_k, R0_v, R0_r, R1_lw, R1_a, R1_k, R1_v, R1_r, R2_lw, R2_a, R2_k, R2_v, R2_r, R3_lw, R3_a, R3_k, R3_v, R3_r;
    float R0_inv, R1_inv, R2_inv, R3_inv; int R0_yoff, R1_yoff, R2_yoff, R3_yoff, R0_vm, R1_vm, R2_vm, R3_vm;
#define U4(x) make_uint4((x)[0], (x)[1], (x)[2], (x)[3])
#define LST(g, buf_) lstore(U4(g##_lw), U4(g##_a), U4(g##_k), U4(g##_v), U4(g##_r), g##_inv, g##_yoff, g##_vm, buf_)
    asm volatile("s_waitcnt vmcnt(0)" ::: "memory");
    LLOAD(0, R0); LLOAD(1, R1); LLOAD(2, R2); LLOAD(3, R3);
    LWAIT(R0); LST(R0, 0); LLOAD(4, R0);
    __syncthreads();
    h16* yout = p.Y2() + (size_t)dir * NR * 512 + h * 64 + part * (RGB * 16) + ca * 4;
    auto ystore = [&](int cj) {
      const int n = cj * 16 + st;
      if (n >= 1 && n <= SB) {
        const h16* yb = ybuf + ((cj & 1) * 32 + ca * 4) * 24 + st;
        const unsigned short a0 = __builtin_bit_cast(unsigned short, yb[0]), a1 = __builtin_bit_cast(unsigned short, yb[24]);
        const unsigned short a2 = __builtin_bit_cast(unsigned short, yb[48]), a3 = __builtin_bit_cast(unsigned short, yb[72]);
        typedef unsigned u32x2 __attribute__((ext_vector_type(2)));
        u32x2 u; u[0] = (unsigned)a0 | ((unsigned)a1 << 16); u[1] = (unsigned)a2 | ((unsigned)a3 << 16);
        h16* yp = yout + (size_t)maprow(dir, b, n - 1) * 512;
        asm volatile("global_store_dwordx2 %0, %1, off" : : "v"(yp), "v"(u) : "memory");
      }
    };
    for (int ci = 0; ci < NCHUNK; ci += 4) {
      if (ci > 0) ystore(ci - 1);
      LWAIT(R1); if (ci + 1 < NCHUNK) LST(R1, 1); LLOAD(ci + 5, R1);
      __syncthreads();
      if (ci + 1 < NCHUNK) { ystore(ci); LWAIT(R2); if (ci + 2 < NCHUNK) LST(R2, 0); LLOAD(ci + 6, R2); __syncthreads(); }
      if (ci + 2 < NCHUNK) { ystore(ci + 1); LWAIT(R3); if (ci + 3 < NCHUNK) LST(R3, 1); LLOAD(ci + 7, R3); __syncthreads(); }
      if (ci + 3 < NCHUNK) { ystore(ci + 2); LWAIT(R0); if (ci + 4 < NCHUNK) LST(R0, 0); LLOAD(ci + 8, R0); __syncthreads(); }
    }
    ystore(NCHUNK - 1);
    asm volatile("s_waitcnt vmcnt(0)" ::: "memory");
#undef LST
#undef U4
#undef LLOAD
#undef LWAIT
  } else {
    const int c = lane & 15, hq = lane >> 4;
    const int rg = part * RGB + wv;
    const bool h0 = (hq == 0);
    f32x4 ST[4];
#pragma unroll
    for (int t = 0; t < 4; ++t) ST[t] = (f32x4){0.f, 0.f, 0.f, 0.f};
    __builtin_amdgcn_s_setprio(3);
    __syncthreads();
    for (int ci = 0; ci < NCHUNK; ++ci) {
      const int buf = ci & 1;
#if PROBE == 211
      const unsigned long long ct0 = __builtin_amdgcn_s_memrealtime();
#endif
      float yv[16];
      h16x8 rA0[2], rA1[2]; float rvv[2]; f32x4 rw[2][4]; unsigned rbe[2][4];
      {
        const Slot& t = sl[buf * 16];
        rA0[0] = *(const h16x8*)(&t.ah[c & 3][8 * hq]); rA1[0] = *(const h16x8*)(&t.ah[c & 3][32 + 8 * hq]);
        rvv[0] = t.vv[rg * 16 + c];
#pragma unroll
        for (int tt = 0; tt < 4; ++tt) { rw[0][tt] = *(const f32x4*)(t.w + 16 * tt + 4 * hq); rbe[0][tt] = t.bke[16 * tt + c]; }
      }
#pragma unroll
      for (int s = 0; s < 16; ++s) {
        const int cur = s & 1, nxt = cur ^ 1;
        uint4 sh0, sh1;
        sh0.x = pk2(ST[0][0], ST[0][1]); sh0.y = pk2(ST[0][2], ST[0][3]); sh0.z = pk2(ST[1][0], ST[1][1]); sh0.w = pk2(ST[1][2], ST[1][3]);
        sh1.x = pk2(ST[2][0], ST[2][1]); sh1.y = pk2(ST[2][2], ST[2][3]); sh1.z = pk2(ST[3][0], ST[3][1]); sh1.w = pk2(ST[3][2], ST[3][3]);
        const f32x4 z4 = {0.f, 0.f, 0.f, 0.f};
        f32x4 acc0 = __builtin_amdgcn_mfma_f32_16x16x32_f16(rA0[cur], __builtin_bit_cast(h16x8, sh0), z4, 0, 0, 0);
        f32x4 acc1 = __builtin_amdgcn_mfma_f32_16x16x32_f16(rA1[cur], __builtin_bit_cast(h16x8, sh1), z4, 0, 0, 0);
        if (s + 1 < 16) {
          const Slot& t = sl[buf * 16 + s + 1];
          rA0[nxt] = *(const h16x8*)(&t.ah[c & 3][8 * hq]); rA1[nxt] = *(const h16x8*)(&t.ah[c & 3][32 + 8 * hq]);
          rvv[nxt] = t.vv[rg * 16 + c];
#pragma unroll
          for (int tt = 0; tt < 4; ++tt) { rw[nxt][tt] = *(const f32x4*)(t.w + 16 * tt + 4 * hq); rbe[nxt][tt] = t.bke[16 * tt + c]; }
        }
#pragma unroll
        for (int tt = 0; tt < 4; ++tt) ST[tt] = ST[tt] * rw[cur][tt];
        __builtin_amdgcn_sched_barrier(0);
        yv[s] = acc0[1] + acc1[1];
        const float sa = -(acc0[0] + acc1[0]);
        const uint4 bu = make_uint4(h0 ? pk2(sa, rvv[cur]) : 0u, 0u, 0u, 0u);
#pragma unroll
        for (int tt = 0; tt < 4; ++tt) {
          const uint4 au = make_uint4(h0 ? rbe[cur][tt] : 0u, 0u, 0u, 0u);
          ST[tt] = __builtin_amdgcn_mfma_f32_16x16x32_f16(__builtin_bit_cast(h16x8, au), __builtin_bit_cast(h16x8, bu), ST[tt], 0, 0, 0);
        }
      }
#if PROBE == 211
      if (job == 0 && tid == 0) g_tacc[0] += __builtin_amdgcn_s_memrealtime() - ct0;
#endif
      if (lane < 16) {
        uint4 u0, u1;
        u0.x = pk2n(yv[0], yv[1]); u0.y = pk2n(yv[2], yv[3]); u0.z = pk2n(yv[4], yv[5]); u0.w = pk2n(yv[6], yv[7]);
        u1.x = pk2n(yv[8], yv[9]); u1.y = pk2n(yv[10], yv[11]); u1.z = pk2n(yv[12], yv[13]); u1.w = pk2n(yv[14], yv[15]);
        h16* yr = ybuf + (buf * 32 + wv * 16 + c) * 24;
        *(uint4*)yr = u0; *(uint4*)(yr + 8) = u1;
      }
#if PROBE == 210
      const unsigned long long bt0 = __builtin_amdgcn_s_memrealtime();
#endif
      __syncthreads();
#if PROBE == 210
      if (job == 0 && tid == 0) g_tacc[0] += __builtin_amdgcn_s_memrealtime() - bt0;
#endif
    }
    __builtin_amdgcn_s_setprio(0);
  }
}

DEVI void gla_pre_job(const P& p, int l, int job, char* smem) {
  typedef short bf16x8 __attribute__((ext_vector_type(8)));
  float* lg = (float*)smem;
  float* gku = lg + 64 * 65;
  float* gkb = gku + 1024;
  float* tot = gkb + 64;
  unsigned short* qb = (unsigned short*)(tot + 256);
  unsigned short* kb = qb + 64 * 72;
  h16* vt = (h16*)(kb + 64 * 72);
  const int tid = tidx(), lane = tid & 63, wv = tid >> 6, l31 = lane & 31, hh = lane >> 5;
  const int chain = job / 68, ci = job - chain * 68;
  const int dir = chain >> 4, b = (chain >> 2) & 3, h = chain & 3;
  for (int i = tid; i < 1024; i += 256) gku[i] = p.gk_up[(((size_t)l * 2 + dir) * 16 + (i >> 6)) * 256 + h * 64 + (i & 63)];
  if (tid < 64) gkb[tid] = p.gk_b[((size_t)l * 2 + dir) * 256 + h * 64 + tid];
  const int ri = tid >> 2, dq = tid & 3;
  const int row = maprow(dir, b, ci * 64 + ri);
  const h16* zr = p.Z() + (size_t)row * ZW;
  uint4 q0 = *(const uint4*)(zr + h * 64 + dq * 16), q1 = *(const uint4*)(zr + h * 64 + dq * 16 + 8);
  uint4 k0 = *(const uint4*)(zr + 256 + h * 64 + dq * 16), k1 = *(const uint4*)(zr + 256 + h * 64 + dq * 16 + 8);
  uint4 g0 = *(const uint4*)(zr + 1024 + dir * 16), g1 = *(const uint4*)(zr + 1024 + dir * 16 + 8);
  {
    const h16* zv = zr + 512 + h * 128 + dq * 32;
#pragma unroll
    for (int c = 0; c < 4; ++c) {
      h16x8 vv = *(const h16x8*)(zv + c * 8);
#pragma unroll
      for (int j = 0; j < 8; ++j) vt[(dq * 32 + c * 8 + j) * 72 + ri] = vv[j];
    }
  }
  __syncthreads();
  {
    h16x8 gh0 = __builtin_bit_cast(h16x8, g0), gh1 = __builtin_bit_cast(h16x8, g1);
    float gd[16];
#pragma unroll
    for (int j = 0; j < 8; ++j) { gd[j] = (float)gh0[j]; gd[8 + j] = (float)gh1[j]; }
#pragma unroll 4
    for (int dd = 0; dd < 16; ++dd) {
      const int d = dq * 16 + dd;
      float xx = gkb[d];
#pragma unroll
      for (int r = 0; r < 16; ++r) xx += gd[r] * gku[r * 64 + d];
      float ls = fminf(xx, 0.f) - __logf(1.f + __expf(-fabsf(xx)));
      lg[ri * 65 + d] = ls * (1.f / 16.f);
    }
  }
  __syncthreads();
  {
    const int d = tid & 63, part = tid >> 6;
    float run = 0.f;
#pragma unroll 4
    for (int ii = 0; ii < 16; ++ii) { const int i = part * 16 + ii; run += lg[i * 65 + d]; lg[i * 65 + d] = run; }
    tot[part * 64 + d] = run;
  }
  __syncthreads();
  {
    h16x8 qh0 = __builtin_bit_cast(h16x8, q0), qh1 = __builtin_bit_cast(h16x8, q1), kh0 = __builtin_bit_cast(h16x8, k0), kh1 = __builtin_bit_cast(h16x8, k1);
    const int part = ri >> 4;
    unsigned qp[8], kp[8];
#pragma unroll
    for (int j = 0; j < 8; ++j) {
      unsigned qq[2], kk2[2];
#pragma unroll
      for (int e = 0; e < 2; ++e) {
        const int dd = 2 * j + e, d = dq * 16 + dd;
        float off = 0.f;
        if (part > 0) off += tot[d];
        if (part > 1) off += tot[64 + d];
        if (part > 2) off += tot[128 + d];
        const float bb = lg[ri * 65 + d] + off;
        const float qv = dd < 8 ? (float)qh0[dd & 7] : (float)qh1[dd & 7];
        const float kv = dd < 8 ? (float)kh0[dd & 7] : (float)kh1[dd & 7];
        qq[e] = f2bf(qv * __expf(bb) * 0.125f);
        kk2[e] = f2bf(kv * __expf(-bb));
      }
      qp[j] = qq[0] | (qq[1] << 16); kp[j] = kk2[0] | (kk2[1] << 16);
    }
    const uint4 qa = make_uint4(qp[0], qp[1], qp[2], qp[3]), qc = make_uint4(qp[4], qp[5], qp[6], qp[7]);
    const uint4 ka = make_uint4(kp[0], kp[1], kp[2], kp[3]), kc = make_uint4(kp[4], kp[5], kp[6], kp[7]);
    *(uint4*)(qb + ri * 72 + dq * 16) = qa; *(uint4*)(qb + ri * 72 + dq * 16 + 8) = qc;
    *(uint4*)(kb + ri * 72 + dq * 16) = ka; *(uint4*)(kb + ri * 72 + dq * 16 + 8) = kc;
    unsigned short* qd = p.QIN() + ((size_t)dir * NR + row) * 256 + h * 64 + dq * 16;
    unsigned short* kd = p.KIN() + ((size_t)dir * NR + row) * 256 + h * 64 + dq * 16;
    *(uint4*)qd = qa; *(uint4*)(qd + 8) = qc;
    *(uint4*)kd = ka; *(uint4*)(kd + 8) = kc;
    if (tid < 64) p.DEC()[((size_t)chain * 68 + ci) * 64 + tid] = __expf(tot[tid] + tot[64 + tid] + tot[128 + tid] + tot[192 + tid]);
  }
  __syncthreads();
  const int it = wv & 1, jh = wv >> 1;
  f32x16 o0, o1;
#pragma unroll
  for (int r = 0; r < 16; ++r) { o0[r] = 0.f; o1[r] = 0.f; }
  bf16x8 qf[4];
#pragma unroll
  for (int ks = 0; ks < 4; ++ks) qf[ks] = *(const bf16x8*)(qb + (it * 32 + l31) * 72 + ks * 16 + hh * 8);
#pragma unroll
  for (int st = 0; st < 2; ++st) {
    if (st > it) continue;
    f32x16 at;
#pragma unroll
    for (int r = 0; r < 16; ++r) at[r] = 0.f;
#pragma unroll
    for (int ks = 0; ks < 4; ++ks) {
      bf16x8 kf = *(const bf16x8*)(kb + (st * 32 + l31) * 72 + ks * 16 + hh * 8);
      at = __builtin_amdgcn_mfma_f32_32x32x16_bf16(kf, qf[ks], at, 0, 0, 0);
    }
    if (st == it) {
#pragma unroll
      for (int r = 0; r < 16; ++r) { const int sl = (r & 3) + 8 * (r >> 2) + 4 * hh; if (sl > l31) at[r] = 0.f; }
    }
    const h16* vs = vt + (jh * 64 + l31) * 72 + st * 32 + 4 * hh;
#pragma unroll
    for (int s2 = 0; s2 < 2; ++s2) {
      uint4 pu;
      pu.x = pk2n(at[8 * s2], at[8 * s2 + 1]); pu.y = pk2n(at[8 * s2 + 2], at[8 * s2 + 3]);
      pu.z = pk2n(at[8 * s2 + 4], at[8 * s2 + 5]); pu.w = pk2n(at[8 * s2 + 6], at[8 * s2 + 7]);
      const h16x8 pf = __builtin_bit_cast(h16x8, pu);
      const uint2 va = *(const uint2*)(vs + 16 * s2), vb = *(const uint2*)(vs + 16 * s2 + 8);
      const uint2 vc = *(const uint2*)(vs + 32 * 72 + 16 * s2), vd = *(const uint2*)(vs + 32 * 72 + 16 * s2 + 8);
      o0 = __builtin_amdgcn_mfma_f32_32x32x16_f16(__builtin_bit_cast(h16x8, make_uint4(va.x, va.y, vb.x, vb.y)), pf, o0, 0, 0, 0);
      o1 = __builtin_amdgcn_mfma_f32_32x32x16_f16(__builtin_bit_cast(h16x8, make_uint4(vc.x, vc.y, vd.x, vd.y)), pf, o1, 0, 0, 0);
    }
  }
  {
    const int orow = maprow(dir, b, ci * 64 + it * 32 + l31);
    h16* od = p.OFB() + ((size_t)dir * NR + orow) * 512 + h * 128 + jh * 64 + 4 * hh;
#pragma unroll
    for (int g = 0; g < 4; ++g) {
      st4h(od + 8 * g, o0[4 * g], o0[4 * g + 1], o0[4 * g + 2], o0[4 * g + 3]);
      st4h(od + 32 + 8 * g, o1[4 * g], o1[4 * g + 1], o1[4 * g + 2], o1[4 * g + 3]);
    }
  }
  __syncthreads();
}

DEVI void gla_job(const P& p, int l, int job, char* smem) {
  float* qi = (float*)smem;
  float* ki = qi + 64 * 65;
  float* vs = ki + 64 * 65;
  float* Ss = vs + 64 * 33;
  const int tid = tidx();
  const int dvs = job & 3, chain = job >> 2;
  const int dir = chain >> 4, b = (chain >> 2) & 3, h = chain & 3;
  for (int i = tid; i < 64 * 33; i += 256) Ss[i] = 0.f;
  const int ri = tid >> 2, dq = tid & 3;
  const int t2 = tid >> 3, tj = tid & 7;
  h16* Od = p.OFB() + (size_t)dir * NR * 512 + h * 128 + dvs * 32;
  const unsigned short* Qg = p.QIN() + (size_t)dir * NR * 256 + h * 64 + dq * 16;
  const unsigned short* Kg = p.KIN() + (size_t)dir * NR * 256 + h * 64 + dq * 16;
  const float* Dg = p.DEC() + (size_t)chain * 68 * 64 + 2 * t2;
  uint4 gq0, gq1, gk0, gk1, gv; uint2 goa, gob; float gd0, gd1;
  auto pre = [&](int ci) {
    const int row = maprow(dir, b, ci * 64 + ri);
    gq0 = *(const uint4*)(Qg + (size_t)row * 256); gq1 = *(const uint4*)(Qg + (size_t)row * 256 + 8);
    gk0 = *(const uint4*)(Kg + (size_t)row * 256); gk1 = *(const uint4*)(Kg + (size_t)row * 256 + 8);
    gv = *(const uint4*)(p.Z() + (size_t)row * ZW + 512 + h * 128 + dvs * 32 + dq * 8);
    const int rowa = maprow(dir, b, ci * 64 + 2 * t2), rowb = maprow(dir, b, ci * 64 + 2 * t2 + 1);
    goa = *(const uint2*)(Od + (size_t)rowa * 512 + 4 * tj); gob = *(const uint2*)(Od + (size_t)rowb * 512 + 4 * tj);
    gd0 = Dg[ci * 64]; gd1 = Dg[ci * 64 + 1];
  };
  pre(0);
  __syncthreads();
  for (int ci = 0; ci < SB / 64; ++ci) {
    {
      const unsigned qa[8] = {gq0.x, gq0.y, gq0.z, gq0.w, gq1.x, gq1.y, gq1.z, gq1.w};
      const unsigned ka[8] = {gk0.x, gk0.y, gk0.z, gk0.w, gk1.x, gk1.y, gk1.z, gk1.w};
#pragma unroll
      for (int j = 0; j < 8; ++j) {
        qi[ri * 65 + dq * 16 + 2 * j] = __builtin_bit_cast(float, qa[j] << 16); qi[ri * 65 + dq * 16 + 2 * j + 1] = __builtin_bit_cast(float, qa[j] & 0xffff0000u);
        ki[ri * 65 + dq * 16 + 2 * j] = __builtin_bit_cast(float, ka[j] << 16); ki[ri * 65 + dq * 16 + 2 * j + 1] = __builtin_bit_cast(float, ka[j] & 0xffff0000u);
      }
      h16x8 vh = __builtin_bit_cast(h16x8, gv);
#pragma unroll
      for (int j = 0; j < 8; ++j) vs[ri * 33 + dq * 8 + j] = (float)vh[j];
    }
    const uint2 oia = goa, oib = gob; const float e0 = gd0, e1 = gd1;
    const int rowa = maprow(dir, b, ci * 64 + 2 * t2), rowb = maprow(dir, b, ci * 64 + 2 * t2 + 1);
    if (ci + 1 < SB / 64) pre(ci + 1);
    __syncthreads();
    {
      h16x4 ha = __builtin_bit_cast(h16x4, oia), hb = __builtin_bit_cast(h16x4, oib);
      float a0[4], a1[4];
#pragma unroll
      for (int y = 0; y < 4; ++y) { a0[y] = (float)ha[y]; a1[y] = (float)hb[y]; }
#pragma unroll 4
      for (int d = 0; d < 64; ++d) {
        const float x0 = qi[(2 * t2) * 65 + d], x1 = qi[(2 * t2 + 1) * 65 + d];
#pragma unroll
        for (int y = 0; y < 4; ++y) { const float v = Ss[d * 33 + 4 * tj + y]; a0[y] += x0 * v; a1[y] += x1 * v; }
      }
      st4h(Od + (size_t)rowa * 512 + 4 * tj, a0[0], a0[1], a0[2], a0[3]);
      st4h(Od + (size_t)rowb * 512 + 4 * tj, a1[0], a1[1], a1[2], a1[3]);
    }
    __syncthreads();
    {
      float a0[4], a1[4];
#pragma unroll
      for (int y = 0; y < 4; ++y) { a0[y] = Ss[(2 * t2) * 33 + 4 * tj + y]; a1[y] = Ss[(2 * t2 + 1) * 33 + 4 * tj + y]; }
#pragma unroll 4
      for (int s2 = 0; s2 < 64; ++s2) {
        const float x0 = ki[s2 * 65 + 2 * t2], x1 = ki[s2 * 65 + 2 * t2 + 1];
#pragma unroll
        for (int y = 0; y < 4; ++y) { const float v = vs[s2 * 33 + 4 * tj + y]; a0[y] += x0 * v; a1[y] += x1 * v; }
      }
#pragma unroll
      for (int y = 0; y < 4; ++y) { Ss[(2 * t2) * 33 + 4 * tj + y] = a0[y] * e0; Ss[(2 * t2 + 1) * 33 + 4 * tj + y] = a1[y] * e1; }
    }
    __syncthreads();
  }
}

DEVI void mixer_phase(const P& p, int l, char* smem, int cslot, int mode = 0, int role = -1, int rank = 0) {
  if (role < 0) role = blockIdx.x;
#if PROBE >= 200
  unsigned long long pt0 = __builtin_amdgcn_s_memrealtime();
#endif
  __shared__ int4 sjobv;
  int& sjob = sjobv.x;
  for (int j = role; j < NSCAN + NGLA; j += gridDim.x) {
    if (mode == 1 && j >= NSCAN) break;
    if (mode == 2 && j < NSCAN) continue;
    if (j < NSCAN) {
      scan_job(p, l, j, smem, 0);
    }
    else gla_job(p, l, j - NSCAN, smem);
    __syncthreads();
#if PROBE == 200
    if (role == 0 && tidx() == 0) g_tacc[0] += __builtin_amdgcn_s_memrealtime() - pt0;
#endif
#if PROBE == 201
    if (role == NSCAN && tidx() == 0) g_tacc[0] += __builtin_amdgcn_s_memrealtime() - pt0;
#endif
  }
  if (mode == 1) return;
  const int njobs = (l < DEPTH - 1) ? 1024 + 64 : 1024;
  while (true) {
    if (tidx() == 0) sjob = (int)atomicAdd(p.CTR() + cslot, 1u);
    __syncthreads();
    const int j = sjob;
    __syncthreads();
    if (j >= njobs) break;
    attn_job(p, j, smem);
  }
#if PROBE == 202
  if (role == 300 && tidx() == 0) g_tacc[0] += __builtin_amdgcn_s_memrealtime() - pt0;
#endif
}

DEVI void post_phase(const P& p, int l) {
  const int lane = tidx() & 63;
  const int wid = blockIdx.x * 4 + (tidx() >> 6), nw = gridDim.x * 4;
  const int c8 = lane * 8;
  for (int r = wid; r < NR; r += nw) {
    {
      h16* zr = p.Z() + (size_t)r * ZW + ZRW + c8;
      h16x8 yf = *(const h16x8*)(p.Y2() + (size_t)r * 512 + c8), yb = *(const h16x8*)(p.Y2() + (size_t)(NR + r) * 512 + c8);
      h16x8 rr = *(const h16x8*)zr, kk = *(const h16x8*)(zr + 512), vv = *(const h16x8*)(zr + 1024);
      h16x8 af = *(const h16x8*)(p.AA() + (size_t)r * 512 + c8), ab = *(const h16x8*)(p.AA() + (size_t)(NR + r) * 512 + c8);
      h16x8 gg = *(const h16x8*)(p.G() + (size_t)r * 512 + c8);
      float y[8], sm = 0.f;
#pragma unroll
      for (int i = 0; i < 8; ++i) { y[i] = (float)yf[i] + (float)yb[i]; sm += y[i]; }
      sm += __shfl_xor(sm, 1); sm += __shfl_xor(sm, 2); sm += __shfl_xor(sm, 4);
      const float mean = sm * (1.f / 64.f);
      float sq = 0.f;
#pragma unroll
      for (int i = 0; i < 8; ++i) { y[i] -= mean; sq += y[i] * y[i]; }
      sq += __shfl_xor(sq, 1); sq += __shfl_xor(sq, 2); sq += __shfl_xor(sq, 4);
      const float rs = rsqrtf(sq * (1.f / 64.f) + 64e-5f);
      const float* ka = p.k_a + l * 512 + c8; const float* rk = p.r_k + l * 512 + c8;
      const float* lg = p.rln_g + l * 512 + c8; const float* lb = p.rln_b + l * 512 + c8;
      float bs = 0.f;
#pragma unroll
      for (int i = 0; i < 8; ++i) {
        const float kf = (float)kk[i], kav = ka[i];
        const float ke = kf * (1.f + ((float)af[i] - 1.f) * kav) + kf * (1.f + ((float)ab[i] - 1.f) * kav);
        bs += (float)rr[i] * ke * rk[i];
      }
      bs += __shfl_xor(bs, 1); bs += __shfl_xor(bs, 2); bs += __shfl_xor(bs, 4);
      float o[8];
#pragma unroll
      for (int i = 0; i < 8; ++i) o[i] = (y[i] * rs * lg[i] + lb[i] + bs * (float)vv[i]) * (float)gg[i];
      uint4 u; u.x = pk2n(o[0], o[1]); u.y = pk2n(o[2], o[3]); u.z = pk2n(o[4], o[5]); u.w = pk2n(o[6], o[7]);
      *(uint4*)zr = u;
    }
    {
      h16x8 of = *(const h16x8*)(p.OFB() + (size_t)r * 512 + c8), ob = *(const h16x8*)(p.OFB() + (size_t)(NR + r) * 512 + c8);
      h16x8 og = *(const h16x8*)(p.Z() + (size_t)r * ZW + 1056 + c8);
      float o[8], sq = 0.f;
#pragma unroll
      for (int i = 0; i < 8; ++i) { o[i] = (float)of[i] + (float)ob[i]; sq += o[i] * o[i]; }
      sq += __shfl_xor(sq, 1); sq += __shfl_xor(sq, 2); sq += __shfl_xor(sq, 4); sq += __shfl_xor(sq, 8);
      const float rs = rsqrtf(sq * (1.f / 128.f) + 1e-6f);
      const float* ng = p.gla_ng + l * 128 + (c8 & 127);
#pragma unroll
      for (int i = 0; i < 8; ++i) { const float g = (float)og[i]; o[i] = o[i] * rs * ng[i] * (g * sigm(g)); }
      uint4 u; u.x = pk2n(o[0], o[1]); u.y = pk2n(o[2], o[3]); u.z = pk2n(o[4], o[5]); u.w = pk2n(o[6], o[7]);
      *(uint4*)(p.YA() + (size_t)r * ZW + c8) = u;
    }
  }
}

DEVI void merge_phase(const P& p, char* smem) {
  constexpr int MT = NR / 128, NT = 16;
  const int lane = tidx() & 63, wv = tidx() >> 6;
  const int wm = wv >> 1, wn = wv & 1, l31 = lane & 31, hh = lane >> 5;
  for (int job = blockIdx.x; job < MT * NT; job += gridDim.x) {
    int nt = job / MT, mt = job - nt * MT;
    float out[2][16];
#pragma unroll
    for (int a = 0; a < 2; ++a)
#pragma unroll
      for (int r = 0; r < 16; ++r) out[a][r] = 0.f;
#pragma unroll 1
    for (int br = 0; br < 3; ++br) {
      const h16* Y = br == 0 ? p.YA() : (br == 1 ? p.Z() + ZMLA : p.Z() + ZRW);
      const int ldy = ZW;
      f32x16 acc[2][1];
#pragma unroll
      for (int a = 0; a < 2; ++a)
#pragma unroll
        for (int r = 0; r < 16; ++r) acc[a][0][r] = 0.f;
      gemm_deep<1>(Y, ldy, p.WB() + (size_t)br * D * 512, 512, 512, mt * 128, nt * 64, D, smem, acc);
      float u[2][16];
#pragma unroll
      for (int a = 0; a < 2; ++a)
#pragma unroll
        for (int r = 0; r < 16; ++r) { u[a][r] = acc[a][0][r]; acc[a][0][r] = 0.f; }
      gemm_deep<1>(p.H(), D, p.WIN() + (size_t)(ZW + br * D) * D, D, D, mt * 128, nt * 64, D, smem, acc);
#pragma unroll
      for (int a = 0; a < 2; ++a)
#pragma unroll
        for (int r = 0; r < 16; ++r) out[a][r] += sigm(acc[a][0][r]) * u[a][r];
    }
#pragma unroll
    for (int a = 0; a < 2; ++a)
#pragma unroll
      for (int g = 0; g < 4; ++g)
        st4h(p.M() + (size_t)(mt * 128 + wm * 64 + a * 32 + l31) * D + nt * 64 + wn * 32 + 8 * g + 4 * hh, out[a][4 * g], out[a][4 * g + 1],
             out[a][4 * g + 2], out[a][4 * g + 3]);
  }
}

DEVI void resid_gemm_phase(const P& p, int l, const h16* A, int K, const h16* Bt, int gate_idx, char* smem) {
  constexpr int MT = NR / 128, NT = 8;
  const float alpha = 1.6817928305074290f;
  for (int job = blockIdx.x; job < MT * NT; job += gridDim.x) {
    int nt = job / MT, mt = job - nt * MT;
    f32x16 acc[2][2]; zero_acc(acc);
    gemm_deep<2>(A, K, Bt, K, K, mt * 128, nt * 128, D, smem, acc);
    epi_quads(acc, mt * 128, nt * 128, [&](int m, int n, float v0, float v1, float v2, float v3) {
      int b = m / SB, s = m - b * SB;
      int g = s < CTX ? 4 : b;
      float4 gt = *(const float4*)(p.MOD() + ((size_t)l * 5 + g) * 6144 + gate_idx * D + n);
      float* xp = xrow(p, m) + n;
      float4 xv = *(float4*)xp;
      xv.x = alpha * xv.x + gt.x * v0; xv.y = alpha * xv.y + gt.y * v1; xv.z = alpha * xv.z + gt.z * v2; xv.w = alpha * xv.w + gt.w * v3;
      *(float4*)xp = xv;
    });
  }
}
DEVI void mlp1_phase(const P& p, char* smem) {
  constexpr int MT = NR / 128, NT = DFF / 128;
  h16* HID = p.Z();
  for (int job = blockIdx.x; job < MT * NT; job += gridDim.x) {
    int nt = job / MT, mt = job - nt * MT;
    f32x16 acc[2][2]; zero_acc(acc);
    gemm_deep<2>(p.H(), D, p.W1T(), D, D, mt * 128, nt * 128, DFF, smem, acc);
    epi_quads(acc, mt * 128, nt * 128, [&](int m, int n, float v0, float v1, float v2, float v3) {
      v0 = fmaxf(v0, 0.f); v1 = fmaxf(v1, 0.f); v2 = fmaxf(v2, 0.f); v3 = fmaxf(v3, 0.f);
      st4h(HID + (size_t)m * DFF + n, v0 * v0, v1 * v1, v2 * v2, v3 * v3);
    });
  }
}

constexpr int PH_PER_LAYER = 11;
constexpr int NPHASES = 1 + DEPTH * PH_PER_LAYER + 1;

DEVI void run_phase(const P& p, int ph, char* smem, int role, int rank) {
  if (ph == 0) { phase0(p, smem); return; }
  if (ph == NPHASES - 1) { ln_phase(p, DEPTH, 2); return; }
  const int l = (ph - 1) / PH_PER_LAYER, k = (ph - 1) - l * PH_PER_LAYER;
  switch (k) {
    case 0: ln_phase(p, l, 0); conv_phase(p, l, 0, 12, smem); break;
    case 1: inproj_phase(p, smem);
#if PROBE == 2
      inproj_phase(p, smem);
#endif
      break;
    case 2: {
      constexpr int NPRE = 32 * 68, NSH = (NR / 64) * 8, NUP = (NR / 128) * 14;
      for (int j = blockIdx.x; j < NPRE + NSH + NUP; j += gridDim.x) {
        if (j < NPRE) gla_pre_job(p, l, j, smem);
        else if (j < NPRE + NSH) shift_job(p, l, j - NPRE, smem);
        else mla_up_job(p, j - NPRE - NSH, smem);
        __syncthreads();
      }
    } break;
    case 3: {
      constexpr int NLR = 5 * 4 * (NR / 128);
      for (int j = blockIdx.x; j < NLR; j += gridDim.x) { lowrank_job(p, l, j, smem); __syncthreads(); }
    } break;
    case 4: mixer_phase(p, l, smem, l, 0, role, rank);
#if PROBE == 1
      mixer_phase(p, l, smem, 8 + l);
#endif
      break;
    case 5: post_phase(p, l); break;
    case 6: merge_phase(p, smem); conv_phase(p, l, 12, 14, smem); break;
    case 7: resid_gemm_phase(p, l, p.M(), D, p.WO(), 2, smem); break;
    case 8: ln_phase(p, l, 1); break;
    case 9: mlp1_phase(p, smem);
#if PROBE == 2
      mlp1_phase(p, smem);
#endif
      break;
    default: resid_gemm_phase(p, l, p.Z(), DFF, p.W2T(), 5, smem); break;
  }
}

__global__ void __launch_bounds__(256, 2) mega(P p, int pb, int pe) {
  extern __shared__ __attribute__((aligned(16))) char smem[];
  cg::grid_group grid = cg::this_grid();
  __shared__ uint4 xb_words;
  if (threadIdx_x_raw() == 0) xb_words = make_uint4(0u, 0u, 0u, 0u);
  __syncthreads();
  XcdBarrier xb = xcd_barrier_post(p.BAR(), (volatile LAS unsigned*)&xb_words);
  __shared__ int4 rolev;
  unsigned* cut = p.BAR() + 3584;
  if (threadIdx_x_raw() == 0) {
    const unsigned key = (xb_xcc_id() << 8) | ((unsigned)__builtin_amdgcn_s_getreg((7 << 11) | (8 << 6) | 4) & 0xffu);
    const unsigned rank = xb_add(cut + key, 1u);
    if (rank == 0u) { const unsigned ord = xb_add(cut + 8192, 1u); __hip_atomic_store(cut + 4096 + key, ord, __ATOMIC_RELAXED, __HIP_MEMORY_SCOPE_AGENT); }
    if (rank >= 2u) xb_add(cut + 8193, 1u);
    rolev = make_int4((int)blockIdx.x, 0, (int)key, (int)rank);
  }
  __syncthreads();
#if PROBE >= 100
  unsigned long long tacc = 0;
#endif
#if PROBE >= 200
  if (blockIdx.x == 0 && threadIdx_x_raw() == 0) g_tacc[0] = 0;
#endif
  for (int ph = pb; ph < pe; ++ph) {
    if (ph > pb) {
      if (ph == pb + 1) {
        grid.sync();
        if (threadIdx_x_raw() == 0) {
          const unsigned key = (unsigned)rolev.z, rank = (unsigned)rolev.w;
          const unsigned ord = xb_ld(cut + 4096 + key), ncu = xb_ld(cut + 8192), bad = xb_ld(cut + 8193);
          if (bad == 0u && 2u * ncu == gridDim.x && rank < 2u && ncu >= 256u) {
            if (ord < 128u) rolev.x = rank == 0u ? (int)ord : (int)(256u + ord);
            else if (ord < 192u) rolev.x = (int)(128u + 2u * (ord - 128u) + rank);
            else rolev.x = (int)(384u + 2u * (ord - 192u) + rank);
            rolev.y = 1;
          }
        }
        __syncthreads();
      } else xcd_barrier(xb);
    }
#if PROBE == 6
    if (ph >= 1 && ph < NPHASES - 1 && ((ph - 1) % PH_PER_LAYER) == 4) {
      const int l = (ph - 1) / PH_PER_LAYER;
      mixer_phase(p, l, smem, l, 1);
      xcd_barrier(xb);
      mixer_phase(p, l, smem, l, 1);
      xcd_barrier(xb);
      mixer_phase(p, l, smem, l, 2);
      continue;
    }
#endif
#if PROBE >= 100
    const bool tph = (ph >= 1 && ph < NPHASES - 1 && ((ph - 1) % PH_PER_LAYER) == (PROBE - 100));
    unsigned long long t0 = 0;
    if (tph && blockIdx.x == 0) t0 = __builtin_amdgcn_s_memrealtime();
#endif
    run_phase(p, ph, smem, rolev.x, rolev.y);
#if PROBE >= 100
    if (tph) { xcd_barrier(xb); if (blockIdx.x == 0) tacc += __builtin_amdgcn_s_memrealtime() - t0; }
#endif
  }
#if PROBE >= 100
#if PROBE == 300
  if (blockIdx.x == 0) { const unsigned long long te = __builtin_amdgcn_s_memrealtime() + (rolev.w == 1000 ? 300000ull : (rolev.w == 2001 ? 600000ull : 900000ull)); while (__builtin_amdgcn_s_memrealtime() < te) __builtin_amdgcn_s_sleep(8); }
#elif PROBE >= 200
  {
    __syncthreads();
    const unsigned long long ta = g_tacc[0];
    if (ta) { const unsigned long long te = __builtin_amdgcn_s_memrealtime() + 4ull * ta; while (__builtin_amdgcn_s_memrealtime() < te) __builtin_amdgcn_s_sleep(8); }
  }
#else
  if (blockIdx.x == 0) { const unsigned long long te = __builtin_amdgcn_s_memrealtime() + 4ull * tacc; while (__builtin_amdgcn_s_memrealtime() < te) __builtin_amdgcn_s_sleep(8); }
#endif
#endif
}

extern "C" void kernel_launch(void* const* d_in, const int* in_sizes, int n_in, void* d_out, int out_size, void* d_ws,
                              size_t ws_size, hipStream_t stream) {
  static int grid_blocks = 0;
  if (grid_blocks == 0) {
    int dev = 0, cus = 0, per_cu = 0;
    hipGetDevice(&dev);
    hipDeviceGetAttribute(&cus, hipDeviceAttributeMultiprocessorCount, dev);
    hipFuncSetAttribute((const void*)mega, hipFuncAttributeMaxDynamicSharedMemorySize, LDS_BYTES);
    hipOccupancyMaxActiveBlocksPerMultiprocessor(&per_cu, (const void*)mega, 256, LDS_BYTES);
    if (per_cu < 1) per_cu = 1;
    if (per_cu > 2) per_cu = 2;
    grid_blocks = cus * per_cu;
    fprintf(stderr, "mega: cus %d per_cu %d grid %d\n", cus, per_cu, grid_blocks);
  }
  P p{};
  const float** ins = (const float**)&p;
  for (int i = 0; i < 33; ++i) ins[i] = (const float*)d_in[i];
  p.XL = (float*)d_out;
  p.ws = (char*)d_ws;
  const size_t off = WS_TOTAL;
  if (off > ws_size || n_in != 33) { fprintf(stderr, "mega: workspace too small (%zu > %zu) or n_in %d\n", off, ws_size, n_in); return; }
  (void)hipMemsetAsync((char*)d_ws + OFF_BAR, 0, BAR_BYTES, stream);
  int pb = 0, pe = NPHASES;
  void* args[] = {&p, &pb, &pe};
  hipError_t e = hipLaunchCooperativeKernel((const void*)mega, dim3(grid_blocks), dim3(256), args, LDS_BYTES, stream);
  if (e != hipSuccess) fprintf(stderr, "mega: cooperative launch failed: %s (grid %d)\n", hipGetErrorString(e), grid_blocks);
}
```

```cpp
#include <hip/hip_runtime.h>
#include <hip/hip_cooperative_groups.h>
#include <cstdio>
#include <cstdint>
namespace cg = cooperative_groups;

typedef _Float16 h16;
typedef _Float16 h16x8 __attribute__((ext_vector_type(8)));
typedef _Float16 h16x4 __attribute__((ext_vector_type(4)));
typedef float f32x16 __attribute__((ext_vector_type(16)));
typedef float f32x4 __attribute__((ext_vector_type(4)));

#define DEVI __device__ __forceinline__
DEVI int threadIdx_x_raw() { return (int)__builtin_amdgcn_workitem_id_x(); }

#define PROBE 0
constexpr int D = 1024, NB = 4, SEQ = 4096, CTX = 256, DEPTH = 4;
constexpr int SB = SEQ + CTX;
constexpr int NR = NB * SB;
constexpr int ZW = 4160;
constexpr int ZMLA = 1568, ZRW = 2240;
constexpr int NIN = 7232;
constexpr int DFF = 4096;
constexpr int LDS_BYTES = 74752;
constexpr int NSCAN_BPC = 2;
constexpr int NSCAN = 64 * NSCAN_BPC;
constexpr int NGLA = 128;
constexpr int TSTEPS = SB + 1;
constexpr int NCHUNK = (TSTEPS + 15) / 16;

constexpr size_t al256(size_t x) { return (x + 255) & ~(size_t)255; }
constexpr size_t OFF_XC = 0;
constexpr size_t OFF_MOD = OFF_XC + al256((size_t)NB * CTX * D * 4);
constexpr size_t OFF_ROPE = OFF_MOD + al256((size_t)DEPTH * 5 * 6144 * 4);
constexpr size_t OFF_INVN = OFF_ROPE + al256((size_t)SEQ * 32 * 4);
constexpr size_t OFF_CTR = OFF_INVN + al256((size_t)NR * 8 * 4);
constexpr size_t OFF_BAR = OFF_CTR + al256(256);
constexpr size_t BAR_BYTES = (size_t)(3584 + 4096 + 4096 + 64) * 4;
constexpr size_t OFF_HLO = OFF_BAR + al256(BAR_BYTES);
constexpr size_t OFF_HHI = OFF_HLO + al256((size_t)(NR / 64) * 1920 * 2);
constexpr size_t OFF_H = OFF_HHI + al256((size_t)(NR / 64) * 1920 * 2);
constexpr size_t OFF_Z = OFF_H + al256((size_t)NR * D * 2);
constexpr size_t OFF_WIN = OFF_Z + al256((size_t)NR * ZW * 2);
constexpr size_t OFF_UQ = OFF_WIN + al256((size_t)NIN * D * 2);
constexpr size_t OFF_UKV = OFF_UQ + al256((size_t)768 * 384 * 2);
constexpr size_t OFF_WB = OFF_UKV + al256((size_t)1024 * 256 * 2);
constexpr size_t OFF_WO = OFF_WB + al256((size_t)3 * D * 512 * 2);
constexpr size_t OFF_WUP = OFF_WO + al256((size_t)D * D * 2);
constexpr size_t OFF_AUP = OFF_WUP + al256((size_t)2 * 512 * 64 * 2);
constexpr size_t OFF_GUP = OFF_AUP + al256((size_t)2 * 512 * 64 * 2);
constexpr size_t OFF_LW = OFF_GUP + al256((size_t)512 * 128 * 2);
constexpr size_t OFF_AA = OFF_LW + al256((size_t)2 * NR * 512 * 2);
constexpr size_t OFF_G = OFF_AA + al256((size_t)2 * NR * 512 * 2);
constexpr size_t OFF_Y2 = OFF_G + al256((size_t)NR * 512 * 2);
constexpr size_t OFF_Q = OFF_Y2 + al256((size_t)2 * NR * 512 * 2);
constexpr size_t OFF_K = OFF_Q + al256((size_t)NR * 768 * 2);
constexpr size_t OFF_VT = OFF_K + al256((size_t)NR * 768 * 2);
constexpr size_t OFF_QIN = OFF_VT + al256((size_t)NR * 512 * 2);
constexpr size_t OFF_KIN = OFF_QIN + al256((size_t)2 * NR * 256 * 2);
constexpr size_t OFF_DEC = OFF_KIN + al256((size_t)2 * NR * 256 * 2);
constexpr size_t OFF_OFB = OFF_DEC + al256((size_t)32 * 68 * 64 * 4);
constexpr size_t WS_TOTAL = OFF_OFB + al256((size_t)2 * NR * 512 * 2);
struct P {
  const float *x, *c, *ctx, *c_ctx, *ada_w, *ada_b, *w_in, *gk_up, *gk_b, *gla_ng, *qn_g, *kvn_g, *w_uq, *w_ukv,
      *mu, *w0, *w_up, *a0, *a_up, *g_up, *k_k, *k_a, *r_k, *rln_g, *rln_b, *w_branch, *w_out, *ln1_g, *ln1_b,
      *w1, *w2, *ln2_g, *ln2_b;
  float* XL;
  char* ws;
  DEVI float* XC() const { return (float*)(ws + OFF_XC); }
  DEVI float* MOD() const { return (float*)(ws + OFF_MOD); }
  DEVI float* ROPE() const { return (float*)(ws + OFF_ROPE); }
  DEVI float* INVN() const { return (float*)(ws + OFF_INVN); }
  DEVI unsigned* CTR() const { return (unsigned*)(ws + OFF_CTR); }
  DEVI unsigned* BAR() const { return (unsigned*)(ws + OFF_BAR); }
  DEVI h16* HLO() const { return (h16*)(ws + OFF_HLO); }
  DEVI h16* HHI() const { return (h16*)(ws + OFF_HHI); }
  DEVI h16* H() const { return (h16*)(ws + OFF_H); }
  DEVI h16* Z() const { return (h16*)(ws + OFF_Z); }
  DEVI h16* WIN() const { return (h16*)(ws + OFF_WIN); }
  DEVI h16* UQ() const { return (h16*)(ws + OFF_UQ); }
  DEVI h16* UKV() const { return (h16*)(ws + OFF_UKV); }
  DEVI h16* WB() const { return (h16*)(ws + OFF_WB); }
  DEVI h16* WO() const { return (h16*)(ws + OFF_WO); }
  DEVI h16* WUP() const { return (h16*)(ws + OFF_WUP); }
  DEVI h16* AUP() const { return (h16*)(ws + OFF_AUP); }
  DEVI h16* GUP() const { return (h16*)(ws + OFF_GUP); }
  DEVI h16* LW() const { return (h16*)(ws + OFF_LW); }
  DEVI h16* AA() const { return (h16*)(ws + OFF_AA); }
  DEVI h16* G() const { return (h16*)(ws + OFF_G); }
  DEVI h16* Y2() const { return (h16*)(ws + OFF_Y2); }
  DEVI h16* Q() const { return (h16*)(ws + OFF_Q); }
  DEVI h16* K() const { return (h16*)(ws + OFF_K); }
  DEVI h16* VT() const { return (h16*)(ws + OFF_VT); }
  DEVI unsigned short* QIN() const { return (unsigned short*)(ws + OFF_QIN); }
  DEVI unsigned short* KIN() const { return (unsigned short*)(ws + OFF_KIN); }
  DEVI float* DEC() const { return (float*)(ws + OFF_DEC); }
  DEVI h16* OFB() const { return (h16*)(ws + OFF_OFB); }
  DEVI h16* W1T() const { return (h16*)(ws + OFF_LW); }
  DEVI h16* W2T() const { return (h16*)(ws + OFF_LW + (size_t)DFF * D * 2); }
  DEVI h16* M() const { return (h16*)(ws + OFF_Q); }
  DEVI h16* YA() const { return (h16*)(ws + OFF_Z + 1056 * 2); }
};

DEVI int tidx() { int t = threadIdx_x_raw(); asm volatile("" : "+v"(t)); return t; }
DEVI float wsum(float v) {
#pragma unroll
  for (int o = 32; o; o >>= 1) v += __shfl_xor(v, o);
  return v;
}
DEVI float sigm(float x) { return 1.f / (1.f + __expf(-x)); }
DEVI unsigned pk2(float a, float b) {
  auto h = __builtin_amdgcn_cvt_pkrtz(a, b);
  return __builtin_bit_cast(unsigned, h);
}
DEVI unsigned pk2n(float a, float b) {
  h16 x = (h16)a, y = (h16)b;
  unsigned short ux = __builtin_bit_cast(unsigned short, x), uy = __builtin_bit_cast(unsigned short, y);
  return (unsigned)ux | ((unsigned)uy << 16);
}
DEVI unsigned f2bf(float f) { unsigned u = __builtin_bit_cast(unsigned, f); u += 0x7fffu + ((u >> 16) & 1u); return u >> 16; }
DEVI float h2f(unsigned short u) { return (float)__builtin_bit_cast(h16, u); }
DEVI void st4h(h16* dst, float a, float b, float c, float d) {
  uint2 u; u.x = pk2n(a, b); u.y = pk2n(c, d);
  *(uint2*)dst = u;
}
DEVI float* xrow(const P& p, int r) {
  int b = r / SB, s = r - b * SB;
  return s < CTX ? p.XC() + (size_t)(b * CTX + s) * D : p.XL + (size_t)(b * SEQ + s - CTX) * D;
}
DEVI int maprow(int dir, int b, int n) {
  if (dir == 0) return b * SB + n;
  return n < CTX ? b * SB + (CTX - 1 - n) : b * SB + (SB + CTX - 1 - n);
}


#define XB_TMO      128
#define XB_XCNT(j)  (256  + 64 * (j))
#define XB_XSUB(j)  (1280 + 64 * (j))
#define XB_XGEN(j)  (2304 + 64 * (j))
#define XB_TOP      3328
#define XB_TOPGEN   3392
#define XCD_BAR_WORDS 3456
#define XB_SPIN_CAP (1u << 22)
#define LAS __attribute__((address_space(3)))
DEVI unsigned xb_ld(unsigned* p) { return __hip_atomic_load(p, __ATOMIC_RELAXED, __HIP_MEMORY_SCOPE_AGENT); }
DEVI unsigned xb_add(unsigned* p, unsigned v) { return __hip_atomic_fetch_add(p, v, __ATOMIC_RELAXED, __HIP_MEMORY_SCOPE_AGENT); }
DEVI unsigned xb_xcc_id() { return (unsigned)__builtin_amdgcn_s_getreg((3 << 11) | 20) & 0xFu; }
#define XB_SPIN(cond, bar) do { unsigned _sp = 0; while (cond) { __builtin_amdgcn_s_sleep(1); \
    if ((++_sp & 255u) == 0u) { if (xb_ld(&(bar)[XB_TMO])) break; if (_sp > XB_SPIN_CAP) { atomicAdd(&(bar)[XB_TMO], 1u); break; } } } } while (0)
struct XcdBarrier { unsigned* bar; unsigned x; volatile LAS unsigned* st; };
DEVI XcdBarrier xcd_barrier_post(unsigned* bar, volatile LAS unsigned* st) {
  XcdBarrier b; b.bar = bar; b.x = xb_xcc_id(); b.st = st;
  if (threadIdx_x_raw() == 0) (void)xb_add(&bar[XB_XCNT(b.x)], 1u);
  return b;
}
DEVI void xcd_barrier_complete(unsigned* bar, unsigned x, unsigned& nloc, unsigned& nx) {
  const unsigned G = gridDim.x;
  unsigned sum, cnt, mine, sp = 0u;
  for (;;) {
    sum = 0u; cnt = 0u; mine = 0u;
#pragma unroll
    for (unsigned j = 0; j < 16; ++j) { const unsigned c = xb_ld(&bar[XB_XCNT(j)]); sum += c; cnt += (c > 0u) ? 1u : 0u; mine = (j == x) ? c : mine; }
    if (sum == G) break;
    __builtin_amdgcn_s_sleep(1);
    if ((++sp & 255u) == 0u) { if (xb_ld(&bar[XB_TMO])) break; if (sp > XB_SPIN_CAP) { atomicAdd(&bar[XB_TMO], 1u); break; } }
  }
  nloc = mine > 0u ? mine : 1u; nx = cnt > 0u ? cnt : 1u;
}
DEVI void xcd_barrier(const XcdBarrier& b) {
  asm volatile("s_waitcnt vmcnt(0)" ::: "memory");
  __syncthreads();
  if (threadIdx_x_raw() == 0) {
    unsigned* bar = b.bar;
    __builtin_amdgcn_s_waitcnt(0);
    unsigned nloc = b.st[0], nx = b.st[1];
    if (nloc == 0u) { xcd_barrier_complete(bar, b.x, nloc, nx); b.st[0] = nloc; b.st[1] = nx; }
    const unsigned old = xb_add(&bar[XB_XSUB(b.x)], 1u);
    const unsigned gen = old / nloc;
    if (old + 1u == (gen + 1u) * nloc) {
      __builtin_amdgcn_fence(__ATOMIC_RELEASE, "agent");
      asm volatile("s_waitcnt vmcnt(0)" ::: "memory");
      const unsigned og = xb_add(&bar[XB_TOP], 1u);
      const unsigned tg = og / nx;
      if (og + 1u == (tg + 1u) * nx) xb_add(&bar[XB_TOPGEN], 1u);
      else XB_SPIN(xb_ld(&bar[XB_TOPGEN]) == tg, bar);
      __builtin_amdgcn_fence(__ATOMIC_ACQUIRE, "agent");
      xb_add(&bar[XB_XGEN(b.x)], 1u);
      asm volatile("s_waitcnt vmcnt(0)" ::: "memory");
    } else {
      XB_SPIN(xb_ld(&bar[XB_XGEN(b.x)]) == gen, bar);
      __builtin_amdgcn_fence(__ATOMIC_ACQUIRE, "agent");
      asm volatile("s_waitcnt vmcnt(0)" ::: "memory");
    }
  }
  __syncthreads();
}

DEVI void phase0(const P& p, char* smem) {
  const int tid = tidx();
  float* sc = (float*)smem;
  float* red = sc + 5 * 1024;
  for (int i = tid; i < 5 * 1024; i += 256) {
    int g = i >> 10, k = i & 1023;
    float v = g < 4 ? p.c[g * D + k] : p.c_ctx[k];
    sc[i] = v * sigm(v);
  }
  __syncthreads();
  for (int job = blockIdx.x; job < DEPTH * 96; job += gridDim.x) {
    int l = job / 96, n0 = (job % 96) * 64;
    int kq = tid >> 6, cc = tid & 63;
    const float* w = p.ada_w + ((size_t)l * D + kq * 256) * 6144 + n0 + cc;
    float a0 = 0, a1 = 0, a2 = 0, a3 = 0, a4 = 0;
#pragma unroll 8
    for (int k = 0; k < 256; ++k) {
      float wv = w[(size_t)k * 6144];
      int kk = kq * 256 + k;
      a0 += sc[kk] * wv; a1 += sc[1024 + kk] * wv; a2 += sc[2048 + kk] * wv; a3 += sc[3072 + kk] * wv; a4 += sc[4096 + kk] * wv;
    }
    red[(kq * 5 + 0) * 64 + cc] = a0; red[(kq * 5 + 1) * 64 + cc] = a1; red[(kq * 5 + 2) * 64 + cc] = a2;
    red[(kq * 5 + 3) * 64 + cc] = a3; red[(kq * 5 + 4) * 64 + cc] = a4;
    __syncthreads();
    for (int i = tid; i < 320; i += 256) {
      int g = i >> 6, c2 = i & 63;
      float s = red[(0 * 5 + g) * 64 + c2] + red[(1 * 5 + g) * 64 + c2] + red[(2 * 5 + g) * 64 + c2] + red[(3 * 5 + g) * 64 + c2];
      p.MOD()[((size_t)l * 5 + g) * 6144 + n0 + c2] = s + p.ada_b[l * 6144 + n0 + c2];
    }
    __syncthreads();
  }
  for (int i = blockIdx.x * 256 + tid; i < SEQ * 16; i += gridDim.x * 256) {
    int s = i >> 4, j = i & 15;
    float pos = (float)(j < 8 ? (s >> 6) : (s & 63));
    float inv = exp2f(-(float)(j & 7) * (13.287712379549449f / 8.f));
    float ang = pos * inv;
    p.ROPE()[s * 32 + j] = cosf(ang);
    p.ROPE()[s * 32 + 16 + j] = sinf(ang);
  }
  if (blockIdx.x == 0 && tid < 64) p.CTR()[tid] = 0;
}

struct CE { const float* src; h16* dst; const float* scale; int K, N; };
DEVI CE get_ce(const P& p, int l, int e) {
  CE c; c.scale = nullptr;
  switch (e) {
    case 0: c.src = p.w_in + (size_t)l * D * NIN; c.dst = p.WIN(); c.K = D; c.N = NIN; break;
    case 1: c.src = p.w_uq + (size_t)l * 384 * 768; c.dst = p.UQ(); c.K = 384; c.N = 768; c.scale = p.qn_g + l * 384; break;
    case 2: c.src = p.w_ukv + (size_t)l * 256 * 1024; c.dst = p.UKV(); c.K = 256; c.N = 1024; c.scale = p.kvn_g + l * 256; break;
    case 3: case 4: case 5: c.src = p.w_branch + ((size_t)l * 3 + (e - 3)) * 512 * D; c.dst = p.WB() + (size_t)(e - 3) * D * 512; c.K = 512; c.N = D; break;
    case 6: c.src = p.w_out + (size_t)l * D * D; c.dst = p.WO(); c.K = D; c.N = D; break;
    case 7: case 8: c.src = p.w_up + ((size_t)l * 2 + (e - 7)) * 64 * 512; c.dst = p.WUP() + (size_t)(e - 7) * 512 * 64; c.K = 64; c.N = 512; break;
    case 9: case 10: c.src = p.a_up + ((size_t)l * 2 + (e - 9)) * 64 * 512; c.dst = p.AUP() + (size_t)(e - 9) * 512 * 64; c.K = 64; c.N = 512; break;
    case 11: c.src = p.g_up + (size_t)l * 128 * 512; c.dst = p.GUP(); c.K = 128; c.N = 512; break;
    case 12: c.src = p.w1 + (size_t)l * D * DFF; c.dst = p.W1T(); c.K = D; c.N = DFF; break;
    default: c.src = p.w2 + (size_t)l * DFF * D; c.dst = p.W2T(); c.K = DFF; c.N = D; break;
  }
  return c;
}
DEVI void conv_tile(const CE& e, int tile, char* smem) {
  float* s = (float*)smem;
  const int tid = tidx();
  int ntn = e.N >> 6;
  int kt = tile / ntn, nt = tile - kt * ntn;
  {
    int r = tid >> 4, c4 = (tid & 15) * 4;
#pragma unroll
    for (int rr = 0; rr < 4; ++rr) {
      int k = r + 16 * rr;
      float4 v = *(const float4*)(e.src + (size_t)(kt * 64 + k) * e.N + nt * 64 + c4);
      float sc = e.scale ? e.scale[kt * 64 + k] : 1.f;
      s[k * 65 + c4 + 0] = v.x * sc; s[k * 65 + c4 + 1] = v.y * sc; s[k * 65 + c4 + 2] = v.z * sc; s[k * 65 + c4 + 3] = v.w * sc;
    }
  }
  __syncthreads();
  {
    int n = tid >> 2, kq = (tid & 3) * 16;
    uint4 u0, u1;
    u0.x = pk2n(s[(kq + 0) * 65 + n], s[(kq + 1) * 65 + n]); u0.y = pk2n(s[(kq + 2) * 65 + n], s[(kq + 3) * 65 + n]);
    u0.z = pk2n(s[(kq + 4) * 65 + n], s[(kq + 5) * 65 + n]); u0.w = pk2n(s[(kq + 6) * 65 + n], s[(kq + 7) * 65 + n]);
    u1.x = pk2n(s[(kq + 8) * 65 + n], s[(kq + 9) * 65 + n]); u1.y = pk2n(s[(kq + 10) * 65 + n], s[(kq + 11) * 65 + n]);
    u1.z = pk2n(s[(kq + 12) * 65 + n], s[(kq + 13) * 65 + n]); u1.w = pk2n(s[(kq + 14) * 65 + n], s[(kq + 15) * 65 + n]);
    h16* d = e.dst + (size_t)(nt * 64 + n) * e.K + kt * 64 + kq;
    *(uint4*)d = u0; *(uint4*)(d + 8) = u1;
  }
  __syncthreads();
}
DEVI void conv_phase(const P& p, int l, int e0, int e1, char* smem) {
  int total = 0;
  for (int e = e0; e < e1; ++e) { CE c = get_ce(p, l, e); total += (c.K >> 6) * (c.N >> 6); }
  for (int t = blockIdx.x; t < total; t += gridDim.x) {
    int tt = t;
    for (int e = e0; e < e1; ++e) {
      CE c = get_ce(p, l, e);
      int nt = (c.K >> 6) * (c.N >> 6);
      if (tt < nt) { conv_tile(c, tt, smem); break; }
      tt -= nt;
    }
  }
}

DEVI void ln_phase(const P& p, int l, int which) {
  const int lane = tidx() & 63;
  const int wid = blockIdx.x * 4 + (tidx() >> 6), nw = gridDim.x * 4;
  for (int r = wid; r < NR; r += nw) {
    int b = r / SB, s = r - b * SB;
    if (which == 2 && s < CTX) continue;
    int g = s < CTX ? 4 : b;
    float* xr = xrow(p, r);
    const float* src = xr;
    if (which == 0 && l == 0) src = s < CTX ? p.ctx + (size_t)(b * CTX + s) * D : p.x + (size_t)(b * SEQ + s - CTX) * D;
    float4 v[4];
#pragma unroll
    for (int i = 0; i < 4; ++i) v[i] = *(const float4*)(src + i * 256 + lane * 4);
    bool do_ln = !(which == 0 && l == 0);
    if (do_ln) {
      const float* gg = which == 1 ? p.ln1_g + l * D : p.ln2_g + (which == 2 ? 3 : l - 1) * D;
      const float* bb = which == 1 ? p.ln1_b + l * D : p.ln2_b + (which == 2 ? 3 : l - 1) * D;
      float sm = 0;
#pragma unroll
      for (int i = 0; i < 4; ++i) sm += v[i].x + v[i].y + v[i].z + v[i].w;
      float mean = wsum(sm) * (1.f / D);
      float sq = 0;
#pragma unroll
      for (int i = 0; i < 4; ++i) {
        v[i].x -= mean; v[i].y -= mean; v[i].z -= mean; v[i].w -= mean;
        sq += v[i].x * v[i].x + v[i].y * v[i].y + v[i].z * v[i].z + v[i].w * v[i].w;
      }
      float rs = rsqrtf(wsum(sq) * (1.f / D) + 1e-5f);
#pragma unroll
      for (int i = 0; i < 4; ++i) {
        float4 g4 = *(const float4*)(gg + i * 256 + lane * 4), b4 = *(const float4*)(bb + i * 256 + lane * 4);
        v[i].x = v[i].x * rs * g4.x + b4.x; v[i].y = v[i].y * rs * g4.y + b4.y;
        v[i].z = v[i].z * rs * g4.z + b4.z; v[i].w = v[i].w * rs * g4.w + b4.w;
      }
    }
#pragma unroll
    for (int i = 0; i < 4; ++i) *(float4*)(xr + i * 256 + lane * 4) = v[i];
    if (which == 2) continue;
    const float* shf = p.MOD() + ((size_t)l * 5 + g) * 6144 + (which == 0 ? 0 : 3) * D;
    const float* scl = shf + D;
    float sm = 0;
#pragma unroll
    for (int i = 0; i < 4; ++i) sm += v[i].x + v[i].y + v[i].z + v[i].w;
    float mean = wsum(sm) * (1.f / D);
    float sq = 0;
#pragma unroll
    for (int i = 0; i < 4; ++i) {
      v[i].x -= mean; v[i].y -= mean; v[i].z -= mean; v[i].w -= mean;
      sq += v[i].x * v[i].x + v[i].y * v[i].y + v[i].z * v[i].z + v[i].w * v[i].w;
    }
    float rs = rsqrtf(wsum(sq) * (1.f / D) + 1e-6f);
    h16* hr = p.H() + (size_t)r * D;
#pragma unroll
    for (int i = 0; i < 4; ++i) {
      float4 s4 = *(const float4*)(shf + i * 256 + lane * 4), c4 = *(const float4*)(scl + i * 256 + lane * 4);
      st4h(hr + i * 256 + lane * 4, v[i].x * rs * (1.f + c4.x) + s4.x, v[i].y * rs * (1.f + c4.y) + s4.y,
           v[i].z * rs * (1.f + c4.z) + s4.z, v[i].w * rs * (1.f + c4.w) + s4.w);
    }
  }
}

constexpr int GLD = 72;
template <bool ROWSQ, int NI = 2>
DEVI void gemm_main(const h16* __restrict__ A, int lda, const h16* __restrict__ Bt, int ldb, int K, int m0, int n0, int nmax,
                    char* smem, f32x16 (&acc)[2][NI], float* rowsq) {
  h16* As = (h16*)smem;
  h16* Bs = As + 2 * 128 * GLD;
  const int tid = tidx(), lane = tid & 63, wv = tid >> 6;
  const int wm = wv >> 1, wn = wv & 1, l31 = lane & 31, hh = lane >> 5;
  const int lrow = tid >> 3, lkc = (tid & 7) * 8;
  uint4 ga[4], gb[2 * NI];
  float sq[4] = {0.f, 0.f, 0.f, 0.f};
  const h16* Ap = A + (size_t)(m0 + lrow) * lda + lkc;
  const h16* Bp = Bt + (size_t)(n0 + lrow) * ldb + lkc;
#pragma unroll
  for (int i = 0; i < 4; ++i) ga[i] = *(const uint4*)(Ap + (size_t)(32 * i) * lda);
#pragma unroll
  for (int i = 0; i < 2 * NI; ++i)
    gb[i] = (n0 + lrow + 32 * i < nmax) ? *(const uint4*)(Bp + (size_t)(32 * i) * ldb) : make_uint4(0, 0, 0, 0);
  const int KT = K >> 6;
#pragma unroll
  for (int i = 0; i < 4; ++i) *(uint4*)(As + (lrow + 32 * i) * GLD + lkc) = ga[i];
#pragma unroll
  for (int i = 0; i < 2 * NI; ++i) *(uint4*)(Bs + (lrow + 32 * i) * GLD + lkc) = gb[i];
  __syncthreads();
  for (int kt = 0; kt < KT; ++kt) {
    const int buf = kt & 1;
    if (ROWSQ) {
#pragma unroll
      for (int i = 0; i < 4; ++i) {
        h16x8 hv = __builtin_bit_cast(h16x8, ga[i]);
#pragma unroll
        for (int j = 0; j < 8; ++j) { float f = (float)hv[j]; sq[i] += f * f; }
      }
    }
    if (kt + 1 < KT) {
#pragma unroll
      for (int i = 0; i < 4; ++i) ga[i] = *(const uint4*)(Ap + (size_t)(32 * i) * lda + (kt + 1) * 64);
#pragma unroll
      for (int i = 0; i < 2 * NI; ++i)
        gb[i] = (n0 + lrow + 32 * i < nmax) ? *(const uint4*)(Bp + (size_t)(32 * i) * ldb + (kt + 1) * 64) : make_uint4(0, 0, 0, 0);
    }
    const h16* as = As + buf * 128 * GLD + (wm * 64 + l31) * GLD + hh * 8;
    const h16* bs = Bs + buf * 128 * GLD + (wn * 32 * NI + l31) * GLD + hh * 8;
#pragma unroll
    for (int ks = 0; ks < 4; ++ks) {
      h16x8 a0 = *(const h16x8*)(as + ks * 16), a1 = *(const h16x8*)(as + 32 * GLD + ks * 16);
#pragma unroll
      for (int ni = 0; ni < NI; ++ni) {
        h16x8 b0 = *(const h16x8*)(bs + ni * 32 * GLD + ks * 16);
        acc[0][ni] = __builtin_amdgcn_mfma_f32_32x32x16_f16(b0, a0, acc[0][ni], 0, 0, 0);
        acc[1][ni] = __builtin_amdgcn_mfma_f32_32x32x16_f16(b0, a1, acc[1][ni], 0, 0, 0);
      }
    }
    if (kt + 1 < KT) {
      h16* ad = As + (buf ^ 1) * 128 * GLD;
      h16* bd = Bs + (buf ^ 1) * 128 * GLD;
#pragma unroll
      for (int i = 0; i < 4; ++i) *(uint4*)(ad + (lrow + 32 * i) * GLD + lkc) = ga[i];
#pragma unroll
      for (int i = 0; i < 2 * NI; ++i) *(uint4*)(bd + (lrow + 32 * i) * GLD + lkc) = gb[i];
    }
    __syncthreads();
  }
  if (ROWSQ) {
#pragma unroll
    for (int i = 0; i < 4; ++i) {
      float s = sq[i];
      s += __shfl_xor(s, 1); s += __shfl_xor(s, 2); s += __shfl_xor(s, 4);
      if ((tid & 7) == 0) rowsq[lrow + 32 * i] = s;
    }
    __syncthreads();
  }
}
template <int NI = 2>
DEVI void gemm_deep(const h16* __restrict__ A, int lda, const h16* __restrict__ Bt, int ldb, int K, int m0, int n0, int nmax,
                    char* smem, f32x16 (&acc)[2][NI]) {
  h16* As = (h16*)smem;
  h16* Bs = As + 2 * 128 * GLD;
  const int tid = tidx(), lane = tid & 63, wv = tid >> 6;
  const int wm = wv >> 1, wn = wv & 1, l31 = lane & 31, hh = lane >> 5;
  const int lrow = tid >> 3, lkc = (tid & 7) * 8;
  uint4 pa0, pa1, pa2, pa3, pb0, pb1, pb2, pb3;
  uint4 qa0, qa1, qa2, qa3, qb0, qb1, qb2, qb3;
  const h16* Ap = A + (size_t)(m0 + lrow) * lda + lkc;
  const int KT = K >> 6;
  const uint4 zz = make_uint4(0, 0, 0, 0);
  const h16* Bq0 = Bt + (size_t)min(n0 + lrow, nmax - 1) * ldb + lkc;
  const h16* Bq1 = Bt + (size_t)min(n0 + lrow + 32, nmax - 1) * ldb + lkc;
  const h16* Bq2 = Bt + (size_t)min(n0 + lrow + 64, nmax - 1) * ldb + lkc;
  const h16* Bq3 = Bt + (size_t)min(n0 + lrow + 96, nmax - 1) * ldb + lkc;
#define GLOAD(S, kt_)                                                                   \
  {                                                                                     \
    const h16* ap_ = Ap + (kt_) * 64;                                                   \
    S##a0 = *(const uint4*)(ap_); S##a1 = *(const uint4*)(ap_ + (size_t)32 * lda);      \
    S##a2 = *(const uint4*)(ap_ + (size_t)64 * lda); S##a3 = *(const uint4*)(ap_ + (size_t)96 * lda); \
    S##b0 = *(const uint4*)(Bq0 + (kt_) * 64); S##b1 = *(const uint4*)(Bq1 + (kt_) * 64); \
    if (NI == 2) { S##b2 = *(const uint4*)(Bq2 + (kt_) * 64); S##b3 = *(const uint4*)(Bq3 + (kt_) * 64); } \
  }
#define LSTORE(S, buf_)                                                                 \
  {                                                                                     \
    h16* ad = As + (buf_) * 128 * GLD + lrow * GLD + lkc;                               \
    h16* bd = Bs + (buf_) * 128 * GLD + lrow * GLD + lkc;                               \
    *(uint4*)(ad) = S##a0; *(uint4*)(ad + 32 * GLD) = S##a1; *(uint4*)(ad + 64 * GLD) = S##a2; *(uint4*)(ad + 96 * GLD) = S##a3; \
    *(uint4*)(bd) = S##b0; *(uint4*)(bd + 32 * GLD) = S##b1;                            \
    if (NI == 2) { *(uint4*)(bd + 64 * GLD) = S##b2; *(uint4*)(bd + 96 * GLD) = S##b3; } \
  }
#define COMPUTE(buf_)                                                                                              \
  {                                                                                                                \
    const h16* as = As + (buf_) * 128 * GLD + (wm * 64 + l31) * GLD + hh * 8;                                      \
    const h16* bs = Bs + (buf_) * 128 * GLD + (wn * 32 * NI + l31) * GLD + hh * 8;                                 \
    _Pragma("unroll") for (int ks = 0; ks < 4; ++ks) {                                                             \
      h16x8 a0 = *(const h16x8*)(as + ks * 16), a1 = *(const h16x8*)(as + 32 * GLD + ks * 16);                     \
      _Pragma("unroll") for (int ni = 0; ni < NI; ++ni) {                                                          \
        h16x8 b0 = *(const h16x8*)(bs + ni * 32 * GLD + ks * 16);                                                  \
        acc[0][ni] = __builtin_amdgcn_mfma_f32_32x32x16_f16(b0, a0, acc[0][ni], 0, 0, 0);                          \
        acc[1][ni] = __builtin_amdgcn_mfma_f32_32x32x16_f16(b0, a1, acc[1][ni], 0, 0, 0);                          \
      }                                                                                                            \
    }                                                                                                              \
  }
  pb2 = zz; pb3 = zz; qb2 = zz; qb3 = zz;
  GLOAD(p, 0);
  GLOAD(q, 1);
  LSTORE(p, 0);
  if (KT > 2) GLOAD(p, 2);
  __syncthreads();
  for (int kt = 0; kt < KT; kt += 2) {
    COMPUTE(0);
    if (kt + 1 < KT) LSTORE(q, 1);
    if (kt + 3 < KT) GLOAD(q, kt + 3);
    __syncthreads();
    if (kt + 1 < KT) {
      COMPUTE(1);
      if (kt + 2 < KT) LSTORE(p, 0);
      if (kt + 4 < KT) GLOAD(p, kt + 4);
      __syncthreads();
    }
  }
#undef GLOAD
#undef LSTORE
#undef COMPUTE
}
DEVI void zero_acc(f32x16 (&acc)[2][2]) {
#pragma unroll
  for (int i = 0; i < 2; ++i)
#pragma unroll
    for (int j = 0; j < 2; ++j)
#pragma unroll
      for (int r = 0; r < 16; ++r) acc[i][j][r] = 0.f;
}
template <class F>
DEVI void epi_quads(const f32x16 (&acc)[2][2], int m0, int n0, F f) {
  const int lane = tidx() & 63, wv = tidx() >> 6;
  const int wm = wv >> 1, wn = wv & 1, l31 = lane & 31, hh = lane >> 5;
#pragma unroll
  for (int mi = 0; mi < 2; ++mi)
#pragma unroll
    for (int ni = 0; ni < 2; ++ni)
#pragma unroll
      for (int g = 0; g < 4; ++g)
        f(m0 + wm * 64 + mi * 32 + l31, n0 + wn * 64 + ni * 32 + 8 * g + 4 * hh, acc[mi][ni][4 * g], acc[mi][ni][4 * g + 1],
          acc[mi][ni][4 * g + 2], acc[mi][ni][4 * g + 3]);
}

DEVI void inproj_phase(const P& p, char* smem) {
  constexpr int MT = NR / 128, NT = (ZW + 127) / 128;
  for (int job = blockIdx.x; job < MT * NT; job += gridDim.x) {
    int nt = job / MT, mt = job - nt * MT;
    f32x16 acc[2][2]; zero_acc(acc);
    gemm_deep<2>(p.H(), D, p.WIN(), D, D, mt * 128, nt * 128, ZW, smem, acc);
    epi_quads(acc, mt * 128, nt * 128, [&](int m, int n, float v0, float v1, float v2, float v3) {
      if (n < ZW) {
        st4h(p.Z() + (size_t)m * ZW + n, v0, v1, v2, v3);
        if (n >= ZRW) {
          if ((m & 63) == 0) st4h(p.HLO() + (size_t)(m >> 6) * 1920 + n - ZRW, v0, v1, v2, v3);
          if ((m & 63) == 63) st4h(p.HHI() + (size_t)(m >> 6) * 1920 + n - ZRW, v0, v1, v2, v3);
        }
      }
    });
  }
}

DEVI void shift_job(const P& p, int l, int jj, char* smem) {
  const int j = jj >> 3, slab0 = jj & 7;
  h16* raw = (h16*)smem;
  const int tid = tidx(), lane = tid & 63;
  const int r0 = j * 64;
  const int s0 = r0 % SB;
  const bool first = (s0 == 0) || (s0 == CTX);
  const bool last = (s0 + 64 == CTX) || (s0 + 64 == SB);
  for (int slab = slab0; slab <= slab0; ++slab) {
    const int c0 = slab * 256;
    const int ncols = slab == 7 ? 128 : 256;
    const int cpr = ncols >> 3;
    for (int c = tid; c < 66 * cpr; c += 256) {
      int row = c / cpr, ch = (c - row * cpr) * 8;
      uint4 v = make_uint4(0, 0, 0, 0);
      if (row == 0) { if (!first) v = *(const uint4*)(p.HHI() + (size_t)(j - 1) * 1920 + c0 + ch); }
      else if (row == 65) { if (!last) v = *(const uint4*)(p.HLO() + (size_t)(j + 1) * 1920 + c0 + ch); }
      else v = *(const uint4*)(p.Z() + (size_t)(r0 + row - 1) * ZW + ZRW + c0 + ch);
      *(uint4*)(raw + row * 264 + ch) = v;
    }
    __syncthreads();
    if (tid < ncols) {
      const int col = c0 + tid;
      const float mup = p.mu[(size_t)l * 2 * 1920 + col], mun = p.mu[(size_t)l * 2 * 1920 + 1920 + col];
      const bool isk = (col >= 512 && col < 1024);
      const float kkp = isk ? p.k_k[l * 512 + col - 512] : 0.f;
      float prev = (float)raw[tid], cur = (float)raw[264 + tid];
      h16* zc = p.Z() + (size_t)r0 * ZW + ZRW + col;
      for (int t = 0; t < 64; ++t) {
        float nxt = (float)raw[(t + 2) * 264 + tid];
        float o = cur + mup * (prev - cur) + mun * (nxt - cur);
        float ov = o;
        if (col >= 1536 && col < 1664) ov = tanhf(o);
        else if (col >= 1792) ov = sigm(o);
        zc[(size_t)t * ZW] = (h16)ov;
        if (isk) {
          float q = o * kkp;
          float ss = wsum(q * q);
          if (lane == 0) p.INVN()[(size_t)(r0 + t) * 8 + ((col - 512) >> 6)] = rsqrtf(ss + 1e-12f);
        }
        prev = cur; cur = nxt;
      }
    }
    __syncthreads();
  }
}

DEVI void mla_up_job(const P& p, int job, char* smem) {
  constexpr int MT = NR / 128;
  float* rowsq = (float*)(smem + 2 * 2 * 128 * GLD * 2);
  const int tid = tidx();
  f32x16 acc[2][2]; zero_acc(acc);
  if (job < MT * 6) {
    int nt = job / MT, mt = job - nt * MT;
    gemm_main<true>(p.Z() + ZMLA, ZW, p.UQ(), 384, 384, mt * 128, nt * 128, 768, smem, acc, rowsq);
    const int m0 = mt * 128, n0 = nt * 128;
    const int lane = tid & 63, wv = tid >> 6, wm = wv >> 1, wn = wv & 1, l31 = lane & 31, hh = lane >> 5;
    const float qs = 0.10206207261596575f * 1.4426950408889634f;
#pragma unroll
    for (int mi = 0; mi < 2; ++mi) {
      const int ml = wm * 64 + mi * 32 + l31, m = m0 + ml;
      const float sc = rsqrtf(rowsq[ml] * (1.f / 384.f) + 1e-6f) * qs;
      const int sp = m % SB;
      const bool lat = sp >= CTX;
      const float* rp = p.ROPE() + (size_t)(lat ? sp - CTX : 0) * 32;
#pragma unroll
      for (int ni = 0; ni < 2; ++ni) {
        const int nb = n0 + wn * 64 + ni * 32;
        h16* qd = p.Q() + (size_t)m * 768 + nb;
        const bool ropet = (nb % 96) == 64;
        if (ropet && lat) {
#pragma unroll
          for (int g = 0; g < 2; ++g) {
            float o1[4], o2[4];
#pragma unroll
            for (int jj = 0; jj < 4; ++jj) {
              int i = 8 * g + 4 * hh + jj;
              float x1 = acc[mi][ni][4 * g + jj] * sc, x2 = acc[mi][ni][4 * (g + 2) + jj] * sc;
              float cs = rp[i], sn = rp[16 + i];
              o1[jj] = x1 * cs - x2 * sn; o2[jj] = x1 * sn + x2 * cs;
            }
            st4h(qd + 8 * g + 4 * hh, o1[0], o1[1], o1[2], o1[3]);
            st4h(qd + 16 + 8 * g + 4 * hh, o2[0], o2[1], o2[2], o2[3]);
          }
        } else {
#pragma unroll
          for (int g = 0; g < 4; ++g)
            st4h(qd + 8 * g + 4 * hh, acc[mi][ni][4 * g] * sc, acc[mi][ni][4 * g + 1] * sc, acc[mi][ni][4 * g + 2] * sc, acc[mi][ni][4 * g + 3] * sc);
        }
      }
    }
  } else {
    int j2 = job - MT * 6;
    int nt = j2 / MT, mt = j2 - nt * MT;
    gemm_main<true>(p.Z() + ZMLA + 384, ZW, p.UKV(), 256, 256, mt * 128, nt * 128, 1024, smem, acc, rowsq);
    const int m0 = mt * 128;
    epi_quads(acc, m0, 0, [&](int m, int n, float v0, float v1, float v2, float v3) {
      const float sc = rsqrtf(rowsq[m - m0] * (1.f / 256.f) + 1e-6f);
      if (n < 64) st4h(p.K() + (size_t)m * 768 + nt * 96 + n, v0 * sc, v1 * sc, v2 * sc, v3 * sc);
      else {
        int b = m / SB, s = m - b * SB;
        h16* vt = p.VT() + ((size_t)(b * 8 + nt) * 64 + (n - 64)) * SB + s;
        vt[0] = (h16)(v0 * sc); vt[SB] = (h16)(v1 * sc); vt[2 * SB] = (h16)(v2 * sc); vt[3 * SB] = (h16)(v3 * sc);
      }
    });
    {
      int row = tid >> 1, sub = tid & 1;
      int m = m0 + row;
      int sp = m % SB;
      const h16* kr = p.Z() + (size_t)m * ZW + ZMLA + 640 + sub * 8;
      h16x8 x1 = *(const h16x8*)kr, x2 = *(const h16x8*)(kr + 16);
      h16* kd = p.K() + (size_t)m * 768 + nt * 96 + 64 + sub * 8;
      if (sp >= CTX) {
        const float* rp = p.ROPE() + (size_t)(sp - CTX) * 32 + sub * 8;
        h16x8 o1, o2;
#pragma unroll
        for (int i = 0; i < 8; ++i) {
          float a = (float)x1[i], b2 = (float)x2[i], cs = rp[i], sn = rp[16 + i];
          o1[i] = (h16)(a * cs - b2 * sn); o2[i] = (h16)(a * sn + b2 * cs);
        }
        *(h16x8*)kd = o1; *(h16x8*)(kd + 16) = o2;
      } else { *(h16x8*)kd = x1; *(h16x8*)(kd + 16) = x2; }
    }
  }
}

DEVI void lowrank_job(const P& p, int l, int job, char* smem) {
  constexpr int MT = NR / 128;
  int mat = job / (MT * 4), rem = job - mat * MT * 4;
  int nt = rem / MT, mt = rem - nt * MT;
  f32x16 acc[2][2]; zero_acc(acc);
  if (mat < 2) {
    const int dir = mat;
    gemm_main<false>(p.Z() + ZRW + 1536 + dir * 64, ZW, p.WUP() + (size_t)dir * 512 * 64, 64, 64, mt * 128, nt * 128, 512, smem, acc, nullptr);
    const float* w0 = p.w0 + ((size_t)l * 2 + dir) * 512;
    h16* dst = p.LW() + (size_t)dir * NR * 512;
    epi_quads(acc, mt * 128, nt * 128, [&](int m, int n, float v0, float v1, float v2, float v3) {
      float4 b = *(const float4*)(w0 + n);
      const float e = 0.6065306597126334f;
      st4h(dst + (size_t)m * 512 + n, sigm(v0 + b.x) * e, sigm(v1 + b.y) * e, sigm(v2 + b.z) * e, sigm(v3 + b.w) * e);
    });
  } else if (mat < 4) {
    const int dir = mat - 2;
    gemm_main<false>(p.Z() + ZRW + 1664 + dir * 64, ZW, p.AUP() + (size_t)dir * 512 * 64, 64, 64, mt * 128, nt * 128, 512, smem, acc, nullptr);
    const float* a0 = p.a0 + ((size_t)l * 2 + dir) * 512;
    h16* dst = p.AA() + (size_t)dir * NR * 512;
    epi_quads(acc, mt * 128, nt * 128, [&](int m, int n, float v0, float v1, float v2, float v3) {
      float4 b = *(const float4*)(a0 + n);
      st4h(dst + (size_t)m * 512 + n, sigm(v0 + b.x), sigm(v1 + b.y), sigm(v2 + b.z), sigm(v3 + b.w));
    });
  } else {
    gemm_main<false>(p.Z() + ZRW + 1792, ZW, p.GUP(), 128, 128, mt * 128, nt * 128, 512, smem, acc, nullptr);
    epi_quads(acc, mt * 128, nt * 128, [&](int m, int n, float v0, float v1, float v2, float v3) {
      st4h(p.G() + (size_t)m * 512 + n, v0, v1, v2, v3);
    });
  }
}

DEVI void attn_job(const P& p, int job, char* smem) {
  h16* Ks = (h16*)smem;
  h16* Vs = Ks + 2 * 64 * 104;
  const int tid = tidx(), lane = tid & 63, wv = tid >> 6, l31 = lane & 31, hh = lane >> 5;
  int b, h, q0, nk;
  if (job < 1024) { b = job >> 8; h = (job >> 5) & 7; q0 = b * SB + CTX + (job & 31) * 128; nk = SB; }
  else { int j = job - 1024; b = j >> 4; h = (j >> 1) & 7; q0 = b * SB + (j & 1) * 128; nk = CTX; }
  const int NKT = nk >> 6;
  const h16* Kg = p.K() + (size_t)(b * SB) * 768 + h * 96;
  const h16* Vg = p.VT() + (size_t)(b * 8 + h) * 64 * SB;
  h16x8 qf[6];
  {
    const h16* qp = p.Q() + (size_t)(q0 + wv * 32 + l31) * 768 + h * 96 + hh * 8;
#pragma unroll
    for (int ds = 0; ds < 6; ++ds) qf[ds] = *(const h16x8*)(qp + ds * 16);
  }
  uint4 pk0, pk1, pk2_, pv0, pv1, qk0, qk1, qk2_, qv0, qv1;
  int krow[3], kcol[3];
#pragma unroll
  for (int i = 0; i < 3; ++i) { int c = tid + 256 * i; krow[i] = c / 12; kcol[i] = (c - krow[i] * 12) * 8; }
  const int vrow = tid >> 3, vcol = (tid & 7) * 8;
  const h16* kp0 = Kg + (size_t)krow[0] * 768 + kcol[0];
  const h16* kp1 = Kg + (size_t)krow[1] * 768 + kcol[1];
  const h16* kp2 = Kg + (size_t)krow[2] * 768 + kcol[2];
  const h16* vp0 = Vg + (size_t)vrow * SB + vcol;
  const h16* vp1 = Vg + (size_t)(vrow + 32) * SB + vcol;
#define ALOAD(S, kt_) { S##k0 = *(const uint4*)(kp0 + (size_t)(kt_) * 64 * 768); S##k1 = *(const uint4*)(kp1 + (size_t)(kt_) * 64 * 768); \
    S##k2_ = *(const uint4*)(kp2 + (size_t)(kt_) * 64 * 768); S##v0 = *(const uint4*)(vp0 + (kt_) * 64); S##v1 = *(const uint4*)(vp1 + (kt_) * 64); }
#define ASTORE(S, buf_) { h16* kd = Ks + (buf_) * 64 * 104; h16* vd = Vs + (buf_) * 64 * 72; \
    *(uint4*)(kd + krow[0] * 104 + kcol[0]) = S##k0; *(uint4*)(kd + krow[1] * 104 + kcol[1]) = S##k1; *(uint4*)(kd + krow[2] * 104 + kcol[2]) = S##k2_; \
    *(uint4*)(vd + vrow * 72 + vcol) = S##v0; *(uint4*)(vd + (vrow + 32) * 72 + vcol) = S##v1; }
  f32x16 o0, o1;
#pragma unroll
  for (int r = 0; r < 16; ++r) { o0[r] = 0.f; o1[r] = 0.f; }
  float mrun = -1e30f, lsum = 0.f;
  auto compute = [&](int buf) {
    const h16* ks = Ks + buf * 64 * 104 + l31 * 104 + hh * 8;
    f32x16 s0, s1;
#pragma unroll
    for (int r = 0; r < 16; ++r) { s0[r] = 0.f; s1[r] = 0.f; }
#pragma unroll
    for (int ds = 0; ds < 6; ++ds) {
      h16x8 a0 = *(const h16x8*)(ks + ds * 16), a1 = *(const h16x8*)(ks + 32 * 104 + ds * 16);
      s0 = __builtin_amdgcn_mfma_f32_32x32x16_f16(a0, qf[ds], s0, 0, 0, 0);
      s1 = __builtin_amdgcn_mfma_f32_32x32x16_f16(a1, qf[ds], s1, 0, 0, 0);
    }
    float mx = s0[0];
#pragma unroll
    for (int r = 1; r < 16; ++r) mx = fmaxf(mx, s0[r]);
#pragma unroll
    for (int r = 0; r < 16; ++r) mx = fmaxf(mx, s1[r]);
    mx = fmaxf(mx, __shfl_xor(mx, 32));
    const float mnew = fmaxf(mrun, mx);
    const float alpha = __builtin_amdgcn_exp2f(mrun - mnew);
    mrun = mnew;
    float ps = 0.f;
#pragma unroll
    for (int r = 0; r < 16; ++r) { s0[r] = __builtin_amdgcn_exp2f(s0[r] - mnew); ps += s0[r]; }
#pragma unroll
    for (int r = 0; r < 16; ++r) { s1[r] = __builtin_amdgcn_exp2f(s1[r] - mnew); ps += s1[r]; }
    lsum = lsum * alpha + ps;
#pragma unroll
    for (int r = 0; r < 16; ++r) { o0[r] *= alpha; o1[r] *= alpha; }
    const h16* vs = Vs + buf * 64 * 72 + l31 * 72 + 4 * hh;
#pragma unroll
    for (int k2 = 0; k2 < 2; ++k2) {
#pragma unroll
      for (int s2 = 0; s2 < 2; ++s2) {
        uint4 pu;
        if (k2 == 0) { pu.x = pk2(s0[8 * s2], s0[8 * s2 + 1]); pu.y = pk2(s0[8 * s2 + 2], s0[8 * s2 + 3]); pu.z = pk2(s0[8 * s2 + 4], s0[8 * s2 + 5]); pu.w = pk2(s0[8 * s2 + 6], s0[8 * s2 + 7]); }
        else { pu.x = pk2(s1[8 * s2], s1[8 * s2 + 1]); pu.y = pk2(s1[8 * s2 + 2], s1[8 * s2 + 3]); pu.z = pk2(s1[8 * s2 + 4], s1[8 * s2 + 5]); pu.w = pk2(s1[8 * s2 + 6], s1[8 * s2 + 7]); }
        h16x8 pf = __builtin_bit_cast(h16x8, pu);
        const int kb = k2 * 32 + 16 * s2;
        uint2 va = *(const uint2*)(vs + kb), vb = *(const uint2*)(vs + kb + 8);
        uint2 vc = *(const uint2*)(vs + 32 * 72 + kb), vd = *(const uint2*)(vs + 32 * 72 + kb + 8);
        h16x8 vf0 = __builtin_bit_cast(h16x8, make_uint4(va.x, va.y, vb.x, vb.y));
        h16x8 vf1 = __builtin_bit_cast(h16x8, make_uint4(vc.x, vc.y, vd.x, vd.y));
        o0 = __builtin_amdgcn_mfma_f32_32x32x16_f16(vf0, pf, o0, 0, 0, 0);
        o1 = __builtin_amdgcn_mfma_f32_32x32x16_f16(vf1, pf, o1, 0, 0, 0);
      }
    }
  };
  ALOAD(p, 0);
  if (NKT > 1) ALOAD(q, 1);
  ASTORE(p, 0);
  if (NKT > 2) ALOAD(p, 2);
  __syncthreads();
  for (int kt = 0; kt < NKT; kt += 2) {
    compute(0);
    if (kt + 1 < NKT) ASTORE(q, 1);
    if (kt + 3 < NKT) ALOAD(q, kt + 3);
    __syncthreads();
    if (kt + 1 < NKT) {
      compute(1);
      if (kt + 2 < NKT) ASTORE(p, 0);
      if (kt + 4 < NKT) ALOAD(p, kt + 4);
      __syncthreads();
    }
  }
#undef ALOAD
#undef ASTORE
  const float ltot = lsum + __shfl_xor(lsum, 32);
  const float inv = 1.f / ltot;
  h16* yo = p.Z() + (size_t)(q0 + wv * 32 + l31) * ZW + ZMLA + h * 64 + 4 * hh;
#pragma unroll
  for (int g = 0; g < 4; ++g) {
    st4h(yo + 8 * g, o0[4 * g] * inv, o0[4 * g + 1] * inv, o0[4 * g + 2] * inv, o0[4 * g + 3] * inv);
    st4h(yo + 32 + 8 * g, o1[4 * g] * inv, o1[4 * g + 1] * inv, o1[4 * g + 2] * inv, o1[4 * g + 3] * inv);
  }
}

#if PROBE >= 200
__device__ unsigned long long g_tacc[4];
#endif
struct Slot { float w[64]; unsigned bke[64]; float vv[64]; h16 ah[4][64]; int yoff; int pad[3]; };
struct LSet { uint4 lw, a, k, v, r; float inv; int yoff; int vm; };
DEVI void scan_job(const P& p, int l, int job, char* smem, int rank) {
  constexpr int RGB = 4 / NSCAN_BPC;
  constexpr int NLD = (4 - RGB) * 64;
  static_assert(NLD == 128, "loader mapping assumes 128 loader threads");
  Slot* sl = (Slot*)smem;
  h16* ybuf = (h16*)(smem + 2 * 16 * sizeof(Slot));
  const int tid = tidx(), lane = tid & 63, wv = rank ? ((tid >> 6) ^ 2) : (tid >> 6);
  const int chain = job / NSCAN_BPC, part = job - chain * NSCAN_BPC;
  const int dir = chain >> 5, b = (chain >> 3) & 3, h = chain & 7;
  for (int i = tid; i < 32 * 128; i += 256) { int s = i >> 7, e = i & 127; sl[s].ah[2 + (e >> 6)][e & 63] = (h16)0.f; }
  if (wv >= RGB) {
    const int lt = (wv - RGB) * 64 + lane;
    const int st = lt >> 3, ca = lt & 7, c8 = ca * 8;
    const int pp0 = (ca >> 2) * 32 + (2 * (ca & 1)) * 8 + ((ca & 3) >> 1) * 4;
    const int pp1 = pp0 + 8;
    const float4 kkA = *(const float4*)(p.k_k + l * 512 + h * 64 + c8), kkB = *(const float4*)(p.k_k + l * 512 + h * 64 + c8 + 4);
    const float4 kaA = *(const float4*)(p.k_a + l * 512 + h * 64 + c8), kaB = *(const float4*)(p.k_a + l * 512 + h * 64 + c8 + 4);
    const h16* LWd = p.LW() + (size_t)dir * NR * 512 + h * 64 + c8;
    const h16* AAd = p.AA() + (size_t)dir * NR * 512 + h * 64 + c8;
    const h16* Zr = p.Z() + ZRW + h * 64 + c8;
#define LLOAD(ci_, g)                                                                                         \
    {                                                                                                         \
      const int n_ = (ci_) * 16 + st;                                                                         \
      const int rowm_ = maprow(dir, b, min(n_, SB - 1));                                                      \
      const int rowr_ = maprow(dir, b, min(max(n_ - 1, 0), SB - 1));                                          \
      g##_yoff = (n_ >= 1 && n_ <= SB) ? rowr_ * 512 : -1;                                                      \
      g##_vm = (n_ < SB) ? 1 : 0;                                                                               \
      const h16* p0_ = LWd + (size_t)rowm_ * 512; const h16* p1_ = AAd + (size_t)rowm_ * 512;                 \
      const h16* p2_ = Zr + (size_t)rowm_ * ZW + 512; const h16* p3_ = Zr + (size_t)rowm_ * ZW + 1024;        \
      const h16* p4_ = Zr + (size_t)rowr_ * ZW; const float* p5_ = p.INVN() + (size_t)rowm_ * 8 + h;          \
      asm volatile("global_load_dwordx4 %0, %1, off" : "=v"(g##_lw) : "v"(p0_) : "memory");                     \
      asm volatile("global_load_dwordx4 %0, %1, off" : "=v"(g##_a) : "v"(p1_) : "memory");                      \
      asm volatile("global_load_dwordx4 %0, %1, off" : "=v"(g##_k) : "v"(p2_) : "memory");                      \
      asm volatile("global_load_dwordx4 %0, %1, off" : "=v"(g##_v) : "v"(p3_) : "memory");                      \
      asm volatile("global_load_dwordx4 %0, %1, off" : "=v"(g##_r) : "v"(p4_) : "memory");                      \
      asm volatile("global_load_dword %0, %1, off" : "=v"(g##_inv) : "v"(p5_) : "memory");                      \
    }
#define LWAIT(g) asm volatile("s_waitcnt vmcnt(18)" : "+v"(g##_lw), "+v"(g##_a), "+v"(g##_k), "+v"(g##_v), "+v"(g##_r), "+v"(g##_inv) : : "memory")
    auto lstore = [&](uint4 g_lw, uint4 g_a, uint4 g_k, uint4 g_v, uint4 g_r, float g_inv, int g_yoff, int g_vm, int buf) {
      Slot& s = sl[buf * 16 + st];
      const h16x8 lw = __builtin_bit_cast(h16x8, g_lw), a = __builtin_bit_cast(h16x8, g_a), k = __builtin_bit_cast(h16x8, g_k), v = __builtin_bit_cast(h16x8, g_v);
      const float kkp[8] = {kkA.x, kkA.y, kkA.z, kkA.w, kkB.x, kkB.y, kkB.z, kkB.w};
      const float kap[8] = {kaA.x, kaA.y, kaA.z, kaA.w, kaB.x, kaB.y, kaB.z, kaB.w};
      const float vmf = g_vm ? 1.f : 0.f;
      const float inv = g_inv * vmf;
      float w8[8], v8[8], q8[8], r8[8]; unsigned be8[8];
      const h16x8 rh = __builtin_bit_cast(h16x8, g_r);
      const float rvalid = (g_yoff >= 0) ? 1.f : 0.f;
#pragma unroll
      for (int i = 0; i < 8; ++i) w8[i] = __expf(-(float)lw[i] * vmf);
      float P8[8];
#pragma unroll
      for (int i = 0; i < 8; ++i) P8[i] = w8[i];
#pragma unroll
      for (int d = 8; d < 64; d <<= 1) {
#pragma unroll
        for (int i = 0; i < 8; ++i) { const float t = __shfl_up(P8[i], d); if (lane >= d) P8[i] *= t; }
      }
#pragma unroll
      for (int i = 0; i < 8; ++i) {
        const float kf = (float)k[i] * vmf, af = (float)a[i];
        const float kkv = kf * kkp[i] * inv;
        const float rP = __builtin_amdgcn_rcpf(P8[i]);
        const float Pex = P8[i] * __builtin_amdgcn_rcpf(w8[i]);
        be8[i] = pk2n(kkv * af * rP, kf * (1.f + (af - 1.f) * kap[i]) * rP);
        v8[i] = (float)v[i] * vmf;
        q8[i] = kkv * Pex;
        r8[i] = (float)rh[i] * Pex * rvalid;
        w8[i] = P8[i];
      }
      const uint4 rr = make_uint4(pk2n(r8[0], r8[1]), pk2n(r8[2], r8[3]), pk2n(r8[4], r8[5]), pk2n(r8[6], r8[7]));
      *(float4*)(s.w + c8) = make_float4(w8[0], w8[1], w8[2], w8[3]); *(float4*)(s.w + c8 + 4) = make_float4(w8[4], w8[5], w8[6], w8[7]);
      *(uint4*)(s.bke + c8) = make_uint4(be8[0], be8[1], be8[2], be8[3]); *(uint4*)(s.bke + c8 + 4) = make_uint4(be8[4], be8[5], be8[6], be8[7]);
      *(float4*)(s.vv + c8) = make_float4(v8[0], v8[1], v8[2], v8[3]); *(float4*)(s.vv + c8 + 4) = make_float4(v8[4], v8[5], v8[6], v8[7]);
      *(uint2*)(&s.ah[0][pp0]) = make_uint2(pk2n(q8[0], q8[1]), pk2n(q8[2], q8[3]));
      *(uint2*)(&s.ah[0][pp1]) = make_uint2(pk2n(q8[4], q8[5]), pk2n(q8[6], q8[7]));
      *(uint2*)(&s.ah[1][pp0]) = make_uint2(rr.x, rr.y);
      *(uint2*)(&s.ah[1][pp1]) = make_uint2(rr.z, rr.w);
      if (ca == 0) s.yoff = g_yoff;
    };
    typedef unsigned u32x4 __attribute__((ext_vector_type(4)));
    u32x4 R0_lw, R0_a, R0_k, R0_v, R0_r, R1_lw, R1_a, R1_k, R1_v, R1_r, R2_lw, R2_a, R2_k, R2_v, R2_r, R3_lw, R3_a, R3_k, R3_v, R3_r;
    float R0_inv, R1_inv, R2_inv, R3_inv; int R0_yoff, R1_yoff, R2_yoff, R3_yoff, R0_vm, R1_vm, R2_vm, R3_vm;
#define U4(x) make_uint4((x)[0], (x)[1], (x)[2], (x)[3])
#define LST(g, buf_) lstore(U4(g##_lw), U4(g##_a), U4(g##_k), U4(g##_v), U4(g##_r), g##_inv, g##_yoff, g##_vm, buf_)
    asm volatile("s_waitcnt vmcnt(0)" ::: "memory");
    LLOAD(0, R0); LLOAD(1, R1); LLOAD(2, R2); LLOAD(3, R3);
    LWAIT(R0); LST(R0, 0); LLOAD(4, R0);
    __syncthreads();
    h16* yout = p.Y2() + (size_t)dir * NR * 512 + h * 64 + part * (RGB * 16) + ca * 4;
    auto ystore = [&](int cj) {
      const int n = cj * 16 + st;
      if (n >= 1 && n <= SB) {
        const h16* yb = ybuf + ((cj & 1) * 32 + ca * 4) * 24 + st;
        const unsigned short a0 = __builtin_bit_cast(unsigned short, yb[0]), a1 = __builtin_bit_cast(unsigned short, yb[24]);
        const unsigned short a2 = __builtin_bit_cast(unsigned short, yb[48]), a3 = __builtin_bit_cast(unsigned short, yb[72]);
        typedef unsigned u32x2 __attribute__((ext_vector_type(2)));
        u32x2 u; u[0] = (unsigned)a0 | ((unsigned)a1 << 16); u[1] = (unsigned)a2 | ((unsigned)a3 << 16);
        h16* yp = yout + (size_t)maprow(dir, b, n - 1) * 512;
        asm volatile("global_store_dwordx2 %0, %1, off" : : "v"(yp), "v"(u) : "memory");
      }
    };
    for (int ci = 0; ci < NCHUNK; ci += 4) {
      if (ci > 0) ystore(ci - 1);
      LWAIT(R1); if (ci + 1 < NCHUNK) LST(R1, 1); LLOAD(ci + 5, R1);
      __syncthreads();
      if (ci + 1 < NCHUNK) { ystore(ci); LWAIT(R2); if (ci + 2 < NCHUNK) LST(R2, 0); LLOAD(ci + 6, R2); __syncthreads(); }
      if (ci + 2 < NCHUNK) { ystore(ci + 1); LWAIT(R3); if (ci + 3 < NCHUNK) LST(R3, 1); LLOAD(ci + 7, R3); __syncthreads(); }
      if (ci + 3 < NCHUNK) { ystore(ci + 2); LWAIT(R0); if (ci + 4 < NCHUNK) LST(R0, 0); LLOAD(ci + 8, R0); __syncthreads(); }
    }
    ystore(NCHUNK - 1);
    asm volatile("s_waitcnt vmcnt(0)" ::: "memory");
#undef LST
#undef U4
#undef LLOAD
#undef LWAIT
  } else {
    const int c = lane & 15, hq = lane >> 4;
    const int rg = part * RGB + wv;
    const bool h0 = (hq == 0);
    f32x4 ST[4];
#pragma unroll
    for (int t = 0; t < 4; ++t) ST[t] = (f32x4){0.f, 0.f, 0.f, 0.f};
    __builtin_amdgcn_s_setprio(3);
    __syncthreads();
    for (int ci = 0; ci < NCHUNK; ++ci) {
      const int buf = ci & 1;
#if PROBE == 211
      const unsigned long long ct0 = __builtin_amdgcn_s_memrealtime();
#endif
      float yv[16];
      h16x8 rA0[2], rA1[2]; float rvv[2]; unsigned rbe[2][4];
      {
        const Slot& t = sl[buf * 16];
        rA0[0] = *(const h16x8*)(&t.ah[c & 3][8 * hq]); rA1[0] = *(const h16x8*)(&t.ah[c & 3][32 + 8 * hq]);
        rvv[0] = t.vv[rg * 16 + c];
#pragma unroll
        for (int tt = 0; tt < 4; ++tt) rbe[0][tt] = t.bke[16 * tt + c];
      }
#pragma unroll
      for (int s = 0; s < 16; ++s) {
        const int cur = s & 1, nxt = cur ^ 1;
        uint4 sh0, sh1;
        sh0.x = pk2(ST[0][0], ST[0][1]); sh0.y = pk2(ST[0][2], ST[0][3]); sh0.z = pk2(ST[1][0], ST[1][1]); sh0.w = pk2(ST[1][2], ST[1][3]);
        sh1.x = pk2(ST[2][0], ST[2][1]); sh1.y = pk2(ST[2][2], ST[2][3]); sh1.z = pk2(ST[3][0], ST[3][1]); sh1.w = pk2(ST[3][2], ST[3][3]);
        const f32x4 z4 = {0.f, 0.f, 0.f, 0.f};
        f32x4 acc0 = __builtin_amdgcn_mfma_f32_16x16x32_f16(rA0[cur], __builtin_bit_cast(h16x8, sh0), z4, 0, 0, 0);
        f32x4 acc1 = __builtin_amdgcn_mfma_f32_16x16x32_f16(rA1[cur], __builtin_bit_cast(h16x8, sh1), z4, 0, 0, 0);
        f32x4 pe[4];
        if ((s & 7) == 7) {
#pragma unroll
          for (int tt = 0; tt < 4; ++tt) pe[tt] = *(const f32x4*)(sl[buf * 16 + s].w + 16 * tt + 4 * hq);
        }
        if (s + 1 < 16) {
          const Slot& t = sl[buf * 16 + s + 1];
          rA0[nxt] = *(const h16x8*)(&t.ah[c & 3][8 * hq]); rA1[nxt] = *(const h16x8*)(&t.ah[c & 3][32 + 8 * hq]);
          rvv[nxt] = t.vv[rg * 16 + c];
#pragma unroll
          for (int tt = 0; tt < 4; ++tt) rbe[nxt][tt] = t.bke[16 * tt + c];
        }
        __builtin_amdgcn_sched_barrier(0);
        yv[s] = acc0[1] + acc1[1];
        const float sa = -(acc0[0] + acc1[0]);
        const uint4 bu = make_uint4(h0 ? pk2(sa, rvv[cur]) : 0u, 0u, 0u, 0u);
#pragma unroll
        for (int tt = 0; tt < 4; ++tt) {
          const uint4 au = make_uint4(h0 ? rbe[cur][tt] : 0u, 0u, 0u, 0u);
          ST[tt] = __builtin_amdgcn_mfma_f32_16x16x32_f16(__builtin_bit_cast(h16x8, au), __builtin_bit_cast(h16x8, bu), ST[tt], 0, 0, 0);
        }
        if ((s & 7) == 7) {
#pragma unroll
          for (int tt = 0; tt < 4; ++tt) ST[tt] = ST[tt] * pe[tt];
        }
      }
      if (lane < 16) {
        uint4 u0, u1;
        u0.x = pk2n(yv[0], yv[1]); u0.y = pk2n(yv[2], yv[3]); u0.z = pk2n(yv[4], yv[5]); u0.w = pk2n(yv[6], yv[7]);
        u1.x = pk2n(yv[8], yv[9]); u1.y = pk2n(yv[10], yv[11]); u1.z = pk2n(yv[12], yv[13]); u1.w = pk2n(yv[14], yv[15]);
        h16* yr = ybuf + (buf * 32 + wv * 16 + c) * 24;
        *(uint4*)yr = u0; *(uint4*)(yr + 8) = u1;
      }
#if PROBE == 210
      const unsigned long long bt0 = __builtin_amdgcn_s_memrealtime();
#endif
      __syncthreads();
#if PROBE == 210
      if (job == 0 && tid == 0) g_tacc[0] += __builtin_amdgcn_s_memrealtime() - bt0;
#endif
    }
    __builtin_amdgcn_s_setprio(0);
  }
}

DEVI void gla_pre_job(const P& p, int l, int job, char* smem) {
  typedef short bf16x8 __attribute__((ext_vector_type(8)));
  float* lg = (float*)smem;
  float* gku = lg + 64 * 65;
  float* gkb = gku + 1024;
  float* tot = gkb + 64;
  unsigned short* qb = (unsigned short*)(tot + 256);
  unsigned short* kb = qb + 64 * 72;
  h16* vt = (h16*)(kb + 64 * 72);
  const int tid = tidx(), lane = tid & 63, wv = tid >> 6, l31 = lane & 31, hh = lane >> 5;
  const int chain = job / 68, ci = job - chain * 68;
  const int dir = chain >> 4, b = (chain >> 2) & 3, h = chain & 3;
  for (int i = tid; i < 1024; i += 256) gku[i] = p.gk_up[(((size_t)l * 2 + dir) * 16 + (i >> 6)) * 256 + h * 64 + (i & 63)];
  if (tid < 64) gkb[tid] = p.gk_b[((size_t)l * 2 + dir) * 256 + h * 64 + tid];
  const int ri = tid >> 2, dq = tid & 3;
  const int row = maprow(dir, b, ci * 64 + ri);
  const h16* zr = p.Z() + (size_t)row * ZW;
  uint4 q0 = *(const uint4*)(zr + h * 64 + dq * 16), q1 = *(const uint4*)(zr + h * 64 + dq * 16 + 8);
  uint4 k0 = *(const uint4*)(zr + 256 + h * 64 + dq * 16), k1 = *(const uint4*)(zr + 256 + h * 64 + dq * 16 + 8);
  uint4 g0 = *(const uint4*)(zr + 1024 + dir * 16), g1 = *(const uint4*)(zr + 1024 + dir * 16 + 8);
  {
    const h16* zv = zr + 512 + h * 128 + dq * 32;
#pragma unroll
    for (int c = 0; c < 4; ++c) {
      h16x8 vv = *(const h16x8*)(zv + c * 8);
#pragma unroll
      for (int j = 0; j < 8; ++j) vt[(dq * 32 + c * 8 + j) * 72 + ri] = vv[j];
    }
  }
  __syncthreads();
  {
    h16x8 gh0 = __builtin_bit_cast(h16x8, g0), gh1 = __builtin_bit_cast(h16x8, g1);
    float gd[16];
#pragma unroll
    for (int j = 0; j < 8; ++j) { gd[j] = (float)gh0[j]; gd[8 + j] = (float)gh1[j]; }
#pragma unroll 4
    for (int dd = 0; dd < 16; ++dd) {
      const int d = dq * 16 + dd;
      float xx = gkb[d];
#pragma unroll
      for (int r = 0; r < 16; ++r) xx += gd[r] * gku[r * 64 + d];
      float ls = fminf(xx, 0.f) - __logf(1.f + __expf(-fabsf(xx)));
      lg[ri * 65 + d] = ls * (1.f / 16.f);
    }
  }
  __syncthreads();
  {
    const int d = tid & 63, part = tid >> 6;
    float run = 0.f;
#pragma unroll 4
    for (int ii = 0; ii < 16; ++ii) { const int i = part * 16 + ii; run += lg[i * 65 + d]; lg[i * 65 + d] = run; }
    tot[part * 64 + d] = run;
  }
  __syncthreads();
  {
    h16x8 qh0 = __builtin_bit_cast(h16x8, q0), qh1 = __builtin_bit_cast(h16x8, q1), kh0 = __builtin_bit_cast(h16x8, k0), kh1 = __builtin_bit_cast(h16x8, k1);
    const int part = ri >> 4;
    unsigned qp[8], kp[8];
#pragma unroll
    for (int j = 0; j < 8; ++j) {
      unsigned qq[2], kk2[2];
#pragma unroll
      for (int e = 0; e < 2; ++e) {
        const int dd = 2 * j + e, d = dq * 16 + dd;
        float off = 0.f;
        if (part > 0) off += tot[d];
        if (part > 1) off += tot[64 + d];
        if (part > 2) off += tot[128 + d];
        const float bb = lg[ri * 65 + d] + off;
        const float qv = dd < 8 ? (float)qh0[dd & 7] : (float)qh1[dd & 7];
        const float kv = dd < 8 ? (float)kh0[dd & 7] : (float)kh1[dd & 7];
        qq[e] = f2bf(qv * __expf(bb) * 0.125f);
        kk2[e] = f2bf(kv * __expf(-bb));
      }
      qp[j] = qq[0] | (qq[1] << 16); kp[j] = kk2[0] | (kk2[1] << 16);
    }
    const uint4 qa = make_uint4(qp[0], qp[1], qp[2], qp[3]), qc = make_uint4(qp[4], qp[5], qp[6], qp[7]);
    const uint4 ka = make_uint4(kp[0], kp[1], kp[2], kp[3]), kc = make_uint4(kp[4], kp[5], kp[6], kp[7]);
    *(uint4*)(qb + ri * 72 + dq * 16) = qa; *(uint4*)(qb + ri * 72 + dq * 16 + 8) = qc;
    *(uint4*)(kb + ri * 72 + dq * 16) = ka; *(uint4*)(kb + ri * 72 + dq * 16 + 8) = kc;
    unsigned short* qd = p.QIN() + ((size_t)dir * NR + row) * 256 + h * 64 + dq * 16;
    unsigned short* kd = p.KIN() + ((size_t)dir * NR + row) * 256 + h * 64 + dq * 16;
    *(uint4*)qd = qa; *(uint4*)(qd + 8) = qc;
    *(uint4*)kd = ka; *(uint4*)(kd + 8) = kc;
    if (tid < 64) p.DEC()[((size_t)chain * 68 + ci) * 64 + tid] = __expf(tot[tid] + tot[64 + tid] + tot[128 + tid] + tot[192 + tid]);
  }
  __syncthreads();
  const int it = wv & 1, jh = wv >> 1;
  f32x16 o0, o1;
#pragma unroll
  for (int r = 0; r < 16; ++r) { o0[r] = 0.f; o1[r] = 0.f; }
  bf16x8 qf[4];
#pragma unroll
  for (int ks = 0; ks < 4; ++ks) qf[ks] = *(const bf16x8*)(qb + (it * 32 + l31) * 72 + ks * 16 + hh * 8);
#pragma unroll
  for (int st = 0; st < 2; ++st) {
    if (st > it) continue;
    f32x16 at;
#pragma unroll
    for (int r = 0; r < 16; ++r) at[r] = 0.f;
#pragma unroll
    for (int ks = 0; ks < 4; ++ks) {
      bf16x8 kf = *(const bf16x8*)(kb + (st * 32 + l31) * 72 + ks * 16 + hh * 8);
      at = __builtin_amdgcn_mfma_f32_32x32x16_bf16(kf, qf[ks], at, 0, 0, 0);
    }
    if (st == it) {
#pragma unroll
      for (int r = 0; r < 16; ++r) { const int sl = (r & 3) + 8 * (r >> 2) + 4 * hh; if (sl > l31) at[r] = 0.f; }
    }
    const h16* vs = vt + (jh * 64 + l31) * 72 + st * 32 + 4 * hh;
#pragma unroll
    for (int s2 = 0; s2 < 2; ++s2) {
      uint4 pu;
      pu.x = pk2n(at[8 * s2], at[8 * s2 + 1]); pu.y = pk2n(at[8 * s2 + 2], at[8 * s2 + 3]);
      pu.z = pk2n(at[8 * s2 + 4], at[8 * s2 + 5]); pu.w = pk2n(at[8 * s2 + 6], at[8 * s2 + 7]);
      const h16x8 pf = __builtin_bit_cast(h16x8, pu);
      const uint2 va = *(const uint2*)(vs + 16 * s2), vb = *(const uint2*)(vs + 16 * s2 + 8);
      const uint2 vc = *(const uint2*)(vs + 32 * 72 + 16 * s2), vd = *(const uint2*)(vs + 32 * 72 + 16 * s2 + 8);
      o0 = __builtin_amdgcn_mfma_f32_32x32x16_f16(__builtin_bit_cast(h16x8, make_uint4(va.x, va.y, vb.x, vb.y)), pf, o0, 0, 0, 0);
      o1 = __builtin_amdgcn_mfma_f32_32x32x16_f16(__builtin_bit_cast(h16x8, make_uint4(vc.x, vc.y, vd.x, vd.y)), pf, o1, 0, 0, 0);
    }
  }
  {
    const int orow = maprow(dir, b, ci * 64 + it * 32 + l31);
    h16* od = p.OFB() + ((size_t)dir * NR + orow) * 512 + h * 128 + jh * 64 + 4 * hh;
#pragma unroll
    for (int g = 0; g < 4; ++g) {
      st4h(od + 8 * g, o0[4 * g], o0[4 * g + 1], o0[4 * g + 2], o0[4 * g + 3]);
      st4h(od + 32 + 8 * g, o1[4 * g], o1[4 * g + 1], o1[4 * g + 2], o1[4 * g + 3]);
    }
  }
  __syncthreads();
}

DEVI void gla_job(const P& p, int l, int job, char* smem) {
  float* qi = (float*)smem;
  float* ki = qi + 64 * 65;
  float* vs = ki + 64 * 65;
  float* Ss = vs + 64 * 33;
  const int tid = tidx();
  const int dvs = job & 3, chain = job >> 2;
  const int dir = chain >> 4, b = (chain >> 2) & 3, h = chain & 3;
  for (int i = tid; i < 64 * 33; i += 256) Ss[i] = 0.f;
  const int ri = tid >> 2, dq = tid & 3;
  const int t2 = tid >> 3, tj = tid & 7;
  h16* Od = p.OFB() + (size_t)dir * NR * 512 + h * 128 + dvs * 32;
  const unsigned short* Qg = p.QIN() + (size_t)dir * NR * 256 + h * 64 + dq * 16;
  const unsigned short* Kg = p.KIN() + (size_t)dir * NR * 256 + h * 64 + dq * 16;
  const float* Dg = p.DEC() + (size_t)chain * 68 * 64 + 2 * t2;
  uint4 gq0, gq1, gk0, gk1, gv; uint2 goa, gob; float gd0, gd1;
  auto pre = [&](int ci) {
    const int row = maprow(dir, b, ci * 64 + ri);
    gq0 = *(const uint4*)(Qg + (size_t)row * 256); gq1 = *(const uint4*)(Qg + (size_t)row * 256 + 8);
    gk0 = *(const uint4*)(Kg + (size_t)row * 256); gk1 = *(const uint4*)(Kg + (size_t)row * 256 + 8);
    gv = *(const uint4*)(p.Z() + (size_t)row * ZW + 512 + h * 128 + dvs * 32 + dq * 8);
    const int rowa = maprow(dir, b, ci * 64 + 2 * t2), rowb = maprow(dir, b, ci * 64 + 2 * t2 + 1);
    goa = *(const uint2*)(Od + (size_t)rowa * 512 + 4 * tj); gob = *(const uint2*)(Od + (size_t)rowb * 512 + 4 * tj);
    gd0 = Dg[ci * 64]; gd1 = Dg[ci * 64 + 1];
  };
  pre(0);
  __syncthreads();
  for (int ci = 0; ci < SB / 64; ++ci) {
    {
      const unsigned qa[8] = {gq0.x, gq0.y, gq0.z, gq0.w, gq1.x, gq1.y, gq1.z, gq1.w};
      const unsigned ka[8] = {gk0.x, gk0.y, gk0.z, gk0.w, gk1.x, gk1.y, gk1.z, gk1.w};
#pragma unroll
      for (int j = 0; j < 8; ++j) {
        qi[ri * 65 + dq * 16 + 2 * j] = __builtin_bit_cast(float, qa[j] << 16); qi[ri * 65 + dq * 16 + 2 * j + 1] = __builtin_bit_cast(float, qa[j] & 0xffff0000u);
        ki[ri * 65 + dq * 16 + 2 * j] = __builtin_bit_cast(float, ka[j] << 16); ki[ri * 65 + dq * 16 + 2 * j + 1] = __builtin_bit_cast(float, ka[j] & 0xffff0000u);
      }
      h16x8 vh = __builtin_bit_cast(h16x8, gv);
#pragma unroll
      for (int j = 0; j < 8; ++j) vs[ri * 33 + dq * 8 + j] = (float)vh[j];
    }
    const uint2 oia = goa, oib = gob; const float e0 = gd0, e1 = gd1;
    const int rowa = maprow(dir, b, ci * 64 + 2 * t2), rowb = maprow(dir, b, ci * 64 + 2 * t2 + 1);
    if (ci + 1 < SB / 64) pre(ci + 1);
    __syncthreads();
    {
      h16x4 ha = __builtin_bit_cast(h16x4, oia), hb = __builtin_bit_cast(h16x4, oib);
      float a0[4], a1[4];
#pragma unroll
      for (int y = 0; y < 4; ++y) { a0[y] = (float)ha[y]; a1[y] = (float)hb[y]; }
#pragma unroll 4
      for (int d = 0; d < 64; ++d) {
        const float x0 = qi[(2 * t2) * 65 + d], x1 = qi[(2 * t2 + 1) * 65 + d];
#pragma unroll
        for (int y = 0; y < 4; ++y) { const float v = Ss[d * 33 + 4 * tj + y]; a0[y] += x0 * v; a1[y] += x1 * v; }
      }
      st4h(Od + (size_t)rowa * 512 + 4 * tj, a0[0], a0[1], a0[2], a0[3]);
      st4h(Od + (size_t)rowb * 512 + 4 * tj, a1[0], a1[1], a1[2], a1[3]);
    }
    __syncthreads();
    {
      float a0[4], a1[4];
#pragma unroll
      for (int y = 0; y < 4; ++y) { a0[y] = Ss[(2 * t2) * 33 + 4 * tj + y]; a1[y] = Ss[(2 * t2 + 1) * 33 + 4 * tj + y]; }
#pragma unroll 4
      for (int s2 = 0; s2 < 64; ++s2) {
        const float x0 = ki[s2 * 65 + 2 * t2], x1 = ki[s2 * 65 + 2 * t2 + 1];
#pragma unroll
        for (int y = 0; y < 4; ++y) { const float v = vs[s2 * 33 + 4 * tj + y]; a0[y] += x0 * v; a1[y] += x1 * v; }
      }
#pragma unroll
      for (int y = 0; y < 4; ++y) { Ss[(2 * t2) * 33 + 4 * tj + y] = a0[y] * e0; Ss[(2 * t2 + 1) * 33 + 4 * tj + y] = a1[y] * e1; }
    }
    __syncthreads();
  }
}

DEVI void mixer_phase(const P& p, int l, char* smem, int cslot, int mode = 0, int role = -1, int rank = 0) {
  if (role < 0) role = blockIdx.x;
#if PROBE >= 200
  unsigned long long pt0 = __builtin_amdgcn_s_memrealtime();
#endif
  __shared__ int4 sjobv;
  int& sjob = sjobv.x;
  for (int j = role; j < NSCAN + NGLA; j += gridDim.x) {
    if (mode == 1 && j >= NSCAN) break;
    if (mode == 2 && j < NSCAN) continue;
    if (j < NSCAN) {
      scan_job(p, l, j, smem, 0);
    }
    else gla_job(p, l, j - NSCAN, smem);
    __syncthreads();
#if PROBE == 200
    if (role == 0 && tidx() == 0) g_tacc[0] += __builtin_amdgcn_s_memrealtime() - pt0;
#endif
#if PROBE == 201
    if (role == NSCAN && tidx() == 0) g_tacc[0] += __builtin_amdgcn_s_memrealtime() - pt0;
#endif
  }
  if (mode == 1) return;
  const int njobs = (l < DEPTH - 1) ? 1024 + 64 : 1024;
  while (true) {
    if (tidx() == 0) sjob = (int)atomicAdd(p.CTR() + cslot, 1u);
    __syncthreads();
    const int j = sjob;
    __syncthreads();
    if (j >= njobs) break;
    attn_job(p, j, smem);
  }
#if PROBE == 202
  if (role == 300 && tidx() == 0) g_tacc[0] += __builtin_amdgcn_s_memrealtime() - pt0;
#endif
}

DEVI void post_phase(const P& p, int l) {
  const int lane = tidx() & 63;
  const int wid = blockIdx.x * 4 + (tidx() >> 6), nw = gridDim.x * 4;
  const int c8 = lane * 8;
  for (int r = wid; r < NR; r += nw) {
    {
      h16* zr = p.Z() + (size_t)r * ZW + ZRW + c8;
      h16x8 yf = *(const h16x8*)(p.Y2() + (size_t)r * 512 + c8), yb = *(const h16x8*)(p.Y2() + (size_t)(NR + r) * 512 + c8);
      h16x8 rr = *(const h16x8*)zr, kk = *(const h16x8*)(zr + 512), vv = *(const h16x8*)(zr + 1024);
      h16x8 af = *(const h16x8*)(p.AA() + (size_t)r * 512 + c8), ab = *(const h16x8*)(p.AA() + (size_t)(NR + r) * 512 + c8);
      h16x8 gg = *(const h16x8*)(p.G() + (size_t)r * 512 + c8);
      float y[8], sm = 0.f;
#pragma unroll
      for (int i = 0; i < 8; ++i) { y[i] = (float)yf[i] + (float)yb[i]; sm += y[i]; }
      sm += __shfl_xor(sm, 1); sm += __shfl_xor(sm, 2); sm += __shfl_xor(sm, 4);
      const float mean = sm * (1.f / 64.f);
      float sq = 0.f;
#pragma unroll
      for (int i = 0; i < 8; ++i) { y[i] -= mean; sq += y[i] * y[i]; }
      sq += __shfl_xor(sq, 1); sq += __shfl_xor(sq, 2); sq += __shfl_xor(sq, 4);
      const float rs = rsqrtf(sq * (1.f / 64.f) + 64e-5f);
      const float* ka = p.k_a + l * 512 + c8; const float* rk = p.r_k + l * 512 + c8;
      const float* lg = p.rln_g + l * 512 + c8; const float* lb = p.rln_b + l * 512 + c8;
      float bs = 0.f;
#pragma unroll
      for (int i = 0; i < 8; ++i) {
        const float kf = (float)kk[i], kav = ka[i];
        const float ke = kf * (1.f + ((float)af[i] - 1.f) * kav) + kf * (1.f + ((float)ab[i] - 1.f) * kav);
        bs += (float)rr[i] * ke * rk[i];
      }
      bs += __shfl_xor(bs, 1); bs += __shfl_xor(bs, 2); bs += __shfl_xor(bs, 4);
      float o[8];
#pragma unroll
      for (int i = 0; i < 8; ++i) o[i] = (y[i] * rs * lg[i] + lb[i] + bs * (float)vv[i]) * (float)gg[i];
      uint4 u; u.x = pk2n(o[0], o[1]); u.y = pk2n(o[2], o[3]); u.z = pk2n(o[4], o[5]); u.w = pk2n(o[6], o[7]);
      *(uint4*)zr = u;
    }
    {
      h16x8 of = *(const h16x8*)(p.OFB() + (size_t)r * 512 + c8), ob = *(const h16x8*)(p.OFB() + (size_t)(NR + r) * 512 + c8);
      h16x8 og = *(const h16x8*)(p.Z() + (size_t)r * ZW + 1056 + c8);
      float o[8], sq = 0.f;
#pragma unroll
      for (int i = 0; i < 8; ++i) { o[i] = (float)of[i] + (float)ob[i]; sq += o[i] * o[i]; }
      sq += __shfl_xor(sq, 1); sq += __shfl_xor(sq, 2); sq += __shfl_xor(sq, 4); sq += __shfl_xor(sq, 8);
      const float rs = rsqrtf(sq * (1.f / 128.f) + 1e-6f);
      const float* ng = p.gla_ng + l * 128 + (c8 & 127);
#pragma unroll
      for (int i = 0; i < 8; ++i) { const float g = (float)og[i]; o[i] = o[i] * rs * ng[i] * (g * sigm(g)); }
      uint4 u; u.x = pk2n(o[0], o[1]); u.y = pk2n(o[2], o[3]); u.z = pk2n(o[4], o[5]); u.w = pk2n(o[6], o[7]);
      *(uint4*)(p.YA() + (size_t)r * ZW + c8) = u;
    }
  }
}

DEVI void merge_phase(const P& p, char* smem) {
  constexpr int MT = NR / 128, NT = 16;
  const int lane = tidx() & 63, wv = tidx() >> 6;
  const int wm = wv >> 1, wn = wv & 1, l31 = lane & 31, hh = lane >> 5;
  for (int job = blockIdx.x; job < MT * NT; job += gridDim.x) {
    int nt = job / MT, mt = job - nt * MT;
    float out[2][16];
#pragma unroll
    for (int a = 0; a < 2; ++a)
#pragma unroll
      for (int r = 0; r < 16; ++r) out[a][r] = 0.f;
#pragma unroll 1
    for (int br = 0; br < 3; ++br) {
      const h16* Y = br == 0 ? p.YA() : (br == 1 ? p.Z() + ZMLA : p.Z() + ZRW);
      const int ldy = ZW;
      f32x16 acc[2][1];
#pragma unroll
      for (int a = 0; a < 2; ++a)
#pragma unroll
        for (int r = 0; r < 16; ++r) acc[a][0][r] = 0.f;
      gemm_deep<1>(Y, ldy, p.WB() + (size_t)br * D * 512, 512, 512, mt * 128, nt * 64, D, smem, acc);
      float u[2][16];
#pragma unroll
      for (int a = 0; a < 2; ++a)
#pragma unroll
        for (int r = 0; r < 16; ++r) { u[a][r] = acc[a][0][r]; acc[a][0][r] = 0.f; }
      gemm_deep<1>(p.H(), D, p.WIN() + (size_t)(ZW + br * D) * D, D, D, mt * 128, nt * 64, D, smem, acc);
#pragma unroll
      for (int a = 0; a < 2; ++a)
#pragma unroll
        for (int r = 0; r < 16; ++r) out[a][r] += sigm(acc[a][0][r]) * u[a][r];
    }
#pragma unroll
    for (int a = 0; a < 2; ++a)
#pragma unroll
      for (int g = 0; g < 4; ++g)
        st4h(p.M() + (size_t)(mt * 128 + wm * 64 + a * 32 + l31) * D + nt * 64 + wn * 32 + 8 * g + 4 * hh, out[a][4 * g], out[a][4 * g + 1],
             out[a][4 * g + 2], out[a][4 * g + 3]);
  }
}

DEVI void resid_gemm_phase(const P& p, int l, const h16* A, int K, const h16* Bt, int gate_idx, char* smem) {
  constexpr int MT = NR / 128, NT = 8;
  const float alpha = 1.6817928305074290f;
  for (int job = blockIdx.x; job < MT * NT; job += gridDim.x) {
    int nt = job / MT, mt = job - nt * MT;
    f32x16 acc[2][2]; zero_acc(acc);
    gemm_deep<2>(A, K, Bt, K, K, mt * 128, nt * 128, D, smem, acc);
    epi_quads(acc, mt * 128, nt * 128, [&](int m, int n, float v0, float v1, float v2, float v3) {
      int b = m / SB, s = m - b * SB;
      int g = s < CTX ? 4 : b;
      float4 gt = *(const float4*)(p.MOD() + ((size_t)l * 5 + g) * 6144 + gate_idx * D + n);
      float* xp = xrow(p, m) + n;
      float4 xv = *(float4*)xp;
      xv.x = alpha * xv.x + gt.x * v0; xv.y = alpha * xv.y + gt.y * v1; xv.z = alpha * xv.z + gt.z * v2; xv.w = alpha * xv.w + gt.w * v3;
      *(float4*)xp = xv;
    });
  }
}
DEVI void mlp1_phase(const P& p, char* smem) {
  constexpr int MT = NR / 128, NT = DFF / 128;
  h16* HID = p.Z();
  for (int job = blockIdx.x; job < MT * NT; job += gridDim.x) {
    int nt = job / MT, mt = job - nt * MT;
    f32x16 acc[2][2]; zero_acc(acc);
    gemm_deep<2>(p.H(), D, p.W1T(), D, D, mt * 128, nt * 128, DFF, smem, acc);
    epi_quads(acc, mt * 128, nt * 128, [&](int m, int n, float v0, float v1, float v2, float v3) {
      v0 = fmaxf(v0, 0.f); v1 = fmaxf(v1, 0.f); v2 = fmaxf(v2, 0.f); v3 = fmaxf(v3, 0.f);
      st4h(HID + (size_t)m * DFF + n, v0 * v0, v1 * v1, v2 * v2, v3 * v3);
    });
  }
}

constexpr int PH_PER_LAYER = 11;
constexpr int NPHASES = 1 + DEPTH * PH_PER_LAYER + 1;

DEVI void run_phase(const P& p, int ph, char* smem, int role, int rank) {
  if (ph == 0) { phase0(p, smem); return; }
  if (ph == NPHASES - 1) { ln_phase(p, DEPTH, 2); return; }
  const int l = (ph - 1) / PH_PER_LAYER, k = (ph - 1) - l * PH_PER_LAYER;
  switch (k) {
    case 0: ln_phase(p, l, 0); conv_phase(p, l, 0, 12, smem); break;
    case 1: inproj_phase(p, smem);
#if PROBE == 2
      inproj_phase(p, smem);
#endif
      break;
    case 2: {
      constexpr int NPRE = 32 * 68, NSH = (NR / 64) * 8, NUP = (NR / 128) * 14;
      for (int j = blockIdx.x; j < NPRE + NSH + NUP; j += gridDim.x) {
        if (j < NPRE) gla_pre_job(p, l, j, smem);
        else if (j < NPRE + NSH) shift_job(p, l, j - NPRE, smem);
        else mla_up_job(p, j - NPRE - NSH, smem);
        __syncthreads();
      }
    } break;
    case 3: {
      constexpr int NLR = 5 * 4 * (NR / 128);
      for (int j = blockIdx.x; j < NLR; j += gridDim.x) { lowrank_job(p, l, j, smem); __syncthreads(); }
    } break;
    case 4: mixer_phase(p, l, smem, l, 0, role, rank);
#if PROBE == 1
      mixer_phase(p, l, smem, 8 + l);
#endif
      break;
    case 5: post_phase(p, l); break;
    case 6: merge_phase(p, smem); conv_phase(p, l, 12, 14, smem); break;
    case 7: resid_gemm_phase(p, l, p.M(), D, p.WO(), 2, smem); break;
    case 8: ln_phase(p, l, 1); break;
    case 9: mlp1_phase(p, smem);
#if PROBE == 2
      mlp1_phase(p, smem);
#endif
      break;
    default: resid_gemm_phase(p, l, p.Z(), DFF, p.W2T(), 5, smem); break;
  }
}

__global__ void __launch_bounds__(256, 2) mega(P p, int pb, int pe) {
  extern __shared__ __attribute__((aligned(16))) char smem[];
  cg::grid_group grid = cg::this_grid();
  __shared__ uint4 xb_words;
  if (threadIdx_x_raw() == 0) xb_words = make_uint4(0u, 0u, 0u, 0u);
  __syncthreads();
  XcdBarrier xb = xcd_barrier_post(p.BAR(), (volatile LAS unsigned*)&xb_words);
  __shared__ int4 rolev;
  unsigned* cut = p.BAR() + 3584;
  if (threadIdx_x_raw() == 0) {
    const unsigned key = (xb_xcc_id() << 8) | ((unsigned)__builtin_amdgcn_s_getreg((7 << 11) | (8 << 6) | 4) & 0xffu);
    const unsigned rank = xb_add(cut + key, 1u);
    if (rank == 0u) { const unsigned ord = xb_add(cut + 8192, 1u); __hip_atomic_store(cut + 4096 + key, ord, __ATOMIC_RELAXED, __HIP_MEMORY_SCOPE_AGENT); }
    if (rank >= 2u) xb_add(cut + 8193, 1u);
    rolev = make_int4((int)blockIdx.x, 0, (int)key, (int)rank);
  }
  __syncthreads();
#if PROBE >= 100
  unsigned long long tacc = 0;
#endif
#if PROBE >= 200
  if (blockIdx.x == 0 && threadIdx_x_raw() == 0) g_tacc[0] = 0;
#endif
  for (int ph = pb; ph < pe; ++ph) {
    if (ph > pb) {
      if (ph == pb + 1) {
        grid.sync();
        if (threadIdx_x_raw() == 0) {
          const unsigned key = (unsigned)rolev.z, rank = (unsigned)rolev.w;
          const unsigned ord = xb_ld(cut + 4096 + key), ncu = xb_ld(cut + 8192), bad = xb_ld(cut + 8193);
          if (bad == 0u && 2u * ncu == gridDim.x && rank < 2u && ncu >= 256u) {
            if (ord < 128u) rolev.x = rank == 0u ? (int)ord : (int)(256u + ord);
            else if (ord < 192u) rolev.x = (int)(128u + 2u * (ord - 128u) + rank);
            else rolev.x = (int)(384u + 2u * (ord - 192u) + rank);
            rolev.y = 1;
          }
        }
        __syncthreads();
      } else xcd_barrier(xb);
    }
#if PROBE == 6
    if (ph >= 1 && ph < NPHASES - 1 && ((ph - 1) % PH_PER_LAYER) == 4) {
      const int l = (ph - 1) / PH_PER_LAYER;
      mixer_phase(p, l, smem, l, 1);
      xcd_barrier(xb);
      mixer_phase(p, l, smem, l, 1);
      xcd_barrier(xb);
      mixer_phase(p, l, smem, l, 2);
      continue;
    }
#endif
#if PROBE >= 100
    const bool tph = (ph >= 1 && ph < NPHASES - 1 && ((ph - 1) % PH_PER_LAYER) == (PROBE - 100));
    unsigned long long t0 = 0;
    if (tph && blockIdx.x == 0) t0 = __builtin_amdgcn_s_memrealtime();
#endif
    run_phase(p, ph, smem, rolev.x, rolev.y);
#if PROBE >= 100
    if (tph) { xcd_barrier(xb); if (blockIdx.x == 0) tacc += __builtin_amdgcn_s_memrealtime() - t0; }
#endif
  }
#if PROBE >= 100
#if PROBE == 300
  if (blockIdx.x == 0) { const unsigned long long te = __builtin_amdgcn_s_memrealtime() + (rolev.w == 1000 ? 300000ull : (rolev.w == 2001 ? 600000ull : 900000ull)); while (__builtin_amdgcn_s_memrealtime() < te) __builtin_amdgcn_s_sleep(8); }
#elif PROBE >= 200
  {
    __syncthreads();
    const unsigned long long ta = g_tacc[0];
    if (ta) { const unsigned long long te = __builtin_amdgcn_s_memrealtime() + 4ull * ta; while (__builtin_amdgcn_s_memrealtime() < te) __builtin_amdgcn_s_sleep(8); }
  }
#else
  if (blockIdx.x == 0) { const unsigned long long te = __builtin_amdgcn_s_memrealtime() + 4ull * tacc; while (__builtin_amdgcn_s_memrealtime() < te) __builtin_amdgcn_s_sleep(8); }
#endif
#endif
}

extern "C" void kernel_launch(void* const* d_in, const int* in_sizes, int n_in, void* d_out, int out_size, void* d_ws,
                              size_t ws_size, hipStream_t stream) {
  static int grid_blocks = 0;
  if (grid_blocks == 0) {
    int dev = 0, cus = 0, per_cu = 0;
    hipGetDevice(&dev);
    hipDeviceGetAttribute(&cus, hipDeviceAttributeMultiprocessorCount, dev);
    hipFuncSetAttribute((const void*)mega, hipFuncAttributeMaxDynamicSharedMemorySize, LDS_BYTES);
    hipOccupancyMaxActiveBlocksPerMultiprocessor(&per_cu, (const void*)mega, 256, LDS_BYTES);
    if (per_cu < 1) per_cu = 1;
    if (per_cu > 2) per_cu = 2;
    grid_blocks = cus * per_cu;
    fprintf(stderr, "mega: cus %d per_cu %d grid %d\n", cus, per_cu, grid_blocks);
  }
  P p{};
  const float** ins = (const float**)&p;
  for (int i = 0; i < 33; ++i) ins[i] = (const float*)d_in[i];
  p.XL = (float*)d_out;
  p.ws = (char*)d_ws;
  const size_t off = WS_TOTAL;
  if (off > ws_size || n_in != 33) { fprintf(stderr, "mega: workspace too small (%zu > %zu) or n_in %d\n", off, ws_size, n_in); return; }
  (void)hipMemsetAsync((char*)d_ws + OFF_BAR, 0, BAR_BYTES, stream);
  int pb = 0, pe = NPHASES;
  void* args[] = {&p, &pb, &pe};
  hipError_t e = hipLaunchCooperativeKernel((const void*)mega, dim3(grid_blocks), dim3(256), args, LDS_BYTES, stream);
  if (e != hipSuccess) fprintf(stderr, "mega: cooperative launch failed: %s (grid %d)\n", hipGetErrorString(e), grid_blocks);
}
```

```cpp
#include <hip/hip_runtime.h>
#include <hip/hip_cooperative_groups.h>
#include <cstdio>
#include <cstdint>
namespace cg = cooperative_groups;

typedef _Float16 h16;
typedef _Float16 h16x8 __attribute__((ext_vector_type(8)));
typedef _Float16 h16x4 __attribute__((ext_vector_type(4)));
typedef float f32x16 __attribute__((ext_vector_type(16)));
typedef float f32x4 __attribute__((ext_vector_type(4)));

#define DEVI __device__ __forceinline__
DEVI int threadIdx_x_raw() { return (int)__builtin_amdgcn_workitem_id_x(); }

#define PROBE 0
constexpr int D = 1024, NB = 4, SEQ = 4096, CTX = 256, DEPTH = 4;
constexpr int SB = SEQ + CTX;
constexpr int NR = NB * SB;
constexpr int ZW = 4160;
constexpr int ZMLA = 1568, ZRW = 2240;
constexpr int NIN = 7232;
constexpr int DFF = 4096;
constexpr int LDS_BYTES = 74752;
constexpr int NSCAN_BPC = 2;
constexpr int NSCAN = 64 * NSCAN_BPC;
constexpr int NGLA = 128;
constexpr int TSTEPS = SB + 1;
constexpr int NCHUNK = (TSTEPS + 15) / 16;

constexpr size_t al256(size_t x) { return (x + 255) & ~(size_t)255; }
constexpr size_t OFF_XC = 0;
constexpr size_t OFF_MOD = OFF_XC + al256((size_t)NB * CTX * D * 4);
constexpr size_t OFF_ROPE = OFF_MOD + al256((size_t)DEPTH * 5 * 6144 * 4);
constexpr size_t OFF_INVN = OFF_ROPE + al256((size_t)SEQ * 32 * 4);
constexpr size_t OFF_CTR = OFF_INVN + al256((size_t)NR * 8 * 4);
constexpr size_t OFF_BAR = OFF_CTR + al256(256);
constexpr size_t BAR_BYTES = (size_t)(3584 + 4096 + 4096 + 64) * 4;
constexpr size_t OFF_HLO = OFF_BAR + al256(BAR_BYTES);
constexpr size_t OFF_HHI = OFF_HLO + al256((size_t)(NR / 64) * 1920 * 2);
constexpr size_t OFF_H = OFF_HHI + al256((size_t)(NR / 64) * 1920 * 2);
constexpr size_t OFF_Z = OFF_H + al256((size_t)NR * D * 2);
constexpr size_t OFF_WIN = OFF_Z + al256((size_t)NR * ZW * 2);
constexpr size_t OFF_UQ = OFF_WIN + al256((size_t)NIN * D * 2);
constexpr size_t OFF_UKV = OFF_UQ + al256((size_t)768 * 384 * 2);
constexpr size_t OFF_WB = OFF_UKV + al256((size_t)1024 * 256 * 2);
constexpr size_t OFF_WO = OFF_WB + al256((size_t)3 * D * 512 * 2);
constexpr size_t OFF_WUP = OFF_WO + al256((size_t)D * D * 2);
constexpr size_t OFF_AUP = OFF_WUP + al256((size_t)2 * 512 * 64 * 2);
constexpr size_t OFF_GUP = OFF_AUP + al256((size_t)2 * 512 * 64 * 2);
constexpr size_t OFF_LW = OFF_GUP + al256((size_t)512 * 128 * 2);
constexpr size_t OFF_AA = OFF_LW + al256((size_t)2 * NR * 512 * 2);
constexpr size_t OFF_G = OFF_AA + al256((size_t)2 * NR * 512 * 2);
constexpr size_t OFF_Y2 = OFF_G + al256((size_t)NR * 512 * 2);
constexpr size_t OFF_Q = OFF_Y2 + al256((size_t)2 * NR * 512 * 2);
constexpr size_t OFF_K = OFF_Q + al256((size_t)NR * 768 * 2);
constexpr size_t OFF_VT = OFF_K + al256((size_t)NR * 768 * 2);
constexpr size_t OFF_QIN = OFF_VT + al256((size_t)NR * 512 * 2);
constexpr size_t OFF_KIN = OFF_QIN + al256((size_t)2 * NR * 256 * 2);
constexpr size_t OFF_DEC = OFF_KIN + al256((size_t)2 * NR * 256 * 2);
constexpr size_t OFF_OFB = OFF_DEC + al256((size_t)32 * 68 * 64 * 4);
constexpr size_t WS_TOTAL = OFF_OFB + al256((size_t)2 * NR * 512 * 2);
struct P {
  const float *x, *c, *ctx, *c_ctx, *ada_w, *ada_b, *w_in, *gk_up, *gk_b, *gla_ng, *qn_g, *kvn_g, *w_uq, *w_ukv,
      *mu, *w0, *w_up, *a0, *a_up, *g_up, *k_k, *k_a, *r_k, *rln_g, *rln_b, *w_branch, *w_out, *ln1_g, *ln1_b,
      *w1, *w2, *ln2_g, *ln2_b;
  float* XL;
  char* ws;
  DEVI float* XC() const { return (float*)(ws + OFF_XC); }
  DEVI float* MOD() const { return (float*)(ws + OFF_MOD); }
  DEVI float* ROPE() const { return (float*)(ws + OFF_ROPE); }
  DEVI float* INVN() const { return (float*)(ws + OFF_INVN); }
  DEVI unsigned* CTR() const { return (unsigned*)(ws + OFF_CTR); }
  DEVI unsigned* BAR() const { return (unsigned*)(ws + OFF_BAR); }
  DEVI h16* HLO() const { return (h16*)(ws + OFF_HLO); }
  DEVI h16* HHI() const { return (h16*)(ws + OFF_HHI); }
  DEVI h16* H() const { return (h16*)(ws + OFF_H); }
  DEVI h16* Z() const { return (h16*)(ws + OFF_Z); }
  DEVI h16* WIN() const { return (h16*)(ws + OFF_WIN); }
  DEVI h16* UQ() const { return (h16*)(ws + OFF_UQ); }
  DEVI h16* UKV() const { return (h16*)(ws + OFF_UKV); }
  DEVI h16* WB() const { return (h16*)(ws + OFF_WB); }
  DEVI h16* WO() const { return (h16*)(ws + OFF_WO); }
  DEVI h16* WUP() const { return (h16*)(ws + OFF_WUP); }
  DEVI h16* AUP() const { return (h16*)(ws + OFF_AUP); }
  DEVI h16* GUP() const { return (h16*)(ws + OFF_GUP); }
  DEVI h16* LW() const { return (h16*)(ws + OFF_LW); }
  DEVI h16* AA() const { return (h16*)(ws + OFF_AA); }
  DEVI h16* G() const { return (h16*)(ws + OFF_G); }
  DEVI h16* Y2() const { return (h16*)(ws + OFF_Y2); }
  DEVI h16* Q() const { return (h16*)(ws + OFF_Q); }
  DEVI h16* K() const { return (h16*)(ws + OFF_K); }
  DEVI h16* VT() const { return (h16*)(ws + OFF_VT); }
  DEVI unsigned short* QIN() const { return (unsigned short*)(ws + OFF_QIN); }
  DEVI unsigned short* KIN() const { return (unsigned short*)(ws + OFF_KIN); }
  DEVI float* DEC() const { return (float*)(ws + OFF_DEC); }
  DEVI h16* OFB() const { return (h16*)(ws + OFF_OFB); }
  DEVI h16* W1T() const { return (h16*)(ws + OFF_LW); }
  DEVI h16* W2T() const { return (h16*)(ws + OFF_LW + (size_t)DFF * D * 2); }
  DEVI h16* M() const { return (h16*)(ws + OFF_Q); }
  DEVI h16* YA() const { return (h16*)(ws + OFF_Z + 1056 * 2); }
};

DEVI int tidx() { int t = threadIdx_x_raw(); asm volatile("" : "+v"(t)); return t; }
DEVI float wsum(float v) {
#pragma unroll
  for (int o = 32; o; o >>= 1) v += __shfl_xor(v, o);
  return v;
}
DEVI float sigm(float x) { return 1.f / (1.f + __expf(-x)); }
DEVI unsigned pk2(float a, float b) {
  auto h = __builtin_amdgcn_cvt_pkrtz(a, b);
  return __builtin_bit_cast(unsigned, h);
}
DEVI unsigned pk2n(float a, float b) {
  h16 x = (h16)a, y = (h16)b;
  unsigned short ux = __builtin_bit_cast(unsigned short, x), uy = __builtin_bit_cast(unsigned short, y);
  return (unsigned)ux | ((unsigned)uy << 16);
}
DEVI unsigned f2bf(float f) { unsigned u = __builtin_bit_cast(unsigned, f); u += 0x7fffu + ((u >> 16) & 1u); return u >> 16; }
DEVI float h2f(unsigned short u) { return (float)__builtin_bit_cast(h16, u); }
DEVI void st4h(h16* dst, float a, float b, float c, float d) {
  uint2 u; u.x = pk2n(a, b); u.y = pk2n(c, d);
  *(uint2*)dst = u;
}
DEVI float* xrow(const P& p, int r) {
  int b = r / SB, s = r - b * SB;
  return s < CTX ? p.XC() + (size_t)(b * CTX + s) * D : p.XL + (size_t)(b * SEQ + s - CTX) * D;
}
DEVI int maprow(int dir, int b, int n) {
  if (dir == 0) return b * SB + n;
  return n < CTX ? b * SB + (CTX - 1 - n) : b * SB + (SB + CTX - 1 - n);
}


#define XB_TMO      128
#define XB_XCNT(j)  (256  + 64 * (j))
#define XB_XSUB(j)  (1280 + 64 * (j))
#define XB_XGEN(j)  (2304 + 64 * (j))
#define XB_TOP      3328
#define XB_TOPGEN   3392
#define XCD_BAR_WORDS 3456
#define XB_SPIN_CAP (1u << 22)
#define LAS __attribute__((address_space(3)))
DEVI unsigned xb_ld(unsigned* p) { return __hip_atomic_load(p, __ATOMIC_RELAXED, __HIP_MEMORY_SCOPE_AGENT); }
DEVI unsigned xb_add(unsigned* p, unsigned v) { return __hip_atomic_fetch_add(p, v, __ATOMIC_RELAXED, __HIP_MEMORY_SCOPE_AGENT); }
DEVI unsigned xb_xcc_id() { return (unsigned)__builtin_amdgcn_s_getreg((3 << 11) | 20) & 0xFu; }
#define XB_SPIN(cond, bar) do { unsigned _sp = 0; while (cond) { __builtin_amdgcn_s_sleep(1); \
    if ((++_sp & 255u) == 0u) { if (xb_ld(&(bar)[XB_TMO])) break; if (_sp > XB_SPIN_CAP) { atomicAdd(&(bar)[XB_TMO], 1u); break; } } } } while (0)
struct XcdBarrier { unsigned* bar; unsigned x; volatile LAS unsigned* st; };
DEVI XcdBarrier xcd_barrier_post(unsigned* bar, volatile LAS unsigned* st) {
  XcdBarrier b; b.bar = bar; b.x = xb_xcc_id(); b.st = st;
  if (threadIdx_x_raw() == 0) (void)xb_add(&bar[XB_XCNT(b.x)], 1u);
  return b;
}
DEVI void xcd_barrier_complete(unsigned* bar, unsigned x, unsigned& nloc, unsigned& nx) {
  const unsigned G = gridDim.x;
  unsigned sum, cnt, mine, sp = 0u;
  for (;;) {
    sum = 0u; cnt = 0u; mine = 0u;
#pragma unroll
    for (unsigned j = 0; j < 16; ++j) { const unsigned c = xb_ld(&bar[XB_XCNT(j)]); sum += c; cnt += (c > 0u) ? 1u : 0u; mine = (j == x) ? c : mine; }
    if (sum == G) break;
    __builtin_amdgcn_s_sleep(1);
    if ((++sp & 255u) == 0u) { if (xb_ld(&bar[XB_TMO])) break; if (sp > XB_SPIN_CAP) { atomicAdd(&bar[XB_TMO], 1u); break; } }
  }
  nloc = mine > 0u ? mine : 1u; nx = cnt > 0u ? cnt : 1u;
}
DEVI void xcd_barrier(const XcdBarrier& b) {
  asm volatile("s_waitcnt vmcnt(0)" ::: "memory");
  __syncthreads();
  if (threadIdx_x_raw() == 0) {
    unsigned* bar = b.bar;
    __builtin_amdgcn_s_waitcnt(0);
    unsigned nloc = b.st[0], nx = b.st[1];
    if (nloc == 0u) { xcd_barrier_complete(bar, b.x, nloc, nx); b.st[0] = nloc; b.st[1] = nx; }
    const unsigned old = xb_add(&bar[XB_XSUB(b.x)], 1u);
    const unsigned gen = old / nloc;
    if (old + 1u == (gen + 1u) * nloc) {
      __builtin_amdgcn_fence(__ATOMIC_RELEASE, "agent");
      asm volatile("s_waitcnt vmcnt(0)" ::: "memory");
      const unsigned og = xb_add(&bar[XB_TOP], 1u);
      const unsigned tg = og / nx;
      if (og + 1u == (tg + 1u) * nx) xb_add(&bar[XB_TOPGEN], 1u);
      else XB_SPIN(xb_ld(&bar[XB_TOPGEN]) == tg, bar);
      __builtin_amdgcn_fence(__ATOMIC_ACQUIRE, "agent");
      xb_add(&bar[XB_XGEN(b.x)], 1u);
      asm volatile("s_waitcnt vmcnt(0)" ::: "memory");
    } else {
      XB_SPIN(xb_ld(&bar[XB_XGEN(b.x)]) == gen, bar);
      __builtin_amdgcn_fence(__ATOMIC_ACQUIRE, "agent");
      asm volatile("s_waitcnt vmcnt(0)" ::: "memory");
    }
  }
  __syncthreads();
}

DEVI void phase0(const P& p, char* smem) {
  const int tid = tidx();
  float* sc = (float*)smem;
  float* red = sc + 5 * 1024;
  for (int i = tid; i < 5 * 1024; i += 256) {
    int g = i >> 10, k = i & 1023;
    float v = g < 4 ? p.c[g * D + k] : p.c_ctx[k];
    sc[i] = v * sigm(v);
  }
  __syncthreads();
  for (int job = blockIdx.x; job < DEPTH * 96; job += gridDim.x) {
    int l = job / 96, n0 = (job % 96) * 64;
    int kq = tid >> 6, cc = tid & 63;
    const float* w = p.ada_w + ((size_t)l * D + kq * 256) * 6144 + n0 + cc;
    float a0 = 0, a1 = 0, a2 = 0, a3 = 0, a4 = 0;
#pragma unroll 8
    for (int k = 0; k < 256; ++k) {
      float wv = w[(size_t)k * 6144];
      int kk = kq * 256 + k;
      a0 += sc[kk] * wv; a1 += sc[1024 + kk] * wv; a2 += sc[2048 + kk] * wv; a3 += sc[3072 + kk] * wv; a4 += sc[4096 + kk] * wv;
    }
    red[(kq * 5 + 0) * 64 + cc] = a0; red[(kq * 5 + 1) * 64 + cc] = a1; red[(kq * 5 + 2) * 64 + cc] = a2;
    red[(kq * 5 + 3) * 64 + cc] = a3; red[(kq * 5 + 4) * 64 + cc] = a4;
    __syncthreads();
    for (int i = tid; i < 320; i += 256) {
      int g = i >> 6, c2 = i & 63;
      float s = red[(0 * 5 + g) * 64 + c2] + red[(1 * 5 + g) * 64 + c2] + red[(2 * 5 + g) * 64 + c2] + red[(3 * 5 + g) * 64 + c2];
      p.MOD()[((size_t)l * 5 + g) * 6144 + n0 + c2] = s + p.ada_b[l * 6144 + n0 + c2];
    }
    __syncthreads();
  }
  for (int i = blockIdx.x * 256 + tid; i < SEQ * 16; i += gridDim.x * 256) {
    int s = i >> 4, j = i & 15;
    float pos = (float)(j < 8 ? (s >> 6) : (s & 63));
    float inv = exp2f(-(float)(j & 7) * (13.287712379549449f / 8.f));
    float ang = pos * inv;
    p.ROPE()[s * 32 + j] = cosf(ang);
    p.ROPE()[s * 32 + 16 + j] = sinf(ang);
  }
  if (blockIdx.x == 0 && tid < 64) p.CTR()[tid] = 0;
}

struct CE { const float* src; h16* dst; const float* scale; int K, N; };
DEVI CE get_ce(const P& p, int l, int e) {
  CE c; c.scale = nullptr;
  switch (e) {
    case 0: c.src = p.w_in + (size_t)l * D * NIN; c.dst = p.WIN(); c.K = D; c.N = NIN; break;
    case 1: c.src = p.w_uq + (size_t)l * 384 * 768; c.dst = p.UQ(); c.K = 384; c.N = 768; c.scale = p.qn_g + l * 384; break;
    case 2: c.src = p.w_ukv + (size_t)l * 256 * 1024; c.dst = p.UKV(); c.K = 256; c.N = 1024; c.scale = p.kvn_g + l * 256; break;
    case 3: case 4: case 5: c.src = p.w_branch + ((size_t)l * 3 + (e - 3)) * 512 * D; c.dst = p.WB() + (size_t)(e - 3) * D * 512; c.K = 512; c.N = D; break;
    case 6: c.src = p.w_out + (size_t)l * D * D; c.dst = p.WO(); c.K = D; c.N = D; break;
    case 7: case 8: c.src = p.w_up + ((size_t)l * 2 + (e - 7)) * 64 * 512; c.dst = p.WUP() + (size_t)(e - 7) * 512 * 64; c.K = 64; c.N = 512; break;
    case 9: case 10: c.src = p.a_up + ((size_t)l * 2 + (e - 9)) * 64 * 512; c.dst = p.AUP() + (size_t)(e - 9) * 512 * 64; c.K = 64; c.N = 512; break;
    case 11: c.src = p.g_up + (size_t)l * 128 * 512; c.dst = p.GUP(); c.K = 128; c.N = 512; break;
    case 12: c.src = p.w1 + (size_t)l * D * DFF; c.dst = p.W1T(); c.K = D; c.N = DFF; break;
    default: c.src = p.w2 + (size_t)l * DFF * D; c.dst = p.W2T(); c.K = DFF; c.N = D; break;
  }
  return c;
}
DEVI void conv_tile(const CE& e, int tile, char* smem) {
  float* s = (float*)smem;
  const int tid = tidx();
  int ntn = e.N >> 6;
  int kt = tile / ntn, nt = tile - kt * ntn;
  {
    int r = tid >> 4, c4 = (tid & 15) * 4;
#pragma unroll
    for (int rr = 0; rr < 4; ++rr) {
      int k = r + 16 * rr;
      float4 v = *(const float4*)(e.src + (size_t)(kt * 64 + k) * e.N + nt * 64 + c4);
      float sc = e.scale ? e.scale[kt * 64 + k] : 1.f;
      s[k * 65 + c4 + 0] = v.x * sc; s[k * 65 + c4 + 1] = v.y * sc; s[k * 65 + c4 + 2] = v.z * sc; s[k * 65 + c4 + 3] = v.w * sc;
    }
  }
  __syncthreads();
  {
    int n = tid >> 2, kq = (tid & 3) * 16;
    uint4 u0, u1;
    u0.x = pk2n(s[(kq + 0) * 65 + n], s[(kq + 1) * 65 + n]); u0.y = pk2n(s[(kq + 2) * 65 + n], s[(kq + 3) * 65 + n]);
    u0.z = pk2n(s[(kq + 4) * 65 + n], s[(kq + 5) * 65 + n]); u0.w = pk2n(s[(kq + 6) * 65 + n], s[(kq + 7) * 65 + n]);
    u1.x = pk2n(s[(kq + 8) * 65 + n], s[(kq + 9) * 65 + n]); u1.y = pk2n(s[(kq + 10) * 65 + n], s[(kq + 11) * 65 + n]);
    u1.z = pk2n(s[(kq + 12) * 65 + n], s[(kq + 13) * 65 + n]); u1.w = pk2n(s[(kq + 14) * 65 + n], s[(kq + 15) * 65 + n]);
    h16* d = e.dst + (size_t)(nt * 64 + n) * e.K + kt * 64 + kq;
    *(uint4*)d = u0; *(uint4*)(d + 8) = u1;
  }
  __syncthreads();
}
DEVI void conv_phase(const P& p, int l, int e0, int e1, char* smem) {
  int total = 0;
  for (int e = e0; e < e1; ++e) { CE c = get_ce(p, l, e); total += (c.K >> 6) * (c.N >> 6); }
  for (int t = blockIdx.x; t < total; t += gridDim.x) {
    int tt = t;
    for (int e = e0; e < e1; ++e) {
      CE c = get_ce(p, l, e);
      int nt = (c.K >> 6) * (c.N >> 6);
      if (tt < nt) { conv_tile(c, tt, smem); break; }
      tt -= nt;
    }
  }
}

DEVI void ln_phase(const P& p, int l, int which) {
  const int lane = tidx() & 63;
  const int wid = blockIdx.x * 4 + (tidx() >> 6), nw = gridDim.x * 4;
  for (int r = wid; r < NR; r += nw) {
    int b = r / SB, s = r - b * SB;
    if (which == 2 && s < CTX) continue;
    int g = s < CTX ? 4 : b;
    float* xr = xrow(p, r);
    const float* src = xr;
    if (which == 0 && l == 0) src = s < CTX ? p.ctx + (size_t)(b * CTX + s) * D : p.x + (size_t)(b * SEQ + s - CTX) * D;
    float4 v[4];
#pragma unroll
    for (int i = 0; i < 4; ++i) v[i] = *(const float4*)(src + i * 256 + lane * 4);
    bool do_ln = !(which == 0 && l == 0);
    if (do_ln) {
      const float* gg = which == 1 ? p.ln1_g + l * D : p.ln2_g + (which == 2 ? 3 : l - 1) * D;
      const float* bb = which == 1 ? p.ln1_b + l * D : p.ln2_b + (which == 2 ? 3 : l - 1) * D;
      float sm = 0;
#pragma unroll
      for (int i = 0; i < 4; ++i) sm += v[i].x + v[i].y + v[i].z + v[i].w;
      float mean = wsum(sm) * (1.f / D);
      float sq = 0;
#pragma unroll
      for (int i = 0; i < 4; ++i) {
        v[i].x -= mean; v[i].y -= mean; v[i].z -= mean; v[i].w -= mean;
        sq += v[i].x * v[i].x + v[i].y * v[i].y + v[i].z * v[i].z + v[i].w * v[i].w;
      }
      float rs = rsqrtf(wsum(sq) * (1.f / D) + 1e-5f);
#pragma unroll
      for (int i = 0; i < 4; ++i) {
        float4 g4 = *(const float4*)(gg + i * 256 + lane * 4), b4 = *(const float4*)(bb + i * 256 + lane * 4);
        v[i].x = v[i].x * rs * g4.x + b4.x; v[i].y = v[i].y * rs * g4.y + b4.y;
        v[i].z = v[i].z * rs * g4.z + b4.z; v[i].w = v[i].w * rs * g4.w + b4.w;
      }
    }
#pragma unroll
    for (int i = 0; i < 4; ++i) *(float4*)(xr + i * 256 + lane * 4) = v[i];
    if (which == 2) continue;
    const float* shf = p.MOD() + ((size_t)l * 5 + g) * 6144 + (which == 0 ? 0 : 3) * D;
    const float* scl = shf + D;
    float sm = 0;
#pragma unroll
    for (int i = 0; i < 4; ++i) sm += v[i].x + v[i].y + v[i].z + v[i].w;
    float mean = wsum(sm) * (1.f / D);
    float sq = 0;
#pragma unroll
    for (int i = 0; i < 4; ++i) {
      v[i].x -= mean; v[i].y -= mean; v[i].z -= mean; v[i].w -= mean;
      sq += v[i].x * v[i].x + v[i].y * v[i].y + v[i].z * v[i].z + v[i].w * v[i].w;
    }
    float rs = rsqrtf(wsum(sq) * (1.f / D) + 1e-6f);
    h16* hr = p.H() + (size_t)r * D;
#pragma unroll
    for (int i = 0; i < 4; ++i) {
      float4 s4 = *(const float4*)(shf + i * 256 + lane * 4), c4 = *(const float4*)(scl + i * 256 + lane * 4);
      st4h(hr + i * 256 + lane * 4, v[i].x * rs * (1.f + c4.x) + s4.x, v[i].y * rs * (1.f + c4.y) + s4.y,
           v[i].z * rs * (1.f + c4.z) + s4.z, v[i].w * rs * (1.f + c4.w) + s4.w);
    }
  }
}

constexpr int GLD = 72;
template <bool ROWSQ, int NI = 2>
DEVI void gemm_main(const h16* __restrict__ A, int lda, const h16* __restrict__ Bt, int ldb, int K, int m0, int n0, int nmax,
                    char* smem, f32x16 (&acc)[2][NI], float* rowsq) {
  h16* As = (h16*)smem;
  h16* Bs = As + 2 * 128 * GLD;
  const int tid = tidx(), lane = tid & 63, wv = tid >> 6;
  const int wm = wv >> 1, wn = wv & 1, l31 = lane & 31, hh = lane >> 5;
  const int lrow = tid >> 3, lkc = (tid & 7) * 8;
  uint4 ga[4], gb[2 * NI];
  float sq[4] = {0.f, 0.f, 0.f, 0.f};
  const h16* Ap = A + (size_t)(m0 + lrow) * lda + lkc;
  const h16* Bp = Bt + (size_t)(n0 + lrow) * ldb + lkc;
#pragma unroll
  for (int i = 0; i < 4; ++i) ga[i] = *(const uint4*)(Ap + (size_t)(32 * i) * lda);
#pragma unroll
  for (int i = 0; i < 2 * NI; ++i)
    gb[i] = (n0 + lrow + 32 * i < nmax) ? *(const uint4*)(Bp + (size_t)(32 * i) * ldb) : make_uint4(0, 0, 0, 0);
  const int KT = K >> 6;
#pragma unroll
  for (int i = 0; i < 4; ++i) *(uint4*)(As + (lrow + 32 * i) * GLD + lkc) = ga[i];
#pragma unroll
  for (int i = 0; i < 2 * NI; ++i) *(uint4*)(Bs + (lrow + 32 * i) * GLD + lkc) = gb[i];
  __syncthreads();
  for (int kt = 0; kt < KT; ++kt) {
    const int buf = kt & 1;
    if (ROWSQ) {
#pragma unroll
      for (int i = 0; i < 4; ++i) {
        h16x8 hv = __builtin_bit_cast(h16x8, ga[i]);
#pragma unroll
        for (int j = 0; j < 8; ++j) { float f = (float)hv[j]; sq[i] += f * f; }
      }
    }
    if (kt + 1 < KT) {
#pragma unroll
      for (int i = 0; i < 4; ++i) ga[i] = *(const uint4*)(Ap + (size_t)(32 * i) * lda + (kt + 1) * 64);
#pragma unroll
      for (int i = 0; i < 2 * NI; ++i)
        gb[i] = (n0 + lrow + 32 * i < nmax) ? *(const uint4*)(Bp + (size_t)(32 * i) * ldb + (kt + 1) * 64) : make_uint4(0, 0, 0, 0);
    }
    const h16* as = As + buf * 128 * GLD + (wm * 64 + l31) * GLD + hh * 8;
    const h16* bs = Bs + buf * 128 * GLD + (wn * 32 * NI + l31) * GLD + hh * 8;
#pragma unroll
    for (int ks = 0; ks < 4; ++ks) {
      h16x8 a0 = *(const h16x8*)(as + ks * 16), a1 = *(const h16x8*)(as + 32 * GLD + ks * 16);
#pragma unroll
      for (int ni = 0; ni < NI; ++ni) {
        h16x8 b0 = *(const h16x8*)(bs + ni * 32 * GLD + ks * 16);
        acc[0][ni] = __builtin_amdgcn_mfma_f32_32x32x16_f16(b0, a0, acc[0][ni], 0, 0, 0);
        acc[1][ni] = __builtin_amdgcn_mfma_f32_32x32x16_f16(b0, a1, acc[1][ni], 0, 0, 0);
      }
    }
    if (kt + 1 < KT) {
      h16* ad = As + (buf ^ 1) * 128 * GLD;
      h16* bd = Bs + (buf ^ 1) * 128 * GLD;
#pragma unroll
      for (int i = 0; i < 4; ++i) *(uint4*)(ad + (lrow + 32 * i) * GLD + lkc) = ga[i];
#pragma unroll
      for (int i = 0; i < 2 * NI; ++i) *(uint4*)(bd + (lrow + 32 * i) * GLD + lkc) = gb[i];
    }
    __syncthreads();
  }
  if (ROWSQ) {
#pragma unroll
    for (int i = 0; i < 4; ++i) {
      float s = sq[i];
      s += __shfl_xor(s, 1); s += __shfl_xor(s, 2); s += __shfl_xor(s, 4);
      if ((tid & 7) == 0) rowsq[lrow + 32 * i] = s;
    }
    __syncthreads();
  }
}
template <int NI = 2>
DEVI void gemm_deep(const h16* __restrict__ A, int lda, const h16* __restrict__ Bt, int ldb, int K, int m0, int n0, int nmax,
                    char* smem, f32x16 (&acc)[2][NI]) {
  h16* As = (h16*)smem;
  h16* Bs = As + 2 * 128 * GLD;
  const int tid = tidx(), lane = tid & 63, wv = tid >> 6;
  const int wm = wv >> 1, wn = wv & 1, l31 = lane & 31, hh = lane >> 5;
  const int lrow = tid >> 3, lkc = (tid & 7) * 8;
  uint4 pa0, pa1, pa2, pa3, pb0, pb1, pb2, pb3;
  uint4 qa0, qa1, qa2, qa3, qb0, qb1, qb2, qb3;
  const h16* Ap = A + (size_t)(m0 + lrow) * lda + lkc;
  const int KT = K >> 6;
  const uint4 zz = make_uint4(0, 0, 0, 0);
  const h16* Bq0 = Bt + (size_t)min(n0 + lrow, nmax - 1) * ldb + lkc;
  const h16* Bq1 = Bt + (size_t)min(n0 + lrow + 32, nmax - 1) * ldb + lkc;
  const h16* Bq2 = Bt + (size_t)min(n0 + lrow + 64, nmax - 1) * ldb + lkc;
  const h16* Bq3 = Bt + (size_t)min(n0 + lrow + 96, nmax - 1) * ldb + lkc;
#define GLOAD(S, kt_)                                                                   \
  {                                                                                     \
    const h16* ap_ = Ap + (kt_) * 64;                                                   \
    S##a0 = *(const uint4*)(ap_); S##a1 = *(const uint4*)(ap_ + (size_t)32 * lda);      \
    S##a2 = *(const uint4*)(ap_ + (size_t)64 * lda); S##a3 = *(const uint4*)(ap_ + (size_t)96 * lda); \
    S##b0 = *(const uint4*)(Bq0 + (kt_) * 64); S##b1 = *(const uint4*)(Bq1 + (kt_) * 64); \
    if (NI == 2) { S##b2 = *(const uint4*)(Bq2 + (kt_) * 64); S##b3 = *(const uint4*)(Bq3 + (kt_) * 64); } \
  }
#define LSTORE(S, buf_)                                                                 \
  {                                                                                     \
    h16* ad = As + (buf_) * 128 * GLD + lrow * GLD + lkc;                               \
    h16* bd = Bs + (buf_) * 128 * GLD + lrow * GLD + lkc;                               \
    *(uint4*)(ad) = S##a0; *(uint4*)(ad + 32 * GLD) = S##a1; *(uint4*)(ad + 64 * GLD) = S##a2; *(uint4*)(ad + 96 * GLD) = S##a3; \
    *(uint4*)(bd) = S##b0; *(uint4*)(bd + 32 * GLD) = S##b1;                            \
    if (NI == 2) { *(uint4*)(bd + 64 * GLD) = S##b2; *(uint4*)(bd + 96 * GLD) = S##b3; } \
  }
#define COMPUTE(buf_)                                                                                              \
  {                                                                                                                \
    const h16* as = As + (buf_) * 128 * GLD + (wm * 64 + l31) * GLD + hh * 8;                                      \
    const h16* bs = Bs + (buf_) * 128 * GLD + (wn * 32 * NI + l31) * GLD + hh * 8;                                 \
    _Pragma("unroll") for (int ks = 0; ks < 4; ++ks) {                                                             \
      h16x8 a0 = *(const h16x8*)(as + ks * 16), a1 = *(const h16x8*)(as + 32 * GLD + ks * 16);                     \
      _Pragma("unroll") for (int ni = 0; ni < NI; ++ni) {                                                          \
        h16x8 b0 = *(const h16x8*)(bs + ni * 32 * GLD + ks * 16);                                                  \
        acc[0][ni] = __builtin_amdgcn_mfma_f32_32x32x16_f16(b0, a0, acc[0][ni], 0, 0, 0);                          \
        acc[1][ni] = __builtin_amdgcn_mfma_f32_32x32x16_f16(b0, a1, acc[1][ni], 0, 0, 0);                          \
      }                                                                                                            \
    }                                                                                                              \
  }
  pb2 = zz; pb3 = zz; qb2 = zz; qb3 = zz;
  GLOAD(p, 0);
  GLOAD(q, 1);
  LSTORE(p, 0);
  if (KT > 2) GLOAD(p, 2);
  __syncthreads();
  for (int kt = 0; kt < KT; kt += 2) {
    COMPUTE(0);
    if (kt + 1 < KT) LSTORE(q, 1);
    if (kt + 3 < KT) GLOAD(q, kt + 3);
    __syncthreads();
    if (kt + 1 < KT) {
      COMPUTE(1);
      if (kt + 2 < KT) LSTORE(p, 0);
      if (kt + 4 < KT) GLOAD(p, kt + 4);
      __syncthreads();
    }
  }
#undef GLOAD
#undef LSTORE
#undef COMPUTE
}
DEVI void zero_acc(f32x16 (&acc)[2][2]) {
#pragma unroll
  for (int i = 0; i < 2; ++i)
#pragma unroll
    for (int j = 0; j < 2; ++j)
#pragma unroll
      for (int r = 0; r < 16; ++r) acc[i][j][r] = 0.f;
}
template <class F>
DEVI void epi_quads(const f32x16 (&acc)[2][2], int m0, int n0, F f) {
  const int lane = tidx() & 63, wv = tidx() >> 6;
  const int wm = wv >> 1, wn = wv & 1, l31 = lane & 31, hh = lane >> 5;
#pragma unroll
  for (int mi = 0; mi < 2; ++mi)
#pragma unroll
    for (int ni = 0; ni < 2; ++ni)
#pragma unroll
      for (int g = 0; g < 4; ++g)
        f(m0 + wm * 64 + mi * 32 + l31, n0 + wn * 64 + ni * 32 + 8 * g + 4 * hh, acc[mi][ni][4 * g], acc[mi][ni][4 * g + 1],
          acc[mi][ni][4 * g + 2], acc[mi][ni][4 * g + 3]);
}

DEVI void inproj_phase(const P& p, char* smem) {
  constexpr int MT = NR / 128, NT = (ZW + 127) / 128;
  for (int job = blockIdx.x; job < MT * NT; job += gridDim.x) {
    int nt = job / MT, mt = job - nt * MT;
    f32x16 acc[2][2]; zero_acc(acc);
    gemm_deep<2>(p.H(), D, p.WIN(), D, D, mt * 128, nt * 128, ZW, smem, acc);
    epi_quads(acc, mt * 128, nt * 128, [&](int m, int n, float v0, float v1, float v2, float v3) {
      if (n < ZW) {
        st4h(p.Z() + (size_t)m * ZW + n, v0, v1, v2, v3);
        if (n >= ZRW) {
          if ((m & 63) == 0) st4h(p.HLO() + (size_t)(m >> 6) * 1920 + n - ZRW, v0, v1, v2, v3);
          if ((m & 63) == 63) st4h(p.HHI() + (size_t)(m >> 6) * 1920 + n - ZRW, v0, v1, v2, v3);
        }
      }
    });
  }
}

DEVI void shift_job(const P& p, int l, int jj, char* smem) {
  const int j = jj >> 3, slab0 = jj & 7;
  h16* raw = (h16*)smem;
  const int tid = tidx(), lane = tid & 63;
  const int r0 = j * 64;
  const int s0 = r0 % SB;
  const bool first = (s0 == 0) || (s0 == CTX);
  const bool last = (s0 + 64 == CTX) || (s0 + 64 == SB);
  for (int slab = slab0; slab <= slab0; ++slab) {
    const int c0 = slab * 256;
    const int ncols = slab == 7 ? 128 : 256;
    const int cpr = ncols >> 3;
    for (int c = tid; c < 66 * cpr; c += 256) {
      int row = c / cpr, ch = (c - row * cpr) * 8;
      uint4 v = make_uint4(0, 0, 0, 0);
      if (row == 0) { if (!first) v = *(const uint4*)(p.HHI() + (size_t)(j - 1) * 1920 + c0 + ch); }
      else if (row == 65) { if (!last) v = *(const uint4*)(p.HLO() + (size_t)(j + 1) * 1920 + c0 + ch); }
      else v = *(const uint4*)(p.Z() + (size_t)(r0 + row - 1) * ZW + ZRW + c0 + ch);
      *(uint4*)(raw + row * 264 + ch) = v;
    }
    __syncthreads();
    if (tid < ncols) {
      const int col = c0 + tid;
      const float mup = p.mu[(size_t)l * 2 * 1920 + col], mun = p.mu[(size_t)l * 2 * 1920 + 1920 + col];
      const bool isk = (col >= 512 && col < 1024);
      const float kkp = isk ? p.k_k[l * 512 + col - 512] : 0.f;
      float prev = (float)raw[tid], cur = (float)raw[264 + tid];
      h16* zc = p.Z() + (size_t)r0 * ZW + ZRW + col;
      for (int t = 0; t < 64; ++t) {
        float nxt = (float)raw[(t + 2) * 264 + tid];
        float o = cur + mup * (prev - cur) + mun * (nxt - cur);
        float ov = o;
        if (col >= 1536 && col < 1664) ov = tanhf(o);
        else if (col >= 1792) ov = sigm(o);
        zc[(size_t)t * ZW] = (h16)ov;
        if (isk) {
          float q = o * kkp;
          float ss = wsum(q * q);
          if (lane == 0) p.INVN()[(size_t)(r0 + t) * 8 + ((col - 512) >> 6)] = rsqrtf(ss + 1e-12f);
        }
        prev = cur; cur = nxt;
      }
    }
    __syncthreads();
  }
}

DEVI void mla_up_job(const P& p, int job, char* smem) {
  constexpr int MT = NR / 128;
  float* rowsq = (float*)(smem + 2 * 2 * 128 * GLD * 2);
  const int tid = tidx();
  f32x16 acc[2][2]; zero_acc(acc);
  if (job < MT * 6) {
    int nt = job / MT, mt = job - nt * MT;
    gemm_main<true>(p.Z() + ZMLA, ZW, p.UQ(), 384, 384, mt * 128, nt * 128, 768, smem, acc, rowsq);
    const int m0 = mt * 128, n0 = nt * 128;
    const int lane = tid & 63, wv = tid >> 6, wm = wv >> 1, wn = wv & 1, l31 = lane & 31, hh = lane >> 5;
    const float qs = 0.10206207261596575f * 1.4426950408889634f;
#pragma unroll
    for (int mi = 0; mi < 2; ++mi) {
      const int ml = wm * 64 + mi * 32 + l31, m = m0 + ml;
      const float sc = rsqrtf(rowsq[ml] * (1.f / 384.f) + 1e-6f) * qs;
      const int sp = m % SB;
      const bool lat = sp >= CTX;
      const float* rp = p.ROPE() + (size_t)(lat ? sp - CTX : 0) * 32;
#pragma unroll
      for (int ni = 0; ni < 2; ++ni) {
        const int nb = n0 + wn * 64 + ni * 32;
        h16* qd = p.Q() + (size_t)m * 768 + nb;
        const bool ropet = (nb % 96) == 64;
        if (ropet && lat) {
#pragma unroll
          for (int g = 0; g < 2; ++g) {
            float o1[4], o2[4];
#pragma unroll
            for (int jj = 0; jj < 4; ++jj) {
              int i = 8 * g + 4 * hh + jj;
              float x1 = acc[mi][ni][4 * g + jj] * sc, x2 = acc[mi][ni][4 * (g + 2) + jj] * sc;
              float cs = rp[i], sn = rp[16 + i];
              o1[jj] = x1 * cs - x2 * sn; o2[jj] = x1 * sn + x2 * cs;
            }
            st4h(qd + 8 * g + 4 * hh, o1[0], o1[1], o1[2], o1[3]);
            st4h(qd + 16 + 8 * g + 4 * hh, o2[0], o2[1], o2[2], o2[3]);
          }
        } else {
#pragma unroll
          for (int g = 0; g < 4; ++g)
            st4h(qd + 8 * g + 4 * hh, acc[mi][ni][4 * g] * sc, acc[mi][ni][4 * g + 1] * sc, acc[mi][ni][4 * g + 2] * sc, acc[mi][ni][4 * g + 3] * sc);
        }
      }
    }
  } else {
    int j2 = job - MT * 6;
    int nt = j2 / MT, mt = j2 - nt * MT;
    gemm_main<true>(p.Z() + ZMLA + 384, ZW, p.UKV(), 256, 256, mt * 128, nt * 128, 1024, smem, acc, rowsq);
    const int m0 = mt * 128;
    epi_quads(acc, m0, 0, [&](int m, int n, float v0, float v1, float v2, float v3) {
      const float sc = rsqrtf(rowsq[m - m0] * (1.f / 256.f) + 1e-6f);
      if (n < 64) st4h(p.K() + (size_t)m * 768 + nt * 96 + n, v0 * sc, v1 * sc, v2 * sc, v3 * sc);
      else {
        int b = m / SB, s = m - b * SB;
        h16* vt = p.VT() + ((size_t)(b * 8 + nt) * 64 + (n - 64)) * SB + s;
        vt[0] = (h16)(v0 * sc); vt[SB] = (h16)(v1 * sc); vt[2 * SB] = (h16)(v2 * sc); vt[3 * SB] = (h16)(v3 * sc);
      }
    });
    {
      int row = tid >> 1, sub = tid & 1;
      int m = m0 + row;
      int sp = m % SB;
      const h16* kr = p.Z() + (size_t)m * ZW + ZMLA + 640 + sub * 8;
      h16x8 x1 = *(const h16x8*)kr, x2 = *(const h16x8*)(kr + 16);
      h16* kd = p.K() + (size_t)m * 768 + nt * 96 + 64 + sub * 8;
      if (sp >= CTX) {
        const float* rp = p.ROPE() + (size_t)(sp - CTX) * 32 + sub * 8;
        h16x8 o1, o2;
#pragma unroll
        for (int i = 0; i < 8; ++i) {
          float a = (float)x1[i], b2 = (float)x2[i], cs = rp[i], sn = rp[16 + i];
          o1[i] = (h16)(a * cs - b2 * sn); o2[i] = (h16)(a * sn + b2 * cs);
        }
        *(h16x8*)kd = o1; *(h16x8*)(kd + 16) = o2;
      } else { *(h16x8*)kd = x1; *(h16x8*)(kd + 16) = x2; }
    }
  }
}

DEVI void lowrank_job(const P& p, int l, int job, char* smem) {
  constexpr int MT = NR / 128;
  int mat = job / (MT * 4), rem = job - mat * MT * 4;
  int nt = rem / MT, mt = rem - nt * MT;
  f32x16 acc[2][2]; zero_acc(acc);
  if (mat < 2) {
    const int dir = mat;
    gemm_main<false>(p.Z() + ZRW + 1536 + dir * 64, ZW, p.WUP() + (size_t)dir * 512 * 64, 64, 64, mt * 128, nt * 128, 512, smem, acc, nullptr);
    const float* w0 = p.w0 + ((size_t)l * 2 + dir) * 512;
    h16* dst = p.LW() + (size_t)dir * NR * 512;
    epi_quads(acc, mt * 128, nt * 128, [&](int m, int n, float v0, float v1, float v2, float v3) {
      float4 b = *(const float4*)(w0 + n);
      const float e = 0.6065306597126334f;
      st4h(dst + (size_t)m * 512 + n, sigm(v0 + b.x) * e, sigm(v1 + b.y) * e, sigm(v2 + b.z) * e, sigm(v3 + b.w) * e);
    });
  } else if (mat < 4) {
    const int dir = mat - 2;
    gemm_main<false>(p.Z() + ZRW + 1664 + dir * 64, ZW, p.AUP() + (size_t)dir * 512 * 64, 64, 64, mt * 128, nt * 128, 512, smem, acc, nullptr);
    const float* a0 = p.a0 + ((size_t)l * 2 + dir) * 512;
    h16* dst = p.AA() + (size_t)dir * NR * 512;
    epi_quads(acc, mt * 128, nt * 128, [&](int m, int n, float v0, float v1, float v2, float v3) {
      float4 b = *(const float4*)(a0 + n);
      st4h(dst + (size_t)m * 512 + n, sigm(v0 + b.x), sigm(v1 + b.y), sigm(v2 + b.z), sigm(v3 + b.w));
    });
  } else {
    gemm_main<false>(p.Z() + ZRW + 1792, ZW, p.GUP(), 128, 128, mt * 128, nt * 128, 512, smem, acc, nullptr);
    epi_quads(acc, mt * 128, nt * 128, [&](int m, int n, float v0, float v1, float v2, float v3) {
      st4h(p.G() + (size_t)m * 512 + n, v0, v1, v2, v3);
    });
  }
}

DEVI void attn_job(const P& p, int job, char* smem) {
  h16* Ks = (h16*)smem;
  h16* Vs = Ks + 2 * 64 * 104;
  const int tid = tidx(), lane = tid & 63, wv = tid >> 6, l31 = lane & 31, hh = lane >> 5;
  int b, h, q0, nk;
  if (job < 1024) { b = job >> 8; h = (job >> 5) & 7; q0 = b * SB + CTX + (job & 31) * 128; nk = SB; }
  else { int j = job - 1024; b = j >> 4; h = (j >> 1) & 7; q0 = b * SB + (j & 1) * 128; nk = CTX; }
  const int NKT = nk >> 6;
  const h16* Kg = p.K() + (size_t)(b * SB) * 768 + h * 96;
  const h16* Vg = p.VT() + (size_t)(b * 8 + h) * 64 * SB;
  h16x8 qf[6];
  {
    const h16* qp = p.Q() + (size_t)(q0 + wv * 32 + l31) * 768 + h * 96 + hh * 8;
#pragma unroll
    for (int ds = 0; ds < 6; ++ds) qf[ds] = *(const h16x8*)(qp + ds * 16);
  }
  uint4 pk0, pk1, pk2_, pv0, pv1, qk0, qk1, qk2_, qv0, qv1;
  int krow[3], kcol[3];
#pragma unroll
  for (int i = 0; i < 3; ++i) { int c = tid + 256 * i; krow[i] = c / 12; kcol[i] = (c - krow[i] * 12) * 8; }
  const int vrow = tid >> 3, vcol = (tid & 7) * 8;
  const h16* kp0 = Kg + (size_t)krow[0] * 768 + kcol[0];
  const h16* kp1 = Kg + (size_t)krow[1] * 768 + kcol[1];
  const h16* kp2 = Kg + (size_t)krow[2] * 768 + kcol[2];
  const h16* vp0 = Vg + (size_t)vrow * SB + vcol;
  const h16* vp1 = Vg + (size_t)(vrow + 32) * SB + vcol;
#define ALOAD(S, kt_) { S##k0 = *(const uint4*)(kp0 + (size_t)(kt_) * 64 * 768); S##k1 = *(const uint4*)(kp1 + (size_t)(kt_) * 64 * 768); \
    S##k2_ = *(const uint4*)(kp2 + (size_t)(kt_) * 64 * 768); S##v0 = *(const uint4*)(vp0 + (kt_) * 64); S##v1 = *(const uint4*)(vp1 + (kt_) * 64); }
#define ASTORE(S, buf_) { h16* kd = Ks + (buf_) * 64 * 104; h16* vd = Vs + (buf_) * 64 * 72; \
    *(uint4*)(kd + krow[0] * 104 + kcol[0]) = S##k0; *(uint4*)(kd + krow[1] * 104 + kcol[1]) = S##k1; *(uint4*)(kd + krow[2] * 104 + kcol[2]) = S##k2_; \
    *(uint4*)(vd + vrow * 72 + vcol) = S##v0; *(uint4*)(vd + (vrow + 32) * 72 + vcol) = S##v1; }
  f32x16 o0, o1;
#pragma unroll
  for (int r = 0; r < 16; ++r) { o0[r] = 0.f; o1[r] = 0.f; }
  float mrun = -1e30f, lsum = 0.f;
  auto compute = [&](int buf) {
    const h16* ks = Ks + buf * 64 * 104 + l31 * 104 + hh * 8;
    f32x16 s0, s1;
#pragma unroll
    for (int r = 0; r < 16; ++r) { s0[r] = 0.f; s1[r] = 0.f; }
#pragma unroll
    for (int ds = 0; ds < 6; ++ds) {
      h16x8 a0 = *(const h16x8*)(ks + ds * 16), a1 = *(const h16x8*)(ks + 32 * 104 + ds * 16);
      s0 = __builtin_amdgcn_mfma_f32_32x32x16_f16(a0, qf[ds], s0, 0, 0, 0);
      s1 = __builtin_amdgcn_mfma_f32_32x32x16_f16(a1, qf[ds], s1, 0, 0, 0);
    }
    float mx = s0[0];
#pragma unroll
    for (int r = 1; r < 16; ++r) mx = fmaxf(mx, s0[r]);
#pragma unroll
    for (int r = 0; r < 16; ++r) mx = fmaxf(mx, s1[r]);
    mx = fmaxf(mx, __shfl_xor(mx, 32));
    const float mnew = fmaxf(mrun, mx);
    const float alpha = __builtin_amdgcn_exp2f(mrun - mnew);
    mrun = mnew;
    float ps = 0.f;
#pragma unroll
    for (int r = 0; r < 16; ++r) { s0[r] = __builtin_amdgcn_exp2f(s0[r] - mnew); ps += s0[r]; }
#pragma unroll
    for (int r = 0; r < 16; ++r) { s1[r] = __builtin_amdgcn_exp2f(s1[r] - mnew); ps += s1[r]; }
    lsum = lsum * alpha + ps;
#pragma unroll
    for (int r = 0; r < 16; ++r) { o0[r] *= alpha; o1[r] *= alpha; }
    const h16* vs = Vs + buf * 64 * 72 + l31 * 72 + 4 * hh;
#pragma unroll
    for (int k2 = 0; k2 < 2; ++k2) {
#pragma unroll
      for (int s2 = 0; s2 < 2; ++s2) {
        uint4 pu;
        if (k2 == 0) { pu.x = pk2(s0[8 * s2], s0[8 * s2 + 1]); pu.y = pk2(s0[8 * s2 + 2], s0[8 * s2 + 3]); pu.z = pk2(s0[8 * s2 + 4], s0[8 * s2 + 5]); pu.w = pk2(s0[8 * s2 + 6], s0[8 * s2 + 7]); }
        else { pu.x = pk2(s1[8 * s2], s1[8 * s2 + 1]); pu.y = pk2(s1[8 * s2 + 2], s1[8 * s2 + 3]); pu.z = pk2(s1[8 * s2 + 4], s1[8 * s2 + 5]); pu.w = pk2(s1[8 * s2 + 6], s1[8 * s2 + 7]); }
        h16x8 pf = __builtin_bit_cast(h16x8, pu);
        const int kb = k2 * 32 + 16 * s2;
        uint2 va = *(const uint2*)(vs + kb), vb = *(const uint2*)(vs + kb + 8);
        uint2 vc = *(const uint2*)(vs + 32 * 72 + kb), vd = *(const uint2*)(vs + 32 * 72 + kb + 8);
        h16x8 vf0 = __builtin_bit_cast(h16x8, make_uint4(va.x, va.y, vb.x, vb.y));
        h16x8 vf1 = __builtin_bit_cast(h16x8, make_uint4(vc.x, vc.y, vd.x, vd.y));
        o0 = __builtin_amdgcn_mfma_f32_32x32x16_f16(vf0, pf, o0, 0, 0, 0);
        o1 = __builtin_amdgcn_mfma_f32_32x32x16_f16(vf1, pf, o1, 0, 0, 0);
      }
    }
  };
  ALOAD(p, 0);
  if (NKT > 1) ALOAD(q, 1);
  ASTORE(p, 0);
  if (NKT > 2) ALOAD(p, 2);
  __syncthreads();
  for (int kt = 0; kt < NKT; kt += 2) {
    compute(0);
    if (kt + 1 < NKT) ASTORE(q, 1);
    if (kt + 3 < NKT) ALOAD(q, kt + 3);
    __syncthreads();
    if (kt + 1 < NKT) {
      compute(1);
      if (kt + 2 < NKT) ASTORE(p, 0);
      if (kt + 4 < NKT) ALOAD(p, kt + 4);
      __syncthreads();
    }
  }
#undef ALOAD
#undef ASTORE
  const float ltot = lsum + __shfl_xor(lsum, 32);
  const float inv = 1.f / ltot;
  h16* yo = p.Z() + (size_t)(q0 + wv * 32 + l31) * ZW + ZMLA + h * 64 + 4 * hh;
#pragma unroll
  for (int g = 0; g < 4; ++g) {
    st4h(yo + 8 * g, o0[4 * g] * inv, o0[4 * g + 1] * inv, o0[4 * g + 2] * inv, o0[4 * g + 3] * inv);
    st4h(yo + 32 + 8 * g, o1[4 * g] * inv, o1[4 * g + 1] * inv, o1[4 * g + 2] * inv, o1[4 * g + 3] * inv);
  }
}

#if PROBE >= 200
__device__ unsigned long long g_tacc[4];
#endif
struct Slot { float w[64]; unsigned bke[64]; float vv[64]; h16 ah[4][64]; int yoff; int pad[3]; };
struct LSet { uint4 lw, a, k, v, r; float inv; int yoff; int vm; };
DEVI void scan_job(const P& p, int l, int job, char* smem, int rank) {
  constexpr int RGB = 4 / NSCAN_BPC;
  constexpr int NLD = (4 - RGB) * 64;
  static_assert(NLD == 128, "loader mapping assumes 128 loader threads");
  Slot* sl = (Slot*)smem;
  h16* ybuf = (h16*)(smem + 2 * 16 * sizeof(Slot));
  const int tid = tidx(), lane = tid & 63, wv = rank ? ((tid >> 6) ^ 2) : (tid >> 6);
  const int chain = job / NSCAN_BPC, part = job - chain * NSCAN_BPC;
  const int dir = chain >> 5, b = (chain >> 3) & 3, h = chain & 7;
  for (int i = tid; i < 32 * 128; i += 256) { int s = i >> 7, e = i & 127; sl[s].ah[2 + (e >> 6)][e & 63] = (h16)0.f; }
  if (wv >= RGB) {
    const int lt = (wv - RGB) * 64 + lane;
    const int st = lt >> 3, ca = lt & 7, c8 = ca * 8;
    const int pp0 = (ca >> 2) * 32 + (2 * (ca & 1)) * 8 + ((ca & 3) >> 1) * 4;
    const int pp1 = pp0 + 8;
    const float4 kkA = *(const float4*)(p.k_k + l * 512 + h * 64 + c8), kkB = *(const float4*)(p.k_k + l * 512 + h * 64 + c8 + 4);
    const float4 kaA = *(const float4*)(p.k_a + l * 512 + h * 64 + c8), kaB = *(const float4*)(p.k_a + l * 512 + h * 64 + c8 + 4);
    const h16* LWd = p.LW() + (size_t)dir * NR * 512 + h * 64 + c8;
    const h16* AAd = p.AA() + (size_t)dir * NR * 512 + h * 64 + c8;
    const h16* Zr = p.Z() + ZRW + h * 64 + c8;
#define LLOAD(ci_, g)                                                                                         \
    {                                                                                                         \
      const int n_ = (ci_) * 16 + st;                                                                         \
      const int rowm_ = maprow(dir, b, min(n_, SB - 1));                                                      \
      const int rowr_ = maprow(dir, b, min(max(n_ - 1, 0), SB - 1));                                          \
      g##_yoff = (n_ >= 1 && n_ <= SB) ? rowr_ * 512 : -1;                                                      \
      g##_vm = (n_ < SB) ? 1 : 0;                                                                               \
      const h16* p0_ = LWd + (size_t)rowm_ * 512; const h16* p1_ = AAd + (size_t)rowm_ * 512;                 \
      const h16* p2_ = Zr + (size_t)rowm_ * ZW + 512; const h16* p3_ = Zr + (size_t)rowm_ * ZW + 1024;        \
      const h16* p4_ = Zr + (size_t)rowr_ * ZW; const float* p5_ = p.INVN() + (size_t)rowm_ * 8 + h;          \
      asm volatile("global_load_dwordx4 %0, %1, off" : "=v"(g##_lw) : "v"(p0_) : "memory");                     \
      asm volatile("global_load_dwordx4 %0, %1, off" : "=v"(g##_a) : "v"(p1_) : "memory");                      \
      asm volatile("global_load_dwordx4 %0, %1, off" : "=v"(g##_k) : "v"(p2_) : "memory");                      \
      asm volatile("global_load_dwordx4 %0, %1, off" : "=v"(g##_v) : "v"(p3_) : "memory");                      \
      asm volatile("global_load_dwordx4 %0, %1, off" : "=v"(g##_r) : "v"(p4_) : "memory");                      \
      asm volatile("global_load_dword %0, %1, off" : "=v"(g##_inv) : "v"(p5_) : "memory");                      \
    }
#define LWAIT(g) asm volatile("s_waitcnt vmcnt(18)" : "+v"(g##_lw), "+v"(g##_a), "+v"(g##_k), "+v"(g##_v), "+v"(g##_r), "+v"(g##_inv) : : "memory")
    auto lstore = [&](uint4 g_lw, uint4 g_a, uint4 g_k, uint4 g_v, uint4 g_r, float g_inv, int g_yoff, int g_vm, int buf) {
      Slot& s = sl[buf * 16 + st];
      const h16x8 lw = __builtin_bit_cast(h16x8, g_lw), a = __builtin_bit_cast(h16x8, g_a), k = __builtin_bit_cast(h16x8, g_k), v = __builtin_bit_cast(h16x8, g_v);
      const float kkp[8] = {kkA.x, kkA.y, kkA.z, kkA.w, kkB.x, kkB.y, kkB.z, kkB.w};
      const float kap[8] = {kaA.x, kaA.y, kaA.z, kaA.w, kaB.x, kaB.y, kaB.z, kaB.w};
      const float vmf = g_vm ? 1.f : 0.f;
      const float inv = g_inv * vmf;
      float w8[8], v8[8], q8[8], r8[8]; unsigned be8[8];
      const h16x8 rh = __builtin_bit_cast(h16x8, g_r);
      const float rvalid = (g_yoff >= 0) ? 1.f : 0.f;
#pragma unroll
      for (int i = 0; i < 8; ++i) w8[i] = __expf(-(float)lw[i] * vmf);
      float P8[8];
#pragma unroll
      for (int i = 0; i < 8; ++i) P8[i] = w8[i];
#pragma unroll
      for (int d = 8; d < 64; d <<= 1) {
#pragma unroll
        for (int i = 0; i < 8; ++i) { const float t = __shfl_up(P8[i], d); if (lane >= d) P8[i] *= t; }
      }
#pragma unroll
      for (int i = 0; i < 8; ++i) {
        const float kf = (float)k[i] * vmf, af = (float)a[i];
        const float kkv = kf * kkp[i] * inv;
        const float rP = __builtin_amdgcn_rcpf(P8[i]);
        const float Pex = P8[i] * __builtin_amdgcn_rcpf(w8[i]);
        be8[i] = pk2n(kkv * af * rP, kf * (1.f + (af - 1.f) * kap[i]) * rP);
        v8[i] = (float)v[i] * vmf;
        q8[i] = kkv * Pex;
        r8[i] = (float)rh[i] * Pex * rvalid;
        w8[i] = P8[i];
      }
      const uint4 rr = make_uint4(pk2n(r8[0], r8[1]), pk2n(r8[2], r8[3]), pk2n(r8[4], r8[5]), pk2n(r8[6], r8[7]));
      *(float4*)(s.w + c8) = make_float4(w8[0], w8[1], w8[2], w8[3]); *(float4*)(s.w + c8 + 4) = make_float4(w8[4], w8[5], w8[6], w8[7]);
      *(uint4*)(s.bke + c8) = make_uint4(be8[0], be8[1], be8[2], be8[3]); *(uint4*)(s.bke + c8 + 4) = make_uint4(be8[4], be8[5], be8[6], be8[7]);
      *(float4*)(s.vv + c8) = make_float4(v8[0], v8[1], v8[2], v8[3]); *(float4*)(s.vv + c8 + 4) = make_float4(v8[4], v8[5], v8[6], v8[7]);
      *(uint2*)(&s.ah[0][pp0]) = make_uint2(pk2n(q8[0], q8[1]), pk2n(q8[2], q8[3]));
      *(uint2*)(&s.ah[0][pp1]) = make_uint2(pk2n(q8[4], q8[5]), pk2n(q8[6], q8[7]));
      *(uint2*)(&s.ah[1][pp0]) = make_uint2(rr.x, rr.y);
      *(uint2*)(&s.ah[1][pp1]) = make_uint2(rr.z, rr.w);
      if (ca == 0) s.yoff = g_yoff;
    };
    typedef unsigned u32x4 __attribute__((ext_vector_type(4)));
    u32x4 R0_lw, R0_a, R0_k, R0_v, R0_r, R1_lw, R1_a, R1_k, R1_v, R1_r, R2_lw, R2_a, R2_k, R2_v, R2_r, R3_lw, R3_a, R3_k, R3_v, R3_r;
    float R0_inv, R1_inv, R2_inv, R3_inv; int R0_yoff, R1_yoff, R2_yoff, R3_yoff, R0_vm, R1_vm, R2_vm, R3_vm;
#define U4(x) make_uint4((x)[0], (x)[1], (x)[2], (x)[3])
#define LST(g, buf_) lstore(U4(g##_lw), U4(g##_a), U4(g##_k), U4(g##_v), U4(g##_r), g##_inv, g##_yoff, g##_vm, buf_)
    asm volatile("s_waitcnt vmcnt(0)" ::: "memory");
    LLOAD(0, R0); LLOAD(1, R1); LLOAD(2, R2); LLOAD(3, R3);
    LWAIT(R0); LST(R0, 0); LLOAD(4, R0);
    __syncthreads();
    h16* yout = p.Y2() + (size_t)dir * NR * 512 + h * 64 + part * (RGB * 16) + ca * 4;
    auto ystore = [&](int cj) {
      const int n = cj * 16 + st;
      if (n >= 1 && n <= SB) {
        const h16* yb = ybuf + ((cj & 1) * 32 + ca * 4) * 24 + st;
        const unsigned short a0 = __builtin_bit_cast(unsigned short, yb[0]), a1 = __builtin_bit_cast(unsigned short, yb[24]);
        const unsigned short a2 = __builtin_bit_cast(unsigned short, yb[48]), a3 = __builtin_bit_cast(unsigned short, yb[72]);
        typedef unsigned u32x2 __attribute__((ext_vector_type(2)));
        u32x2 u; u[0] = (unsigned)a0 | ((unsigned)a1 << 16); u[1] = (unsigned)a2 | ((unsigned)a3 << 16);
        h16* yp = yout + (size_t)maprow(dir, b, n - 1) * 512;
        asm volatile("global_store_dwordx2 %0, %1, off" : : "v"(yp), "v"(u) : "memory");
      }
    };
    for (int ci = 0; ci < NCHUNK; ci += 4) {
      if (ci > 0) ystore(ci - 1);
      LWAIT(R1); if (ci + 1 < NCHUNK) LST(R1, 1); LLOAD(ci + 5, R1);
      __syncthreads();
      if (ci + 1 < NCHUNK) { ystore(ci); LWAIT(R2); if (ci + 2 < NCHUNK) LST(R2, 0); LLOAD(ci + 6, R2); __syncthreads(); }
      if (ci + 2 < NCHUNK) { ystore(ci + 1); LWAIT(R3); if (ci + 3 < NCHUNK) LST(R3, 1); LLOAD(ci + 7, R3); __syncthreads(); }
      if (ci + 3 < NCHUNK) { ystore(ci + 2); LWAIT(R0); if (ci + 4 < NCHUNK) LST(R0, 0); LLOAD(ci + 8, R0); __syncthreads(); }
    }
    ystore(NCHUNK - 1);
    asm volatile("s_waitcnt vmcnt(0)" ::: "memory");
#undef LST
#undef U4
#undef LLOAD
#undef LWAIT
  } else {
    const int c = lane & 15, hq = lane >> 4;
    const int rg = part * RGB + wv;
    const bool h0 = (hq == 0);
    f32x4 ST[4];
#pragma unroll
    for (int t = 0; t < 4; ++t) ST[t] = (f32x4){0.f, 0.f, 0.f, 0.f};
    __builtin_amdgcn_s_setprio(3);
    __syncthreads();
    for (int ci = 0; ci < NCHUNK; ++ci) {
      const int buf = ci & 1;
#if PROBE == 211
      const unsigned long long ct0 = __builtin_amdgcn_s_memrealtime();
#endif
      float yv[16];
      h16x8 rA0[2], rA1[2]; float rvv[2]; unsigned rbe[2][4];
      {
        const Slot& t = sl[buf * 16];
        rA0[0] = *(const h16x8*)(&t.ah[c & 3][8 * hq]); rA1[0] = *(const h16x8*)(&t.ah[c & 3][32 + 8 * hq]);
        rvv[0] = t.vv[rg * 16 + c];
#pragma unroll
        for (int tt = 0; tt < 4; ++tt) rbe[0][tt] = t.bke[16 * tt + c];
      }
#pragma unroll
      for (int s = 0; s < 16; ++s) {
        const int cur = s & 1, nxt = cur ^ 1;
        uint4 sh0, sh1;
        sh0.x = pk2(ST[0][0], ST[0][1]); sh0.y = pk2(ST[0][2], ST[0][3]); sh0.z = pk2(ST[1][0], ST[1][1]); sh0.w = pk2(ST[1][2], ST[1][3]);
        sh1.x = pk2(ST[2][0], ST[2][1]); sh1.y = pk2(ST[2][2], ST[2][3]); sh1.z = pk2(ST[3][0], ST[3][1]); sh1.w = pk2(ST[3][2], ST[3][3]);
        const f32x4 z4 = {0.f, 0.f, 0.f, 0.f};
        f32x4 acc0 = __builtin_amdgcn_mfma_f32_16x16x32_f16(rA0[cur], __builtin_bit_cast(h16x8, sh0), z4, 0, 0, 0);
        f32x4 acc1 = __builtin_amdgcn_mfma_f32_16x16x32_f16(rA1[cur], __builtin_bit_cast(h16x8, sh1), z4, 0, 0, 0);
        f32x4 pe[4];
        if ((s & 7) == 7) {
#pragma unroll
          for (int tt = 0; tt < 4; ++tt) pe[tt] = *(const f32x4*)(sl[buf * 16 + s].w + 16 * tt + 4 * hq);
        }
        if (s + 1 < 16) {
          const Slot& t = sl[buf * 16 + s + 1];
          rA0[nxt] = *(const h16x8*)(&t.ah[c & 3][8 * hq]); rA1[nxt] = *(const h16x8*)(&t.ah[c & 3][32 + 8 * hq]);
          rvv[nxt] = t.vv[rg * 16 + c];
#pragma unroll
          for (int tt = 0; tt < 4; ++tt) rbe[nxt][tt] = t.bke[16 * tt + c];
        }
        __builtin_amdgcn_sched_barrier(0);
        yv[s] = acc0[1] + acc1[1];
        const float sa = -(acc0[0] + acc1[0]);
        const uint4 bu = make_uint4(h0 ? pk2(sa, rvv[cur]) : 0u, 0u, 0u, 0u);
#pragma unroll
        for (int tt = 0; tt < 4; ++tt) {
          const uint4 au = make_uint4(h0 ? rbe[cur][tt] : 0u, 0u, 0u, 0u);
          ST[tt] = __builtin_amdgcn_mfma_f32_16x16x32_f16(__builtin_bit_cast(h16x8, au), __builtin_bit_cast(h16x8, bu), ST[tt], 0, 0, 0);
        }
        if ((s & 7) == 7) {
#pragma unroll
          for (int tt = 0; tt < 4; ++tt) ST[tt] = ST[tt] * pe[tt];
        }
      }
      if (lane < 16) {
        uint4 u0, u1;
        u0.x = pk2n(yv[0], yv[1]); u0.y = pk2n(yv[2], yv[3]); u0.z = pk2n(yv[4], yv[5]); u0.w = pk2n(yv[6], yv[7]);
        u1.x = pk2n(yv[8], yv[9]); u1.y = pk2n(yv[10], yv[11]); u1.z = pk2n(yv[12], yv[13]); u1.w = pk2n(yv[14], yv[15]);
        h16* yr = ybuf + (buf * 32 + wv * 16 + c) * 24;
        *(uint4*)yr = u0; *(uint4*)(yr + 8) = u1;
      }
#if PROBE == 210
      const unsigned long long bt0 = __builtin_amdgcn_s_memrealtime();
#endif
      __syncthreads();
#if PROBE == 210
      if (job == 0 && tid == 0) g_tacc[0] += __builtin_amdgcn_s_memrealtime() - bt0;
#endif
    }
    __builtin_amdgcn_s_setprio(0);
  }
}

DEVI void gla_pre_job(const P& p, int l, int job, char* smem) {
  typedef short bf16x8 __attribute__((ext_vector_type(8)));
  float* lg = (float*)smem;
  float* gku = lg + 64 * 65;
  float* gkb = gku + 1024;
  float* tot = gkb + 64;
  unsigned short* qb = (unsigned short*)(tot + 256);
  unsigned short* kb = qb + 64 * 72;
  h16* vt = (h16*)(kb + 64 * 72);
  const int tid = tidx(), lane = tid & 63, wv = tid >> 6, l31 = lane & 31, hh = lane >> 5;
  const int chain = job / 68, ci = job - chain * 68;
  const int dir = chain >> 4, b = (chain >> 2) & 3, h = chain & 3;
  for (int i = tid; i < 1024; i += 256) gku[i] = p.gk_up[(((size_t)l * 2 + dir) * 16 + (i >> 6)) * 256 + h * 64 + (i & 63)];
  if (tid < 64) gkb[tid] = p.gk_b[((size_t)l * 2 + dir) * 256 + h * 64 + tid];
  const int ri = tid >> 2, dq = tid & 3;
  const int row = maprow(dir, b, ci * 64 + ri);
  const h16* zr = p.Z() + (size_t)row * ZW;
  uint4 q0 = *(const uint4*)(zr + h * 64 + dq * 16), q1 = *(const uint4*)(zr + h * 64 + dq * 16 + 8);
  uint4 k0 = *(const uint4*)(zr + 256 + h * 64 + dq * 16), k1 = *(const uint4*)(zr + 256 + h * 64 + dq * 16 + 8);
  uint4 g0 = *(const uint4*)(zr + 1024 + dir * 16), g1 = *(const uint4*)(zr + 1024 + dir * 16 + 8);
  {
    const h16* zv = zr + 512 + h * 128 + dq * 32;
#pragma unroll
    for (int c = 0; c < 4; ++c) {
      h16x8 vv = *(const h16x8*)(zv + c * 8);
#pragma unroll
      for (int j = 0; j < 8; ++j) vt[(dq * 32 + c * 8 + j) * 72 + ri] = vv[j];
    }
  }
  __syncthreads();
  {
    h16x8 gh0 = __builtin_bit_cast(h16x8, g0), gh1 = __builtin_bit_cast(h16x8, g1);
    float gd[16];
#pragma unroll
    for (int j = 0; j < 8; ++j) { gd[j] = (float)gh0[j]; gd[8 + j] = (float)gh1[j]; }
#pragma unroll 4
    for (int dd = 0; dd < 16; ++dd) {
      const int d = dq * 16 + dd;
      float xx = gkb[d];
#pragma unroll
      for (int r = 0; r < 16; ++r) xx += gd[r] * gku[r * 64 + d];
      float ls = fminf(xx, 0.f) - __logf(1.f + __expf(-fabsf(xx)));
      lg[ri * 65 + d] = ls * (1.f / 16.f);
    }
  }
  __syncthreads();
  {
    const int d = tid & 63, part = tid >> 6;
    float run = 0.f;
#pragma unroll 4
    for (int ii = 0; ii < 16; ++ii) { const int i = part * 16 + ii; run += lg[i * 65 + d]; lg[i * 65 + d] = run; }
    tot[part * 64 + d] = run;
  }
  __syncthreads();
  {
    h16x8 qh0 = __builtin_bit_cast(h16x8, q0), qh1 = __builtin_bit_cast(h16x8, q1), kh0 = __builtin_bit_cast(h16x8, k0), kh1 = __builtin_bit_cast(h16x8, k1);
    const int part = ri >> 4;
    unsigned qp[8], kp[8];
#pragma unroll
    for (int j = 0; j < 8; ++j) {
      unsigned qq[2], kk2[2];
#pragma unroll
      for (int e = 0; e < 2; ++e) {
        const int dd = 2 * j + e, d = dq * 16 + dd;
        float off = 0.f;
        if (part > 0) off += tot[d];
        if (part > 1) off += tot[64 + d];
        if (part > 2) off += tot[128 + d];
        const float bb = lg[ri * 65 + d] + off;
        const float qv = dd < 8 ? (float)qh0[dd & 7] : (float)qh1[dd & 7];
        const float kv = dd < 8 ? (float)kh0[dd & 7] : (float)kh1[dd & 7];
        qq[e] = f2bf(qv * __expf(bb) * 0.125f);
        kk2[e] = f2bf(kv * __expf(-bb));
      }
      qp[j] = qq[0] | (qq[1] << 16); kp[j] = kk2[0] | (kk2[1] << 16);
    }
    const uint4 qa = make_uint4(qp[0], qp[1], qp[2], qp[3]), qc = make_uint4(qp[4], qp[5], qp[6], qp[7]);
    const uint4 ka = make_uint4(kp[0], kp[1], kp[2], kp[3]), kc = make_uint4(kp[4], kp[5], kp[6], kp[7]);
    *(uint4*)(qb + ri * 72 + dq * 16) = qa; *(uint4*)(qb + ri * 72 + dq * 16 + 8) = qc;
    *(uint4*)(kb + ri * 72 + dq * 16) = ka; *(uint4*)(kb + ri * 72 + dq * 16 + 8) = kc;
    unsigned short* qd = p.QIN() + ((size_t)dir * NR + row) * 256 + h * 64 + dq * 16;
    unsigned short* kd = p.KIN() + ((size_t)dir * NR + row) * 256 + h * 64 + dq * 16;
    *(uint4*)qd = qa; *(uint4*)(qd + 8) = qc;
    *(uint4*)kd = ka; *(uint4*)(kd + 8) = kc;
    if (tid < 64) p.DEC()[((size_t)chain * 68 + ci) * 64 + tid] = __expf(tot[tid] + tot[64 + tid] + tot[128 + tid] + tot[192 + tid]);
  }
  __syncthreads();
  const int it = wv & 1, jh = wv >> 1;
  f32x16 o0, o1;
#pragma unroll
  for (int r = 0; r < 16; ++r) { o0[r] = 0.f; o1[r] = 0.f; }
  bf16x8 qf[4];
#pragma unroll
  for (int ks = 0; ks < 4; ++ks) qf[ks] = *(const bf16x8*)(qb + (it * 32 + l31) * 72 + ks * 16 + hh * 8);
#pragma unroll
  for (int st = 0; st < 2; ++st) {
    if (st > it) continue;
    f32x16 at;
#pragma unroll
    for (int r = 0; r < 16; ++r) at[r] = 0.f;
#pragma unroll
    for (int ks = 0; ks < 4; ++ks) {
      bf16x8 kf = *(const bf16x8*)(kb + (st * 32 + l31) * 72 + ks * 16 + hh * 8);
      at = __builtin_amdgcn_mfma_f32_32x32x16_bf16(kf, qf[ks], at, 0, 0, 0);
    }
    if (st == it) {
#pragma unroll
      for (int r = 0; r < 16; ++r) { const int sl = (r & 3) + 8 * (r >> 2) + 4 * hh; if (sl > l31) at[r] = 0.f; }
    }
    const h16* vs = vt + (jh * 64 + l31) * 72 + st * 32 + 4 * hh;
#pragma unroll
    for (int s2 = 0; s2 < 2; ++s2) {
      uint4 pu;
      pu.x = pk2n(at[8 * s2], at[8 * s2 + 1]); pu.y = pk2n(at[8 * s2 + 2], at[8 * s2 + 3]);
      pu.z = pk2n(at[8 * s2 + 4], at[8 * s2 + 5]); pu.w = pk2n(at[8 * s2 + 6], at[8 * s2 + 7]);
      const h16x8 pf = __builtin_bit_cast(h16x8, pu);
      const uint2 va = *(const uint2*)(vs + 16 * s2), vb = *(const uint2*)(vs + 16 * s2 + 8);
      const uint2 vc = *(const uint2*)(vs + 32 * 72 + 16 * s2), vd = *(const uint2*)(vs + 32 * 72 + 16 * s2 + 8);
      o0 = __builtin_amdgcn_mfma_f32_32x32x16_f16(__builtin_bit_cast(h16x8, make_uint4(va.x, va.y, vb.x, vb.y)), pf, o0, 0, 0, 0);
      o1 = __builtin_amdgcn_mfma_f32_32x32x16_f16(__builtin_bit_cast(h16x8, make_uint4(vc.x, vc.y, vd.x, vd.y)), pf, o1, 0, 0, 0);
    }
  }
  {
    const int orow = maprow(dir, b, ci * 64 + it * 32 + l31);
    h16* od = p.OFB() + ((size_t)dir * NR + orow) * 512 + h * 128 + jh * 64 + 4 * hh;
#pragma unroll
    for (int g = 0; g < 4; ++g) {
      st4h(od + 8 * g, o0[4 * g], o0[4 * g + 1], o0[4 * g + 2], o0[4 * g + 3]);
      st4h(od + 32 + 8 * g, o1[4 * g], o1[4 * g + 1], o1[4 * g + 2], o1[4 * g + 3]);
    }
  }
  __syncthreads();
}

DEVI void gla_job(const P& p, int l, int job, char* smem) {
  float* qi = (float*)smem;
  float* ki = qi + 64 * 65;
  float* vs = ki + 64 * 65;
  float* Ss = vs + 64 * 33;
  const int tid = tidx();
  const int dvs = job & 3, chain = job >> 2;
  const int dir = chain >> 4, b = (chain >> 2) & 3, h = chain & 3;
  for (int i = tid; i < 64 * 33; i += 256) Ss[i] = 0.f;
  const int ri = tid >> 2, dq = tid & 3;
  const int t2 = tid >> 3, tj = tid & 7;
  h16* Od = p.OFB() + (size_t)dir * NR * 512 + h * 128 + dvs * 32;
  const unsigned short* Qg = p.QIN() + (size_t)dir * NR * 256 + h * 64 + dq * 16;
  const unsigned short* Kg = p.KIN() + (size_t)dir * NR * 256 + h * 64 + dq * 16;
  const float* Dg = p.DEC() + (size_t)chain * 68 * 64 + 2 * t2;
  uint4 gq0, gq1, gk0, gk1, gv; uint2 goa, gob; float gd0, gd1;
  auto pre = [&](int ci) {
    const int row = maprow(dir, b, ci * 64 + ri);
    gq0 = *(const uint4*)(Qg + (size_t)row * 256); gq1 = *(const uint4*)(Qg + (size_t)row * 256 + 8);
    gk0 = *(const uint4*)(Kg + (size_t)row * 256); gk1 = *(const uint4*)(Kg + (size_t)row * 256 + 8);
    gv = *(const uint4*)(p.Z() + (size_t)row * ZW + 512 + h * 128 + dvs * 32 + dq * 8);
    const int rowa = maprow(dir, b, ci * 64 + 2 * t2), rowb = maprow(dir, b, ci * 64 + 2 * t2 + 1);
    goa = *(const uint2*)(Od + (size_t)rowa * 512 + 4 * tj); gob = *(const uint2*)(Od + (size_t)rowb * 512 + 4 * tj);
    gd0 = Dg[ci * 64]; gd1 = Dg[ci * 64 + 1];
  };
  pre(0);
  __syncthreads();
  for (int ci = 0; ci < SB / 64; ++ci) {
    {
      const unsigned qa[8] = {gq0.x, gq0.y, gq0.z, gq0.w, gq1.x, gq1.y, gq1.z, gq1.w};
      const unsigned ka[8] = {gk0.x, gk0.y, gk0.z, gk0.w, gk1.x, gk1.y, gk1.z, gk1.w};
#pragma unroll
      for (int j = 0; j < 8; ++j) {
        qi[ri * 65 + dq * 16 + 2 * j] = __builtin_bit_cast(float, qa[j] << 16); qi[ri * 65 + dq * 16 + 2 * j + 1] = __builtin_bit_cast(float, qa[j] & 0xffff0000u);
        ki[ri * 65 + dq * 16 + 2 * j] = __builtin_bit_cast(float, ka[j] << 16); ki[ri * 65 + dq * 16 + 2 * j + 1] = __builtin_bit_cast(float, ka[j] & 0xffff0000u);
      }
      h16x8 vh = __builtin_bit_cast(h16x8, gv);
#pragma unroll
      for (int j = 0; j < 8; ++j) vs[ri * 33 + dq * 8 + j] = (float)vh[j];
    }
    const uint2 oia = goa, oib = gob; const float e0 = gd0, e1 = gd1;
    const int rowa = maprow(dir, b, ci * 64 + 2 * t2), rowb = maprow(dir, b, ci * 64 + 2 * t2 + 1);
    if (ci + 1 < SB / 64) pre(ci + 1);
    __syncthreads();
    {
      h16x4 ha = __builtin_bit_cast(h16x4, oia), hb = __builtin_bit_cast(h16x4, oib);
      float a0[4], a1[4];
#pragma unroll
      for (int y = 0; y < 4; ++y) { a0[y] = (float)ha[y]; a1[y] = (float)hb[y]; }
#pragma unroll 4
      for (int d = 0; d < 64; ++d) {
        const float x0 = qi[(2 * t2) * 65 + d], x1 = qi[(2 * t2 + 1) * 65 + d];
#pragma unroll
        for (int y = 0; y < 4; ++y) { const float v = Ss[d * 33 + 4 * tj + y]; a0[y] += x0 * v; a1[y] += x1 * v; }
      }
      st4h(Od + (size_t)rowa * 512 + 4 * tj, a0[0], a0[1], a0[2], a0[3]);
      st4h(Od + (size_t)rowb * 512 + 4 * tj, a1[0], a1[1], a1[2], a1[3]);
    }
    __syncthreads();
    {
      float a0[4], a1[4];
#pragma unroll
      for (int y = 0; y < 4; ++y) { a0[y] = Ss[(2 * t2) * 33 + 4 * tj + y]; a1[y] = Ss[(2 * t2 + 1) * 33 + 4 * tj + y]; }
#pragma unroll 4
      for (int s2 = 0; s2 < 64; ++s2) {
        const float x0 = ki[s2 * 65 + 2 * t2], x1 = ki[s2 * 65 + 2 * t2 + 1];
#pragma unroll
        for (int y = 0; y < 4; ++y) { const float v = vs[s2 * 33 + 4 * tj + y]; a0[y] += x0 * v; a1[y] += x1 * v; }
      }
#pragma unroll
      for (int y = 0; y < 4; ++y) { Ss[(2 * t2) * 33 + 4 * tj + y] = a0[y] * e0; Ss[(2 * t2 + 1) * 33 + 4 * tj + y] = a1[y] * e1; }
    }
    __syncthreads();
  }
}

DEVI void mixer_phase(const P& p, int l, char* smem, int cslot, int mode = 0, int role = -1, int rank = 0) {
  if (role < 0) role = blockIdx.x;
#if PROBE >= 200
  unsigned long long pt0 = __builtin_amdgcn_s_memrealtime();
#endif
  __shared__ int4 sjobv;
  int& sjob = sjobv.x;
  for (int j = role; j < NSCAN + NGLA; j += gridDim.x) {
    if (mode == 1 && j >= NSCAN) break;
    if (mode == 2 && j < NSCAN) continue;
    if (j < NSCAN) {
      scan_job(p, l, j, smem, 0);
    }
    else gla_job(p, l, j - NSCAN, smem);
    __syncthreads();
#if PROBE == 200
    if (role == 0 && tidx() == 0) g_tacc[0] += __builtin_amdgcn_s_memrealtime() - pt0;
#endif
#if PROBE == 201
    if (role == NSCAN && tidx() == 0) g_tacc[0] += __builtin_amdgcn_s_memrealtime() - pt0;
#endif
  }
  if (mode == 1) return;
  const int njobs = (l < DEPTH - 1) ? 1024 + 64 : 1024;
  while (true) {
    if (tidx() == 0) sjob = (int)atomicAdd(p.CTR() + cslot, 1u);
    __syncthreads();
    const int j = sjob;
    __syncthreads();
    if (j >= njobs) break;
    attn_job(p, j, smem);
  }
#if PROBE == 202
  if (role == 300 && tidx() == 0) g_tacc[0] += __builtin_amdgcn_s_memrealtime() - pt0;
#endif
}

DEVI void post_phase(const P& p, int l) {
  const int lane = tidx() & 63;
  const int wid = blockIdx.x * 4 + (tidx() >> 6), nw = gridDim.x * 4;
  const int c8 = lane * 8;
  for (int r = wid; r < NR; r += nw) {
    {
      h16* zr = p.Z() + (size_t)r * ZW + ZRW + c8;
      h16x8 yf = *(const h16x8*)(p.Y2() + (size_t)r * 512 + c8), yb = *(const h16x8*)(p.Y2() + (size_t)(NR + r) * 512 + c8);
      h16x8 rr = *(const h16x8*)zr, kk = *(const h16x8*)(zr + 512), vv = *(const h16x8*)(zr + 1024);
      h16x8 af = *(const h16x8*)(p.AA() + (size_t)r * 512 + c8), ab = *(const h16x8*)(p.AA() + (size_t)(NR + r) * 512 + c8);
      h16x8 gg = *(const h16x8*)(p.G() + (size_t)r * 512 + c8);
      float y[8], sm = 0.f;
#pragma unroll
      for (int i = 0; i < 8; ++i) { y[i] = (float)yf[i] + (float)yb[i]; sm += y[i]; }
      sm += __shfl_xor(sm, 1); sm += __shfl_xor(sm, 2); sm += __shfl_xor(sm, 4);
      const float mean = sm * (1.f / 64.f);
      float sq = 0.f;
#pragma unroll
      for (int i = 0; i < 8; ++i) { y[i] -= mean; sq += y[i] * y[i]; }
      sq += __shfl_xor(sq, 1); sq += __shfl_xor(sq, 2); sq += __shfl_xor(sq, 4);
      const float rs = rsqrtf(sq * (1.f / 64.f) + 64e-5f);
      const float* ka = p.k_a + l * 512 + c8; const float* rk = p.r_k + l * 512 + c8;
      const float* lg = p.rln_g + l * 512 + c8; const float* lb = p.rln_b + l * 512 + c8;
      float bs = 0.f;
#pragma unroll
      for (int i = 0; i < 8; ++i) {
        const float kf = (float)kk[i], kav = ka[i];
        const float ke = kf * (1.f + ((float)af[i] - 1.f) * kav) + kf * (1.f + ((float)ab[i] - 1.f) * kav);
        bs += (float)rr[i] * ke * rk[i];
      }
      bs += __shfl_xor(bs, 1); bs += __shfl_xor(bs, 2); bs += __shfl_xor(bs, 4);
      float o[8];
#pragma unroll
      for (int i = 0; i < 8; ++i) o[i] = (y[i] * rs * lg[i] + lb[i] + bs * (float)vv[i]) * (float)gg[i];
      uint4 u; u.x = pk2n(o[0], o[1]); u.y = pk2n(o[2], o[3]); u.z = pk2n(o[4], o[5]); u.w = pk2n(o[6], o[7]);
      *(uint4*)zr = u;
    }
    {
      h16x8 of = *(const h16x8*)(p.OFB() + (size_t)r * 512 + c8), ob = *(const h16x8*)(p.OFB() + (size_t)(NR + r) * 512 + c8);
      h16x8 og = *(const h16x8*)(p.Z() + (size_t)r * ZW + 1056 + c8);
      float o[8], sq = 0.f;
#pragma unroll
      for (int i = 0; i < 8; ++i) { o[i] = (float)of[i] + (float)ob[i]; sq += o[i] * o[i]; }
      sq += __shfl_xor(sq, 1); sq += __shfl_xor(sq, 2); sq += __shfl_xor(sq, 4); sq += __shfl_xor(sq, 8);
      const float rs = rsqrtf(sq * (1.f / 128.f) + 1e-6f);
      const float* ng = p.gla_ng + l * 128 + (c8 & 127);
#pragma unroll
      for (int i = 0; i < 8; ++i) { const float g = (float)og[i]; o[i] = o[i] * rs * ng[i] * (g * sigm(g)); }
      uint4 u; u.x = pk2n(o[0], o[1]); u.y = pk2n(o[2], o[3]); u.z = pk2n(o[4], o[5]); u.w = pk2n(o[6], o[7]);
      *(uint4*)(p.YA() + (size_t)r * ZW + c8) = u;
    }
  }
}

DEVI void merge_phase(const P& p, char* smem) {
  constexpr int MT = NR / 128, NT = 16;
  const int lane = tidx() & 63, wv = tidx() >> 6;
  const int wm = wv >> 1, wn = wv & 1, l31 = lane & 31, hh = lane >> 5;
  for (int job = blockIdx.x; job < MT * NT; job += gridDim.x) {
    int nt = job / MT, mt = job - nt * MT;
    float out[2][16];
#pragma unroll
    for (int a = 0; a < 2; ++a)
#pragma unroll
      for (int r = 0; r < 16; ++r) out[a][r] = 0.f;
#pragma unroll 1
    for (int br = 0; br < 3; ++br) {
      const h16* Y = br == 0 ? p.YA() : (br == 1 ? p.Z() + ZMLA : p.Z() + ZRW);
      const int ldy = ZW;
      f32x16 acc[2][1];
#pragma unroll
      for (int a = 0; a < 2; ++a)
#pragma unroll
        for (int r = 0; r < 16; ++r) acc[a][0][r] = 0.f;
      gemm_deep<1>(Y, ldy, p.WB() + (size_t)br * D * 512, 512, 512, mt * 128, nt * 64, D, smem, acc);
      float u[2][16];
#pragma unroll
      for (int a = 0; a < 2; ++a)
#pragma unroll
        for (int r = 0; r < 16; ++r) { u[a][r] = acc[a][0][r]; acc[a][0][r] = 0.f; }
      gemm_deep<1>(p.H(), D, p.WIN() + (size_t)(ZW + br * D) * D, D, D, mt * 128, nt * 64, D, smem, acc);
#pragma unroll
      for (int a = 0; a < 2; ++a)
#pragma unroll
        for (int r = 0; r < 16; ++r) out[a][r] += sigm(acc[a][0][r]) * u[a][r];
    }
#pragma unroll
    for (int a = 0; a < 2; ++a)
#pragma unroll
      for (int g = 0; g < 4; ++g)
        st4h(p.M() + (size_t)(mt * 128 + wm * 64 + a * 32 + l31) * D + nt * 64 + wn * 32 + 8 * g + 4 * hh, out[a][4 * g], out[a][4 * g + 1],
             out[a][4 * g + 2], out[a][4 * g + 3]);
  }
}

DEVI void resid_gemm_phase(const P& p, int l, const h16* A, int K, const h16* Bt, int gate_idx, char* smem) {
  constexpr int MT = NR / 128, NT = 8, T = MT * NT;
  const float alpha = 1.6817928305074290f;
  auto epi = [&](int m, int n, float v0, float v1, float v2, float v3) {
    int b = m / SB, s = m - b * SB;
    int g = s < CTX ? 4 : b;
    float4 gt = *(const float4*)(p.MOD() + ((size_t)l * 5 + g) * 6144 + gate_idx * D + n);
    float* xp = xrow(p, m) + n;
    float4 xv = *(float4*)xp;
    xv.x = alpha * xv.x + gt.x * v0; xv.y = alpha * xv.y + gt.y * v1; xv.z = alpha * xv.z + gt.z * v2; xv.w = alpha * xv.w + gt.w * v3;
    *(float4*)xp = xv;
  };
  const int G = gridDim.x, R = T / G, rem = T - R * G;
  const bool split_tail = (2 * rem <= G);
  const int nfull = split_tail ? R * G : T;
  for (int job = blockIdx.x; job < nfull; job += G) {
    int nt = job / MT, mt = job - nt * MT;
    f32x16 acc[2][2]; zero_acc(acc);
    gemm_deep<2>(A, K, Bt, K, K, mt * 128, nt * 128, D, smem, acc);
    epi_quads(acc, mt * 128, nt * 128, epi);
  }
  if (split_tail && (int)blockIdx.x < 2 * rem) {
    const int job = nfull + (blockIdx.x >> 1), half = blockIdx.x & 1;
    int nt = job / MT, mt = job - nt * MT;
    f32x16 acc[2][1];
#pragma unroll
    for (int a2 = 0; a2 < 2; ++a2)
#pragma unroll
      for (int r = 0; r < 16; ++r) acc[a2][0][r] = 0.f;
    const int n0 = nt * 128 + half * 64;
    gemm_deep<1>(A, K, Bt, K, K, mt * 128, n0, D, smem, acc);
    const int lane = tidx() & 63, wv = tidx() >> 6, wm = wv >> 1, wn = wv & 1, l31 = lane & 31, hh = lane >> 5;
#pragma unroll
    for (int a2 = 0; a2 < 2; ++a2)
#pragma unroll
      for (int g = 0; g < 4; ++g)
        epi(mt * 128 + wm * 64 + a2 * 32 + l31, n0 + wn * 32 + 8 * g + 4 * hh, acc[a2][0][4 * g], acc[a2][0][4 * g + 1], acc[a2][0][4 * g + 2], acc[a2][0][4 * g + 3]);
  }
}
DEVI void mlp1_phase(const P& p, char* smem) {
  constexpr int MT = NR / 128, NT = DFF / 128;
  h16* HID = p.Z();
  for (int job = blockIdx.x; job < MT * NT; job += gridDim.x) {
    int nt = job / MT, mt = job - nt * MT;
    f32x16 acc[2][2]; zero_acc(acc);
    gemm_deep<2>(p.H(), D, p.W1T(), D, D, mt * 128, nt * 128, DFF, smem, acc);
    epi_quads(acc, mt * 128, nt * 128, [&](int m, int n, float v0, float v1, float v2, float v3) {
      v0 = fmaxf(v0, 0.f); v1 = fmaxf(v1, 0.f); v2 = fmaxf(v2, 0.f); v3 = fmaxf(v3, 0.f);
      st4h(HID + (size_t)m * DFF + n, v0 * v0, v1 * v1, v2 * v2, v3 * v3);
    });
  }
}

constexpr int PH_PER_LAYER = 11;
constexpr int NPHASES = 1 + DEPTH * PH_PER_LAYER + 1;

DEVI void run_phase(const P& p, int ph, char* smem, int role, int rank) {
  if (ph == 0) { phase0(p, smem); return; }
  if (ph == NPHASES - 1) { ln_phase(p, DEPTH, 2); return; }
  const int l = (ph - 1) / PH_PER_LAYER, k = (ph - 1) - l * PH_PER_LAYER;
  switch (k) {
    case 0: ln_phase(p, l, 0); conv_phase(p, l, 0, 12, smem); break;
    case 1: inproj_phase(p, smem);
#if PROBE == 2
      inproj_phase(p, smem);
#endif
      break;
    case 2: {
      constexpr int NPRE = 32 * 68, NSH = (NR / 64) * 8, NUP = (NR / 128) * 14;
      for (int j = blockIdx.x; j < NPRE + NSH + NUP; j += gridDim.x) {
        if (j < NPRE) gla_pre_job(p, l, j, smem);
        else if (j < NPRE + NSH) shift_job(p, l, j - NPRE, smem);
        else mla_up_job(p, j - NPRE - NSH, smem);
        __syncthreads();
      }
    } break;
    case 3: {
      constexpr int NLR = 5 * 4 * (NR / 128);
      for (int j = blockIdx.x; j < NLR; j += gridDim.x) { lowrank_job(p, l, j, smem); __syncthreads(); }
    } break;
    case 4: mixer_phase(p, l, smem, l, 0, role, rank);
#if PROBE == 1
      mixer_phase(p, l, smem, 8 + l);
#endif
      break;
    case 5: post_phase(p, l); break;
    case 6: merge_phase(p, smem); conv_phase(p, l, 12, 14, smem); break;
    case 7: resid_gemm_phase(p, l, p.M(), D, p.WO(), 2, smem); break;
    case 8: ln_phase(p, l, 1); break;
    case 9: mlp1_phase(p, smem);
#if PROBE == 2
      mlp1_phase(p, smem);
#endif
      break;
    default: resid_gemm_phase(p, l, p.Z(), DFF, p.W2T(), 5, smem); break;
  }
}

__global__ void __launch_bounds__(256, 2) mega(P p, int pb, int pe) {
  extern __shared__ __attribute__((aligned(16))) char smem[];
  cg::grid_group grid = cg::this_grid();
  __shared__ uint4 xb_words;
  if (threadIdx_x_raw() == 0) xb_words = make_uint4(0u, 0u, 0u, 0u);
  __syncthreads();
  XcdBarrier xb = xcd_barrier_post(p.BAR(), (volatile LAS unsigned*)&xb_words);
  __shared__ int4 rolev;
  unsigned* cut = p.BAR() + 3584;
  if (threadIdx_x_raw() == 0) {
    const unsigned key = (xb_xcc_id() << 8) | ((unsigned)__builtin_amdgcn_s_getreg((7 << 11) | (8 << 6) | 4) & 0xffu);
    const unsigned rank = xb_add(cut + key, 1u);
    if (rank == 0u) { const unsigned ord = xb_add(cut + 8192, 1u); __hip_atomic_store(cut + 4096 + key, ord, __ATOMIC_RELAXED, __HIP_MEMORY_SCOPE_AGENT); }
    if (rank >= 2u) xb_add(cut + 8193, 1u);
    rolev = make_int4((int)blockIdx.x, 0, (int)key, (int)rank);
  }
  __syncthreads();
#if PROBE >= 100
  unsigned long long tacc = 0;
#endif
#if PROBE >= 200
  if (blockIdx.x == 0 && threadIdx_x_raw() == 0) g_tacc[0] = 0;
#endif
  for (int ph = pb; ph < pe; ++ph) {
    if (ph > pb) {
      if (ph == pb + 1) {
        grid.sync();
        if (threadIdx_x_raw() == 0) {
          const unsigned key = (unsigned)rolev.z, rank = (unsigned)rolev.w;
          const unsigned ord = xb_ld(cut + 4096 + key), ncu = xb_ld(cut + 8192), bad = xb_ld(cut + 8193);
          if (bad == 0u && 2u * ncu == gridDim.x && rank < 2u && ncu >= 256u) {
            if (ord < 128u) rolev.x = rank == 0u ? (int)ord : (int)(256u + ord);
            else if (ord < 192u) rolev.x = (int)(128u + 2u * (ord - 128u) + rank);
            else rolev.x = (int)(384u + 2u * (ord - 192u) + rank);
            rolev.y = 1;
          }
        }
        __syncthreads();
      } else xcd_barrier(xb);
    }
#if PROBE == 6
    if (ph >= 1 && ph < NPHASES - 1 && ((ph - 1) % PH_PER_LAYER) == 4) {
      const int l = (ph - 1) / PH_PER_LAYER;
      mixer_phase(p, l, smem, l, 1);
      xcd_barrier(xb);
      mixer_phase(p, l, smem, l, 1);
      xcd_barrier(xb);
      mixer_phase(p, l, smem, l, 2);
      continue;
    }
#endif
#if PROBE >= 100
    const bool tph = (ph >= 1 && ph < NPHASES - 1 && ((ph - 1) % PH_PER_LAYER) == (PROBE - 100));
    unsigned long long t0 = 0;
    if (tph && blockIdx.x == 0) t0 = __builtin_amdgcn_s_memrealtime();
#endif
    run_phase(p, ph, smem, rolev.x, rolev.y);
#if PROBE >= 100
    if (tph) { xcd_barrier(xb); if (blockIdx.x == 0) tacc += __builtin_amdgcn_s_memrealtime() - t0; }
#endif
  }
#if PROBE >= 100
#if PROBE == 300
  if (blockIdx.x == 0) { const unsigned long long te = __builtin_amdgcn_s_memrealtime() + (rolev.w == 1000 ? 300000ull : (rolev.w == 2001 ? 600000ull : 900000ull)); while (__builtin_amdgcn_s_memrealtime() < te) __builtin_amdgcn_s_sleep(8); }
#elif PROBE >= 200
  {
    __syncthreads();
    const unsigned long long ta = g_tacc[0];
    if (ta) { const unsigned long long te = __builtin_amdgcn_s_memrealtime() + 4ull * ta; while (__builtin_amdgcn_s_memrealtime() < te) __builtin_amdgcn_s_sleep(8); }
  }
#else
  if (blockIdx.x == 0) { const unsigned long long te = __builtin_amdgcn_s_memrealtime() + 4ull * tacc; while (__builtin_amdgcn_s_memrealtime() < te) __builtin_amdgcn_s_sleep(8); }
#endif
#endif
}

extern "C" void kernel_launch(void* const* d_in, const int* in_sizes, int n_in, void* d_out, int out_size, void* d_ws,
                              size_t ws_size, hipStream_t stream) {
  static int grid_blocks = 0;
  if (grid_blocks == 0) {
    int dev = 0, cus = 0, per_cu = 0;
    hipGetDevice(&dev);
    hipDeviceGetAttribute(&cus, hipDeviceAttributeMultiprocessorCount, dev);
    hipFuncSetAttribute((const void*)mega, hipFuncAttributeMaxDynamicSharedMemorySize, LDS_BYTES);
    hipOccupancyMaxActiveBlocksPerMultiprocessor(&per_cu, (const void*)mega, 256, LDS_BYTES);
    if (per_cu < 1) per_cu = 1;
    if (per_cu > 2) per_cu = 2;
    grid_blocks = cus * per_cu;
    fprintf(stderr, "mega: cus %d per_cu %d grid %d\n", cus, per_cu, grid_blocks);
  }
  P p{};
  const float** ins = (const float**)&p;
  for (int i = 0; i < 33; ++i) ins[i] = (const float*)d_in[i];
  p.XL = (float*)d_out;
  p.ws = (char*)d_ws;
  const size_t off = WS_TOTAL;
  if (off > ws_size || n_in != 33) { fprintf(stderr, "mega: workspace too small (%zu > %zu) or n_in %d\n", off, ws_size, n_in); return; }
  (void)hipMemsetAsync((char*)d_ws + OFF_BAR, 0, BAR_BYTES, stream);
  int pb = 0, pe = NPHASES;
  void* args[] = {&p, &pb, &pe};
  hipError_t e = hipLaunchCooperativeKernel((const void*)mega, dim3(grid_blocks), dim3(256), args, LDS_BYTES, stream);
  if (e != hipSuccess) fprintf(stderr, "mega: cooperative launch failed: %s (grid %d)\n", hipGetErrorString(e), grid_blocks);
}
```

```cpp
#include <hip/hip_runtime.h>
#include <hip/hip_cooperative_groups.h>
#include <cstdio>
#include <cstdint>
namespace cg = cooperative_groups;

typedef _Float16 h16;
typedef _Float16 h16x8 __attribute__((ext_vector_type(8)));
typedef _Float16 h16x4 __attribute__((ext_vector_type(4)));
typedef float f32x16 __attribute__((ext_vector_type(16)));
typedef float f32x4 __attribute__((ext_vector_type(4)));

#define DEVI __device__ __forceinline__
DEVI int threadIdx_x_raw() { return (int)__builtin_amdgcn_workitem_id_x(); }

#define PROBE 0
constexpr int D = 1024, NB = 4, SEQ = 4096, CTX = 256, DEPTH = 4;
constexpr int SB = SEQ + CTX;
constexpr int NR = NB * SB;
constexpr int ZW = 4160;
constexpr int ZMLA = 1568, ZRW = 2240;
constexpr int NIN = 7232;
constexpr int DFF = 4096;
constexpr int LDS_BYTES = 74752;
constexpr int NSCAN_BPC = 2;
constexpr int NSCAN = 64 * NSCAN_BPC;
constexpr int NGLA = 128;
constexpr int TSTEPS = SB + 1;
constexpr int NCHUNK = (TSTEPS + 15) / 16;

constexpr size_t al256(size_t x) { return (x + 255) & ~(size_t)255; }
constexpr size_t OFF_XC = 0;
constexpr size_t OFF_MOD = OFF_XC + al256((size_t)NB * CTX * D * 4);
constexpr size_t OFF_ROPE = OFF_MOD + al256((size_t)DEPTH * 5 * 6144 * 4);
constexpr size_t OFF_INVN = OFF_ROPE + al256((size_t)SEQ * 32 * 4);
constexpr size_t OFF_CTR = OFF_INVN + al256((size_t)NR * 8 * 4);
constexpr size_t OFF_BAR = OFF_CTR + al256(256);
constexpr size_t BAR_BYTES = (size_t)(3584 + 4096 + 4096 + 64) * 4;
constexpr size_t OFF_HLO = OFF_BAR + al256(BAR_BYTES);
constexpr size_t OFF_HHI = OFF_HLO + al256((size_t)(NR / 64) * 1920 * 2);
constexpr size_t OFF_H = OFF_HHI + al256((size_t)(NR / 64) * 1920 * 2);
constexpr size_t OFF_Z = OFF_H + al256((size_t)NR * D * 2);
constexpr size_t OFF_WIN = OFF_Z + al256((size_t)NR * ZW * 2);
constexpr size_t OFF_UQ = OFF_WIN + al256((size_t)NIN * D * 2);
constexpr size_t OFF_UKV = OFF_UQ + al256((size_t)768 * 384 * 2);
constexpr size_t OFF_WB = OFF_UKV + al256((size_t)1024 * 256 * 2);
constexpr size_t OFF_WO = OFF_WB + al256((size_t)3 * D * 512 * 2);
constexpr size_t OFF_WUP = OFF_WO + al256((size_t)D * D * 2);
constexpr size_t OFF_AUP = OFF_WUP + al256((size_t)2 * 512 * 64 * 2);
constexpr size_t OFF_GUP = OFF_AUP + al256((size_t)2 * 512 * 64 * 2);
constexpr size_t OFF_LW = OFF_GUP + al256((size_t)512 * 128 * 2);
constexpr size_t OFF_AA = OFF_LW + al256((size_t)2 * NR * 512 * 2);
constexpr size_t OFF_G = OFF_AA + al256((size_t)2 * NR * 512 * 2);
constexpr size_t OFF_Y2 = OFF_G + al256((size_t)NR * 512 * 2);
constexpr size_t OFF_Q = OFF_Y2 + al256((size_t)2 * NR * 512 * 2);
constexpr size_t OFF_K = OFF_Q + al256((size_t)NR * 768 * 2);
constexpr size_t OFF_VT = OFF_K + al256((size_t)NR * 768 * 2);
constexpr size_t OFF_QIN = OFF_VT + al256((size_t)NR * 512 * 2);
constexpr size_t OFF_KIN = OFF_QIN + al256((size_t)2 * NR * 256 * 2);
constexpr size_t OFF_DEC = OFF_KIN + al256((size_t)2 * NR * 256 * 2);
constexpr size_t OFF_OFB = OFF_DEC + al256((size_t)32 * 68 * 64 * 4);
constexpr size_t WS_TOTAL = OFF_OFB + al256((size_t)2 * NR * 512 * 2);
struct P {
  const float *x, *c, *ctx, *c_ctx, *ada_w, *ada_b, *w_in, *gk_up, *gk_b, *gla_ng, *qn_g, *kvn_g, *w_uq, *w_ukv,
      *mu, *w0, *w_up, *a0, *a_up, *g_up, *k_k, *k_a, *r_k, *rln_g, *rln_b, *w_branch, *w_out, *ln1_g, *ln1_b,
      *w1, *w2, *ln2_g, *ln2_b;
  float* XL;
  char* ws;
  DEVI float* XC() const { return (float*)(ws + OFF_XC); }
  DEVI float* MOD() const { return (float*)(ws + OFF_MOD); }
  DEVI float* ROPE() const { return (float*)(ws + OFF_ROPE); }
  DEVI float* INVN() const { return (float*)(ws + OFF_INVN); }
  DEVI unsigned* CTR() const { return (unsigned*)(ws + OFF_CTR); }
  DEVI unsigned* BAR() const { return (unsigned*)(ws + OFF_BAR); }
  DEVI h16* HLO() const { return (h16*)(ws + OFF_HLO); }
  DEVI h16* HHI() const { return (h16*)(ws + OFF_HHI); }
  DEVI h16* H() const { return (h16*)(ws + OFF_H); }
  DEVI h16* Z() const { return (h16*)(ws + OFF_Z); }
  DEVI h16* WIN() const { return (h16*)(ws + OFF_WIN); }
  DEVI h16* UQ() const { return (h16*)(ws + OFF_UQ); }
  DEVI h16* UKV() const { return (h16*)(ws + OFF_UKV); }
  DEVI h16* WB() const { return (h16*)(ws + OFF_WB); }
  DEVI h16* WO() const { return (h16*)(ws + OFF_WO); }
  DEVI h16* WUP() const { return (h16*)(ws + OFF_WUP); }
  DEVI h16* AUP() const { return (h16*)(ws + OFF_AUP); }
  DEVI h16* GUP() const { return (h16*)(ws + OFF_GUP); }
  DEVI h16* LW() const { return (h16*)(ws + OFF_LW); }
  DEVI h16* AA() const { return (h16*)(ws + OFF_AA); }
  DEVI h16* G() const { return (h16*)(ws + OFF_G); }
  DEVI h16* Y2() const { return (h16*)(ws + OFF_Y2); }
  DEVI h16* Q() const { return (h16*)(ws + OFF_Q); }
  DEVI h16* K() const { return (h16*)(ws + OFF_K); }
  DEVI h16* VT() const { return (h16*)(ws + OFF_VT); }
  DEVI unsigned short* QIN() const { return (unsigned short*)(ws + OFF_QIN); }
  DEVI unsigned short* KIN() const { return (unsigned short*)(ws + OFF_KIN); }
  DEVI float* DEC() const { return (float*)(ws + OFF_DEC); }
  DEVI h16* OFB() const { return (h16*)(ws + OFF_OFB); }
  DEVI h16* W1T() const { return (h16*)(ws + OFF_LW); }
  DEVI h16* W2T() const { return (h16*)(ws + OFF_LW + (size_t)DFF * D * 2); }
  DEVI h16* M() const { return (h16*)(ws + OFF_Q); }
  DEVI h16* YA() const { return (h16*)(ws + OFF_Z + 1056 * 2); }
};

DEVI int tidx() { int t = threadIdx_x_raw(); asm volatile("" : "+v"(t)); return t; }
DEVI float wsum(float v) {
#pragma unroll
  for (int o = 32; o; o >>= 1) v += __shfl_xor(v, o);
  return v;
}
DEVI float sigm(float x) { return 1.f / (1.f + __expf(-x)); }
DEVI unsigned pk2(float a, float b) {
  auto h = __builtin_amdgcn_cvt_pkrtz(a, b);
  return __builtin_bit_cast(unsigned, h);
}
DEVI unsigned pk2n(float a, float b) {
  h16 x = (h16)a, y = (h16)b;
  unsigned short ux = __builtin_bit_cast(unsigned short, x), uy = __builtin_bit_cast(unsigned short, y);
  return (unsigned)ux | ((unsigned)uy << 16);
}
DEVI unsigned f2bf(float f) { unsigned u = __builtin_bit_cast(unsigned, f); u += 0x7fffu + ((u >> 16) & 1u); return u >> 16; }
DEVI float h2f(unsigned short u) { return (float)__builtin_bit_cast(h16, u); }
DEVI void st4h(h16* dst, float a, float b, float c, float d) {
  uint2 u; u.x = pk2n(a, b); u.y = pk2n(c, d);
  *(uint2*)dst = u;
}
DEVI float* xrow(const P& p, int r) {
  int b = r / SB, s = r - b * SB;
  return s < CTX ? p.XC() + (size_t)(b * CTX + s) * D : p.XL + (size_t)(b * SEQ + s - CTX) * D;
}
DEVI int maprow(int dir, int b, int n) {
  if (dir == 0) return b * SB + n;
  return n < CTX ? b * SB + (CTX - 1 - n) : b * SB + (SB + CTX - 1 - n);
}


#define XB_TMO      128
#define XB_XCNT(j)  (256  + 64 * (j))
#define XB_XSUB(j)  (1280 + 64 * (j))
#define XB_XGEN(j)  (2304 + 64 * (j))
#define XB_TOP      3328
#define XB_TOPGEN   3392
#define XCD_BAR_WORDS 3456
#define XB_SPIN_CAP (1u << 22)
#define LAS __attribute__((address_space(3)))
DEVI unsigned xb_ld(unsigned* p) { return __hip_atomic_load(p, __ATOMIC_RELAXED, __HIP_MEMORY_SCOPE_AGENT); }
DEVI unsigned xb_add(unsigned* p, unsigned v) { return __hip_atomic_fetch_add(p, v, __ATOMIC_RELAXED, __HIP_MEMORY_SCOPE_AGENT); }
DEVI unsigned xb_xcc_id() { return (unsigned)__builtin_amdgcn_s_getreg((3 << 11) | 20) & 0xFu; }
#define XB_SPIN(cond, bar) do { unsigned _sp = 0; while (cond) { __builtin_amdgcn_s_sleep(1); \
    if ((++_sp & 255u) == 0u) { if (xb_ld(&(bar)[XB_TMO])) break; if (_sp > XB_SPIN_CAP) { atomicAdd(&(bar)[XB_TMO], 1u); break; } } } } while (0)
struct XcdBarrier { unsigned* bar; unsigned x; volatile LAS unsigned* st; };
DEVI XcdBarrier xcd_barrier_post(unsigned* bar, volatile LAS unsigned* st) {
  XcdBarrier b; b.bar = bar; b.x = xb_xcc_id(); b.st = st;
  if (threadIdx_x_raw() == 0) (void)xb_add(&bar[XB_XCNT(b.x)], 1u);
  return b;
}
DEVI void xcd_barrier_complete(unsigned* bar, unsigned x, unsigned& nloc, unsigned& nx) {
  const unsigned G = gridDim.x;
  unsigned sum, cnt, mine, sp = 0u;
  for (;;) {
    sum = 0u; cnt = 0u; mine = 0u;
#pragma unroll
    for (unsigned j = 0; j < 16; ++j) { const unsigned c = xb_ld(&bar[XB_XCNT(j)]); sum += c; cnt += (c > 0u) ? 1u : 0u; mine = (j == x) ? c : mine; }
    if (sum == G) break;
    __builtin_amdgcn_s_sleep(1);
    if ((++sp & 255u) == 0u) { if (xb_ld(&bar[XB_TMO])) break; if (sp > XB_SPIN_CAP) { atomicAdd(&bar[XB_TMO], 1u); break; } }
  }
  nloc = mine > 0u ? mine : 1u; nx = cnt > 0u ? cnt : 1u;
}
DEVI void xcd_barrier(const XcdBarrier& b) {
  asm volatile("s_waitcnt vmcnt(0)" ::: "memory");
  __syncthreads();
  if (threadIdx_x_raw() == 0) {
    unsigned* bar = b.bar;
    __builtin_amdgcn_s_waitcnt(0);
    unsigned nloc = b.st[0], nx = b.st[1];
    if (nloc == 0u) { xcd_barrier_complete(bar, b.x, nloc, nx); b.st[0] = nloc; b.st[1] = nx; }
    const unsigned old = xb_add(&bar[XB_XSUB(b.x)], 1u);
    const unsigned gen = old / nloc;
    if (old + 1u == (gen + 1u) * nloc) {
      __builtin_amdgcn_fence(__ATOMIC_RELEASE, "agent");
      asm volatile("s_waitcnt vmcnt(0)" ::: "memory");
      const unsigned og = xb_add(&bar[XB_TOP], 1u);
      const unsigned tg = og / nx;
      if (og + 1u == (tg + 1u) * nx) xb_add(&bar[XB_TOPGEN], 1u);
      else XB_SPIN(xb_ld(&bar[XB_TOPGEN]) == tg, bar);
      __builtin_amdgcn_fence(__ATOMIC_ACQUIRE, "agent");
      xb_add(&bar[XB_XGEN(b.x)], 1u);
      asm volatile("s_waitcnt vmcnt(0)" ::: "memory");
    } else {
      XB_SPIN(xb_ld(&bar[XB_XGEN(b.x)]) == gen, bar);
      __builtin_amdgcn_fence(__ATOMIC_ACQUIRE, "agent");
      asm volatile("s_waitcnt vmcnt(0)" ::: "memory");
    }
  }
  __syncthreads();
}

DEVI void phase0(const P& p, char* smem) {
  const int tid = tidx();
  float* sc = (float*)smem;
  float* red = sc + 5 * 1024;
  for (int i = tid; i < 5 * 1024; i += 256) {
    int g = i >> 10, k = i & 1023;
    float v = g < 4 ? p.c[g * D + k] : p.c_ctx[k];
    sc[i] = v * sigm(v);
  }
  __syncthreads();
  for (int job = blockIdx.x; job < DEPTH * 96; job += gridDim.x) {
    int l = job / 96, n0 = (job % 96) * 64;
    int kq = tid >> 6, cc = tid & 63;
    const float* w = p.ada_w + ((size_t)l * D + kq * 256) * 6144 + n0 + cc;
    float a0 = 0, a1 = 0, a2 = 0, a3 = 0, a4 = 0;
#pragma unroll 8
    for (int k = 0; k < 256; ++k) {
      float wv = w[(size_t)k * 6144];
      int kk = kq * 256 + k;
      a0 += sc[kk] * wv; a1 += sc[1024 + kk] * wv; a2 += sc[2048 + kk] * wv; a3 += sc[3072 + kk] * wv; a4 += sc[4096 + kk] * wv;
    }
    red[(kq * 5 + 0) * 64 + cc] = a0; red[(kq * 5 + 1) * 64 + cc] = a1; red[(kq * 5 + 2) * 64 + cc] = a2;
    red[(kq * 5 + 3) * 64 + cc] = a3; red[(kq * 5 + 4) * 64 + cc] = a4;
    __syncthreads();
    for (int i = tid; i < 320; i += 256) {
      int g = i >> 6, c2 = i & 63;
      float s = red[(0 * 5 + g) * 64 + c2] + red[(1 * 5 + g) * 64 + c2] + red[(2 * 5 + g) * 64 + c2] + red[(3 * 5 + g) * 64 + c2];
      p.MOD()[((size_t)l * 5 + g) * 6144 + n0 + c2] = s + p.ada_b[l * 6144 + n0 + c2];
    }
    __syncthreads();
  }
  for (int i = blockIdx.x * 256 + tid; i < SEQ * 16; i += gridDim.x * 256) {
    int s = i >> 4, j = i & 15;
    float pos = (float)(j < 8 ? (s >> 6) : (s & 63));
    float inv = exp2f(-(float)(j & 7) * (13.287712379549449f / 8.f));
    float ang = pos * inv;
    p.ROPE()[s * 32 + j] = cosf(ang);
    p.ROPE()[s * 32 + 16 + j] = sinf(ang);
  }
  if (blockIdx.x == 0 && tid < 64) p.CTR()[tid] = 0;
}

struct CE { const float* src; h16* dst; const float* scale; int K, N; };
DEVI CE get_ce(const P& p, int l, int e) {
  CE c; c.scale = nullptr;
  switch (e) {
    case 0: c.src = p.w_in + (size_t)l * D * NIN; c.dst = p.WIN(); c.K = D; c.N = NIN; break;
    case 1: c.src = p.w_uq + (size_t)l * 384 * 768; c.dst = p.UQ(); c.K = 384; c.N = 768; c.scale = p.qn_g + l * 384; break;
    case 2: c.src = p.w_ukv + (size_t)l * 256 * 1024; c.dst = p.UKV(); c.K = 256; c.N = 1024; c.scale = p.kvn_g + l * 256; break;
    case 3: case 4: case 5: c.src = p.w_branch + ((size_t)l * 3 + (e - 3)) * 512 * D; c.dst = p.WB() + (size_t)(e - 3) * D * 512; c.K = 512; c.N = D; break;
    case 6: c.src = p.w_out + (size_t)l * D * D; c.dst = p.WO(); c.K = D; c.N = D; break;
    case 7: case 8: c.src = p.w_up + ((size_t)l * 2 + (e - 7)) * 64 * 512; c.dst = p.WUP() + (size_t)(e - 7) * 512 * 64; c.K = 64; c.N = 512; break;
    case 9: case 10: c.src = p.a_up + ((size_t)l * 2 + (e - 9)) * 64 * 512; c.dst = p.AUP() + (size_t)(e - 9) * 512 * 64; c.K = 64; c.N = 512; break;
    case 11: c.src = p.g_up + (size_t)l * 128 * 512; c.dst = p.GUP(); c.K = 128; c.N = 512; break;
    case 12: c.src = p.w1 + (size_t)l * D * DFF; c.dst = p.W1T(); c.K = D; c.N = DFF; break;
    default: c.src = p.w2 + (size_t)l * DFF * D; c.dst = p.W2T(); c.K = DFF; c.N = D; break;
  }
  return c;
}
DEVI void conv_tile(const CE& e, int tile, char* smem) {
  float* s = (float*)smem;
  const int tid = tidx();
  int ntn = e.N >> 6;
  int kt = tile / ntn, nt = tile - kt * ntn;
  {
    int r = tid >> 4, c4 = (tid & 15) * 4;
#pragma unroll
    for (int rr = 0; rr < 4; ++rr) {
      int k = r + 16 * rr;
      float4 v = *(const float4*)(e.src + (size_t)(kt * 64 + k) * e.N + nt * 64 + c4);
      float sc = e.scale ? e.scale[kt * 64 + k] : 1.f;
      s[k * 65 + c4 + 0] = v.x * sc; s[k * 65 + c4 + 1] = v.y * sc; s[k * 65 + c4 + 2] = v.z * sc; s[k * 65 + c4 + 3] = v.w * sc;
    }
  }
  __syncthreads();
  {
    int n = tid >> 2, kq = (tid & 3) * 16;
    uint4 u0, u1;
    u0.x = pk2n(s[(kq + 0) * 65 + n], s[(kq + 1) * 65 + n]); u0.y = pk2n(s[(kq + 2) * 65 + n], s[(kq + 3) * 65 + n]);
    u0.z = pk2n(s[(kq + 4) * 65 + n], s[(kq + 5) * 65 + n]); u0.w = pk2n(s[(kq + 6) * 65 + n], s[(kq + 7) * 65 + n]);
    u1.x = pk2n(s[(kq + 8) * 65 + n], s[(kq + 9) * 65 + n]); u1.y = pk2n(s[(kq + 10) * 65 + n], s[(kq + 11) * 65 + n]);
    u1.z = pk2n(s[(kq + 12) * 65 + n], s[(kq + 13) * 65 + n]); u1.w = pk2n(s[(kq + 14) * 65 + n], s[(kq + 15) * 65 + n]);
    h16* d = e.dst + (size_t)(nt * 64 + n) * e.K + kt * 64 + kq;
    *(uint4*)d = u0; *(uint4*)(d + 8) = u1;
  }
  __syncthreads();
}
DEVI void conv_phase(const P& p, int l, int e0, int e1, char* smem) {
  int total = 0;
  for (int e = e0; e < e1; ++e) { CE c = get_ce(p, l, e); total += (c.K >> 6) * (c.N >> 6); }
  for (int t = blockIdx.x; t < total; t += gridDim.x) {
    int tt = t;
    for (int e = e0; e < e1; ++e) {
      CE c = get_ce(p, l, e);
      int nt = (c.K >> 6) * (c.N >> 6);
      if (tt < nt) { conv_tile(c, tt, smem); break; }
      tt -= nt;
    }
  }
}

DEVI void ln_phase(const P& p, int l, int which) {
  const int lane = tidx() & 63;
  const int wid = blockIdx.x * 4 + (tidx() >> 6), nw = gridDim.x * 4;
  for (int r = wid; r < NR; r += nw) {
    int b = r / SB, s = r - b * SB;
    if (which == 2 && s < CTX) continue;
    int g = s < CTX ? 4 : b;
    float* xr = xrow(p, r);
    const float* src = xr;
    if (which == 0 && l == 0) src = s < CTX ? p.ctx + (size_t)(b * CTX + s) * D : p.x + (size_t)(b * SEQ + s - CTX) * D;
    float4 v[4];
#pragma unroll
    for (int i = 0; i < 4; ++i) v[i] = *(const float4*)(src + i * 256 + lane * 4);
    bool do_ln = !(which == 0 && l == 0);
    if (do_ln) {
      const float* gg = which == 1 ? p.ln1_g + l * D : p.ln2_g + (which == 2 ? 3 : l - 1) * D;
      const float* bb = which == 1 ? p.ln1_b + l * D : p.ln2_b + (which == 2 ? 3 : l - 1) * D;
      float sm = 0;
#pragma unroll
      for (int i = 0; i < 4; ++i) sm += v[i].x + v[i].y + v[i].z + v[i].w;
      float mean = wsum(sm) * (1.f / D);
      float sq = 0;
#pragma unroll
      for (int i = 0; i < 4; ++i) {
        v[i].x -= mean; v[i].y -= mean; v[i].z -= mean; v[i].w -= mean;
        sq += v[i].x * v[i].x + v[i].y * v[i].y + v[i].z * v[i].z + v[i].w * v[i].w;
      }
      float rs = rsqrtf(wsum(sq) * (1.f / D) + 1e-5f);
#pragma unroll
      for (int i = 0; i < 4; ++i) {
        float4 g4 = *(const float4*)(gg + i * 256 + lane * 4), b4 = *(const float4*)(bb + i * 256 + lane * 4);
        v[i].x = v[i].x * rs * g4.x + b4.x; v[i].y = v[i].y * rs * g4.y + b4.y;
        v[i].z = v[i].z * rs * g4.z + b4.z; v[i].w = v[i].w * rs * g4.w + b4.w;
      }
    }
#pragma unroll
    for (int i = 0; i < 4; ++i) *(float4*)(xr + i * 256 + lane * 4) = v[i];
    if (which == 2) continue;
    const float* shf = p.MOD() + ((size_t)l * 5 + g) * 6144 + (which == 0 ? 0 : 3) * D;
    const float* scl = shf + D;
    float sm = 0;
#pragma unroll
    for (int i = 0; i < 4; ++i) sm += v[i].x + v[i].y + v[i].z + v[i].w;
    float mean = wsum(sm) * (1.f / D);
    float sq = 0;
#pragma unroll
    for (int i = 0; i < 4; ++i) {
      v[i].x -= mean; v[i].y -= mean; v[i].z -= mean; v[i].w -= mean;
      sq += v[i].x * v[i].x + v[i].y * v[i].y + v[i].z * v[i].z + v[i].w * v[i].w;
    }
    float rs = rsqrtf(wsum(sq) * (1.f / D) + 1e-6f);
    h16* hr = p.H() + (size_t)r * D;
#pragma unroll
    for (int i = 0; i < 4; ++i) {
      float4 s4 = *(const float4*)(shf + i * 256 + lane * 4), c4 = *(const float4*)(scl + i * 256 + lane * 4);
      st4h(hr + i * 256 + lane * 4, v[i].x * rs * (1.f + c4.x) + s4.x, v[i].y * rs * (1.f + c4.y) + s4.y,
           v[i].z * rs * (1.f + c4.z) + s4.z, v[i].w * rs * (1.f + c4.w) + s4.w);
    }
  }
}

constexpr int GLD = 72;
template <bool ROWSQ, int NI = 2>
DEVI void gemm_main(const h16* __restrict__ A, int lda, const h16* __restrict__ Bt, int ldb, int K, int m0, int n0, int nmax,
                    char* smem, f32x16 (&acc)[2][NI], float* rowsq) {
  h16* As = (h16*)smem;
  h16* Bs = As + 2 * 128 * GLD;
  const int tid = tidx(), lane = tid & 63, wv = tid >> 6;
  const int wm = wv >> 1, wn = wv & 1, l31 = lane & 31, hh = lane >> 5;
  const int lrow = tid >> 3, lkc = (tid & 7) * 8;
  uint4 ga[4], gb[2 * NI];
  float sq[4] = {0.f, 0.f, 0.f, 0.f};
  const h16* Ap = A + (size_t)(m0 + lrow) * lda + lkc;
  const h16* Bp = Bt + (size_t)(n0 + lrow) * ldb + lkc;
#pragma unroll
  for (int i = 0; i < 4; ++i) ga[i] = *(const uint4*)(Ap + (size_t)(32 * i) * lda);
#pragma unroll
  for (int i = 0; i < 2 * NI; ++i)
    gb[i] = (n0 + lrow + 32 * i < nmax) ? *(const uint4*)(Bp + (size_t)(32 * i) * ldb) : make_uint4(0, 0, 0, 0);
  const int KT = K >> 6;
#pragma unroll
  for (int i = 0; i < 4; ++i) *(uint4*)(As + (lrow + 32 * i) * GLD + lkc) = ga[i];
#pragma unroll
  for (int i = 0; i < 2 * NI; ++i) *(uint4*)(Bs + (lrow + 32 * i) * GLD + lkc) = gb[i];
  __syncthreads();
  for (int kt = 0; kt < KT; ++kt) {
    const int buf = kt & 1;
    if (ROWSQ) {
#pragma unroll
      for (int i = 0; i < 4; ++i) {
        h16x8 hv = __builtin_bit_cast(h16x8, ga[i]);
#pragma unroll
        for (int j = 0; j < 8; ++j) { float f = (float)hv[j]; sq[i] += f * f; }
      }
    }
    if (kt + 1 < KT) {
#pragma unroll
      for (int i = 0; i < 4; ++i) ga[i] = *(const uint4*)(Ap + (size_t)(32 * i) * lda + (kt + 1) * 64);
#pragma unroll
      for (int i = 0; i < 2 * NI; ++i)
        gb[i] = (n0 + lrow + 32 * i < nmax) ? *(const uint4*)(Bp + (size_t)(32 * i) * ldb + (kt + 1) * 64) : make_uint4(0, 0, 0, 0);
    }
    const h16* as = As + buf * 128 * GLD + (wm * 64 + l31) * GLD + hh * 8;
    const h16* bs = Bs + buf * 128 * GLD + (wn * 32 * NI + l31) * GLD + hh * 8;
#pragma unroll
    for (int ks = 0; ks < 4; ++ks) {
      h16x8 a0 = *(const h16x8*)(as + ks * 16), a1 = *(const h16x8*)(as + 32 * GLD + ks * 16);
#pragma unroll
      for (int ni = 0; ni < NI; ++ni) {
        h16x8 b0 = *(const h16x8*)(bs + ni * 32 * GLD + ks * 16);
        acc[0][ni] = __builtin_amdgcn_mfma_f32_32x32x16_f16(b0, a0, acc[0][ni], 0, 0, 0);
        acc[1][ni] = __builtin_amdgcn_mfma_f32_32x32x16_f16(b0, a1, acc[1][ni], 0, 0, 0);
      }
    }
    if (kt + 1 < KT) {
      h16* ad = As + (buf ^ 1) * 128 * GLD;
      h16* bd = Bs + (buf ^ 1) * 128 * GLD;
#pragma unroll
      for (int i = 0; i < 4; ++i) *(uint4*)(ad + (lrow + 32 * i) * GLD + lkc) = ga[i];
#pragma unroll
      for (int i = 0; i < 2 * NI; ++i) *(uint4*)(bd + (lrow + 32 * i) * GLD + lkc) = gb[i];
    }
    __syncthreads();
  }
  if (ROWSQ) {
#pragma unroll
    for (int i = 0; i < 4; ++i) {
      float s = sq[i];
      s += __shfl_xor(s, 1); s += __shfl_xor(s, 2); s += __shfl_xor(s, 4);
      if ((tid & 7) == 0) rowsq[lrow + 32 * i] = s;
    }
    __syncthreads();
  }
}
template <int NI = 2, bool ROWSQ = false>
DEVI void gemm_deep(const h16* __restrict__ A, int lda, const h16* __restrict__ Bt, int ldb, int K, int m0, int n0, int nmax,
                    char* smem, f32x16 (&acc)[2][NI], float* rowsq = nullptr) {
  h16* As = (h16*)smem;
  h16* Bs = As + 2 * 128 * GLD;
  const int tid = tidx(), lane = tid & 63, wv = tid >> 6;
  const int wm = wv >> 1, wn = wv & 1, l31 = lane & 31, hh = lane >> 5;
  const int lrow = tid >> 3, lkc = (tid & 7) * 8;
  uint4 pa0, pa1, pa2, pa3, pb0, pb1, pb2, pb3;
  uint4 qa0, qa1, qa2, qa3, qb0, qb1, qb2, qb3;
  const h16* Ap = A + (size_t)(m0 + lrow) * lda + lkc;
  const int KT = K >> 6;
  const uint4 zz = make_uint4(0, 0, 0, 0);
  const h16* Bq0 = Bt + (size_t)min(n0 + lrow, nmax - 1) * ldb + lkc;
  const h16* Bq1 = Bt + (size_t)min(n0 + lrow + 32, nmax - 1) * ldb + lkc;
  const h16* Bq2 = Bt + (size_t)min(n0 + lrow + 64, nmax - 1) * ldb + lkc;
  const h16* Bq3 = Bt + (size_t)min(n0 + lrow + 96, nmax - 1) * ldb + lkc;
#define GLOAD(S, kt_)                                                                   \
  {                                                                                     \
    const h16* ap_ = Ap + (kt_) * 64;                                                   \
    S##a0 = *(const uint4*)(ap_); S##a1 = *(const uint4*)(ap_ + (size_t)32 * lda);      \
    S##a2 = *(const uint4*)(ap_ + (size_t)64 * lda); S##a3 = *(const uint4*)(ap_ + (size_t)96 * lda); \
    S##b0 = *(const uint4*)(Bq0 + (kt_) * 64); S##b1 = *(const uint4*)(Bq1 + (kt_) * 64); \
    if (NI == 2) { S##b2 = *(const uint4*)(Bq2 + (kt_) * 64); S##b3 = *(const uint4*)(Bq3 + (kt_) * 64); } \
  }
#define SQ8(u_, acc_) { _Pragma("unroll") for (int j_ = 0; j_ < 8; ++j_) { float f_ = (float)(u_)[j_]; acc_ += f_ * f_; } }
#define LSTORE(S, buf_)                                                                 \
  {                                                                                     \
    h16* ad = As + (buf_) * 128 * GLD + lrow * GLD + lkc;                               \
    h16* bd = Bs + (buf_) * 128 * GLD + lrow * GLD + lkc;                               \
    *(uint4*)(ad) = S##a0; *(uint4*)(ad + 32 * GLD) = S##a1; *(uint4*)(ad + 64 * GLD) = S##a2; *(uint4*)(ad + 96 * GLD) = S##a3; \
    *(uint4*)(bd) = S##b0; *(uint4*)(bd + 32 * GLD) = S##b1;                            \
    if (NI == 2) { *(uint4*)(bd + 64 * GLD) = S##b2; *(uint4*)(bd + 96 * GLD) = S##b3; } \
    if (ROWSQ) {   \
      const h16x8 t0_ = *(const h16x8*)(ad), t1_ = *(const h16x8*)(ad + 32 * GLD), t2_ = *(const h16x8*)(ad + 64 * GLD), t3_ = *(const h16x8*)(ad + 96 * GLD); \
      SQ8(t0_, sq0); SQ8(t1_, sq1); SQ8(t2_, sq2); SQ8(t3_, sq3); }                     \
  }
#define COMPUTE(buf_)                                                                                              \
  {                                                                                                                \
    const h16* as = As + (buf_) * 128 * GLD + (wm * 64 + l31) * GLD + hh * 8;                                      \
    const h16* bs = Bs + (buf_) * 128 * GLD + (wn * 32 * NI + l31) * GLD + hh * 8;                                 \
    _Pragma("unroll") for (int ks = 0; ks < 4; ++ks) {                                                             \
      h16x8 a0 = *(const h16x8*)(as + ks * 16), a1 = *(const h16x8*)(as + 32 * GLD + ks * 16);                     \
      _Pragma("unroll") for (int ni = 0; ni < NI; ++ni) {                                                          \
        h16x8 b0 = *(const h16x8*)(bs + ni * 32 * GLD + ks * 16);                                                  \
        acc[0][ni] = __builtin_amdgcn_mfma_f32_32x32x16_f16(b0, a0, acc[0][ni], 0, 0, 0);                          \
        acc[1][ni] = __builtin_amdgcn_mfma_f32_32x32x16_f16(b0, a1, acc[1][ni], 0, 0, 0);                          \
      }                                                                                                            \
    }                                                                                                              \
  }
  pb2 = zz; pb3 = zz; qb2 = zz; qb3 = zz;
  float sq0 = 0.f, sq1 = 0.f, sq2 = 0.f, sq3 = 0.f;
  GLOAD(p, 0);
  GLOAD(q, 1);
  LSTORE(p, 0);
  if (KT > 2) GLOAD(p, 2);
  __syncthreads();
  for (int kt = 0; kt < KT; kt += 2) {
    COMPUTE(0);
    if (kt + 1 < KT) LSTORE(q, 1);
    if (kt + 3 < KT) GLOAD(q, kt + 3);
    __syncthreads();
    if (kt + 1 < KT) {
      COMPUTE(1);
      if (kt + 2 < KT) LSTORE(p, 0);
      if (kt + 4 < KT) GLOAD(p, kt + 4);
      __syncthreads();
    }
  }
#undef GLOAD
#undef LSTORE
#undef COMPUTE
#undef SQ8
  if (ROWSQ) {
    float sqv[4] = {sq0, sq1, sq2, sq3};
#pragma unroll
    for (int i = 0; i < 4; ++i) {
      float t = sqv[i];
      t += __shfl_xor(t, 1); t += __shfl_xor(t, 2); t += __shfl_xor(t, 4);
      if ((tid & 7) == 0) rowsq[lrow + 32 * i] = t;
    }
    __syncthreads();
  }
}
DEVI void zero_acc(f32x16 (&acc)[2][2]) {
#pragma unroll
  for (int i = 0; i < 2; ++i)
#pragma unroll
    for (int j = 0; j < 2; ++j)
#pragma unroll
      for (int r = 0; r < 16; ++r) acc[i][j][r] = 0.f;
}
template <class F>
DEVI void epi_quads(const f32x16 (&acc)[2][2], int m0, int n0, F f) {
  const int lane = tidx() & 63, wv = tidx() >> 6;
  const int wm = wv >> 1, wn = wv & 1, l31 = lane & 31, hh = lane >> 5;
#pragma unroll
  for (int mi = 0; mi < 2; ++mi)
#pragma unroll
    for (int ni = 0; ni < 2; ++ni)
#pragma unroll
      for (int g = 0; g < 4; ++g)
        f(m0 + wm * 64 + mi * 32 + l31, n0 + wn * 64 + ni * 32 + 8 * g + 4 * hh, acc[mi][ni][4 * g], acc[mi][ni][4 * g + 1],
          acc[mi][ni][4 * g + 2], acc[mi][ni][4 * g + 3]);
}

DEVI void inproj_phase(const P& p, char* smem) {
  constexpr int MT = NR / 128, NT = (ZW + 127) / 128;
  for (int job = blockIdx.x; job < MT * NT; job += gridDim.x) {
    int nt = job / MT, mt = job - nt * MT;
    f32x16 acc[2][2]; zero_acc(acc);
    gemm_deep<2>(p.H(), D, p.WIN(), D, D, mt * 128, nt * 128, ZW, smem, acc);
    epi_quads(acc, mt * 128, nt * 128, [&](int m, int n, float v0, float v1, float v2, float v3) {
      if (n < ZW) {
        st4h(p.Z() + (size_t)m * ZW + n, v0, v1, v2, v3);
        if (n >= ZRW) {
          if ((m & 63) == 0) st4h(p.HLO() + (size_t)(m >> 6) * 1920 + n - ZRW, v0, v1, v2, v3);
          if ((m & 63) == 63) st4h(p.HHI() + (size_t)(m >> 6) * 1920 + n - ZRW, v0, v1, v2, v3);
        }
      }
    });
  }
}

DEVI void shift_job(const P& p, int l, int jj, char* smem) {
  const int j = jj >> 3, slab0 = jj & 7;
  h16* raw = (h16*)smem;
  const int tid = tidx(), lane = tid & 63;
  const int r0 = j * 64;
  const int s0 = r0 % SB;
  const bool first = (s0 == 0) || (s0 == CTX);
  const bool last = (s0 + 64 == CTX) || (s0 + 64 == SB);
  for (int slab = slab0; slab <= slab0; ++slab) {
    const int c0 = slab * 256;
    const int ncols = slab == 7 ? 128 : 256;
    const int cpr = ncols >> 3;
    for (int c = tid; c < 66 * cpr; c += 256) {
      int row = c / cpr, ch = (c - row * cpr) * 8;
      uint4 v = make_uint4(0, 0, 0, 0);
      if (row == 0) { if (!first) v = *(const uint4*)(p.HHI() + (size_t)(j - 1) * 1920 + c0 + ch); }
      else if (row == 65) { if (!last) v = *(const uint4*)(p.HLO() + (size_t)(j + 1) * 1920 + c0 + ch); }
      else v = *(const uint4*)(p.Z() + (size_t)(r0 + row - 1) * ZW + ZRW + c0 + ch);
      *(uint4*)(raw + row * 264 + ch) = v;
    }
    __syncthreads();
    if (tid < ncols) {
      const int col = c0 + tid;
      const float mup = p.mu[(size_t)l * 2 * 1920 + col], mun = p.mu[(size_t)l * 2 * 1920 + 1920 + col];
      const bool isk = (col >= 512 && col < 1024);
      const float kkp = isk ? p.k_k[l * 512 + col - 512] : 0.f;
      float prev = (float)raw[tid], cur = (float)raw[264 + tid];
      h16* zc = p.Z() + (size_t)r0 * ZW + ZRW + col;
      for (int t = 0; t < 64; ++t) {
        float nxt = (float)raw[(t + 2) * 264 + tid];
        float o = cur + mup * (prev - cur) + mun * (nxt - cur);
        float ov = o;
        if (col >= 1536 && col < 1664) ov = tanhf(o);
        else if (col >= 1792) ov = sigm(o);
        zc[(size_t)t * ZW] = (h16)ov;
        if (isk) {
          float q = o * kkp;
          float ss = wsum(q * q);
          if (lane == 0) p.INVN()[(size_t)(r0 + t) * 8 + ((col - 512) >> 6)] = rsqrtf(ss + 1e-12f);
        }
        prev = cur; cur = nxt;
      }
    }
    __syncthreads();
  }
}

DEVI void mla_up_job(const P& p, int job, char* smem) {
  constexpr int MT = NR / 128;
  float* rowsq = (float*)(smem + 2 * 2 * 128 * GLD * 2);
  const int tid = tidx();
  f32x16 acc[2][2]; zero_acc(acc);
  if (job < MT * 6) {
    int nt = job / MT, mt = job - nt * MT;
    gemm_deep<2, true>(p.Z() + ZMLA, ZW, p.UQ(), 384, 384, mt * 128, nt * 128, 768, smem, acc, rowsq);
    const int m0 = mt * 128, n0 = nt * 128;
    const int lane = tid & 63, wv = tid >> 6, wm = wv >> 1, wn = wv & 1, l31 = lane & 31, hh = lane >> 5;
    const float qs = 0.10206207261596575f * 1.4426950408889634f;
#pragma unroll
    for (int mi = 0; mi < 2; ++mi) {
      const int ml = wm * 64 + mi * 32 + l31, m = m0 + ml;
      const float sc = rsqrtf(rowsq[ml] * (1.f / 384.f) + 1e-6f) * qs;
      const int sp = m % SB;
      const bool lat = sp >= CTX;
      const float* rp = p.ROPE() + (size_t)(lat ? sp - CTX : 0) * 32;
#pragma unroll
      for (int ni = 0; ni < 2; ++ni) {
        const int nb = n0 + wn * 64 + ni * 32;
        h16* qd = p.Q() + (size_t)m * 768 + nb;
        const bool ropet = (nb % 96) == 64;
        if (ropet && lat) {
#pragma unroll
          for (int g = 0; g < 2; ++g) {
            float o1[4], o2[4];
#pragma unroll
            for (int jj = 0; jj < 4; ++jj) {
              int i = 8 * g + 4 * hh + jj;
              float x1 = acc[mi][ni][4 * g + jj] * sc, x2 = acc[mi][ni][4 * (g + 2) + jj] * sc;
              float cs = rp[i], sn = rp[16 + i];
              o1[jj] = x1 * cs - x2 * sn; o2[jj] = x1 * sn + x2 * cs;
            }
            st4h(qd + 8 * g + 4 * hh, o1[0], o1[1], o1[2], o1[3]);
            st4h(qd + 16 + 8 * g + 4 * hh, o2[0], o2[1], o2[2], o2[3]);
          }
        } else {
#pragma unroll
          for (int g = 0; g < 4; ++g)
            st4h(qd + 8 * g + 4 * hh, acc[mi][ni][4 * g] * sc, acc[mi][ni][4 * g + 1] * sc, acc[mi][ni][4 * g + 2] * sc, acc[mi][ni][4 * g + 3] * sc);
        }
      }
    }
  } else {
    int j2 = job - MT * 6;
    int nt = j2 / MT, mt = j2 - nt * MT;
    gemm_deep<2, true>(p.Z() + ZMLA + 384, ZW, p.UKV(), 256, 256, mt * 128, nt * 128, 1024, smem, acc, rowsq);
    const int m0 = mt * 128;
    epi_quads(acc, m0, 0, [&](int m, int n, float v0, float v1, float v2, float v3) {
      const float sc = rsqrtf(rowsq[m - m0] * (1.f / 256.f) + 1e-6f);
      if (n < 64) st4h(p.K() + (size_t)m * 768 + nt * 96 + n, v0 * sc, v1 * sc, v2 * sc, v3 * sc);
      else {
        int b = m / SB, s = m - b * SB;
        h16* vt = p.VT() + ((size_t)(b * 8 + nt) * 64 + (n - 64)) * SB + s;
        vt[0] = (h16)(v0 * sc); vt[SB] = (h16)(v1 * sc); vt[2 * SB] = (h16)(v2 * sc); vt[3 * SB] = (h16)(v3 * sc);
      }
    });
    {
      int row = tid >> 1, sub = tid & 1;
      int m = m0 + row;
      int sp = m % SB;
      const h16* kr = p.Z() + (size_t)m * ZW + ZMLA + 640 + sub * 8;
      h16x8 x1 = *(const h16x8*)kr, x2 = *(const h16x8*)(kr + 16);
      h16* kd = p.K() + (size_t)m * 768 + nt * 96 + 64 + sub * 8;
      if (sp >= CTX) {
        const float* rp = p.ROPE() + (size_t)(sp - CTX) * 32 + sub * 8;
        h16x8 o1, o2;
#pragma unroll
        for (int i = 0; i < 8; ++i) {
          float a = (float)x1[i], b2 = (float)x2[i], cs = rp[i], sn = rp[16 + i];
          o1[i] = (h16)(a * cs - b2 * sn); o2[i] = (h16)(a * sn + b2 * cs);
        }
        *(h16x8*)kd = o1; *(h16x8*)(kd + 16) = o2;
      } else { *(h16x8*)kd = x1; *(h16x8*)(kd + 16) = x2; }
    }
  }
}

DEVI void lowrank_job(const P& p, int l, int job, char* smem) {
  constexpr int MT = NR / 128;
  int mat = job / (MT * 4), rem = job - mat * MT * 4;
  int nt = rem / MT, mt = rem - nt * MT;
  f32x16 acc[2][2]; zero_acc(acc);
  if (mat < 2) {
    const int dir = mat;
    gemm_main<false>(p.Z() + ZRW + 1536 + dir * 64, ZW, p.WUP() + (size_t)dir * 512 * 64, 64, 64, mt * 128, nt * 128, 512, smem, acc, nullptr);
    const float* w0 = p.w0 + ((size_t)l * 2 + dir) * 512;
    h16* dst = p.LW() + (size_t)dir * NR * 512;
    epi_quads(acc, mt * 128, nt * 128, [&](int m, int n, float v0, float v1, float v2, float v3) {
      float4 b = *(const float4*)(w0 + n);
      const float e = 0.6065306597126334f;
      st4h(dst + (size_t)m * 512 + n, sigm(v0 + b.x) * e, sigm(v1 + b.y) * e, sigm(v2 + b.z) * e, sigm(v3 + b.w) * e);
    });
  } else if (mat < 4) {
    const int dir = mat - 2;
    gemm_main<false>(p.Z() + ZRW + 1664 + dir * 64, ZW, p.AUP() + (size_t)dir * 512 * 64, 64, 64, mt * 128, nt * 128, 512, smem, acc, nullptr);
    const float* a0 = p.a0 + ((size_t)l * 2 + dir) * 512;
    h16* dst = p.AA() + (size_t)dir * NR * 512;
    epi_quads(acc, mt * 128, nt * 128, [&](int m, int n, float v0, float v1, float v2, float v3) {
      float4 b = *(const float4*)(a0 + n);
      st4h(dst + (size_t)m * 512 + n, sigm(v0 + b.x), sigm(v1 + b.y), sigm(v2 + b.z), sigm(v3 + b.w));
    });
  } else {
    gemm_main<false>(p.Z() + ZRW + 1792, ZW, p.GUP(), 128, 128, mt * 128, nt * 128, 512, smem, acc, nullptr);
    epi_quads(acc, mt * 128, nt * 128, [&](int m, int n, float v0, float v1, float v2, float v3) {
      st4h(p.G() + (size_t)m * 512 + n, v0, v1, v2, v3);
    });
  }
}

DEVI void attn_job(const P& p, int job, char* smem) {
  h16* Ks = (h16*)smem;
  h16* Vs = Ks + 2 * 64 * 104;
  const int tid = tidx(), lane = tid & 63, wv = tid >> 6, l31 = lane & 31, hh = lane >> 5;
  int b, h, q0, nk;
  if (job < 1024) { b = job >> 8; h = (job >> 5) & 7; q0 = b * SB + CTX + (job & 31) * 128; nk = SB; }
  else { int j = job - 1024; b = j >> 4; h = (j >> 1) & 7; q0 = b * SB + (j & 1) * 128; nk = CTX; }
  const int NKT = nk >> 6;
  const h16* Kg = p.K() + (size_t)(b * SB) * 768 + h * 96;
  const h16* Vg = p.VT() + (size_t)(b * 8 + h) * 64 * SB;
  h16x8 qf[6];
  {
    const h16* qp = p.Q() + (size_t)(q0 + wv * 32 + l31) * 768 + h * 96 + hh * 8;
#pragma unroll
    for (int ds = 0; ds < 6; ++ds) qf[ds] = *(const h16x8*)(qp + ds * 16);
  }
  uint4 pk0, pk1, pk2_, pv0, pv1, qk0, qk1, qk2_, qv0, qv1;
  int krow[3], kcol[3];
#pragma unroll
  for (int i = 0; i < 3; ++i) { int c = tid + 256 * i; krow[i] = c / 12; kcol[i] = (c - krow[i] * 12) * 8; }
  const int vrow = tid >> 3, vcol = (tid & 7) * 8;
  const h16* kp0 = Kg + (size_t)krow[0] * 768 + kcol[0];
  const h16* kp1 = Kg + (size_t)krow[1] * 768 + kcol[1];
  const h16* kp2 = Kg + (size_t)krow[2] * 768 + kcol[2];
  const h16* vp0 = Vg + (size_t)vrow * SB + vcol;
  const h16* vp1 = Vg + (size_t)(vrow + 32) * SB + vcol;
#define ALOAD(S, kt_) { S##k0 = *(const uint4*)(kp0 + (size_t)(kt_) * 64 * 768); S##k1 = *(const uint4*)(kp1 + (size_t)(kt_) * 64 * 768); \
    S##k2_ = *(const uint4*)(kp2 + (size_t)(kt_) * 64 * 768); S##v0 = *(const uint4*)(vp0 + (kt_) * 64); S##v1 = *(const uint4*)(vp1 + (kt_) * 64); }
#define ASTORE(S, buf_) { h16* kd = Ks + (buf_) * 64 * 104; h16* vd = Vs + (buf_) * 64 * 72; \
    *(uint4*)(kd + krow[0] * 104 + kcol[0]) = S##k0; *(uint4*)(kd + krow[1] * 104 + kcol[1]) = S##k1; *(uint4*)(kd + krow[2] * 104 + kcol[2]) = S##k2_; \
    *(uint4*)(vd + vrow * 72 + vcol) = S##v0; *(uint4*)(vd + (vrow + 32) * 72 + vcol) = S##v1; }
  f32x16 o0, o1;
#pragma unroll
  for (int r = 0; r < 16; ++r) { o0[r] = 0.f; o1[r] = 0.f; }
  float mrun = -1e30f, lsum = 0.f;
  auto compute = [&](int buf) {
    const h16* ks = Ks + buf * 64 * 104 + l31 * 104 + hh * 8;
    f32x16 s0, s1;
#pragma unroll
    for (int r = 0; r < 16; ++r) { s0[r] = 0.f; s1[r] = 0.f; }
#pragma unroll
    for (int ds = 0; ds < 6; ++ds) {
      h16x8 a0 = *(const h16x8*)(ks + ds * 16), a1 = *(const h16x8*)(ks + 32 * 104 + ds * 16);
      s0 = __builtin_amdgcn_mfma_f32_32x32x16_f16(a0, qf[ds], s0, 0, 0, 0);
      s1 = __builtin_amdgcn_mfma_f32_32x32x16_f16(a1, qf[ds], s1, 0, 0, 0);
    }
    float mx = s0[0];
#pragma unroll
    for (int r = 1; r < 16; ++r) mx = fmaxf(mx, s0[r]);
#pragma unroll
    for (int r = 0; r < 16; ++r) mx = fmaxf(mx, s1[r]);
    mx = fmaxf(mx, __shfl_xor(mx, 32));
    const float mnew = fmaxf(mrun, mx);
    const float alpha = __builtin_amdgcn_exp2f(mrun - mnew);
    mrun = mnew;
    float ps = 0.f;
#pragma unroll
    for (int r = 0; r < 16; ++r) { s0[r] = __builtin_amdgcn_exp2f(s0[r] - mnew); ps += s0[r]; }
#pragma unroll
    for (int r = 0; r < 16; ++r) { s1[r] = __builtin_amdgcn_exp2f(s1[r] - mnew); ps += s1[r]; }
    lsum = lsum * alpha + ps;
#pragma unroll
    for (int r = 0; r < 16; ++r) { o0[r] *= alpha; o1[r] *= alpha; }
    const h16* vs = Vs + buf * 64 * 72 + l31 * 72 + 4 * hh;
#pragma unroll
    for (int k2 = 0; k2 < 2; ++k2) {
#pragma unroll
      for (int s2 = 0; s2 < 2; ++s2) {
        uint4 pu;
        if (k2 == 0) { pu.x = pk2(s0[8 * s2], s0[8 * s2 + 1]); pu.y = pk2(s0[8 * s2 + 2], s0[8 * s2 + 3]); pu.z = pk2(s0[8 * s2 + 4], s0[8 * s2 + 5]); pu.w = pk2(s0[8 * s2 + 6], s0[8 * s2 + 7]); }
        else { pu.x = pk2(s1[8 * s2], s1[8 * s2 + 1]); pu.y = pk2(s1[8 * s2 + 2], s1[8 * s2 + 3]); pu.z = pk2(s1[8 * s2 + 4], s1[8 * s2 + 5]); pu.w = pk2(s1[8 * s2 + 6], s1[8 * s2 + 7]); }
        h16x8 pf = __builtin_bit_cast(h16x8, pu);
        const int kb = k2 * 32 + 16 * s2;
        uint2 va = *(const uint2*)(vs + kb), vb = *(const uint2*)(vs + kb + 8);
        uint2 vc = *(const uint2*)(vs + 32 * 72 + kb), vd = *(const uint2*)(vs + 32 * 72 + kb + 8);
        h16x8 vf0 = __builtin_bit_cast(h16x8, make_uint4(va.x, va.y, vb.x, vb.y));
        h16x8 vf1 = __builtin_bit_cast(h16x8, make_uint4(vc.x, vc.y, vd.x, vd.y));
        o0 = __builtin_amdgcn_mfma_f32_32x32x16_f16(vf0, pf, o0, 0, 0, 0);
        o1 = __builtin_amdgcn_mfma_f32_32x32x16_f16(vf1, pf, o1, 0, 0, 0);
      }
    }
  };
  ALOAD(p, 0);
  if (NKT > 1) ALOAD(q, 1);
  ASTORE(p, 0);
  if (NKT > 2) ALOAD(p, 2);
  __syncthreads();
  for (int kt = 0; kt < NKT; kt += 2) {
    compute(0);
    if (kt + 1 < NKT) ASTORE(q, 1);
    if (kt + 3 < NKT) ALOAD(q, kt + 3);
    __syncthreads();
    if (kt + 1 < NKT) {
      compute(1);
      if (kt + 2 < NKT) ASTORE(p, 0);
      if (kt + 4 < NKT) ALOAD(p, kt + 4);
      __syncthreads();
    }
  }
#undef ALOAD
#undef ASTORE
  const float ltot = lsum + __shfl_xor(lsum, 32);
  const float inv = 1.f / ltot;
  h16* yo = p.Z() + (size_t)(q0 + wv * 32 + l31) * ZW + ZMLA + h * 64 + 4 * hh;
#pragma unroll
  for (int g = 0; g < 4; ++g) {
    st4h(yo + 8 * g, o0[4 * g] * inv, o0[4 * g + 1] * inv, o0[4 * g + 2] * inv, o0[4 * g + 3] * inv);
    st4h(yo + 32 + 8 * g, o1[4 * g] * inv, o1[4 * g + 1] * inv, o1[4 * g + 2] * inv, o1[4 * g + 3] * inv);
  }
}

#if PROBE >= 200
__device__ unsigned long long g_tacc[4];
#endif
struct Slot { float w[64]; unsigned bke[64]; float vv[64]; h16 ah[4][64]; int yoff; int pad[3]; };
struct LSet { uint4 lw, a, k, v, r; float inv; int yoff; int vm; };
DEVI void scan_job(const P& p, int l, int job, char* smem, int rank) {
  constexpr int RGB = 4 / NSCAN_BPC;
  constexpr int NLD = (4 - RGB) * 64;
  static_assert(NLD == 128, "loader mapping assumes 128 loader threads");
  Slot* sl = (Slot*)smem;
  h16* ybuf = (h16*)(smem + 2 * 16 * sizeof(Slot));
  const int tid = tidx(), lane = tid & 63, wv = rank ? ((tid >> 6) ^ 2) : (tid >> 6);
  const int chain = job / NSCAN_BPC, part = job - chain * NSCAN_BPC;
  const int dir = chain >> 5, b = (chain >> 3) & 3, h = chain & 7;
  for (int i = tid; i < 32 * 128; i += 256) { int s = i >> 7, e = i & 127; sl[s].ah[2 + (e >> 6)][e & 63] = (h16)0.f; }
  if (wv >= RGB) {
    const int lt = (wv - RGB) * 64 + lane;
    const int st = lt >> 3, ca = lt & 7, c8 = ca * 8;
    const int pp0 = (ca >> 2) * 32 + (2 * (ca & 1)) * 8 + ((ca & 3) >> 1) * 4;
    const int pp1 = pp0 + 8;
    const float4 kkA = *(const float4*)(p.k_k + l * 512 + h * 64 + c8), kkB = *(const float4*)(p.k_k + l * 512 + h * 64 + c8 + 4);
    const float4 kaA = *(const float4*)(p.k_a + l * 512 + h * 64 + c8), kaB = *(const float4*)(p.k_a + l * 512 + h * 64 + c8 + 4);
    const h16* LWd = p.LW() + (size_t)dir * NR * 512 + h * 64 + c8;
    const h16* AAd = p.AA() + (size_t)dir * NR * 512 + h * 64 + c8;
    const h16* Zr = p.Z() + ZRW + h * 64 + c8;
#define LLOAD(ci_, g)                                                                                         \
    {                                                                                                         \
      const int n_ = (ci_) * 16 + st;                                                                         \
      const int rowm_ = maprow(dir, b, min(n_, SB - 1));                                                      \
      const int rowr_ = maprow(dir, b, min(max(n_ - 1, 0), SB - 1));                                          \
      g##_yoff = (n_ >= 1 && n_ <= SB) ? rowr_ * 512 : -1;                                                      \
      g##_vm = (n_ < SB) ? 1 : 0;                                                                               \
      const h16* p0_ = LWd + (size_t)rowm_ * 512; const h16* p1_ = AAd + (size_t)rowm_ * 512;                 \
      const h16* p2_ = Zr + (size_t)rowm_ * ZW + 512; const h16* p3_ = Zr + (size_t)rowm_ * ZW + 1024;        \
      const h16* p4_ = Zr + (size_t)rowr_ * ZW; const float* p5_ = p.INVN() + (size_t)rowm_ * 8 + h;          \
      asm volatile("global_load_dwordx4 %0, %1, off" : "=v"(g##_lw) : "v"(p0_) : "memory");                     \
      asm volatile("global_load_dwordx4 %0, %1, off" : "=v"(g##_a) : "v"(p1_) : "memory");                      \
      asm volatile("global_load_dwordx4 %0, %1, off" : "=v"(g##_k) : "v"(p2_) : "memory");                      \
      asm volatile("global_load_dwordx4 %0, %1, off" : "=v"(g##_v) : "v"(p3_) : "memory");                      \
      asm volatile("global_load_dwordx4 %0, %1, off" : "=v"(g##_r) : "v"(p4_) : "memory");                      \
      asm volatile("global_load_dword %0, %1, off" : "=v"(g##_inv) : "v"(p5_) : "memory");                      \
    }
#define LWAIT(g) asm volatile("s_waitcnt vmcnt(18)" : "+v"(g##_lw), "+v"(g##_a), "+v"(g##_k), "+v"(g##_v), "+v"(g##_r), "+v"(g##_inv) : : "memory")
    auto lstore = [&](uint4 g_lw, uint4 g_a, uint4 g_k, uint4 g_v, uint4 g_r, float g_inv, int g_yoff, int g_vm, int buf) {
      Slot& s = sl[buf * 16 + st];
      const h16x8 lw = __builtin_bit_cast(h16x8, g_lw), a = __builtin_bit_cast(h16x8, g_a), k = __builtin_bit_cast(h16x8, g_k), v = __builtin_bit_cast(h16x8, g_v);
      const float kkp[8] = {kkA.x, kkA.y, kkA.z, kkA.w, kkB.x, kkB.y, kkB.z, kkB.w};
      const float kap[8] = {kaA.x, kaA.y, kaA.z, kaA.w, kaB.x, kaB.y, kaB.z, kaB.w};
      const float vmf = g_vm ? 1.f : 0.f;
      const float inv = g_inv * vmf;
      float w8[8], v8[8], q8[8], r8[8]; unsigned be8[8];
      const h16x8 rh = __builtin_bit_cast(h16x8, g_r);
      const float rvalid = (g_yoff >= 0) ? 1.f : 0.f;
#pragma unroll
      for (int i = 0; i < 8; ++i) w8[i] = __expf(-(float)lw[i] * vmf);
      float P8[8];
#pragma unroll
      for (int i = 0; i < 8; ++i) P8[i] = w8[i];
#pragma unroll
      for (int d = 8; d < 64; d <<= 1) {
#pragma unroll
        for (int i = 0; i < 8; ++i) { const float t = __shfl_up(P8[i], d); if (lane >= d) P8[i] *= t; }
      }
#pragma unroll
      for (int i = 0; i < 8; ++i) {
        const float kf = (float)k[i] * vmf, af = (float)a[i];
        const float kkv = kf * kkp[i] * inv;
        const float rP = __builtin_amdgcn_rcpf(P8[i]);
        const float Pex = P8[i] * __builtin_amdgcn_rcpf(w8[i]);
        be8[i] = pk2n(kkv * af * rP, kf * (1.f + (af - 1.f) * kap[i]) * rP);
        v8[i] = (float)v[i] * vmf;
        q8[i] = kkv * Pex;
        r8[i] = (float)rh[i] * Pex * rvalid;
        w8[i] = P8[i];
      }
      const uint4 rr = make_uint4(pk2n(r8[0], r8[1]), pk2n(r8[2], r8[3]), pk2n(r8[4], r8[5]), pk2n(r8[6], r8[7]));
      *(float4*)(s.w + c8) = make_float4(w8[0], w8[1], w8[2], w8[3]); *(float4*)(s.w + c8 + 4) = make_float4(w8[4], w8[5], w8[6], w8[7]);
      *(uint4*)(s.bke + c8) = make_uint4(be8[0], be8[1], be8[2], be8[3]); *(uint4*)(s.bke + c8 + 4) = make_uint4(be8[4], be8[5], be8[6], be8[7]);
      *(float4*)(s.vv + c8) = make_float4(v8[0], v8[1], v8[2], v8[3]); *(float4*)(s.vv + c8 + 4) = make_float4(v8[4], v8[5], v8[6], v8[7]);
      *(uint2*)(&s.ah[0][pp0]) = make_uint2(pk2n(q8[0], q8[1]), pk2n(q8[2], q8[3]));
      *(uint2*)(&s.ah[0][pp1]) = make_uint2(pk2n(q8[4], q8[5]), pk2n(q8[6], q8[7]));
      *(uint2*)(&s.ah[1][pp0]) = make_uint2(rr.x, rr.y);
      *(uint2*)(&s.ah[1][pp1]) = make_uint2(rr.z, rr.w);
      if (ca == 0) s.yoff = g_yoff;
    };
    typedef unsigned u32x4 __attribute__((ext_vector_type(4)));
    u32x4 R0_lw, R0_a, R0_k, R0_v, R0_r, R1_lw, R1_a, R1_k, R1_v, R1_r, R2_lw, R2_a, R2_k, R2_v, R2_r, R3_lw, R3_a, R3_k, R3_v, R3_r;
    float R0_inv, R1_inv, R2_inv, R3_inv; int R0_yoff, R1_yoff, R2_yoff, R3_yoff, R0_vm, R1_vm, R2_vm, R3_vm;
#define U4(x) make_uint4((x)[0], (x)[1], (x)[2], (x)[3])
#define LST(g, buf_) lstore(U4(g##_lw), U4(g##_a), U4(g##_k), U4(g##_v), U4(g##_r), g##_inv, g##_yoff, g##_vm, buf_)
    asm volatile("s_waitcnt vmcnt(0)" ::: "memory");
    LLOAD(0, R0); LLOAD(1, R1); LLOAD(2, R2); LLOAD(3, R3);
    LWAIT(R0); LST(R0, 0); LLOAD(4, R0);
    __syncthreads();
    h16* yout = p.Y2() + (size_t)dir * NR * 512 + h * 64 + part * (RGB * 16) + ca * 4;
    auto ystore = [&](int cj) {
      const int n = cj * 16 + st;
      if (n >= 1 && n <= SB) {
        const h16* yb = ybuf + ((cj & 1) * 32 + ca * 4) * 24 + st;
        const unsigned short a0 = __builtin_bit_cast(unsigned short, yb[0]), a1 = __builtin_bit_cast(unsigned short, yb[24]);
        const unsigned short a2 = __builtin_bit_cast(unsigned short, yb[48]), a3 = __builtin_bit_cast(unsigned short, yb[72]);
        typedef unsigned u32x2 __attribute__((ext_vector_type(2)));
        u32x2 u; u[0] = (unsigned)a0 | ((unsigned)a1 << 16); u[1] = (unsigned)a2 | ((unsigned)a3 << 16);
        h16* yp = yout + (size_t)maprow(dir, b, n - 1) * 512;
        asm volatile("global_store_dwordx2 %0, %1, off" : : "v"(yp), "v"(u) : "memory");
      }
    };
    for (int ci = 0; ci < NCHUNK; ci += 4) {
      if (ci > 0) ystore(ci - 1);
      LWAIT(R1); if (ci + 1 < NCHUNK) LST(R1, 1); LLOAD(ci + 5, R1);
      __syncthreads();
      if (ci + 1 < NCHUNK) { ystore(ci); LWAIT(R2); if (ci + 2 < NCHUNK) LST(R2, 0); LLOAD(ci + 6, R2); __syncthreads(); }
      if (ci + 2 < NCHUNK) { ystore(ci + 1); LWAIT(R3); if (ci + 3 < NCHUNK) LST(R3, 1); LLOAD(ci + 7, R3); __syncthreads(); }
      if (ci + 3 < NCHUNK) { ystore(ci + 2); LWAIT(R0); if (ci + 4 < NCHUNK) LST(R0, 0); LLOAD(ci + 8, R0); __syncthreads(); }
    }
    ystore(NCHUNK - 1);
    asm volatile("s_waitcnt vmcnt(0)" ::: "memory");
#undef LST
#undef U4
#undef LLOAD
#undef LWAIT
  } else {
    const int c = lane & 15, hq = lane >> 4;
    const int rg = part * RGB + wv;
    const bool h0 = (hq == 0);
    f32x4 ST[4];
#pragma unroll
    for (int t = 0; t < 4; ++t) ST[t] = (f32x4){0.f, 0.f, 0.f, 0.f};
    __builtin_amdgcn_s_setprio(1);
    __syncthreads();
    for (int ci = 0; ci < NCHUNK; ++ci) {
      const int buf = ci & 1;
#if PROBE == 211
      const unsigned long long ct0 = __builtin_amdgcn_s_memrealtime();
#endif
      float yv[16];
      h16x8 rA0[2], rA1[2]; float rvv[2]; unsigned rbe[2][4];
      {
        const Slot& t = sl[buf * 16];
        rA0[0] = *(const h16x8*)(&t.ah[c & 3][8 * hq]); rA1[0] = *(const h16x8*)(&t.ah[c & 3][32 + 8 * hq]);
        rvv[0] = t.vv[rg * 16 + c];
#pragma unroll
        for (int tt = 0; tt < 4; ++tt) rbe[0][tt] = t.bke[16 * tt + c];
      }
#pragma unroll
      for (int s = 0; s < 16; ++s) {
        const int cur = s & 1, nxt = cur ^ 1;
        uint4 sh0, sh1;
        sh0.x = pk2(ST[0][0], ST[0][1]); sh0.y = pk2(ST[0][2], ST[0][3]); sh0.z = pk2(ST[1][0], ST[1][1]); sh0.w = pk2(ST[1][2], ST[1][3]);
        sh1.x = pk2(ST[2][0], ST[2][1]); sh1.y = pk2(ST[2][2], ST[2][3]); sh1.z = pk2(ST[3][0], ST[3][1]); sh1.w = pk2(ST[3][2], ST[3][3]);
        const f32x4 z4 = {0.f, 0.f, 0.f, 0.f};
        f32x4 acc0 = __builtin_amdgcn_mfma_f32_16x16x32_f16(rA0[cur], __builtin_bit_cast(h16x8, sh0), z4, 0, 0, 0);
        f32x4 acc1 = __builtin_amdgcn_mfma_f32_16x16x32_f16(rA1[cur], __builtin_bit_cast(h16x8, sh1), z4, 0, 0, 0);
        f32x4 pe[4];
        if ((s & 7) == 7) {
#pragma unroll
          for (int tt = 0; tt < 4; ++tt) pe[tt] = *(const f32x4*)(sl[buf * 16 + s].w + 16 * tt + 4 * hq);
        }
        if (s + 1 < 16) {
          const Slot& t = sl[buf * 16 + s + 1];
          rA0[nxt] = *(const h16x8*)(&t.ah[c & 3][8 * hq]); rA1[nxt] = *(const h16x8*)(&t.ah[c & 3][32 + 8 * hq]);
          rvv[nxt] = t.vv[rg * 16 + c];
#pragma unroll
          for (int tt = 0; tt < 4; ++tt) rbe[nxt][tt] = t.bke[16 * tt + c];
        }
        __builtin_amdgcn_sched_barrier(0);
        yv[s] = acc0[1] + acc1[1];
        const float sa = -(acc0[0] + acc1[0]);
        const uint4 bu = make_uint4(h0 ? pk2(sa, rvv[cur]) : 0u, 0u, 0u, 0u);
#pragma unroll
        for (int tt = 0; tt < 4; ++tt) {
          const uint4 au = make_uint4(h0 ? rbe[cur][tt] : 0u, 0u, 0u, 0u);
          ST[tt] = __builtin_amdgcn_mfma_f32_16x16x32_f16(__builtin_bit_cast(h16x8, au), __builtin_bit_cast(h16x8, bu), ST[tt], 0, 0, 0);
        }
        if ((s & 7) == 7) {
#pragma unroll
          for (int tt = 0; tt < 4; ++tt) ST[tt] = ST[tt] * pe[tt];
        }
      }
      if (lane < 16) {
        uint4 u0, u1;
        u0.x = pk2n(yv[0], yv[1]); u0.y = pk2n(yv[2], yv[3]); u0.z = pk2n(yv[4], yv[5]); u0.w = pk2n(yv[6], yv[7]);
        u1.x = pk2n(yv[8], yv[9]); u1.y = pk2n(yv[10], yv[11]); u1.z = pk2n(yv[12], yv[13]); u1.w = pk2n(yv[14], yv[15]);
        h16* yr = ybuf + (buf * 32 + wv * 16 + c) * 24;
        *(uint4*)yr = u0; *(uint4*)(yr + 8) = u1;
      }
#if PROBE == 210
      const unsigned long long bt0 = __builtin_amdgcn_s_memrealtime();
#endif
      __syncthreads();
#if PROBE == 210
      if (job == 0 && tid == 0) g_tacc[0] += __builtin_amdgcn_s_memrealtime() - bt0;
#endif
    }
    __builtin_amdgcn_s_setprio(0);
  }
}

DEVI void gla_pre_job(const P& p, int l, int job, char* smem) {
  typedef short bf16x8 __attribute__((ext_vector_type(8)));
  float* lg = (float*)smem;
  float* gku = lg + 64 * 65;
  float* gkb = gku + 1024;
  float* tot = gkb + 64;
  unsigned short* qb = (unsigned short*)(tot + 256);
  unsigned short* kb = qb + 64 * 72;
  h16* vt = (h16*)(kb + 64 * 72);
  const int tid = tidx(), lane = tid & 63, wv = tid >> 6, l31 = lane & 31, hh = lane >> 5;
  const int chain = job / 68, ci = job - chain * 68;
  const int dir = chain >> 4, b = (chain >> 2) & 3, h = chain & 3;
  for (int i = tid; i < 1024; i += 256) gku[i] = p.gk_up[(((size_t)l * 2 + dir) * 16 + (i >> 6)) * 256 + h * 64 + (i & 63)];
  if (tid < 64) gkb[tid] = p.gk_b[((size_t)l * 2 + dir) * 256 + h * 64 + tid];
  const int ri = tid >> 2, dq = tid & 3;
  const int row = maprow(dir, b, ci * 64 + ri);
  const h16* zr = p.Z() + (size_t)row * ZW;
  uint4 q0 = *(const uint4*)(zr + h * 64 + dq * 16), q1 = *(const uint4*)(zr + h * 64 + dq * 16 + 8);
  uint4 k0 = *(const uint4*)(zr + 256 + h * 64 + dq * 16), k1 = *(const uint4*)(zr + 256 + h * 64 + dq * 16 + 8);
  uint4 g0 = *(const uint4*)(zr + 1024 + dir * 16), g1 = *(const uint4*)(zr + 1024 + dir * 16 + 8);
  {
    const h16* zv = zr + 512 + h * 128 + dq * 32;
#pragma unroll
    for (int c = 0; c < 4; ++c) {
      h16x8 vv = *(const h16x8*)(zv + c * 8);
#pragma unroll
      for (int j = 0; j < 8; ++j) vt[(dq * 32 + c * 8 + j) * 72 + ri] = vv[j];
    }
  }
  __syncthreads();
  {
    h16x8 gh0 = __builtin_bit_cast(h16x8, g0), gh1 = __builtin_bit_cast(h16x8, g1);
    float gd[16];
#pragma unroll
    for (int j = 0; j < 8; ++j) { gd[j] = (float)gh0[j]; gd[8 + j] = (float)gh1[j]; }
#pragma unroll 4
    for (int dd = 0; dd < 16; ++dd) {
      const int d = dq * 16 + dd;
      float xx = gkb[d];
#pragma unroll
      for (int r = 0; r < 16; ++r) xx += gd[r] * gku[r * 64 + d];
      float ls = fminf(xx, 0.f) - __logf(1.f + __expf(-fabsf(xx)));
      lg[ri * 65 + d] = ls * (1.f / 16.f);
    }
  }
  __syncthreads();
  {
    const int d = tid & 63, part = tid >> 6;
    float run = 0.f;
#pragma unroll 4
    for (int ii = 0; ii < 16; ++ii) { const int i = part * 16 + ii; run += lg[i * 65 + d]; lg[i * 65 + d] = run; }
    tot[part * 64 + d] = run;
  }
  __syncthreads();
  {
    h16x8 qh0 = __builtin_bit_cast(h16x8, q0), qh1 = __builtin_bit_cast(h16x8, q1), kh0 = __builtin_bit_cast(h16x8, k0), kh1 = __builtin_bit_cast(h16x8, k1);
    const int part = ri >> 4;
    unsigned qp[8], kp[8];
#pragma unroll
    for (int j = 0; j < 8; ++j) {
      unsigned qq[2], kk2[2];
#pragma unroll
      for (int e = 0; e < 2; ++e) {
        const int dd = 2 * j + e, d = dq * 16 + dd;
        float off = 0.f;
        if (part > 0) off += tot[d];
        if (part > 1) off += tot[64 + d];
        if (part > 2) off += tot[128 + d];
        const float bb = lg[ri * 65 + d] + off;
        const float qv = dd < 8 ? (float)qh0[dd & 7] : (float)qh1[dd & 7];
        const float kv = dd < 8 ? (float)kh0[dd & 7] : (float)kh1[dd & 7];
        qq[e] = f2bf(qv * __expf(bb) * 0.125f);
        kk2[e] = f2bf(kv * __expf(-bb));
      }
      qp[j] = qq[0] | (qq[1] << 16); kp[j] = kk2[0] | (kk2[1] << 16);
    }
    const uint4 qa = make_uint4(qp[0], qp[1], qp[2], qp[3]), qc = make_uint4(qp[4], qp[5], qp[6], qp[7]);
    const uint4 ka = make_uint4(kp[0], kp[1], kp[2], kp[3]), kc = make_uint4(kp[4], kp[5], kp[6], kp[7]);
    *(uint4*)(qb + ri * 72 + dq * 16) = qa; *(uint4*)(qb + ri * 72 + dq * 16 + 8) = qc;
    *(uint4*)(kb + ri * 72 + dq * 16) = ka; *(uint4*)(kb + ri * 72 + dq * 16 + 8) = kc;
    unsigned short* qd = p.QIN() + ((size_t)dir * NR + row) * 256 + h * 64 + dq * 16;
    unsigned short* kd = p.KIN() + ((size_t)dir * NR + row) * 256 + h * 64 + dq * 16;
    *(uint4*)qd = qa; *(uint4*)(qd + 8) = qc;
    *(uint4*)kd = ka; *(uint4*)(kd + 8) = kc;
    if (tid < 64) p.DEC()[((size_t)chain * 68 + ci) * 64 + tid] = __expf(tot[tid] + tot[64 + tid] + tot[128 + tid] + tot[192 + tid]);
  }
  __syncthreads();
  const int it = wv & 1, jh = wv >> 1;
  f32x16 o0, o1;
#pragma unroll
  for (int r = 0; r < 16; ++r) { o0[r] = 0.f; o1[r] = 0.f; }
  bf16x8 qf[4];
#pragma unroll
  for (int ks = 0; ks < 4; ++ks) qf[ks] = *(const bf16x8*)(qb + (it * 32 + l31) * 72 + ks * 16 + hh * 8);
#pragma unroll
  for (int st = 0; st < 2; ++st) {
    if (st > it) continue;
    f32x16 at;
#pragma unroll
    for (int r = 0; r < 16; ++r) at[r] = 0.f;
#pragma unroll
    for (int ks = 0; ks < 4; ++ks) {
      bf16x8 kf = *(const bf16x8*)(kb + (st * 32 + l31) * 72 + ks * 16 + hh * 8);
      at = __builtin_amdgcn_mfma_f32_32x32x16_bf16(kf, qf[ks], at, 0, 0, 0);
    }
    if (st == it) {
#pragma unroll
      for (int r = 0; r < 16; ++r) { const int sl = (r & 3) + 8 * (r >> 2) + 4 * hh; if (sl > l31) at[r] = 0.f; }
    }
    const h16* vs = vt + (jh * 64 + l31) * 72 + st * 32 + 4 * hh;
#pragma unroll
    for (int s2 = 0; s2 < 2; ++s2) {
      uint4 pu;
      pu.x = pk2n(at[8 * s2], at[8 * s2 + 1]); pu.y = pk2n(at[8 * s2 + 2], at[8 * s2 + 3]);
      pu.z = pk2n(at[8 * s2 + 4], at[8 * s2 + 5]); pu.w = pk2n(at[8 * s2 + 6], at[8 * s2 + 7]);
      const h16x8 pf = __builtin_bit_cast(h16x8, pu);
      const uint2 va = *(const uint2*)(vs + 16 * s2), vb = *(const uint2*)(vs + 16 * s2 + 8);
      const uint2 vc = *(const uint2*)(vs + 32 * 72 + 16 * s2), vd = *(const uint2*)(vs + 32 * 72 + 16 * s2 + 8);
      o0 = __builtin_amdgcn_mfma_f32_32x32x16_f16(__builtin_bit_cast(h16x8, make_uint4(va.x, va.y, vb.x, vb.y)), pf, o0, 0, 0, 0);
      o1 = __builtin_amdgcn_mfma_f32_32x32x16_f16(__builtin_bit_cast(h16x8, make_uint4(vc.x, vc.y, vd.x, vd.y)), pf, o1, 0, 0, 0);
    }
  }
  {
    const int orow = maprow(dir, b, ci * 64 + it * 32 + l31);
    h16* od = p.OFB() + ((size_t)dir * NR + orow) * 512 + h * 128 + jh * 64 + 4 * hh;
#pragma unroll
    for (int g = 0; g < 4; ++g) {
      st4h(od + 8 * g, o0[4 * g], o0[4 * g + 1], o0[4 * g + 2], o0[4 * g + 3]);
      st4h(od + 32 + 8 * g, o1[4 * g], o1[4 * g + 1], o1[4 * g + 2], o1[4 * g + 3]);
    }
  }
  __syncthreads();
}

DEVI void gla_job(const P& p, int l, int job, char* smem) {
  float* qi = (float*)smem;
  float* ki = qi + 64 * 65;
  float* vs = ki + 64 * 65;
  float* Ss = vs + 64 * 33;
  const int tid = tidx();
  const int dvs = job & 3, chain = job >> 2;
  const int dir = chain >> 4, b = (chain >> 2) & 3, h = chain & 3;
  for (int i = tid; i < 64 * 33; i += 256) Ss[i] = 0.f;
  const int ri = tid >> 2, dq = tid & 3;
  const int t2 = tid >> 3, tj = tid & 7;
  h16* Od = p.OFB() + (size_t)dir * NR * 512 + h * 128 + dvs * 32;
  const unsigned short* Qg = p.QIN() + (size_t)dir * NR * 256 + h * 64 + dq * 16;
  const unsigned short* Kg = p.KIN() + (size_t)dir * NR * 256 + h * 64 + dq * 16;
  const float* Dg = p.DEC() + (size_t)chain * 68 * 64 + 2 * t2;
  uint4 gq0, gq1, gk0, gk1, gv; uint2 goa, gob; float gd0, gd1;
  auto pre = [&](int ci) {
    const int row = maprow(dir, b, ci * 64 + ri);
    gq0 = *(const uint4*)(Qg + (size_t)row * 256); gq1 = *(const uint4*)(Qg + (size_t)row * 256 + 8);
    gk0 = *(const uint4*)(Kg + (size_t)row * 256); gk1 = *(const uint4*)(Kg + (size_t)row * 256 + 8);
    gv = *(const uint4*)(p.Z() + (size_t)row * ZW + 512 + h * 128 + dvs * 32 + dq * 8);
    const int rowa = maprow(dir, b, ci * 64 + 2 * t2), rowb = maprow(dir, b, ci * 64 + 2 * t2 + 1);
    goa = *(const uint2*)(Od + (size_t)rowa * 512 + 4 * tj); gob = *(const uint2*)(Od + (size_t)rowb * 512 + 4 * tj);
    gd0 = Dg[ci * 64]; gd1 = Dg[ci * 64 + 1];
  };
  pre(0);
  __syncthreads();
  for (int ci = 0; ci < SB / 64; ++ci) {
    {
      const unsigned qa[8] = {gq0.x, gq0.y, gq0.z, gq0.w, gq1.x, gq1.y, gq1.z, gq1.w};
      const unsigned ka[8] = {gk0.x, gk0.y, gk0.z, gk0.w, gk1.x, gk1.y, gk1.z, gk1.w};
#pragma unroll
      for (int j = 0; j < 8; ++j) {
        qi[ri * 65 + dq * 16 + 2 * j] = __builtin_bit_cast(float, qa[j] << 16); qi[ri * 65 + dq * 16 + 2 * j + 1] = __builtin_bit_cast(float, qa[j] & 0xffff0000u);
        ki[ri * 65 + dq * 16 + 2 * j] = __builtin_bit_cast(float, ka[j] << 16); ki[ri * 65 + dq * 16 + 2 * j + 1] = __builtin_bit_cast(float, ka[j] & 0xffff0000u);
      }
      h16x8 vh = __builtin_bit_cast(h16x8, gv);
#pragma unroll
      for (int j = 0; j < 8; ++j) vs[ri * 33 + dq * 8 + j] = (float)vh[j];
    }
    const uint2 oia = goa, oib = gob; const float e0 = gd0, e1 = gd1;
    const int rowa = maprow(dir, b, ci * 64 + 2 * t2), rowb = maprow(dir, b, ci * 64 + 2 * t2 + 1);
    if (ci + 1 < SB / 64) pre(ci + 1);
    __syncthreads();
    {
      h16x4 ha = __builtin_bit_cast(h16x4, oia), hb = __builtin_bit_cast(h16x4, oib);
      float a0[4], a1[4];
#pragma unroll
      for (int y = 0; y < 4; ++y) { a0[y] = (float)ha[y]; a1[y] = (float)hb[y]; }
#pragma unroll 4
      for (int d = 0; d < 64; ++d) {
        const float x0 = qi[(2 * t2) * 65 + d], x1 = qi[(2 * t2 + 1) * 65 + d];
#pragma unroll
        for (int y = 0; y < 4; ++y) { const float v = Ss[d * 33 + 4 * tj + y]; a0[y] += x0 * v; a1[y] += x1 * v; }
      }
      st4h(Od + (size_t)rowa * 512 + 4 * tj, a0[0], a0[1], a0[2], a0[3]);
      st4h(Od + (size_t)rowb * 512 + 4 * tj, a1[0], a1[1], a1[2], a1[3]);
    }
    __syncthreads();
    {
      float a0[4], a1[4];
#pragma unroll
      for (int y = 0; y < 4; ++y) { a0[y] = Ss[(2 * t2) * 33 + 4 * tj + y]; a1[y] = Ss[(2 * t2 + 1) * 33 + 4 * tj + y]; }
#pragma unroll 4
      for (int s2 = 0; s2 < 64; ++s2) {
        const float x0 = ki[s2 * 65 + 2 * t2], x1 = ki[s2 * 65 + 2 * t2 + 1];
#pragma unroll
        for (int y = 0; y < 4; ++y) { const float v = vs[s2 * 33 + 4 * tj + y]; a0[y] += x0 * v; a1[y] += x1 * v; }
      }
#pragma unroll
      for (int y = 0; y < 4; ++y) { Ss[(2 * t2) * 33 + 4 * tj + y] = a0[y] * e0; Ss[(2 * t2 + 1) * 33 + 4 * tj + y] = a1[y] * e1; }
    }
    __syncthreads();
  }
}

DEVI void mixer_phase(const P& p, int l, char* smem, int cslot, int mode = 0, int role = -1, int rank = 0) {
  if (role < 0) role = blockIdx.x;
#if PROBE >= 200
  unsigned long long pt0 = __builtin_amdgcn_s_memrealtime();
#endif
  __shared__ int4 sjobv;
  int& sjob = sjobv.x;
  for (int j = role; j < NSCAN + NGLA; j += gridDim.x) {
    if (mode == 1 && j >= NSCAN) break;
    if (mode == 2 && j < NSCAN) continue;
    if (j < NSCAN) {
      scan_job(p, l, j, smem, 0);
    }
    else gla_job(p, l, j - NSCAN, smem);
    __syncthreads();
#if PROBE == 200
    if (role == 0 && tidx() == 0) g_tacc[0] += __builtin_amdgcn_s_memrealtime() - pt0;
#endif
#if PROBE == 201
    if (role == NSCAN && tidx() == 0) g_tacc[0] += __builtin_amdgcn_s_memrealtime() - pt0;
#endif
  }
  if (mode == 1) return;
  const int njobs = (l < DEPTH - 1) ? 1024 + 64 : 1024;
  while (true) {
    if (tidx() == 0) sjob = (int)atomicAdd(p.CTR() + cslot, 1u);
    __syncthreads();
    const int j = sjob;
    __syncthreads();
    if (j >= njobs) break;
    attn_job(p, j, smem);
  }
#if PROBE == 202
  if (role == 300 && tidx() == 0) g_tacc[0] += __builtin_amdgcn_s_memrealtime() - pt0;
#endif
}

DEVI void post_phase(const P& p, int l) {
  const int lane = tidx() & 63;
  const int wid = blockIdx.x * 4 + (tidx() >> 6), nw = gridDim.x * 4;
  const int c8 = lane * 8;
  for (int r = wid; r < NR; r += nw) {
    {
      h16* zr = p.Z() + (size_t)r * ZW + ZRW + c8;
      h16x8 yf = *(const h16x8*)(p.Y2() + (size_t)r * 512 + c8), yb = *(const h16x8*)(p.Y2() + (size_t)(NR + r) * 512 + c8);
      h16x8 rr = *(const h16x8*)zr, kk = *(const h16x8*)(zr + 512), vv = *(const h16x8*)(zr + 1024);
      h16x8 af = *(const h16x8*)(p.AA() + (size_t)r * 512 + c8), ab = *(const h16x8*)(p.AA() + (size_t)(NR + r) * 512 + c8);
      h16x8 gg = *(const h16x8*)(p.G() + (size_t)r * 512 + c8);
      float y[8], sm = 0.f;
#pragma unroll
      for (int i = 0; i < 8; ++i) { y[i] = (float)yf[i] + (float)yb[i]; sm += y[i]; }
      sm += __shfl_xor(sm, 1); sm += __shfl_xor(sm, 2); sm += __shfl_xor(sm, 4);
      const float mean = sm * (1.f / 64.f);
      float sq = 0.f;
#pragma unroll
      for (int i = 0; i < 8; ++i) { y[i] -= mean; sq += y[i] * y[i]; }
      sq += __shfl_xor(sq, 1); sq += __shfl_xor(sq, 2); sq += __shfl_xor(sq, 4);
      const float rs = rsqrtf(sq * (1.f / 64.f) + 64e-5f);
      const float* ka = p.k_a + l * 512 + c8; const float* rk = p.r_k + l * 512 + c8;
      const float* lg = p.rln_g + l * 512 + c8; const float* lb = p.rln_b + l * 512 + c8;
      float bs = 0.f;
#pragma unroll
      for (int i = 0; i < 8; ++i) {
        const float kf = (float)kk[i], kav = ka[i];
        const float ke = kf * (1.f + ((float)af[i] - 1.f) * kav) + kf * (1.f + ((float)ab[i] - 1.f) * kav);
        bs += (float)rr[i] * ke * rk[i];
      }
      bs += __shfl_xor(bs, 1); bs += __shfl_xor(bs, 2); bs += __shfl_xor(bs, 4);
      float o[8];
#pragma unroll
      for (int i = 0; i < 8; ++i) o[i] = (y[i] * rs * lg[i] + lb[i] + bs * (float)vv[i]) * (float)gg[i];
      uint4 u; u.x = pk2n(o[0], o[1]); u.y = pk2n(o[2], o[3]); u.z = pk2n(o[4], o[5]); u.w = pk2n(o[6], o[7]);
      *(uint4*)zr = u;
    }
    {
      h16x8 of = *(const h16x8*)(p.OFB() + (size_t)r * 512 + c8), ob = *(const h16x8*)(p.OFB() + (size_t)(NR + r) * 512 + c8);
      h16x8 og = *(const h16x8*)(p.Z() + (size_t)r * ZW + 1056 + c8);
      float o[8], sq = 0.f;
#pragma unroll
      for (int i = 0; i < 8; ++i) { o[i] = (float)of[i] + (float)ob[i]; sq += o[i] * o[i]; }
      sq += __shfl_xor(sq, 1); sq += __shfl_xor(sq, 2); sq += __shfl_xor(sq, 4); sq += __shfl_xor(sq, 8);
      const float rs = rsqrtf(sq * (1.f / 128.f) + 1e-6f);
      const float* ng = p.gla_ng + l * 128 + (c8 & 127);
#pragma unroll
      for (int i = 0; i < 8; ++i) { const float g = (float)og[i]; o[i] = o[i] * rs * ng[i] * (g * sigm(g)); }
      uint4 u; u.x = pk2n(o[0], o[1]); u.y = pk2n(o[2], o[3]); u.z = pk2n(o[4], o[5]); u.w = pk2n(o[6], o[7]);
      *(uint4*)(p.YA() + (size_t)r * ZW + c8) = u;
    }
  }
}

DEVI void merge_phase(const P& p, char* smem) {
  constexpr int MT = NR / 128, NT = 16;
  const int lane = tidx() & 63, wv = tidx() >> 6;
  const int wm = wv >> 1, wn = wv & 1, l31 = lane & 31, hh = lane >> 5;
  for (int job = blockIdx.x; job < MT * NT; job += gridDim.x) {
    int nt = job / MT, mt = job - nt * MT;
    float out[2][16];
#pragma unroll
    for (int a = 0; a < 2; ++a)
#pragma unroll
      for (int r = 0; r < 16; ++r) out[a][r] = 0.f;
#pragma unroll 1
    for (int br = 0; br < 3; ++br) {
      const h16* Y = br == 0 ? p.YA() : (br == 1 ? p.Z() + ZMLA : p.Z() + ZRW);
      const int ldy = ZW;
      f32x16 acc[2][1];
#pragma unroll
      for (int a = 0; a < 2; ++a)
#pragma unroll
        for (int r = 0; r < 16; ++r) acc[a][0][r] = 0.f;
      gemm_deep<1>(Y, ldy, p.WB() + (size_t)br * D * 512, 512, 512, mt * 128, nt * 64, D, smem, acc);
      float u[2][16];
#pragma unroll
      for (int a = 0; a < 2; ++a)
#pragma unroll
        for (int r = 0; r < 16; ++r) { u[a][r] = acc[a][0][r]; acc[a][0][r] = 0.f; }
      gemm_deep<1>(p.H(), D, p.WIN() + (size_t)(ZW + br * D) * D, D, D, mt * 128, nt * 64, D, smem, acc);
#pragma unroll
      for (int a = 0; a < 2; ++a)
#pragma unroll
        for (int r = 0; r < 16; ++r) out[a][r] += sigm(acc[a][0][r]) * u[a][r];
    }
#pragma unroll
    for (int a = 0; a < 2; ++a)
#pragma unroll
      for (int g = 0; g < 4; ++g)
        st4h(p.M() + (size_t)(mt * 128 + wm * 64 + a * 32 + l31) * D + nt * 64 + wn * 32 + 8 * g + 4 * hh, out[a][4 * g], out[a][4 * g + 1],
             out[a][4 * g + 2], out[a][4 * g + 3]);
  }
}

DEVI void resid_gemm_phase(const P& p, int l, const h16* A, int K, const h16* Bt, int gate_idx, char* smem) {
  constexpr int MT = NR / 128, NT = 8, T = MT * NT;
  const float alpha = 1.6817928305074290f;
  auto epi = [&](int m, int n, float v0, float v1, float v2, float v3) {
    int b = m / SB, s = m - b * SB;
    int g = s < CTX ? 4 : b;
    float4 gt = *(const float4*)(p.MOD() + ((size_t)l * 5 + g) * 6144 + gate_idx * D + n);
    float* xp = xrow(p, m) + n;
    float4 xv = *(float4*)xp;
    xv.x = alpha * xv.x + gt.x * v0; xv.y = alpha * xv.y + gt.y * v1; xv.z = alpha * xv.z + gt.z * v2; xv.w = alpha * xv.w + gt.w * v3;
    *(float4*)xp = xv;
  };
  const int G = gridDim.x, R = T / G, rem = T - R * G;
  const bool split_tail = (2 * rem <= G);
  const int nfull = split_tail ? R * G : T;
  for (int job = blockIdx.x; job < nfull; job += G) {
    int nt = job / MT, mt = job - nt * MT;
    f32x16 acc[2][2]; zero_acc(acc);
    gemm_deep<2>(A, K, Bt, K, K, mt * 128, nt * 128, D, smem, acc);
    epi_quads(acc, mt * 128, nt * 128, epi);
  }
  if (split_tail && (int)blockIdx.x < 2 * rem) {
    const int job = nfull + (blockIdx.x >> 1), half = blockIdx.x & 1;
    int nt = job / MT, mt = job - nt * MT;
    f32x16 acc[2][1];
#pragma unroll
    for (int a2 = 0; a2 < 2; ++a2)
#pragma unroll
      for (int r = 0; r < 16; ++r) acc[a2][0][r] = 0.f;
    const int n0 = nt * 128 + half * 64;
    gemm_deep<1>(A, K, Bt, K, K, mt * 128, n0, D, smem, acc);
    const int lane = tidx() & 63, wv = tidx() >> 6, wm = wv >> 1, wn = wv & 1, l31 = lane & 31, hh = lane >> 5;
#pragma unroll
    for (int a2 = 0; a2 < 2; ++a2)
#pragma unroll
      for (int g = 0; g < 4; ++g)
        epi(mt * 128 + wm * 64 + a2 * 32 + l31, n0 + wn * 32 + 8 * g + 4 * hh, acc[a2][0][4 * g], acc[a2][0][4 * g + 1], acc[a2][0][4 * g + 2], acc[a2][0][4 * g + 3]);
  }
}
DEVI void mlp1_phase(const P& p, char* smem) {
  constexpr int MT = NR / 128, NT = DFF / 128;
  h16* HID = p.Z();
  for (int job = blockIdx.x; job < MT * NT; job += gridDim.x) {
    int nt = job / MT, mt = job - nt * MT;
    f32x16 acc[2][2]; zero_acc(acc);
    gemm_deep<2>(p.H(), D, p.W1T(), D, D, mt * 128, nt * 128, DFF, smem, acc);
    epi_quads(acc, mt * 128, nt * 128, [&](int m, int n, float v0, float v1, float v2, float v3) {
      v0 = fmaxf(v0, 0.f); v1 = fmaxf(v1, 0.f); v2 = fmaxf(v2, 0.f); v3 = fmaxf(v3, 0.f);
      st4h(HID + (size_t)m * DFF + n, v0 * v0, v1 * v1, v2 * v2, v3 * v3);
    });
  }
}

constexpr int PH_PER_LAYER = 11;
constexpr int NPHASES = 1 + DEPTH * PH_PER_LAYER + 1;

DEVI void run_phase(const P& p, int ph, char* smem, int role, int rank) {
  if (ph == 0) { phase0(p, smem); return; }
  if (ph == NPHASES - 1) { ln_phase(p, DEPTH, 2); return; }
  const int l = (ph - 1) / PH_PER_LAYER, k = (ph - 1) - l * PH_PER_LAYER;
  switch (k) {
    case 0: ln_phase(p, l, 0); conv_phase(p, l, 0, 12, smem); break;
    case 1: inproj_phase(p, smem);
#if PROBE == 2
      inproj_phase(p, smem);
#endif
      break;
    case 2: {
      constexpr int NPRE = 32 * 68, NSH = (NR / 64) * 8, NUP = (NR / 128) * 14;
      for (int j = blockIdx.x; j < NPRE + NSH + NUP; j += gridDim.x) {
        if (j < NPRE) gla_pre_job(p, l, j, smem);
        else if (j < NPRE + NSH) shift_job(p, l, j - NPRE, smem);
        else mla_up_job(p, j - NPRE - NSH, smem);
        __syncthreads();
      }
    } break;
    case 3: {
      constexpr int NLR = 5 * 4 * (NR / 128);
      for (int j = blockIdx.x; j < NLR; j += gridDim.x) { lowrank_job(p, l, j, smem); __syncthreads(); }
    } break;
    case 4: mixer_phase(p, l, smem, l, 0, role, rank);
#if PROBE == 1
      mixer_phase(p, l, smem, 8 + l);
#endif
      break;
    case 5: post_phase(p, l); break;
    case 6: merge_phase(p, smem); conv_phase(p, l, 12, 14, smem); break;
    case 7: resid_gemm_phase(p, l, p.M(), D, p.WO(), 2, smem); break;
    case 8: ln_phase(p, l, 1); break;
    case 9: mlp1_phase(p, smem);
#if PROBE == 2
      mlp1_phase(p, smem);
#endif
      break;
    default: resid_gemm_phase(p, l, p.Z(), DFF, p.W2T(), 5, smem); break;
  }
}

__global__ void __launch_bounds__(256, 2) mega(P p, int pb, int pe) {
  extern __shared__ __attribute__((aligned(16))) char smem[];
  cg::grid_group grid = cg::this_grid();
  __shared__ uint4 xb_words;
  if (threadIdx_x_raw() == 0) xb_words = make_uint4(0u, 0u, 0u, 0u);
  __syncthreads();
  XcdBarrier xb = xcd_barrier_post(p.BAR(), (volatile LAS unsigned*)&xb_words);
  __shared__ int4 rolev;
  unsigned* cut = p.BAR() + 3584;
  if (threadIdx_x_raw() == 0) {
    const unsigned key = (xb_xcc_id() << 8) | ((unsigned)__builtin_amdgcn_s_getreg((7 << 11) | (8 << 6) | 4) & 0xffu);
    const unsigned rank = xb_add(cut + key, 1u);
    if (rank == 0u) { const unsigned ord = xb_add(cut + 8192, 1u); __hip_atomic_store(cut + 4096 + key, ord, __ATOMIC_RELAXED, __HIP_MEMORY_SCOPE_AGENT); }
    if (rank >= 2u) xb_add(cut + 8193, 1u);
    rolev = make_int4((int)blockIdx.x, 0, (int)key, (int)rank);
  }
  __syncthreads();
#if PROBE >= 100
  unsigned long long tacc = 0;
#endif
#if PROBE >= 200
  if (blockIdx.x == 0 && threadIdx_x_raw() == 0) g_tacc[0] = 0;
#endif
  for (int ph = pb; ph < pe; ++ph) {
    if (ph > pb) {
      if (ph == pb + 1) {
        grid.sync();
        if (threadIdx_x_raw() == 0) {
          const unsigned key = (unsigned)rolev.z, rank = (unsigned)rolev.w;
          const unsigned ord = xb_ld(cut + 4096 + key), ncu = xb_ld(cut + 8192), bad = xb_ld(cut + 8193);
          if (bad == 0u && 2u * ncu == gridDim.x && rank < 2u && ncu >= 256u) {
            if (ord < 128u) rolev.x = rank == 0u ? (int)ord : (int)(256u + ord);
            else if (ord < 192u) rolev.x = (int)(128u + 2u * (ord - 128u) + rank);
            else rolev.x = (int)(384u + 2u * (ord - 192u) + rank);
            rolev.y = 1;
          }
        }
        __syncthreads();
      } else xcd_barrier(xb);
    }
#if PROBE == 6
    if (ph >= 1 && ph < NPHASES - 1 && ((ph - 1) % PH_PER_LAYER) == 4) {
      const int l = (ph - 1) / PH_PER_LAYER;
      mixer_phase(p, l, smem, l, 1);
      xcd_barrier(xb);
      mixer_phase(p, l, smem, l, 1);
      xcd_barrier(xb);
      mixer_phase(p, l, smem, l, 2);
      continue;
    }
#endif
#if PROBE >= 100
    const bool tph = (ph >= 1 && ph < NPHASES - 1 && ((ph - 1) % PH_PER_LAYER) == (PROBE - 100));
    unsigned long long t0 = 0;
    if (tph && blockIdx.x == 0) t0 = __builtin_amdgcn_s_memrealtime();
#endif
    run_phase(p, ph, smem, rolev.x, rolev.y);
#if PROBE >= 100
    if (tph) { xcd_barrier(xb); if (blockIdx.x == 0) tacc += __builtin_amdgcn_s_memrealtime() - t0; }
#endif
  }
#if PROBE >= 100
#if PROBE == 300
  if (blockIdx.x == 0) { const unsigned long long te = __builtin_amdgcn_s_memrealtime() + (rolev.w == 1000 ? 300000ull : (rolev.w == 2001 ? 600000ull : 900000ull)); while (__builtin_amdgcn_s_memrealtime() < te) __builtin_amdgcn_s_sleep(8); }
#elif PROBE >= 200
  {
    __syncthreads();
    const unsigned long long ta = g_tacc[0];
    if (ta) { const unsigned long long te = __builtin_amdgcn_s_memrealtime() + 4ull * ta; while (__builtin_amdgcn_s_memrealtime() < te) __builtin_amdgcn_s_sleep(8); }
  }
#else
  if (blockIdx.x == 0) { const unsigned long long te = __builtin_amdgcn_s_memrealtime() + 4ull * tacc; while (__builtin_amdgcn_s_memrealtime() < te) __builtin_amdgcn_s_sleep(8); }
#endif
#endif
}

extern "C" void kernel_launch(void* const* d_in, const int* in_sizes, int n_in, void* d_out, int out_size, void* d_ws,
                              size_t ws_size, hipStream_t stream) {
  static int grid_blocks = 0;
  if (grid_blocks == 0) {
    int dev = 0, cus = 0, per_cu = 0;
    hipGetDevice(&dev);
    hipDeviceGetAttribute(&cus, hipDeviceAttributeMultiprocessorCount, dev);
    hipFuncSetAttribute((const void*)mega, hipFuncAttributeMaxDynamicSharedMemorySize, LDS_BYTES);
    hipOccupancyMaxActiveBlocksPerMultiprocessor(&per_cu, (const void*)mega, 256, LDS_BYTES);
    if (per_cu < 1) per_cu = 1;
    if (per_cu > 2) per_cu = 2;
    grid_blocks = cus * per_cu;
    fprintf(stderr, "mega: cus %d per_cu %d grid %d\n", cus, per_cu, grid_blocks);
  }
  P p{};
  const float** ins = (const float**)&p;
  for (int i = 0; i < 33; ++i) ins[i] = (const float*)d_in[i];
  p.XL = (float*)d_out;
  p.ws = (char*)d_ws;
  const size_t off = WS_TOTAL;
  if (off > ws_size || n_in != 33) { fprintf(stderr, "mega: workspace too small (%zu > %zu) or n_in %d\n", off, ws_size, n_in); return; }
  (void)hipMemsetAsync((char*)d_ws + OFF_BAR, 0, BAR_BYTES, stream);
  int pb = 0, pe = NPHASES;
  void* args[] = {&p, &pb, &pe};
  hipError_t e = hipLaunchCooperativeKernel((const void*)mega, dim3(grid_blocks), dim3(256), args, LDS_BYTES, stream);
  if (e != hipSuccess) fprintf(stderr, "mega: cooperative launch failed: %s (grid %d)\n", hipGetErrorString(e), grid_blocks);
}
```

```cpp
#include <hip/hip_runtime.h>
#include <hip/hip_cooperative_groups.h>
#include <cstdio>
#include <cstdint>
namespace cg = cooperative_groups;

typedef _Float16 h16;
typedef _Float16 h16x8 __attribute__((ext_vector_type(8)));
typedef _Float16 h16x4 __attribute__((ext_vector_type(4)));
typedef float f32x16 __attribute__((ext_vector_type(16)));
typedef float f32x4 __attribute__((ext_vector_type(4)));

#define DEVI __device__ __forceinline__
DEVI int threadIdx_x_raw() { return (int)__builtin_amdgcn_workitem_id_x(); }

#define PROBE 0
constexpr int D = 1024, NB = 4, SEQ = 4096, CTX = 256, DEPTH = 4;
constexpr int SB = SEQ + CTX;
constexpr int NR = NB * SB;
constexpr int ZW = 4160;
constexpr int ZMLA = 1568, ZRW = 2240;
constexpr int NIN = 7232;
constexpr int DFF = 4096;
constexpr int LDS_BYTES = 74752;
constexpr int NSCAN_BPC = 2;
constexpr int NSCAN = 64 * NSCAN_BPC;
constexpr int NGLA = 128;
constexpr int TSTEPS = SB + 1;
constexpr int NCHUNK = (TSTEPS + 15) / 16;

constexpr size_t al256(size_t x) { return (x + 255) & ~(size_t)255; }
constexpr size_t OFF_XC = 0;
constexpr size_t OFF_MOD = OFF_XC + al256((size_t)NB * CTX * D * 4);
constexpr size_t OFF_ROPE = OFF_MOD + al256((size_t)DEPTH * 5 * 6144 * 4);
constexpr size_t OFF_INVN = OFF_ROPE + al256((size_t)SEQ * 32 * 4);
constexpr size_t OFF_CTR = OFF_INVN + al256((size_t)NR * 8 * 4);
constexpr size_t OFF_BAR = OFF_CTR + al256(256);
constexpr size_t BAR_BYTES = (size_t)(3584 + 4096 + 4096 + 64) * 4;
constexpr size_t OFF_HLO = OFF_BAR + al256(BAR_BYTES);
constexpr size_t OFF_HHI = OFF_HLO + al256((size_t)(NR / 64) * 1920 * 2);
constexpr size_t OFF_H = OFF_HHI + al256((size_t)(NR / 64) * 1920 * 2);
constexpr size_t OFF_Z = OFF_H + al256((size_t)NR * D * 2);
constexpr size_t OFF_WIN = OFF_Z + al256((size_t)NR * ZW * 2);
constexpr size_t OFF_UQ = OFF_WIN + al256((size_t)NIN * D * 2);
constexpr size_t OFF_UKV = OFF_UQ + al256((size_t)768 * 384 * 2);
constexpr size_t OFF_WB = OFF_UKV + al256((size_t)1024 * 256 * 2);
constexpr size_t OFF_WO = OFF_WB + al256((size_t)3 * D * 512 * 2);
constexpr size_t OFF_WUP = OFF_WO + al256((size_t)D * D * 2);
constexpr size_t OFF_AUP = OFF_WUP + al256((size_t)2 * 512 * 64 * 2);
constexpr size_t OFF_GUP = OFF_AUP + al256((size_t)2 * 512 * 64 * 2);
constexpr size_t OFF_LW = OFF_GUP + al256((size_t)512 * 128 * 2);
constexpr size_t OFF_AA = OFF_LW + al256((size_t)2 * NR * 512 * 2);
constexpr size_t OFF_G = OFF_AA + al256((size_t)2 * NR * 512 * 2);
constexpr size_t OFF_Y2 = OFF_G + al256((size_t)NR * 512 * 2);
constexpr size_t OFF_Q = OFF_Y2 + al256((size_t)2 * NR * 512 * 2);
constexpr size_t OFF_K = OFF_Q + al256((size_t)NR * 768 * 2);
constexpr size_t OFF_VT = OFF_K + al256((size_t)NR * 768 * 2);
constexpr size_t OFF_QIN = OFF_VT + al256((size_t)NR * 512 * 2);
constexpr size_t OFF_KIN = OFF_QIN + al256((size_t)2 * NR * 256 * 2);
constexpr size_t OFF_DEC = OFF_KIN + al256((size_t)2 * NR * 256 * 2);
constexpr size_t OFF_OFB = OFF_DEC + al256((size_t)32 * 68 * 64 * 4);
constexpr size_t WS_TOTAL = OFF_OFB + al256((size_t)2 * NR * 512 * 2);
struct P {
  const float *x, *c, *ctx, *c_ctx, *ada_w, *ada_b, *w_in, *gk_up, *gk_b, *gla_ng, *qn_g, *kvn_g, *w_uq, *w_ukv,
      *mu, *w0, *w_up, *a0, *a_up, *g_up, *k_k, *k_a, *r_k, *rln_g, *rln_b, *w_branch, *w_out, *ln1_g, *ln1_b,
      *w1, *w2, *ln2_g, *ln2_b;
  float* XL;
  char* ws;
  DEVI float* XC() const { return (float*)(ws + OFF_XC); }
  DEVI float* MOD() const { return (float*)(ws + OFF_MOD); }
  DEVI float* ROPE() const { return (float*)(ws + OFF_ROPE); }
  DEVI float* INVN() const { return (float*)(ws + OFF_INVN); }
  DEVI unsigned* CTR() const { return (unsigned*)(ws + OFF_CTR); }
  DEVI unsigned* BAR() const { return (unsigned*)(ws + OFF_BAR); }
  DEVI h16* HLO() const { return (h16*)(ws + OFF_HLO); }
  DEVI h16* HHI() const { return (h16*)(ws + OFF_HHI); }
  DEVI h16* H() const { return (h16*)(ws + OFF_H); }
  DEVI h16* Z() const { return (h16*)(ws + OFF_Z); }
  DEVI h16* WIN() const { return (h16*)(ws + OFF_WIN); }
  DEVI h16* UQ() const { return (h16*)(ws + OFF_UQ); }
  DEVI h16* UKV() const { return (h16*)(ws + OFF_UKV); }
  DEVI h16* WB() const { return (h16*)(ws + OFF_WB); }
  DEVI h16* WO() const { return (h16*)(ws + OFF_WO); }
  DEVI h16* WUP() const { return (h16*)(ws + OFF_WUP); }
  DEVI h16* AUP() const { return (h16*)(ws + OFF_AUP); }
  DEVI h16* GUP() const { return (h16*)(ws + OFF_GUP); }
  DEVI h16* LW() const { return (h16*)(ws + OFF_LW); }
  DEVI h16* AA() const { return (h16*)(ws + OFF_AA); }
  DEVI h16* G() const { return (h16*)(ws + OFF_G); }
  DEVI h16* Y2() const { return (h16*)(ws + OFF_Y2); }
  DEVI h16* Q() const { return (h16*)(ws + OFF_Q); }
  DEVI h16* K() const { return (h16*)(ws + OFF_K); }
  DEVI h16* VT() const { return (h16*)(ws + OFF_VT); }
  DEVI unsigned short* QIN() const { return (unsigned short*)(ws + OFF_QIN); }
  DEVI unsigned short* KIN() const { return (unsigned short*)(ws + OFF_KIN); }
  DEVI float* DEC() const { return (float*)(ws + OFF_DEC); }
  DEVI h16* OFB() const { return (h16*)(ws + OFF_OFB); }
  DEVI h16* W1T() const { return (h16*)(ws + OFF_LW); }
  DEVI h16* W2T() const { return (h16*)(ws + OFF_LW + (size_t)DFF * D * 2); }
  DEVI h16* M() const { return (h16*)(ws + OFF_Q); }
  DEVI h16* YA() const { return (h16*)(ws + OFF_Z + 1056 * 2); }
};

DEVI int tidx() { int t = threadIdx_x_raw(); asm volatile("" : "+v"(t)); return t; }
DEVI float wsum(float v) {
#pragma unroll
  for (int o = 32; o; o >>= 1) v += __shfl_xor(v, o);
  return v;
}
DEVI float sigm(float x) { return 1.f / (1.f + __expf(-x)); }
DEVI unsigned pk2(float a, float b) {
  auto h = __builtin_amdgcn_cvt_pkrtz(a, b);
  return __builtin_bit_cast(unsigned, h);
}
DEVI unsigned pk2n(float a, float b) {
  h16 x = (h16)a, y = (h16)b;
  unsigned short ux = __builtin_bit_cast(unsigned short, x), uy = __builtin_bit_cast(unsigned short, y);
  return (unsigned)ux | ((unsigned)uy << 16);
}
DEVI unsigned f2bf(float f) { unsigned u = __builtin_bit_cast(unsigned, f); u += 0x7fffu + ((u >> 16) & 1u); return u >> 16; }
DEVI float h2f(unsigned short u) { return (float)__builtin_bit_cast(h16, u); }
DEVI void st4h(h16* dst, float a, float b, float c, float d) {
  uint2 u; u.x = pk2n(a, b); u.y = pk2n(c, d);
  *(uint2*)dst = u;
}
DEVI float* xrow(const P& p, int r) {
  int b = r / SB, s = r - b * SB;
  return s < CTX ? p.XC() + (size_t)(b * CTX + s) * D : p.XL + (size_t)(b * SEQ + s - CTX) * D;
}
DEVI int maprow(int dir, int b, int n) {
  if (dir == 0) return b * SB + n;
  return n < CTX ? b * SB + (CTX - 1 - n) : b * SB + (SB + CTX - 1 - n);
}


#define XB_TMO      128
#define XB_XCNT(j)  (256  + 64 * (j))
#define XB_XSUB(j)  (1280 + 64 * (j))
#define XB_XGEN(j)  (2304 + 64 * (j))
#define XB_TOP      3328
#define XB_TOPGEN   3392
#define XCD_BAR_WORDS 3456
#define XB_SPIN_CAP (1u << 22)
#define LAS __attribute__((address_space(3)))
DEVI unsigned xb_ld(unsigned* p) { return __hip_atomic_load(p, __ATOMIC_RELAXED, __HIP_MEMORY_SCOPE_AGENT); }
DEVI unsigned xb_add(unsigned* p, unsigned v) { return __hip_atomic_fetch_add(p, v, __ATOMIC_RELAXED, __HIP_MEMORY_SCOPE_AGENT); }
DEVI unsigned xb_xcc_id() { return (unsigned)__builtin_amdgcn_s_getreg((3 << 11) | 20) & 0xFu; }
#define XB_SPIN(cond, bar) do { unsigned _sp = 0; while (cond) { __builtin_amdgcn_s_sleep(1); \
    if ((++_sp & 255u) == 0u) { if (xb_ld(&(bar)[XB_TMO])) break; if (_sp > XB_SPIN_CAP) { atomicAdd(&(bar)[XB_TMO], 1u); break; } } } } while (0)
struct XcdBarrier { unsigned* bar; unsigned x; volatile LAS unsigned* st; };
DEVI XcdBarrier xcd_barrier_post(unsigned* bar, volatile LAS unsigned* st) {
  XcdBarrier b; b.bar = bar; b.x = xb_xcc_id(); b.st = st;
  if (threadIdx_x_raw() == 0) (void)xb_add(&bar[XB_XCNT(b.x)], 1u);
  return b;
}
DEVI void xcd_barrier_complete(unsigned* bar, unsigned x, unsigned& nloc, unsigned& nx) {
  const unsigned G = gridDim.x;
  unsigned sum, cnt, mine, sp = 0u;
  for (;;) {
    sum = 0u; cnt = 0u; mine = 0u;
#pragma unroll
    for (unsigned j = 0; j < 16; ++j) { const unsigned c = xb_ld(&bar[XB_XCNT(j)]); sum += c; cnt += (c > 0u) ? 1u : 0u; mine = (j == x) ? c : mine; }
    if (sum == G) break;
    __builtin_amdgcn_s_sleep(1);
    if ((++sp & 255u) == 0u) { if (xb_ld(&bar[XB_TMO])) break; if (sp > XB_SPIN_CAP) { atomicAdd(&bar[XB_TMO], 1u); break; } }
  }
  nloc = mine > 0u ? mine : 1u; nx = cnt > 0u ? cnt : 1u;
}
DEVI void xcd_barrier(const XcdBarrier& b) {
  asm volatile("s_waitcnt vmcnt(0)" ::: "memory");
  __syncthreads();
  if (threadIdx_x_raw() == 0) {
    unsigned* bar = b.bar;
    __builtin_amdgcn_s_waitcnt(0);
    unsigned nloc = b.st[0], nx = b.st[1];
    if (nloc == 0u) { xcd_barrier_complete(bar, b.x, nloc, nx); b.st[0] = nloc; b.st[1] = nx; }
    const unsigned old = xb_add(&bar[XB_XSUB(b.x)], 1u);
    const unsigned gen = old / nloc;
    if (old + 1u == (gen + 1u) * nloc) {
      __builtin_amdgcn_fence(__ATOMIC_RELEASE, "agent");
      asm volatile("s_waitcnt vmcnt(0)" ::: "memory");
      const unsigned og = xb_add(&bar[XB_TOP], 1u);
      const unsigned tg = og / nx;
      if (og + 1u == (tg + 1u) * nx) xb_add(&bar[XB_TOPGEN], 1u);
      else XB_SPIN(xb_ld(&bar[XB_TOPGEN]) == tg, bar);
      __builtin_amdgcn_fence(__ATOMIC_ACQUIRE, "agent");
      xb_add(&bar[XB_XGEN(b.x)], 1u);
      asm volatile("s_waitcnt vmcnt(0)" ::: "memory");
    } else {
      XB_SPIN(xb_ld(&bar[XB_XGEN(b.x)]) == gen, bar);
      __builtin_amdgcn_fence(__ATOMIC_ACQUIRE, "agent");
      asm volatile("s_waitcnt vmcnt(0)" ::: "memory");
    }
  }
  __syncthreads();
}

DEVI void phase0(const P& p, char* smem) {
  const int tid = tidx();
  float* sc = (float*)smem;
  float* red = sc + 5 * 1024;
  for (int i = tid; i < 5 * 1024; i += 256) {
    int g = i >> 10, k = i & 1023;
    float v = g < 4 ? p.c[g * D + k] : p.c_ctx[k];
    sc[i] = v * sigm(v);
  }
  __syncthreads();
  for (int job = blockIdx.x; job < DEPTH * 96; job += gridDim.x) {
    int l = job / 96, n0 = (job % 96) * 64;
    int kq = tid >> 6, cc = tid & 63;
    const float* w = p.ada_w + ((size_t)l * D + kq * 256) * 6144 + n0 + cc;
    float a0 = 0, a1 = 0, a2 = 0, a3 = 0, a4 = 0;
#pragma unroll 8
    for (int k = 0; k < 256; ++k) {
      float wv = w[(size_t)k * 6144];
      int kk = kq * 256 + k;
      a0 += sc[kk] * wv; a1 += sc[1024 + kk] * wv; a2 += sc[2048 + kk] * wv; a3 += sc[3072 + kk] * wv; a4 += sc[4096 + kk] * wv;
    }
    red[(kq * 5 + 0) * 64 + cc] = a0; red[(kq * 5 + 1) * 64 + cc] = a1; red[(kq * 5 + 2) * 64 + cc] = a2;
    red[(kq * 5 + 3) * 64 + cc] = a3; red[(kq * 5 + 4) * 64 + cc] = a4;
    __syncthreads();
    for (int i = tid; i < 320; i += 256) {
      int g = i >> 6, c2 = i & 63;
      float s = red[(0 * 5 + g) * 64 + c2] + red[(1 * 5 + g) * 64 + c2] + red[(2 * 5 + g) * 64 + c2] + red[(3 * 5 + g) * 64 + c2];
      p.MOD()[((size_t)l * 5 + g) * 6144 + n0 + c2] = s + p.ada_b[l * 6144 + n0 + c2];
    }
    __syncthreads();
  }
  for (int i = blockIdx.x * 256 + tid; i < SEQ * 16; i += gridDim.x * 256) {
    int s = i >> 4, j = i & 15;
    float pos = (float)(j < 8 ? (s >> 6) : (s & 63));
    float inv = exp2f(-(float)(j & 7) * (13.287712379549449f / 8.f));
    float ang = pos * inv;
    p.ROPE()[s * 32 + j] = cosf(ang);
    p.ROPE()[s * 32 + 16 + j] = sinf(ang);
  }
  if (blockIdx.x == 0 && tid < 64) p.CTR()[tid] = 0;
}

struct CE { const float* src; h16* dst; const float* scale; int K, N; };
DEVI CE get_ce(const P& p, int l, int e) {
  CE c; c.scale = nullptr;
  switch (e) {
    case 0: c.src = p.w_in + (size_t)l * D * NIN; c.dst = p.WIN(); c.K = D; c.N = NIN; break;
    case 1: c.src = p.w_uq + (size_t)l * 384 * 768; c.dst = p.UQ(); c.K = 384; c.N = 768; c.scale = p.qn_g + l * 384; break;
    case 2: c.src = p.w_ukv + (size_t)l * 256 * 1024; c.dst = p.UKV(); c.K = 256; c.N = 1024; c.scale = p.kvn_g + l * 256; break;
    case 3: case 4: case 5: c.src = p.w_branch + ((size_t)l * 3 + (e - 3)) * 512 * D; c.dst = p.WB() + (size_t)(e - 3) * D * 512; c.K = 512; c.N = D; break;
    case 6: c.src = p.w_out + (size_t)l * D * D; c.dst = p.WO(); c.K = D; c.N = D; break;
    case 7: case 8: c.src = p.w_up + ((size_t)l * 2 + (e - 7)) * 64 * 512; c.dst = p.WUP() + (size_t)(e - 7) * 512 * 64; c.K = 64; c.N = 512; break;
    case 9: case 10: c.src = p.a_up + ((size_t)l * 2 + (e - 9)) * 64 * 512; c.dst = p.AUP() + (size_t)(e - 9) * 512 * 64; c.K = 64; c.N = 512; break;
    case 11: c.src = p.g_up + (size_t)l * 128 * 512; c.dst = p.GUP(); c.K = 128; c.N = 512; break;
    case 12: c.src = p.w1 + (size_t)l * D * DFF; c.dst = p.W1T(); c.K = D; c.N = DFF; break;
    default: c.src = p.w2 + (size_t)l * DFF * D; c.dst = p.W2T(); c.K = DFF; c.N = D; break;
  }
  return c;
}
DEVI void conv_tile(const CE& e, int tile, char* smem) {
  float* s = (float*)smem;
  const int tid = tidx();
  int ntn = e.N >> 6;
  int kt = tile / ntn, nt = tile - kt * ntn;
  {
    int r = tid >> 4, c4 = (tid & 15) * 4;
#pragma unroll
    for (int rr = 0; rr < 4; ++rr) {
      int k = r + 16 * rr;
      float4 v = *(const float4*)(e.src + (size_t)(kt * 64 + k) * e.N + nt * 64 + c4);
      float sc = e.scale ? e.scale[kt * 64 + k] : 1.f;
      s[k * 65 + c4 + 0] = v.x * sc; s[k * 65 + c4 + 1] = v.y * sc; s[k * 65 + c4 + 2] = v.z * sc; s[k * 65 + c4 + 3] = v.w * sc;
    }
  }
  __syncthreads();
  {
    int n = tid >> 2, kq = (tid & 3) * 16;
    uint4 u0, u1;
    u0.x = pk2n(s[(kq + 0) * 65 + n], s[(kq + 1) * 65 + n]); u0.y = pk2n(s[(kq + 2) * 65 + n], s[(kq + 3) * 65 + n]);
    u0.z = pk2n(s[(kq + 4) * 65 + n], s[(kq + 5) * 65 + n]); u0.w = pk2n(s[(kq + 6) * 65 + n], s[(kq + 7) * 65 + n]);
    u1.x = pk2n(s[(kq + 8) * 65 + n], s[(kq + 9) * 65 + n]); u1.y = pk2n(s[(kq + 10) * 65 + n], s[(kq + 11) * 65 + n]);
    u1.z = pk2n(s[(kq + 12) * 65 + n], s[(kq + 13) * 65 + n]); u1.w = pk2n(s[(kq + 14) * 65 + n], s[(kq + 15) * 65 + n]);
    h16* d = e.dst + (size_t)(nt * 64 + n) * e.K + kt * 64 + kq;
    *(uint4*)d = u0; *(uint4*)(d + 8) = u1;
  }
  __syncthreads();
}
DEVI void conv_phase(const P& p, int l, int e0, int e1, char* smem) {
  int total = 0;
  for (int e = e0; e < e1; ++e) { CE c = get_ce(p, l, e); total += (c.K >> 6) * (c.N >> 6); }
  for (int t = blockIdx.x; t < total; t += gridDim.x) {
    int tt = t;
    for (int e = e0; e < e1; ++e) {
      CE c = get_ce(p, l, e);
      int nt = (c.K >> 6) * (c.N >> 6);
      if (tt < nt) { conv_tile(c, tt, smem); break; }
      tt -= nt;
    }
  }
}

DEVI void ln_phase(const P& p, int l, int which) {
  const int lane = tidx() & 63;
  const int wid = blockIdx.x * 4 + (tidx() >> 6), nw = gridDim.x * 4;
  for (int r = wid; r < NR; r += nw) {
    int b = r / SB, s = r - b * SB;
    if (which == 2 && s < CTX) continue;
    int g = s < CTX ? 4 : b;
    float* xr = xrow(p, r);
    const float* src = xr;
    if (which == 0 && l == 0) src = s < CTX ? p.ctx + (size_t)(b * CTX + s) * D : p.x + (size_t)(b * SEQ + s - CTX) * D;
    float4 v[4];
#pragma unroll
    for (int i = 0; i < 4; ++i) v[i] = *(const float4*)(src + i * 256 + lane * 4);
    bool do_ln = !(which == 0 && l == 0);
    if (do_ln) {
      const float* gg = which == 1 ? p.ln1_g + l * D : p.ln2_g + (which == 2 ? 3 : l - 1) * D;
      const float* bb = which == 1 ? p.ln1_b + l * D : p.ln2_b + (which == 2 ? 3 : l - 1) * D;
      float sm = 0;
#pragma unroll
      for (int i = 0; i < 4; ++i) sm += v[i].x + v[i].y + v[i].z + v[i].w;
      float mean = wsum(sm) * (1.f / D);
      float sq = 0;
#pragma unroll
      for (int i = 0; i < 4; ++i) {
        v[i].x -= mean; v[i].y -= mean; v[i].z -= mean; v[i].w -= mean;
        sq += v[i].x * v[i].x + v[i].y * v[i].y + v[i].z * v[i].z + v[i].w * v[i].w;
      }
      float rs = rsqrtf(wsum(sq) * (1.f / D) + 1e-5f);
#pragma unroll
      for (int i = 0; i < 4; ++i) {
        float4 g4 = *(const float4*)(gg + i * 256 + lane * 4), b4 = *(const float4*)(bb + i * 256 + lane * 4);
        v[i].x = v[i].x * rs * g4.x + b4.x; v[i].y = v[i].y * rs * g4.y + b4.y;
        v[i].z = v[i].z * rs * g4.z + b4.z; v[i].w = v[i].w * rs * g4.w + b4.w;
      }
    }
#pragma unroll
    for (int i = 0; i < 4; ++i) *(float4*)(xr + i * 256 + lane * 4) = v[i];
    if (which == 2) continue;
    const float* shf = p.MOD() + ((size_t)l * 5 + g) * 6144 + (which == 0 ? 0 : 3) * D;
    const float* scl = shf + D;
    float sm = 0;
#pragma unroll
    for (int i = 0; i < 4; ++i) sm += v[i].x + v[i].y + v[i].z + v[i].w;
    float mean = wsum(sm) * (1.f / D);
    float sq = 0;
#pragma unroll
    for (int i = 0; i < 4; ++i) {
      v[i].x -= mean; v[i].y -= mean; v[i].z -= mean; v[i].w -= mean;
      sq += v[i].x * v[i].x + v[i].y * v[i].y + v[i].z * v[i].z + v[i].w * v[i].w;
    }
    float rs = rsqrtf(wsum(sq) * (1.f / D) + 1e-6f);
    h16* hr = p.H() + (size_t)r * D;
#pragma unroll
    for (int i = 0; i < 4; ++i) {
      float4 s4 = *(const float4*)(shf + i * 256 + lane * 4), c4 = *(const float4*)(scl + i * 256 + lane * 4);
      st4h(hr + i * 256 + lane * 4, v[i].x * rs * (1.f + c4.x) + s4.x, v[i].y * rs * (1.f + c4.y) + s4.y,
           v[i].z * rs * (1.f + c4.z) + s4.z, v[i].w * rs * (1.f + c4.w) + s4.w);
    }
  }
}

constexpr int GLD = 72;
template <bool ROWSQ, int NI = 2>
DEVI void gemm_main(const h16* __restrict__ A, int lda, const h16* __restrict__ Bt, int ldb, int K, int m0, int n0, int nmax,
                    char* smem, f32x16 (&acc)[2][NI], float* rowsq) {
  h16* As = (h16*)smem;
  h16* Bs = As + 2 * 128 * GLD;
  const int tid = tidx(), lane = tid & 63, wv = tid >> 6;
  const int wm = wv >> 1, wn = wv & 1, l31 = lane & 31, hh = lane >> 5;
  const int lrow = tid >> 3, lkc = (tid & 7) * 8;
  uint4 ga[4], gb[2 * NI];
  float sq[4] = {0.f, 0.f, 0.f, 0.f};
  const h16* Ap = A + (size_t)(m0 + lrow) * lda + lkc;
  const h16* Bp = Bt + (size_t)(n0 + lrow) * ldb + lkc;
#pragma unroll
  for (int i = 0; i < 4; ++i) ga[i] = *(const uint4*)(Ap + (size_t)(32 * i) * lda);
#pragma unroll
  for (int i = 0; i < 2 * NI; ++i)
    gb[i] = (n0 + lrow + 32 * i < nmax) ? *(const uint4*)(Bp + (size_t)(32 * i) * ldb) : make_uint4(0, 0, 0, 0);
  const int KT = K >> 6;
#pragma unroll
  for (int i = 0; i < 4; ++i) *(uint4*)(As + (lrow + 32 * i) * GLD + lkc) = ga[i];
#pragma unroll
  for (int i = 0; i < 2 * NI; ++i) *(uint4*)(Bs + (lrow + 32 * i) * GLD + lkc) = gb[i];
  __syncthreads();
  for (int kt = 0; kt < KT; ++kt) {
    const int buf = kt & 1;
    if (ROWSQ) {
#pragma unroll
      for (int i = 0; i < 4; ++i) {
        h16x8 hv = __builtin_bit_cast(h16x8, ga[i]);
#pragma unroll
        for (int j = 0; j < 8; ++j) { float f = (float)hv[j]; sq[i] += f * f; }
      }
    }
    if (kt + 1 < KT) {
#pragma unroll
      for (int i = 0; i < 4; ++i) ga[i] = *(const uint4*)(Ap + (size_t)(32 * i) * lda + (kt + 1) * 64);
#pragma unroll
      for (int i = 0; i < 2 * NI; ++i)
        gb[i] = (n0 + lrow + 32 * i < nmax) ? *(const uint4*)(Bp + (size_t)(32 * i) * ldb + (kt + 1) * 64) : make_uint4(0, 0, 0, 0);
    }
    const h16* as = As + buf * 128 * GLD + (wm * 64 + l31) * GLD + hh * 8;
    const h16* bs = Bs + buf * 128 * GLD + (wn * 32 * NI + l31) * GLD + hh * 8;
#pragma unroll
    for (int ks = 0; ks < 4; ++ks) {
      h16x8 a0 = *(const h16x8*)(as + ks * 16), a1 = *(const h16x8*)(as + 32 * GLD + ks * 16);
#pragma unroll
      for (int ni = 0; ni < NI; ++ni) {
        h16x8 b0 = *(const h16x8*)(bs + ni * 32 * GLD + ks * 16);
        acc[0][ni] = __builtin_amdgcn_mfma_f32_32x32x16_f16(b0, a0, acc[0][ni], 0, 0, 0);
        acc[1][ni] = __builtin_amdgcn_mfma_f32_32x32x16_f16(b0, a1, acc[1][ni], 0, 0, 0);
      }
    }
    if (kt + 1 < KT) {
      h16* ad = As + (buf ^ 1) * 128 * GLD;
      h16* bd = Bs + (buf ^ 1) * 128 * GLD;
#pragma unroll
      for (int i = 0; i < 4; ++i) *(uint4*)(ad + (lrow + 32 * i) * GLD + lkc) = ga[i];
#pragma unroll
      for (int i = 0; i < 2 * NI; ++i) *(uint4*)(bd + (lrow + 32 * i) * GLD + lkc) = gb[i];
    }
    __syncthreads();
  }
  if (ROWSQ) {
#pragma unroll
    for (int i = 0; i < 4; ++i) {
      float s = sq[i];
      s += __shfl_xor(s, 1); s += __shfl_xor(s, 2); s += __shfl_xor(s, 4);
      if ((tid & 7) == 0) rowsq[lrow + 32 * i] = s;
    }
    __syncthreads();
  }
}
template <int NI = 2>
DEVI void gemm_deep(const h16* __restrict__ A, int lda, const h16* __restrict__ Bt, int ldb, int K, int m0, int n0, int nmax,
                    char* smem, f32x16 (&acc)[2][NI]) {
  h16* As = (h16*)smem;
  h16* Bs = As + 2 * 128 * GLD;
  const int tid = tidx(), lane = tid & 63, wv = tid >> 6;
  const int wm = wv >> 1, wn = wv & 1, l31 = lane & 31, hh = lane >> 5;
  const int lrow = tid >> 3, lkc = (tid & 7) * 8;
  uint4 pa0, pa1, pa2, pa3, pb0, pb1, pb2, pb3;
  uint4 qa0, qa1, qa2, qa3, qb0, qb1, qb2, qb3;
  const h16* Ap = A + (size_t)(m0 + lrow) * lda + lkc;
  const int KT = K >> 6;
  const uint4 zz = make_uint4(0, 0, 0, 0);
  const h16* Bq0 = Bt + (size_t)min(n0 + lrow, nmax - 1) * ldb + lkc;
  const h16* Bq1 = Bt + (size_t)min(n0 + lrow + 32, nmax - 1) * ldb + lkc;
  const h16* Bq2 = Bt + (size_t)min(n0 + lrow + 64, nmax - 1) * ldb + lkc;
  const h16* Bq3 = Bt + (size_t)min(n0 + lrow + 96, nmax - 1) * ldb + lkc;
#define GLOAD(S, kt_)                                                                   \
  {                                                                                     \
    const h16* ap_ = Ap + (kt_) * 64;                                                   \
    S##a0 = *(const uint4*)(ap_); S##a1 = *(const uint4*)(ap_ + (size_t)32 * lda);      \
    S##a2 = *(const uint4*)(ap_ + (size_t)64 * lda); S##a3 = *(const uint4*)(ap_ + (size_t)96 * lda); \
    S##b0 = *(const uint4*)(Bq0 + (kt_) * 64); S##b1 = *(const uint4*)(Bq1 + (kt_) * 64); \
    if (NI == 2) { S##b2 = *(const uint4*)(Bq2 + (kt_) * 64); S##b3 = *(const uint4*)(Bq3 + (kt_) * 64); } \
  }
#define LSTORE(S, buf_)                                                                 \
  {                                                                                     \
    h16* ad = As + (buf_) * 128 * GLD + lrow * GLD + lkc;                               \
    h16* bd = Bs + (buf_) * 128 * GLD + lrow * GLD + lkc;                               \
    *(uint4*)(ad) = S##a0; *(uint4*)(ad + 32 * GLD) = S##a1; *(uint4*)(ad + 64 * GLD) = S##a2; *(uint4*)(ad + 96 * GLD) = S##a3; \
    *(uint4*)(bd) = S##b0; *(uint4*)(bd + 32 * GLD) = S##b1;                            \
    if (NI == 2) { *(uint4*)(bd + 64 * GLD) = S##b2; *(uint4*)(bd + 96 * GLD) = S##b3; } \
  }
#define COMPUTE(buf_)                                                                                              \
  {                                                                                                                \
    const h16* as = As + (buf_) * 128 * GLD + (wm * 64 + l31) * GLD + hh * 8;                                      \
    const h16* bs = Bs + (buf_) * 128 * GLD + (wn * 32 * NI + l31) * GLD + hh * 8;                                 \
    _Pragma("unroll") for (int ks = 0; ks < 4; ++ks) {                                                             \
      h16x8 a0 = *(const h16x8*)(as + ks * 16), a1 = *(const h16x8*)(as + 32 * GLD + ks * 16);                     \
      _Pragma("unroll") for (int ni = 0; ni < NI; ++ni) {                                                          \
        h16x8 b0 = *(const h16x8*)(bs + ni * 32 * GLD + ks * 16);                                                  \
        acc[0][ni] = __builtin_amdgcn_mfma_f32_32x32x16_f16(b0, a0, acc[0][ni], 0, 0, 0);                          \
        acc[1][ni] = __builtin_amdgcn_mfma_f32_32x32x16_f16(b0, a1, acc[1][ni], 0, 0, 0);                          \
      }                                                                                                            \
    }                                                                                                              \
  }
  pb2 = zz; pb3 = zz; qb2 = zz; qb3 = zz;
  GLOAD(p, 0);
  GLOAD(q, 1);
  LSTORE(p, 0);
  if (KT > 2) GLOAD(p, 2);
  __syncthreads();
  for (int kt = 0; kt < KT; kt += 2) {
    COMPUTE(0);
    if (kt + 1 < KT) LSTORE(q, 1);
    if (kt + 3 < KT) GLOAD(q, kt + 3);
    __syncthreads();
    if (kt + 1 < KT) {
      COMPUTE(1);
      if (kt + 2 < KT) LSTORE(p, 0);
      if (kt + 4 < KT) GLOAD(p, kt + 4);
      __syncthreads();
    }
  }
#undef GLOAD
#undef LSTORE
#undef COMPUTE
}
DEVI void zero_acc(f32x16 (&acc)[2][2]) {
#pragma unroll
  for (int i = 0; i < 2; ++i)
#pragma unroll
    for (int j = 0; j < 2; ++j)
#pragma unroll
      for (int r = 0; r < 16; ++r) acc[i][j][r] = 0.f;
}
template <class F>
DEVI void epi_quads(const f32x16 (&acc)[2][2], int m0, int n0, F f) {
  const int lane = tidx() & 63, wv = tidx() >> 6;
  const int wm = wv >> 1, wn = wv & 1, l31 = lane & 31, hh = lane >> 5;
#pragma unroll
  for (int mi = 0; mi < 2; ++mi)
#pragma unroll
    for (int ni = 0; ni < 2; ++ni)
#pragma unroll
      for (int g = 0; g < 4; ++g)
        f(m0 + wm * 64 + mi * 32 + l31, n0 + wn * 64 + ni * 32 + 8 * g + 4 * hh, acc[mi][ni][4 * g], acc[mi][ni][4 * g + 1],
          acc[mi][ni][4 * g + 2], acc[mi][ni][4 * g + 3]);
}

DEVI void inproj_phase(const P& p, char* smem) {
  constexpr int MT = NR / 128, NT = (ZW + 127) / 128;
  for (int job = blockIdx.x; job < MT * NT; job += gridDim.x) {
    int nt = job / MT, mt = job - nt * MT;
    f32x16 acc[2][2]; zero_acc(acc);
    gemm_deep<2>(p.H(), D, p.WIN(), D, D, mt * 128, nt * 128, ZW, smem, acc);
    epi_quads(acc, mt * 128, nt * 128, [&](int m, int n, float v0, float v1, float v2, float v3) {
      if (n < ZW) {
        st4h(p.Z() + (size_t)m * ZW + n, v0, v1, v2, v3);
        if (n >= ZRW) {
          if ((m & 63) == 0) st4h(p.HLO() + (size_t)(m >> 6) * 1920 + n - ZRW, v0, v1, v2, v3);
          if ((m & 63) == 63) st4h(p.HHI() + (size_t)(m >> 6) * 1920 + n - ZRW, v0, v1, v2, v3);
        }
      }
    });
  }
}

DEVI void shift_job(const P& p, int l, int jj, char* smem) {
  const int j = jj >> 3, slab0 = jj & 7;
  h16* raw = (h16*)smem;
  const int tid = tidx(), lane = tid & 63;
  const int r0 = j * 64;
  const int s0 = r0 % SB;
  const bool first = (s0 == 0) || (s0 == CTX);
  const bool last = (s0 + 64 == CTX) || (s0 + 64 == SB);
  for (int slab = slab0; slab <= slab0; ++slab) {
    const int c0 = slab * 256;
    const int ncols = slab == 7 ? 128 : 256;
    const int cpr = ncols >> 3;
    for (int c = tid; c < 66 * cpr; c += 256) {
      int row = c / cpr, ch = (c - row * cpr) * 8;
      uint4 v = make_uint4(0, 0, 0, 0);
      if (row == 0) { if (!first) v = *(const uint4*)(p.HHI() + (size_t)(j - 1) * 1920 + c0 + ch); }
      else if (row == 65) { if (!last) v = *(const uint4*)(p.HLO() + (size_t)(j + 1) * 1920 + c0 + ch); }
      else v = *(const uint4*)(p.Z() + (size_t)(r0 + row - 1) * ZW + ZRW + c0 + ch);
      *(uint4*)(raw + row * 264 + ch) = v;
    }
    __syncthreads();
    if (tid < ncols) {
      const int col = c0 + tid;
      const float mup = p.mu[(size_t)l * 2 * 1920 + col], mun = p.mu[(size_t)l * 2 * 1920 + 1920 + col];
      const bool isk = (col >= 512 && col < 1024);
      const float kkp = isk ? p.k_k[l * 512 + col - 512] : 0.f;
      float prev = (float)raw[tid], cur = (float)raw[264 + tid];
      h16* zc = p.Z() + (size_t)r0 * ZW + ZRW + col;
      for (int t = 0; t < 64; ++t) {
        float nxt = (float)raw[(t + 2) * 264 + tid];
        float o = cur + mup * (prev - cur) + mun * (nxt - cur);
        float ov = o;
        if (col >= 1536 && col < 1664) ov = tanhf(o);
        else if (col >= 1792) ov = sigm(o);
        zc[(size_t)t * ZW] = (h16)ov;
        if (isk) {
          float q = o * kkp;
          float ss = wsum(q * q);
          if (lane == 0) p.INVN()[(size_t)(r0 + t) * 8 + ((col - 512) >> 6)] = rsqrtf(ss + 1e-12f);
        }
        prev = cur; cur = nxt;
      }
    }
    __syncthreads();
  }
}

DEVI void mla_up_job(const P& p, int job, char* smem) {
  constexpr int MT = NR / 128;
  float* rowsq = (float*)(smem + 2 * 2 * 128 * GLD * 2);
  const int tid = tidx();
  f32x16 acc[2][2]; zero_acc(acc);
  if (job < MT * 6) {
    int nt = job / MT, mt = job - nt * MT;
    gemm_main<true>(p.Z() + ZMLA, ZW, p.UQ(), 384, 384, mt * 128, nt * 128, 768, smem, acc, rowsq);
    const int m0 = mt * 128, n0 = nt * 128;
    const int lane = tid & 63, wv = tid >> 6, wm = wv >> 1, wn = wv & 1, l31 = lane & 31, hh = lane >> 5;
    const float qs = 0.10206207261596575f * 1.4426950408889634f;
#pragma unroll
    for (int mi = 0; mi < 2; ++mi) {
      const int ml = wm * 64 + mi * 32 + l31, m = m0 + ml;
      const float sc = rsqrtf(rowsq[ml] * (1.f / 384.f) + 1e-6f) * qs;
      const int sp = m % SB;
      const bool lat = sp >= CTX;
      const float* rp = p.ROPE() + (size_t)(lat ? sp - CTX : 0) * 32;
#pragma unroll
      for (int ni = 0; ni < 2; ++ni) {
        const int nb = n0 + wn * 64 + ni * 32;
        h16* qd = p.Q() + (size_t)m * 768 + nb;
        const bool ropet = (nb % 96) == 64;
        if (ropet && lat) {
#pragma unroll
          for (int g = 0; g < 2; ++g) {
            float o1[4], o2[4];
#pragma unroll
            for (int jj = 0; jj < 4; ++jj) {
              int i = 8 * g + 4 * hh + jj;
              float x1 = acc[mi][ni][4 * g + jj] * sc, x2 = acc[mi][ni][4 * (g + 2) + jj] * sc;
              float cs = rp[i], sn = rp[16 + i];
              o1[jj] = x1 * cs - x2 * sn; o2[jj] = x1 * sn + x2 * cs;
            }
            st4h(qd + 8 * g + 4 * hh, o1[0], o1[1], o1[2], o1[3]);
            st4h(qd + 16 + 8 * g + 4 * hh, o2[0], o2[1], o2[2], o2[3]);
          }
        } else {
#pragma unroll
          for (int g = 0; g < 4; ++g)
            st4h(qd + 8 * g + 4 * hh, acc[mi][ni][4 * g] * sc, acc[mi][ni][4 * g + 1] * sc, acc[mi][ni][4 * g + 2] * sc, acc[mi][ni][4 * g + 3] * sc);
        }
      }
    }
  } else {
    int j2 = job - MT * 6;
    int nt = j2 / MT, mt = j2 - nt * MT;
    gemm_main<true>(p.Z() + ZMLA + 384, ZW, p.UKV(), 256, 256, mt * 128, nt * 128, 1024, smem, acc, rowsq);
    const int m0 = mt * 128;
    epi_quads(acc, m0, 0, [&](int m, int n, float v0, float v1, float v2, float v3) {
      const float sc = rsqrtf(rowsq[m - m0] * (1.f / 256.f) + 1e-6f);
      if (n < 64) st4h(p.K() + (size_t)m * 768 + nt * 96 + n, v0 * sc, v1 * sc, v2 * sc, v3 * sc);
      else {
        int b = m / SB, s = m - b * SB;
        h16* vt = p.VT() + ((size_t)(b * 8 + nt) * 64 + (n - 64)) * SB + s;
        vt[0] = (h16)(v0 * sc); vt[SB] = (h16)(v1 * sc); vt[2 * SB] = (h16)(v2 * sc); vt[3 * SB] = (h16)(v3 * sc);
      }
    });
    {
      int row = tid >> 1, sub = tid & 1;
      int m = m0 + row;
      int sp = m % SB;
      const h16* kr = p.Z() + (size_t)m * ZW + ZMLA + 640 + sub * 8;
      h16x8 x1 = *(const h16x8*)kr, x2 = *(const h16x8*)(kr + 16);
      h16* kd = p.K() + (size_t)m * 768 + nt * 96 + 64 + sub * 8;
      if (sp >= CTX) {
        const float* rp = p.ROPE() + (size_t)(sp - CTX) * 32 + sub * 8;
        h16x8 o1, o2;
#pragma unroll
        for (int i = 0; i < 8; ++i) {
          float a = (float)x1[i], b2 = (float)x2[i], cs = rp[i], sn = rp[16 + i];
          o1[i] = (h16)(a * cs - b2 * sn); o2[i] = (h16)(a * sn + b2 * cs);
        }
        *(h16x8*)kd = o1; *(h16x8*)(kd + 16) = o2;
      } else { *(h16x8*)kd = x1; *(h16x8*)(kd + 16) = x2; }
    }
  }
}

DEVI void lowrank_job(const P& p, int l, int job, char* smem) {
  constexpr int MT = NR / 128;
  int mat = job / (MT * 4), rem = job - mat * MT * 4;
  int nt = rem / MT, mt = rem - nt * MT;
  f32x16 acc[2][2]; zero_acc(acc);
  if (mat < 2) {
    const int dir = mat;
    gemm_main<false>(p.Z() + ZRW + 1536 + dir * 64, ZW, p.WUP() + (size_t)dir * 512 * 64, 64, 64, mt * 128, nt * 128, 512, smem, acc, nullptr);
    const float* w0 = p.w0 + ((size_t)l * 2 + dir) * 512;
    h16* dst = p.LW() + (size_t)dir * NR * 512;
    epi_quads(acc, mt * 128, nt * 128, [&](int m, int n, float v0, float v1, float v2, float v3) {
      float4 b = *(const float4*)(w0 + n);
      const float e = 0.6065306597126334f;
      st4h(dst + (size_t)m * 512 + n, sigm(v0 + b.x) * e, sigm(v1 + b.y) * e, sigm(v2 + b.z) * e, sigm(v3 + b.w) * e);
    });
  } else if (mat < 4) {
    const int dir = mat - 2;
    gemm_main<false>(p.Z() + ZRW + 1664 + dir * 64, ZW, p.AUP() + (size_t)dir * 512 * 64, 64, 64, mt * 128, nt * 128, 512, smem, acc, nullptr);
    const float* a0 = p.a0 + ((size_t)l * 2 + dir) * 512;
    h16* dst = p.AA() + (size_t)dir * NR * 512;
    epi_quads(acc, mt * 128, nt * 128, [&](int m, int n, float v0, float v1, float v2, float v3) {
      float4 b = *(const float4*)(a0 + n);
      st4h(dst + (size_t)m * 512 + n, sigm(v0 + b.x), sigm(v1 + b.y), sigm(v2 + b.z), sigm(v3 + b.w));
    });
  } else {
    gemm_main<false>(p.Z() + ZRW + 1792, ZW, p.GUP(), 128, 128, mt * 128, nt * 128, 512, smem, acc, nullptr);
    epi_quads(acc, mt * 128, nt * 128, [&](int m, int n, float v0, float v1, float v2, float v3) {
      st4h(p.G() + (size_t)m * 512 + n, v0, v1, v2, v3);
    });
  }
}

DEVI void attn_job(const P& p, int job, char* smem) {
  h16* Ks = (h16*)smem;
  h16* Vs = Ks + 2 * 64 * 104;
  const int tid = tidx(), lane = tid & 63, wv = tid >> 6, l31 = lane & 31, hh = lane >> 5;
  int b, h, q0, nk;
  if (job < 1024) { b = job >> 8; h = (job >> 5) & 7; q0 = b * SB + CTX + (job & 31) * 128; nk = SB; }
  else { int j = job - 1024; b = j >> 4; h = (j >> 1) & 7; q0 = b * SB + (j & 1) * 128; nk = CTX; }
  const int NKT = nk >> 6;
  const h16* Kg = p.K() + (size_t)(b * SB) * 768 + h * 96;
  const h16* Vg = p.VT() + (size_t)(b * 8 + h) * 64 * SB;
  h16x8 qf[6];
  {
    const h16* qp = p.Q() + (size_t)(q0 + wv * 32 + l31) * 768 + h * 96 + hh * 8;
#pragma unroll
    for (int ds = 0; ds < 6; ++ds) qf[ds] = *(const h16x8*)(qp + ds * 16);
  }
  uint4 pk0, pk1, pk2_, pv0, pv1, qk0, qk1, qk2_, qv0, qv1;
  int krow[3], kcol[3];
#pragma unroll
  for (int i = 0; i < 3; ++i) { int c = tid + 256 * i; krow[i] = c / 12; kcol[i] = (c - krow[i] * 12) * 8; }
  const int vrow = tid >> 3, vcol = (tid & 7) * 8;
  const h16* kp0 = Kg + (size_t)krow[0] * 768 + kcol[0];
  const h16* kp1 = Kg + (size_t)krow[1] * 768 + kcol[1];
  const h16* kp2 = Kg + (size_t)krow[2] * 768 + kcol[2];
  const h16* vp0 = Vg + (size_t)vrow * SB + vcol;
  const h16* vp1 = Vg + (size_t)(vrow + 32) * SB + vcol;
#define ALOAD(S, kt_) { S##k0 = *(const uint4*)(kp0 + (size_t)(kt_) * 64 * 768); S##k1 = *(const uint4*)(kp1 + (size_t)(kt_) * 64 * 768); \
    S##k2_ = *(const uint4*)(kp2 + (size_t)(kt_) * 64 * 768); S##v0 = *(const uint4*)(vp0 + (kt_) * 64); S##v1 = *(const uint4*)(vp1 + (kt_) * 64); }
#define ASTORE(S, buf_) { h16* kd = Ks + (buf_) * 64 * 104; h16* vd = Vs + (buf_) * 64 * 68; \
    *(uint4*)(kd + krow[0] * 104 + kcol[0]) = S##k0; *(uint4*)(kd + krow[1] * 104 + kcol[1]) = S##k1; *(uint4*)(kd + krow[2] * 104 + kcol[2]) = S##k2_; \
    *(uint2*)(vd + vrow * 68 + vcol) = make_uint2(S##v0.x, S##v0.y); *(uint2*)(vd + vrow * 68 + vcol + 4) = make_uint2(S##v0.z, S##v0.w); \
    *(uint2*)(vd + (vrow + 32) * 68 + vcol) = make_uint2(S##v1.x, S##v1.y); *(uint2*)(vd + (vrow + 32) * 68 + vcol + 4) = make_uint2(S##v1.z, S##v1.w); }
  f32x16 o0, o1;
#pragma unroll
  for (int r = 0; r < 16; ++r) { o0[r] = 0.f; o1[r] = 0.f; }
  float mrun = -1e30f, lsum = 0.f;
  auto compute = [&](int buf) {
    const h16* ks = Ks + buf * 64 * 104 + l31 * 104 + hh * 8;
    f32x16 s0, s1;
#pragma unroll
    for (int r = 0; r < 16; ++r) { s0[r] = 0.f; s1[r] = 0.f; }
#pragma unroll
    for (int ds = 0; ds < 6; ++ds) {
      h16x8 a0 = *(const h16x8*)(ks + ds * 16), a1 = *(const h16x8*)(ks + 32 * 104 + ds * 16);
      s0 = __builtin_amdgcn_mfma_f32_32x32x16_f16(a0, qf[ds], s0, 0, 0, 0);
      s1 = __builtin_amdgcn_mfma_f32_32x32x16_f16(a1, qf[ds], s1, 0, 0, 0);
    }
    float mx = s0[0];
#pragma unroll
    for (int r = 1; r < 16; ++r) mx = fmaxf(mx, s0[r]);
#pragma unroll
    for (int r = 0; r < 16; ++r) mx = fmaxf(mx, s1[r]);
    mx = fmaxf(mx, __shfl_xor(mx, 32));
    const float mnew = fmaxf(mrun, mx);
    const float alpha = __builtin_amdgcn_exp2f(mrun - mnew);
    mrun = mnew;
    float ps = 0.f;
#pragma unroll
    for (int r = 0; r < 16; ++r) { s0[r] = __builtin_amdgcn_exp2f(s0[r] - mnew); ps += s0[r]; }
#pragma unroll
    for (int r = 0; r < 16; ++r) { s1[r] = __builtin_amdgcn_exp2f(s1[r] - mnew); ps += s1[r]; }
    lsum = lsum * alpha + ps;
#pragma unroll
    for (int r = 0; r < 16; ++r) { o0[r] *= alpha; o1[r] *= alpha; }
    const h16* vs = Vs + buf * 64 * 68 + l31 * 68 + 4 * hh;
#pragma unroll
    for (int k2 = 0; k2 < 2; ++k2) {
#pragma unroll
      for (int s2 = 0; s2 < 2; ++s2) {
        uint4 pu;
        if (k2 == 0) { pu.x = pk2(s0[8 * s2], s0[8 * s2 + 1]); pu.y = pk2(s0[8 * s2 + 2], s0[8 * s2 + 3]); pu.z = pk2(s0[8 * s2 + 4], s0[8 * s2 + 5]); pu.w = pk2(s0[8 * s2 + 6], s0[8 * s2 + 7]); }
        else { pu.x = pk2(s1[8 * s2], s1[8 * s2 + 1]); pu.y = pk2(s1[8 * s2 + 2], s1[8 * s2 + 3]); pu.z = pk2(s1[8 * s2 + 4], s1[8 * s2 + 5]); pu.w = pk2(s1[8 * s2 + 6], s1[8 * s2 + 7]); }
        h16x8 pf = __builtin_bit_cast(h16x8, pu);
        const int kb = k2 * 32 + 16 * s2;
        uint2 va = *(const uint2*)(vs + kb), vb = *(const uint2*)(vs + kb + 8);
        uint2 vc = *(const uint2*)(vs + 32 * 68 + kb), vd = *(const uint2*)(vs + 32 * 68 + kb + 8);
        h16x8 vf0 = __builtin_bit_cast(h16x8, make_uint4(va.x, va.y, vb.x, vb.y));
        h16x8 vf1 = __builtin_bit_cast(h16x8, make_uint4(vc.x, vc.y, vd.x, vd.y));
        o0 = __builtin_amdgcn_mfma_f32_32x32x16_f16(vf0, pf, o0, 0, 0, 0);
        o1 = __builtin_amdgcn_mfma_f32_32x32x16_f16(vf1, pf, o1, 0, 0, 0);
      }
    }
  };
  ALOAD(p, 0);
  if (NKT > 1) ALOAD(q, 1);
  ASTORE(p, 0);
  if (NKT > 2) ALOAD(p, 2);
  __syncthreads();
  for (int kt = 0; kt < NKT; kt += 2) {
    compute(0);
    if (kt + 1 < NKT) ASTORE(q, 1);
    if (kt + 3 < NKT) ALOAD(q, kt + 3);
    __syncthreads();
    if (kt + 1 < NKT) {
      compute(1);
      if (kt + 2 < NKT) ASTORE(p, 0);
      if (kt + 4 < NKT) ALOAD(p, kt + 4);
      __syncthreads();
    }
  }
#undef ALOAD
#undef ASTORE
  const float ltot = lsum + __shfl_xor(lsum, 32);
  const float inv = 1.f / ltot;
  h16* yo = p.Z() + (size_t)(q0 + wv * 32 + l31) * ZW + ZMLA + h * 64 + 4 * hh;
#pragma unroll
  for (int g = 0; g < 4; ++g) {
    st4h(yo + 8 * g, o0[4 * g] * inv, o0[4 * g + 1] * inv, o0[4 * g + 2] * inv, o0[4 * g + 3] * inv);
    st4h(yo + 32 + 8 * g, o1[4 * g] * inv, o1[4 * g + 1] * inv, o1[4 * g + 2] * inv, o1[4 * g + 3] * inv);
  }
}

#if PROBE >= 200
__device__ unsigned long long g_tacc[4];
#endif
struct Slot { float w[64]; unsigned bke[64]; float vv[64]; h16 ah[4][64]; int yoff; int pad[3]; };
struct LSet { uint4 lw, a, k, v, r; float inv; int yoff; int vm; };
DEVI void scan_job(const P& p, int l, int job, char* smem, int rank) {
  constexpr int RGB = 4 / NSCAN_BPC;
  constexpr int NLD = (4 - RGB) * 64;
  static_assert(NLD == 128, "loader mapping assumes 128 loader threads");
  Slot* sl = (Slot*)smem;
  h16* ybuf = (h16*)(smem + 2 * 16 * sizeof(Slot));
  const int tid = tidx(), lane = tid & 63, wv = rank ? ((tid >> 6) ^ 2) : (tid >> 6);
  const int chain = job / NSCAN_BPC, part = job - chain * NSCAN_BPC;
  const int dir = chain >> 5, b = (chain >> 3) & 3, h = chain & 7;
  for (int i = tid; i < 32 * 128; i += 256) { int s = i >> 7, e = i & 127; sl[s].ah[2 + (e >> 6)][e & 63] = (h16)0.f; }
  if (wv >= RGB) {
    const int lt = (wv - RGB) * 64 + lane;
    const int st = lt >> 3, ca = lt & 7, c8 = ca * 8;
    const int pp0 = (ca >> 2) * 32 + (2 * (ca & 1)) * 8 + ((ca & 3) >> 1) * 4;
    const int pp1 = pp0 + 8;
    const float4 kkA = *(const float4*)(p.k_k + l * 512 + h * 64 + c8), kkB = *(const float4*)(p.k_k + l * 512 + h * 64 + c8 + 4);
    const float4 kaA = *(const float4*)(p.k_a + l * 512 + h * 64 + c8), kaB = *(const float4*)(p.k_a + l * 512 + h * 64 + c8 + 4);
    const h16* LWd = p.LW() + (size_t)dir * NR * 512 + h * 64 + c8;
    const h16* AAd = p.AA() + (size_t)dir * NR * 512 + h * 64 + c8;
    const h16* Zr = p.Z() + ZRW + h * 64 + c8;
#define LLOAD(ci_, g)                                                                                         \
    {                                                                                                         \
      const int n_ = (ci_) * 16 + st;                                                                         \
      const int rowm_ = maprow(dir, b, min(n_, SB - 1));                                                      \
      const int rowr_ = maprow(dir, b, min(max(n_ - 1, 0), SB - 1));                                          \
      g##_yoff = (n_ >= 1 && n_ <= SB) ? rowr_ * 512 : -1;                                                      \
      g##_vm = (n_ < SB) ? 1 : 0;                                                                               \
      const h16* p0_ = LWd + (size_t)rowm_ * 512; const h16* p1_ = AAd + (size_t)rowm_ * 512;                 \
      const h16* p2_ = Zr + (size_t)rowm_ * ZW + 512; const h16* p3_ = Zr + (size_t)rowm_ * ZW + 1024;        \
      const h16* p4_ = Zr + (size_t)rowr_ * ZW; const float* p5_ = p.INVN() + (size_t)rowm_ * 8 + h;          \
      asm volatile("global_load_dwordx4 %0, %1, off" : "=v"(g##_lw) : "v"(p0_) : "memory");                     \
      asm volatile("global_load_dwordx4 %0, %1, off" : "=v"(g##_a) : "v"(p1_) : "memory");                      \
      asm volatile("global_load_dwordx4 %0, %1, off" : "=v"(g##_k) : "v"(p2_) : "memory");                      \
      asm volatile("global_load_dwordx4 %0, %1, off" : "=v"(g##_v) : "v"(p3_) : "memory");                      \
      asm volatile("global_load_dwordx4 %0, %1, off" : "=v"(g##_r) : "v"(p4_) : "memory");                      \
      asm volatile("global_load_dword %0, %1, off" : "=v"(g##_inv) : "v"(p5_) : "memory");                      \
    }
#define LWAIT(g) asm volatile("s_waitcnt vmcnt(18)" : "+v"(g##_lw), "+v"(g##_a), "+v"(g##_k), "+v"(g##_v), "+v"(g##_r), "+v"(g##_inv) : : "memory")
    auto lstore = [&](uint4 g_lw, uint4 g_a, uint4 g_k, uint4 g_v, uint4 g_r, float g_inv, int g_yoff, int g_vm, int buf) {
      Slot& s = sl[buf * 16 + st];
      const h16x8 lw = __builtin_bit_cast(h16x8, g_lw), a = __builtin_bit_cast(h16x8, g_a), k = __builtin_bit_cast(h16x8, g_k), v = __builtin_bit_cast(h16x8, g_v);
      const float kkp[8] = {kkA.x, kkA.y, kkA.z, kkA.w, kkB.x, kkB.y, kkB.z, kkB.w};
      const float kap[8] = {kaA.x, kaA.y, kaA.z, kaA.w, kaB.x, kaB.y, kaB.z, kaB.w};
      const float vmf = g_vm ? 1.f : 0.f;
      const float inv = g_inv * vmf;
      float w8[8], v8[8], q8[8], r8[8]; unsigned be8[8];
      const h16x8 rh = __builtin_bit_cast(h16x8, g_r);
      const float rvalid = (g_yoff >= 0) ? 1.f : 0.f;
#pragma unroll
      for (int i = 0; i < 8; ++i) w8[i] = __expf(-(float)lw[i] * vmf);
      float P8[8];
#pragma unroll
      for (int i = 0; i < 8; ++i) P8[i] = w8[i];
#pragma unroll
      for (int d = 8; d < 64; d <<= 1) {
#pragma unroll
        for (int i = 0; i < 8; ++i) { const float t = __shfl_up(P8[i], d); if (lane >= d) P8[i] *= t; }
      }
#pragma unroll
      for (int i = 0; i < 8; ++i) {
        const float kf = (float)k[i] * vmf, af = (float)a[i];
        const float kkv = kf * kkp[i] * inv;
        const float rP = __builtin_amdgcn_rcpf(P8[i]);
        const float Pex = P8[i] * __builtin_amdgcn_rcpf(w8[i]);
        be8[i] = pk2n(kkv * af * rP, kf * (1.f + (af - 1.f) * kap[i]) * rP);
        v8[i] = (float)v[i] * vmf;
        q8[i] = kkv * Pex;
        r8[i] = (float)rh[i] * Pex * rvalid;
        w8[i] = P8[i];
      }
      const uint4 rr = make_uint4(pk2n(r8[0], r8[1]), pk2n(r8[2], r8[3]), pk2n(r8[4], r8[5]), pk2n(r8[6], r8[7]));
      *(float4*)(s.w + c8) = make_float4(w8[0], w8[1], w8[2], w8[3]); *(float4*)(s.w + c8 + 4) = make_float4(w8[4], w8[5], w8[6], w8[7]);
      *(uint4*)(s.bke + c8) = make_uint4(be8[0], be8[1], be8[2], be8[3]); *(uint4*)(s.bke + c8 + 4) = make_uint4(be8[4], be8[5], be8[6], be8[7]);
      *(float4*)(s.vv + c8) = make_float4(v8[0], v8[1], v8[2], v8[3]); *(float4*)(s.vv + c8 + 4) = make_float4(v8[4], v8[5], v8[6], v8[7]);
      *(uint2*)(&s.ah[0][pp0]) = make_uint2(pk2n(q8[0], q8[1]), pk2n(q8[2], q8[3]));
      *(uint2*)(&s.ah[0][pp1]) = make_uint2(pk2n(q8[4], q8[5]), pk2n(q8[6], q8[7]));
      *(uint2*)(&s.ah[1][pp0]) = make_uint2(rr.x, rr.y);
      *(uint2*)(&s.ah[1][pp1]) = make_uint2(rr.z, rr.w);
      if (ca == 0) s.yoff = g_yoff;
    };
    typedef unsigned u32x4 __attribute__((ext_vector_type(4)));
    u32x4 R0_lw, R0_a, R0_k, R0_v, R0_r, R1_lw, R1_a, R1_k, R1_v, R1_r, R2_lw, R2_a, R2_k, R2_v, R2_r, R3_lw, R3_a, R3_k, R3_v, R3_r;
    float R0_inv, R1_inv, R2_inv, R3_inv; int R0_yoff, R1_yoff, R2_yoff, R3_yoff, R0_vm, R1_vm, R2_vm, R3_vm;
#define U4(x) make_uint4((x)[0], (x)[1], (x)[2], (x)[3])
#define LST(g, buf_) lstore(U4(g##_lw), U4(g##_a), U4(g##_k), U4(g##_v), U4(g##_r), g##_inv, g##_yoff, g##_vm, buf_)
    asm volatile("s_waitcnt vmcnt(0)" ::: "memory");
    LLOAD(0, R0); LLOAD(1, R1); LLOAD(2, R2); LLOAD(3, R3);
    LWAIT(R0); LST(R0, 0); LLOAD(4, R0);
    __syncthreads();
    h16* yout = p.Y2() + (size_t)dir * NR * 512 + h * 64 + part * (RGB * 16) + ca * 4;
    auto ystore = [&](int cj) {
      const int n = cj * 16 + st;
      if (n >= 1 && n <= SB) {
        const h16* yb = ybuf + ((cj & 1) * 32 + ca * 4) * 24 + st;
        const unsigned short a0 = __builtin_bit_cast(unsigned short, yb[0]), a1 = __builtin_bit_cast(unsigned short, yb[24]);
        const unsigned short a2 = __builtin_bit_cast(unsigned short, yb[48]), a3 = __builtin_bit_cast(unsigned short, yb[72]);
        typedef unsigned u32x2 __attribute__((ext_vector_type(2)));
        u32x2 u; u[0] = (unsigned)a0 | ((unsigned)a1 << 16); u[1] = (unsigned)a2 | ((unsigned)a3 << 16);
        h16* yp = yout + (size_t)maprow(dir, b, n - 1) * 512;
        asm volatile("global_store_dwordx2 %0, %1, off" : : "v"(yp), "v"(u) : "memory");
      }
    };
    for (int ci = 0; ci < NCHUNK; ci += 4) {
      if (ci > 0) ystore(ci - 1);
      LWAIT(R1); if (ci + 1 < NCHUNK) LST(R1, 1); LLOAD(ci + 5, R1);
      __syncthreads();
      if (ci + 1 < NCHUNK) { ystore(ci); LWAIT(R2); if (ci + 2 < NCHUNK) LST(R2, 0); LLOAD(ci + 6, R2); __syncthreads(); }
      if (ci + 2 < NCHUNK) { ystore(ci + 1); LWAIT(R3); if (ci + 3 < NCHUNK) LST(R3, 1); LLOAD(ci + 7, R3); __syncthreads(); }
      if (ci + 3 < NCHUNK) { ystore(ci + 2); LWAIT(R0); if (ci + 4 < NCHUNK) LST(R0, 0); LLOAD(ci + 8, R0); __syncthreads(); }
    }
    ystore(NCHUNK - 1);
    asm volatile("s_waitcnt vmcnt(0)" ::: "memory");
#undef LST
#undef U4
#undef LLOAD
#undef LWAIT
  } else {
    const int c = lane & 15, hq = lane >> 4;
    const int rg = part * RGB + wv;
    const bool h0 = (hq == 0);
    f32x4 ST[4];
#pragma unroll
    for (int t = 0; t < 4; ++t) ST[t] = (f32x4){0.f, 0.f, 0.f, 0.f};
    __builtin_amdgcn_s_setprio(3);
    __syncthreads();
    for (int ci = 0; ci < NCHUNK; ++ci) {
      const int buf = ci & 1;
#if PROBE == 211
      const unsigned long long ct0 = __builtin_amdgcn_s_memrealtime();
#endif
      float yv[16];
      h16x8 rA0[2], rA1[2]; float rvv[2]; unsigned rbe[2][4];
      {
        const Slot& t = sl[buf * 16];
        rA0[0] = *(const h16x8*)(&t.ah[c & 3][8 * hq]); rA1[0] = *(const h16x8*)(&t.ah[c & 3][32 + 8 * hq]);
        rvv[0] = t.vv[rg * 16 + c];
#pragma unroll
        for (int tt = 0; tt < 4; ++tt) rbe[0][tt] = t.bke[16 * tt + c];
      }
#pragma unroll
      for (int s = 0; s < 16; ++s) {
        const int cur = s & 1, nxt = cur ^ 1;
        uint4 sh0, sh1;
        sh0.x = pk2(ST[0][0], ST[0][1]); sh0.y = pk2(ST[0][2], ST[0][3]); sh0.z = pk2(ST[1][0], ST[1][1]); sh0.w = pk2(ST[1][2], ST[1][3]);
        sh1.x = pk2(ST[2][0], ST[2][1]); sh1.y = pk2(ST[2][2], ST[2][3]); sh1.z = pk2(ST[3][0], ST[3][1]); sh1.w = pk2(ST[3][2], ST[3][3]);
        const f32x4 z4 = {0.f, 0.f, 0.f, 0.f};
        f32x4 acc0 = __builtin_amdgcn_mfma_f32_16x16x32_f16(rA0[cur], __builtin_bit_cast(h16x8, sh0), z4, 0, 0, 0);
        f32x4 acc1 = __builtin_amdgcn_mfma_f32_16x16x32_f16(rA1[cur], __builtin_bit_cast(h16x8, sh1), z4, 0, 0, 0);
        f32x4 pe[4];
        if ((s & 7) == 7) {
#pragma unroll
          for (int tt = 0; tt < 4; ++tt) pe[tt] = *(const f32x4*)(sl[buf * 16 + s].w + 16 * tt + 4 * hq);
        }
        if (s + 1 < 16) {
          const Slot& t = sl[buf * 16 + s + 1];
          rA0[nxt] = *(const h16x8*)(&t.ah[c & 3][8 * hq]); rA1[nxt] = *(const h16x8*)(&t.ah[c & 3][32 + 8 * hq]);
          rvv[nxt] = t.vv[rg * 16 + c];
#pragma unroll
          for (int tt = 0; tt < 4; ++tt) rbe[nxt][tt] = t.bke[16 * tt + c];
        }
        __builtin_amdgcn_sched_barrier(0);
        yv[s] = acc0[1] + acc1[1];
        const float sa = -(acc0[0] + acc1[0]);
        const uint4 bu = make_uint4(h0 ? pk2(sa, rvv[cur]) : 0u, 0u, 0u, 0u);
#pragma unroll
        for (int tt = 0; tt < 4; ++tt) {
          const uint4 au = make_uint4(h0 ? rbe[cur][tt] : 0u, 0u, 0u, 0u);
          ST[tt] = __builtin_amdgcn_mfma_f32_16x16x32_f16(__builtin_bit_cast(h16x8, au), __builtin_bit_cast(h16x8, bu), ST[tt], 0, 0, 0);
        }
        if ((s & 7) == 7) {
#pragma unroll
          for (int tt = 0; tt < 4; ++tt) ST[tt] = ST[tt] * pe[tt];
        }
      }
      if (lane < 16) {
        uint4 u0, u1;
        u0.x = pk2n(yv[0], yv[1]); u0.y = pk2n(yv[2], yv[3]); u0.z = pk2n(yv[4], yv[5]); u0.w = pk2n(yv[6], yv[7]);
        u1.x = pk2n(yv[8], yv[9]); u1.y = pk2n(yv[10], yv[11]); u1.z = pk2n(yv[12], yv[13]); u1.w = pk2n(yv[14], yv[15]);
        h16* yr = ybuf + (buf * 32 + wv * 16 + c) * 24;
        *(uint4*)yr = u0; *(uint4*)(yr + 8) = u1;
      }
#if PROBE == 210
      const unsigned long long bt0 = __builtin_amdgcn_s_memrealtime();
#endif
      __syncthreads();
#if PROBE == 210
      if (job == 0 && tid == 0) g_tacc[0] += __builtin_amdgcn_s_memrealtime() - bt0;
#endif
    }
    __builtin_amdgcn_s_setprio(0);
  }
}

DEVI void gla_pre_job(const P& p, int l, int job, char* smem) {
  typedef short bf16x8 __attribute__((ext_vector_type(8)));
  float* lg = (float*)smem;
  float* gku = lg + 64 * 65;
  float* gkb = gku + 1024;
  float* tot = gkb + 64;
  unsigned short* qb = (unsigned short*)(tot + 256);
  unsigned short* kb = qb + 64 * 72;
  h16* vt = (h16*)(kb + 64 * 72);
  const int tid = tidx(), lane = tid & 63, wv = tid >> 6, l31 = lane & 31, hh = lane >> 5;
  const int chain = job / 68, ci = job - chain * 68;
  const int dir = chain >> 4, b = (chain >> 2) & 3, h = chain & 3;
  for (int i = tid; i < 1024; i += 256) gku[i] = p.gk_up[(((size_t)l * 2 + dir) * 16 + (i >> 6)) * 256 + h * 64 + (i & 63)];
  if (tid < 64) gkb[tid] = p.gk_b[((size_t)l * 2 + dir) * 256 + h * 64 + tid];
  const int ri = tid >> 2, dq = tid & 3;
  const int row = maprow(dir, b, ci * 64 + ri);
  const h16* zr = p.Z() + (size_t)row * ZW;
  uint4 q0 = *(const uint4*)(zr + h * 64 + dq * 16), q1 = *(const uint4*)(zr + h * 64 + dq * 16 + 8);
  uint4 k0 = *(const uint4*)(zr + 256 + h * 64 + dq * 16), k1 = *(const uint4*)(zr + 256 + h * 64 + dq * 16 + 8);
  uint4 g0 = *(const uint4*)(zr + 1024 + dir * 16), g1 = *(const uint4*)(zr + 1024 + dir * 16 + 8);
  {
    const h16* zv = zr + 512 + h * 128 + dq * 32;
#pragma unroll
    for (int c = 0; c < 4; ++c) {
      h16x8 vv = *(const h16x8*)(zv + c * 8);
#pragma unroll
      for (int j = 0; j < 8; ++j) vt[(dq * 32 + c * 8 + j) * 72 + ri] = vv[j];
    }
  }
  __syncthreads();
  {
    h16x8 gh0 = __builtin_bit_cast(h16x8, g0), gh1 = __builtin_bit_cast(h16x8, g1);
    float gd[16];
#pragma unroll
    for (int j = 0; j < 8; ++j) { gd[j] = (float)gh0[j]; gd[8 + j] = (float)gh1[j]; }
#pragma unroll 4
    for (int dd = 0; dd < 16; ++dd) {
      const int d = dq * 16 + dd;
      float xx = gkb[d];
#pragma unroll
      for (int r = 0; r < 16; ++r) xx += gd[r] * gku[r * 64 + d];
      float ls = fminf(xx, 0.f) - __logf(1.f + __expf(-fabsf(xx)));
      lg[ri * 65 + d] = ls * (1.f / 16.f);
    }
  }
  __syncthreads();
  {
    const int d = tid & 63, part = tid >> 6;
    float run = 0.f;
#pragma unroll 4
    for (int ii = 0; ii < 16; ++ii) { const int i = part * 16 + ii; run += lg[i * 65 + d]; lg[i * 65 + d] = run; }
    tot[part * 64 + d] = run;
  }
  __syncthreads();
  {
    h16x8 qh0 = __builtin_bit_cast(h16x8, q0), qh1 = __builtin_bit_cast(h16x8, q1), kh0 = __builtin_bit_cast(h16x8, k0), kh1 = __builtin_bit_cast(h16x8, k1);
    const int part = ri >> 4;
    unsigned qp[8], kp[8];
#pragma unroll
    for (int j = 0; j < 8; ++j) {
      unsigned qq[2], kk2[2];
#pragma unroll
      for (int e = 0; e < 2; ++e) {
        const int dd = 2 * j + e, d = dq * 16 + dd;
        float off = 0.f;
        if (part > 0) off += tot[d];
        if (part > 1) off += tot[64 + d];
        if (part > 2) off += tot[128 + d];
        const float bb = lg[ri * 65 + d] + off;
        const float qv = dd < 8 ? (float)qh0[dd & 7] : (float)qh1[dd & 7];
        const float kv = dd < 8 ? (float)kh0[dd & 7] : (float)kh1[dd & 7];
        qq[e] = f2bf(qv * __expf(bb) * 0.125f);
        kk2[e] = f2bf(kv * __expf(-bb));
      }
      qp[j] = qq[0] | (qq[1] << 16); kp[j] = kk2[0] | (kk2[1] << 16);
    }
    const uint4 qa = make_uint4(qp[0], qp[1], qp[2], qp[3]), qc = make_uint4(qp[4], qp[5], qp[6], qp[7]);
    const uint4 ka = make_uint4(kp[0], kp[1], kp[2], kp[3]), kc = make_uint4(kp[4], kp[5], kp[6], kp[7]);
    *(uint4*)(qb + ri * 72 + dq * 16) = qa; *(uint4*)(qb + ri * 72 + dq * 16 + 8) = qc;
    *(uint4*)(kb + ri * 72 + dq * 16) = ka; *(uint4*)(kb + ri * 72 + dq * 16 + 8) = kc;
    unsigned short* qd = p.QIN() + ((size_t)dir * NR + row) * 256 + h * 64 + dq * 16;
    unsigned short* kd = p.KIN() + ((size_t)dir * NR + row) * 256 + h * 64 + dq * 16;
    *(uint4*)qd = qa; *(uint4*)(qd + 8) = qc;
    *(uint4*)kd = ka; *(uint4*)(kd + 8) = kc;
    if (tid < 64) p.DEC()[((size_t)chain * 68 + ci) * 64 + tid] = __expf(tot[tid] + tot[64 + tid] + tot[128 + tid] + tot[192 + tid]);
  }
  __syncthreads();
  const int it = wv & 1, jh = wv >> 1;
  f32x16 o0, o1;
#pragma unroll
  for (int r = 0; r < 16; ++r) { o0[r] = 0.f; o1[r] = 0.f; }
  bf16x8 qf[4];
#pragma unroll
  for (int ks = 0; ks < 4; ++ks) qf[ks] = *(const bf16x8*)(qb + (it * 32 + l31) * 72 + ks * 16 + hh * 8);
#pragma unroll
  for (int st = 0; st < 2; ++st) {
    if (st > it) continue;
    f32x16 at;
#pragma unroll
    for (int r = 0; r < 16; ++r) at[r] = 0.f;
#pragma unroll
    for (int ks = 0; ks < 4; ++ks) {
      bf16x8 kf = *(const bf16x8*)(kb + (st * 32 + l31) * 72 + ks * 16 + hh * 8);
      at = __builtin_amdgcn_mfma_f32_32x32x16_bf16(kf, qf[ks], at, 0, 0, 0);
    }
    if (st == it) {
#pragma unroll
      for (int r = 0; r < 16; ++r) { const int sl = (r & 3) + 8 * (r >> 2) + 4 * hh; if (sl > l31) at[r] = 0.f; }
    }
    const h16* vs = vt + (jh * 64 + l31) * 72 + st * 32 + 4 * hh;
#pragma unroll
    for (int s2 = 0; s2 < 2; ++s2) {
      uint4 pu;
      pu.x = pk2n(at[8 * s2], at[8 * s2 + 1]); pu.y = pk2n(at[8 * s2 + 2], at[8 * s2 + 3]);
      pu.z = pk2n(at[8 * s2 + 4], at[8 * s2 + 5]); pu.w = pk2n(at[8 * s2 + 6], at[8 * s2 + 7]);
      const h16x8 pf = __builtin_bit_cast(h16x8, pu);
      const uint2 va = *(const uint2*)(vs + 16 * s2), vb = *(const uint2*)(vs + 16 * s2 + 8);
      const uint2 vc = *(const uint2*)(vs + 32 * 72 + 16 * s2), vd = *(const uint2*)(vs + 32 * 72 + 16 * s2 + 8);
      o0 = __builtin_amdgcn_mfma_f32_32x32x16_f16(__builtin_bit_cast(h16x8, make_uint4(va.x, va.y, vb.x, vb.y)), pf, o0, 0, 0, 0);
      o1 = __builtin_amdgcn_mfma_f32_32x32x16_f16(__builtin_bit_cast(h16x8, make_uint4(vc.x, vc.y, vd.x, vd.y)), pf, o1, 0, 0, 0);
    }
  }
  {
    const int orow = maprow(dir, b, ci * 64 + it * 32 + l31);
    h16* od = p.OFB() + ((size_t)dir * NR + orow) * 512 + h * 128 + jh * 64 + 4 * hh;
#pragma unroll
    for (int g = 0; g < 4; ++g) {
      st4h(od + 8 * g, o0[4 * g], o0[4 * g + 1], o0[4 * g + 2], o0[4 * g + 3]);
      st4h(od + 32 + 8 * g, o1[4 * g], o1[4 * g + 1], o1[4 * g + 2], o1[4 * g + 3]);
    }
  }
  __syncthreads();
}

DEVI void gla_job(const P& p, int l, int job, char* smem) {
  float* qi = (float*)smem;
  float* ki = qi + 64 * 65;
  float* vs = ki + 64 * 65;
  float* Ss = vs + 64 * 33;
  const int tid = tidx();
  const int dvs = job & 3, chain = job >> 2;
  const int dir = chain >> 4, b = (chain >> 2) & 3, h = chain & 3;
  for (int i = tid; i < 64 * 33; i += 256) Ss[i] = 0.f;
  const int ri = tid >> 2, dq = tid & 3;
  const int t2 = tid >> 3, tj = tid & 7;
  h16* Od = p.OFB() + (size_t)dir * NR * 512 + h * 128 + dvs * 32;
  const unsigned short* Qg = p.QIN() + (size_t)dir * NR * 256 + h * 64 + dq * 16;
  const unsigned short* Kg = p.KIN() + (size_t)dir * NR * 256 + h * 64 + dq * 16;
  const float* Dg = p.DEC() + (size_t)chain * 68 * 64 + 2 * t2;
  uint4 gq0, gq1, gk0, gk1, gv; uint2 goa, gob; float gd0, gd1;
  auto pre = [&](int ci) {
    const int row = maprow(dir, b, ci * 64 + ri);
    gq0 = *(const uint4*)(Qg + (size_t)row * 256); gq1 = *(const uint4*)(Qg + (size_t)row * 256 + 8);
    gk0 = *(const uint4*)(Kg + (size_t)row * 256); gk1 = *(const uint4*)(Kg + (size_t)row * 256 + 8);
    gv = *(const uint4*)(p.Z() + (size_t)row * ZW + 512 + h * 128 + dvs * 32 + dq * 8);
    const int rowa = maprow(dir, b, ci * 64 + 2 * t2), rowb = maprow(dir, b, ci * 64 + 2 * t2 + 1);
    goa = *(const uint2*)(Od + (size_t)rowa * 512 + 4 * tj); gob = *(const uint2*)(Od + (size_t)rowb * 512 + 4 * tj);
    gd0 = Dg[ci * 64]; gd1 = Dg[ci * 64 + 1];
  };
  pre(0);
  __syncthreads();
  for (int ci = 0; ci < SB / 64; ++ci) {
    {
      const unsigned qa[8] = {gq0.x, gq0.y, gq0.z, gq0.w, gq1.x, gq1.y, gq1.z, gq1.w};
      const unsigned ka[8] = {gk0.x, gk0.y, gk0.z, gk0.w, gk1.x, gk1.y, gk1.z, gk1.w};
#pragma unroll
      for (int j = 0; j < 8; ++j) {
        qi[ri * 65 + dq * 16 + 2 * j] = __builtin_bit_cast(float, qa[j] << 16); qi[ri * 65 + dq * 16 + 2 * j + 1] = __builtin_bit_cast(float, qa[j] & 0xffff0000u);
        ki[ri * 65 + dq * 16 + 2 * j] = __builtin_bit_cast(float, ka[j] << 16); ki[ri * 65 + dq * 16 + 2 * j + 1] = __builtin_bit_cast(float, ka[j] & 0xffff0000u);
      }
      h16x8 vh = __builtin_bit_cast(h16x8, gv);
#pragma unroll
      for (int j = 0; j < 8; ++j) vs[ri * 33 + dq * 8 + j] = (float)vh[j];
    }
    const uint2 oia = goa, oib = gob; const float e0 = gd0, e1 = gd1;
    const int rowa = maprow(dir, b, ci * 64 + 2 * t2), rowb = maprow(dir, b, ci * 64 + 2 * t2 + 1);
    if (ci + 1 < SB / 64) pre(ci + 1);
    __syncthreads();
    {
      h16x4 ha = __builtin_bit_cast(h16x4, oia), hb = __builtin_bit_cast(h16x4, oib);
      float a0[4], a1[4];
#pragma unroll
      for (int y = 0; y < 4; ++y) { a0[y] = (float)ha[y]; a1[y] = (float)hb[y]; }
#pragma unroll 4
      for (int d = 0; d < 64; ++d) {
        const float x0 = qi[(2 * t2) * 65 + d], x1 = qi[(2 * t2 + 1) * 65 + d];
#pragma unroll
        for (int y = 0; y < 4; ++y) { const float v = Ss[d * 33 + 4 * tj + y]; a0[y] += x0 * v; a1[y] += x1 * v; }
      }
      st4h(Od + (size_t)rowa * 512 + 4 * tj, a0[0], a0[1], a0[2], a0[3]);
      st4h(Od + (size_t)rowb * 512 + 4 * tj, a1[0], a1[1], a1[2], a1[3]);
    }
    __syncthreads();
    {
      float a0[4], a1[4];
#pragma unroll
      for (int y = 0; y < 4; ++y) { a0[y] = Ss[(2 * t2) * 33 + 4 * tj + y]; a1[y] = Ss[(2 * t2 + 1) * 33 + 4 * tj + y]; }
#pragma unroll 4
      for (int s2 = 0; s2 < 64; ++s2) {
        const float x0 = ki[s2 * 65 + 2 * t2], x1 = ki[s2 * 65 + 2 * t2 + 1];
#pragma unroll
        for (int y = 0; y < 4; ++y) { const float v = vs[s2 * 33 + 4 * tj + y]; a0[y] += x0 * v; a1[y] += x1 * v; }
      }
#pragma unroll
      for (int y = 0; y < 4; ++y) { Ss[(2 * t2) * 33 + 4 * tj + y] = a0[y] * e0; Ss[(2 * t2 + 1) * 33 + 4 * tj + y] = a1[y] * e1; }
    }
    __syncthreads();
  }
}

DEVI void mixer_phase(const P& p, int l, char* smem, int cslot, int mode = 0, int role = -1, int rank = 0) {
  if (role < 0) role = blockIdx.x;
#if PROBE >= 200
  unsigned long long pt0 = __builtin_amdgcn_s_memrealtime();
#endif
  __shared__ int4 sjobv;
  int& sjob = sjobv.x;
  for (int j = role; j < NSCAN + NGLA; j += gridDim.x) {
    if (mode == 1 && j >= NSCAN) break;
    if (mode == 2 && j < NSCAN) continue;
    if (j < NSCAN) {
      scan_job(p, l, j, smem, 0);
    }
    else gla_job(p, l, j - NSCAN, smem);
    __syncthreads();
#if PROBE == 200
    if (role == 0 && tidx() == 0) g_tacc[0] += __builtin_amdgcn_s_memrealtime() - pt0;
#endif
#if PROBE == 201
    if (role == NSCAN && tidx() == 0) g_tacc[0] += __builtin_amdgcn_s_memrealtime() - pt0;
#endif
  }
  if (mode == 1) return;
  const int njobs = (l < DEPTH - 1) ? 1024 + 64 : 1024;
  while (true) {
    if (tidx() == 0) sjob = (int)atomicAdd(p.CTR() + cslot, 1u);
    __syncthreads();
    const int j = sjob;
    __syncthreads();
    if (j >= njobs) break;
    attn_job(p, j, smem);
  }
#if PROBE == 202
  if (role == 300 && tidx() == 0) g_tacc[0] += __builtin_amdgcn_s_memrealtime() - pt0;
#endif
}

DEVI void post_phase(const P& p, int l) {
  const int lane = tidx() & 63;
  const int wid = blockIdx.x * 4 + (tidx() >> 6), nw = gridDim.x * 4;
  const int c8 = lane * 8;
  for (int r = wid; r < NR; r += nw) {
    {
      h16* zr = p.Z() + (size_t)r * ZW + ZRW + c8;
      h16x8 yf = *(const h16x8*)(p.Y2() + (size_t)r * 512 + c8), yb = *(const h16x8*)(p.Y2() + (size_t)(NR + r) * 512 + c8);
      h16x8 rr = *(const h16x8*)zr, kk = *(const h16x8*)(zr + 512), vv = *(const h16x8*)(zr + 1024);
      h16x8 af = *(const h16x8*)(p.AA() + (size_t)r * 512 + c8), ab = *(const h16x8*)(p.AA() + (size_t)(NR + r) * 512 + c8);
      h16x8 gg = *(const h16x8*)(p.G() + (size_t)r * 512 + c8);
      float y[8], sm = 0.f;
#pragma unroll
      for (int i = 0; i < 8; ++i) { y[i] = (float)yf[i] + (float)yb[i]; sm += y[i]; }
      sm += __shfl_xor(sm, 1); sm += __shfl_xor(sm, 2); sm += __shfl_xor(sm, 4);
      const float mean = sm * (1.f / 64.f);
      float sq = 0.f;
#pragma unroll
      for (int i = 0; i < 8; ++i) { y[i] -= mean; sq += y[i] * y[i]; }
      sq += __shfl_xor(sq, 1); sq += __shfl_xor(sq, 2); sq += __shfl_xor(sq, 4);
      const float rs = rsqrtf(sq * (1.f / 64.f) + 64e-5f);
      const float* ka = p.k_a + l * 512 + c8; const float* rk = p.r_k + l * 512 + c8;
      const float* lg = p.rln_g + l * 512 + c8; const float* lb = p.rln_b + l * 512 + c8;
      float bs = 0.f;
#pragma unroll
      for (int i = 0; i < 8; ++i) {
        const float kf = (float)kk[i], kav = ka[i];
        const float ke = kf * (1.f + ((float)af[i] - 1.f) * kav) + kf * (1.f + ((float)ab[i] - 1.f) * kav);
        bs += (float)rr[i] * ke * rk[i];
      }
      bs += __shfl_xor(bs, 1); bs += __shfl_xor(bs, 2); bs += __shfl_xor(bs, 4);
      float o[8];
#pragma unroll
      for (int i = 0; i < 8; ++i) o[i] = (y[i] * rs * lg[i] + lb[i] + bs * (float)vv[i]) * (float)gg[i];
      uint4 u; u.x = pk2n(o[0], o[1]); u.y = pk2n(o[2], o[3]); u.z = pk2n(o[4], o[5]); u.w = pk2n(o[6], o[7]);
      *(uint4*)zr = u;
    }
    {
      h16x8 of = *(const h16x8*)(p.OFB() + (size_t)r * 512 + c8), ob = *(const h16x8*)(p.OFB() + (size_t)(NR + r) * 512 + c8);
      h16x8 og = *(const h16x8*)(p.Z() + (size_t)r * ZW + 1056 + c8);
      float o[8], sq = 0.f;
#pragma unroll
      for (int i = 0; i < 8; ++i) { o[i] = (float)of[i] + (float)ob[i]; sq += o[i] * o[i]; }
      sq += __shfl_xor(sq, 1); sq += __shfl_xor(sq, 2); sq += __shfl_xor(sq, 4); sq += __shfl_xor(sq, 8);
      const float rs = rsqrtf(sq * (1.f / 128.f) + 1e-6f);
      const float* ng = p.gla_ng + l * 128 + (c8 & 127);
#pragma unroll
      for (int i = 0; i < 8; ++i) { const float g = (float)og[i]; o[i] = o[i] * rs * ng[i] * (g * sigm(g)); }
      uint4 u; u.x = pk2n(o[0], o[1]); u.y = pk2n(o[2], o[3]); u.z = pk2n(o[4], o[5]); u.w = pk2n(o[6], o[7]);
      *(uint4*)(p.YA() + (size_t)r * ZW + c8) = u;
    }
  }
}

DEVI void merge_phase(const P& p, char* smem) {
  constexpr int MT = NR / 128, NT = 16;
  const int lane = tidx() & 63, wv = tidx() >> 6;
  const int wm = wv >> 1, wn = wv & 1, l31 = lane & 31, hh = lane >> 5;
  for (int job = blockIdx.x; job < MT * NT; job += gridDim.x) {
    int nt = job / MT, mt = job - nt * MT;
    float out[2][16];
#pragma unroll
    for (int a = 0; a < 2; ++a)
#pragma unroll
      for (int r = 0; r < 16; ++r) out[a][r] = 0.f;
#pragma unroll 1
    for (int br = 0; br < 3; ++br) {
      const h16* Y = br == 0 ? p.YA() : (br == 1 ? p.Z() + ZMLA : p.Z() + ZRW);
      const int ldy = ZW;
      f32x16 acc[2][1];
#pragma unroll
      for (int a = 0; a < 2; ++a)
#pragma unroll
        for (int r = 0; r < 16; ++r) acc[a][0][r] = 0.f;
      gemm_deep<1>(Y, ldy, p.WB() + (size_t)br * D * 512, 512, 512, mt * 128, nt * 64, D, smem, acc);
      float u[2][16];
#pragma unroll
      for (int a = 0; a < 2; ++a)
#pragma unroll
        for (int r = 0; r < 16; ++r) { u[a][r] = acc[a][0][r]; acc[a][0][r] = 0.f; }
      gemm_deep<1>(p.H(), D, p.WIN() + (size_t)(ZW + br * D) * D, D, D, mt * 128, nt * 64, D, smem, acc);
#pragma unroll
      for (int a = 0; a < 2; ++a)
#pragma unroll
        for (int r = 0; r < 16; ++r) out[a][r] += sigm(acc[a][0][r]) * u[a][r];
    }
#pragma unroll
    for (int a = 0; a < 2; ++a)
#pragma unroll
      for (int g = 0; g < 4; ++g)
        st4h(p.M() + (size_t)(mt * 128 + wm * 64 + a * 32 + l31) * D + nt * 64 + wn * 32 + 8 * g + 4 * hh, out[a][4 * g], out[a][4 * g + 1],
             out[a][4 * g + 2], out[a][4 * g + 3]);
  }
}

DEVI void resid_gemm_phase(const P& p, int l, const h16* A, int K, const h16* Bt, int gate_idx, char* smem) {
  constexpr int MT = NR / 128, NT = 8, T = MT * NT;
  const float alpha = 1.6817928305074290f;
  auto epi = [&](int m, int n, float v0, float v1, float v2, float v3) {
    int b = m / SB, s = m - b * SB;
    int g = s < CTX ? 4 : b;
    float4 gt = *(const float4*)(p.MOD() + ((size_t)l * 5 + g) * 6144 + gate_idx * D + n);
    float* xp = xrow(p, m) + n;
    float4 xv = *(float4*)xp;
    xv.x = alpha * xv.x + gt.x * v0; xv.y = alpha * xv.y + gt.y * v1; xv.z = alpha * xv.z + gt.z * v2; xv.w = alpha * xv.w + gt.w * v3;
    *(float4*)xp = xv;
  };
  const int G = gridDim.x, R = T / G, rem = T - R * G;
  const bool split_tail = (2 * rem <= G);
  const int nfull = split_tail ? R * G : T;
  for (int job = blockIdx.x; job < nfull; job += G) {
    int nt = job / MT, mt = job - nt * MT;
    f32x16 acc[2][2]; zero_acc(acc);
    gemm_deep<2>(A, K, Bt, K, K, mt * 128, nt * 128, D, smem, acc);
    epi_quads(acc, mt * 128, nt * 128, epi);
  }
  if (split_tail && (int)blockIdx.x < 2 * rem) {
    const int job = nfull + (blockIdx.x >> 1), half = blockIdx.x & 1;
    int nt = job / MT, mt = job - nt * MT;
    f32x16 acc[2][1];
#pragma unroll
    for (int a2 = 0; a2 < 2; ++a2)
#pragma unroll
      for (int r = 0; r < 16; ++r) acc[a2][0][r] = 0.f;
    const int n0 = nt * 128 + half * 64;
    gemm_deep<1>(A, K, Bt, K, K, mt * 128, n0, D, smem, acc);
    const int lane = tidx() & 63, wv = tidx() >> 6, wm = wv >> 1, wn = wv & 1, l31 = lane & 31, hh = lane >> 5;
#pragma unroll
    for (int a2 = 0; a2 < 2; ++a2)
#pragma unroll
      for (int g = 0; g < 4; ++g)
        epi(mt * 128 + wm * 64 + a2 * 32 + l31, n0 + wn * 32 + 8 * g + 4 * hh, acc[a2][0][4 * g], acc[a2][0][4 * g + 1], acc[a2][0][4 * g + 2], acc[a2][0][4 * g + 3]);
  }
}
DEVI void mlp1_phase(const P& p, char* smem) {
  constexpr int MT = NR / 128, NT = DFF / 128;
  h16* HID = p.Z();
  for (int job = blockIdx.x; job < MT * NT; job += gridDim.x) {
    int nt = job / MT, mt = job - nt * MT;
    f32x16 acc[2][2]; zero_acc(acc);
    gemm_deep<2>(p.H(), D, p.W1T(), D, D, mt * 128, nt * 128, DFF, smem, acc);
    epi_quads(acc, mt * 128, nt * 128, [&](int m, int n, float v0, float v1, float v2, float v3) {
      v0 = fmaxf(v0, 0.f); v1 = fmaxf(v1, 0.f); v2 = fmaxf(v2, 0.f); v3 = fmaxf(v3, 0.f);
      st4h(HID + (size_t)m * DFF + n, v0 * v0, v1 * v1, v2 * v2, v3 * v3);
    });
  }
}

constexpr int PH_PER_LAYER = 11;
constexpr int NPHASES = 1 + DEPTH * PH_PER_LAYER + 1;

DEVI void run_phase(const P& p, int ph, char* smem, int role, int rank) {
  if (ph == 0) { phase0(p, smem); return; }
  if (ph == NPHASES - 1) { ln_phase(p, DEPTH, 2); return; }
  const int l = (ph - 1) / PH_PER_LAYER, k = (ph - 1) - l * PH_PER_LAYER;
  switch (k) {
    case 0: ln_phase(p, l, 0); conv_phase(p, l, 0, 12, smem); break;
    case 1: inproj_phase(p, smem);
#if PROBE == 2
      inproj_phase(p, smem);
#endif
      break;
    case 2: {
      constexpr int NPRE = 32 * 68, NSH = (NR / 64) * 8, NUP = (NR / 128) * 14;
      for (int j = blockIdx.x; j < NPRE + NSH + NUP; j += gridDim.x) {
        if (j < NPRE) gla_pre_job(p, l, j, smem);
        else if (j < NPRE + NSH) shift_job(p, l, j - NPRE, smem);
        else mla_up_job(p, j - NPRE - NSH, smem);
        __syncthreads();
      }
    } break;
    case 3: {
      constexpr int NLR = 5 * 4 * (NR / 128);
      for (int j = blockIdx.x; j < NLR; j += gridDim.x) { lowrank_job(p, l, j, smem); __syncthreads(); }
    } break;
    case 4: mixer_phase(p, l, smem, l, 0, role, rank);
#if PROBE == 1
      mixer_phase(p, l, smem, 8 + l);
#endif
      break;
    case 5: post_phase(p, l); break;
    case 6: merge_phase(p, smem); conv_phase(p, l, 12, 14, smem); break;
    case 7: resid_gemm_phase(p, l, p.M(), D, p.WO(), 2, smem); break;
    case 8: ln_phase(p, l, 1); break;
    case 9: mlp1_phase(p, smem);
#if PROBE == 2
      mlp1_phase(p, smem);
#endif
      break;
    default: resid_gemm_phase(p, l, p.Z(), DFF, p.W2T(), 5, smem); break;
  }
}

__global__ void __launch_bounds__(256, 2) mega(P p, int pb, int pe) {
  extern __shared__ __attribute__((aligned(16))) char smem[];
  cg::grid_group grid = cg::this_grid();
  __shared__ uint4 xb_words;
  if (threadIdx_x_raw() == 0) xb_words = make_uint4(0u, 0u, 0u, 0u);
  __syncthreads();
  XcdBarrier xb = xcd_barrier_post(p.BAR(), (volatile LAS unsigned*)&xb_words);
  __shared__ int4 rolev;
  unsigned* cut = p.BAR() + 3584;
  if (threadIdx_x_raw() == 0) {
    const unsigned key = (xb_xcc_id() << 8) | ((unsigned)__builtin_amdgcn_s_getreg((7 << 11) | (8 << 6) | 4) & 0xffu);
    const unsigned rank = xb_add(cut + key, 1u);
    if (rank == 0u) { const unsigned ord = xb_add(cut + 8192, 1u); __hip_atomic_store(cut + 4096 + key, ord, __ATOMIC_RELAXED, __HIP_MEMORY_SCOPE_AGENT); }
    if (rank >= 2u) xb_add(cut + 8193, 1u);
    rolev = make_int4((int)blockIdx.x, 0, (int)key, (int)rank);
  }
  __syncthreads();
#if PROBE >= 100
  unsigned long long tacc = 0;
#endif
#if PROBE >= 200
  if (blockIdx.x == 0 && threadIdx_x_raw() == 0) g_tacc[0] = 0;
#endif
  for (int ph = pb; ph < pe; ++ph) {
    if (ph > pb) {
      if (ph == pb + 1) {
        grid.sync();
        if (threadIdx_x_raw() == 0) {
          const unsigned key = (unsigned)rolev.z, rank = (unsigned)rolev.w;
          const unsigned ord = xb_ld(cut + 4096 + key), ncu = xb_ld(cut + 8192), bad = xb_ld(cut + 8193);
          if (bad == 0u && 2u * ncu == gridDim.x && rank < 2u && ncu >= 256u) {
            if (ord < 128u) rolev.x = rank == 0u ? (int)ord : (int)(256u + ord);
            else if (ord < 192u) rolev.x = (int)(128u + 2u * (ord - 128u) + rank);
            else rolev.x = (int)(384u + 2u * (ord - 192u) + rank);
            rolev.y = 1;
          }
        }
        __syncthreads();
      } else xcd_barrier(xb);
    }
#if PROBE == 6
    if (ph >= 1 && ph < NPHASES - 1 && ((ph - 1) % PH_PER_LAYER) == 4) {
      const int l = (ph - 1) / PH_PER_LAYER;
      mixer_phase(p, l, smem, l, 1);
      xcd_barrier(xb);
      mixer_phase(p, l, smem, l, 1);
      xcd_barrier(xb);
      mixer_phase(p, l, smem, l, 2);
      continue;
    }
#endif
#if PROBE >= 100
    const bool tph = (ph >= 1 && ph < NPHASES - 1 && ((ph - 1) % PH_PER_LAYER) == (PROBE - 100));
    unsigned long long t0 = 0;
    if (tph && blockIdx.x == 0) t0 = __builtin_amdgcn_s_memrealtime();
#endif
    run_phase(p, ph, smem, rolev.x, rolev.y);
#if PROBE >= 100
    if (tph) { xcd_barrier(xb); if (blockIdx.x == 0) tacc += __builtin_amdgcn_s_memrealtime() - t0; }
#endif
  }
#if PROBE >= 100
#if PROBE == 300
  if (blockIdx.x == 0) { const unsigned long long te = __builtin_amdgcn_s_memrealtime() + (rolev.w == 1000 ? 300000ull : (rolev.w == 2001 ? 600000ull : 900000ull)); while (__builtin_amdgcn_s_memrealtime() < te) __builtin_amdgcn_s_sleep(8); }
#elif PROBE >= 200
  {
    __syncthreads();
    const unsigned long long ta = g_tacc[0];
    if (ta) { const unsigned long long te = __builtin_amdgcn_s_memrealtime() + 4ull * ta; while (__builtin_amdgcn_s_memrealtime() < te) __builtin_amdgcn_s_sleep(8); }
  }
#else
  if (blockIdx.x == 0) { const unsigned long long te = __builtin_amdgcn_s_memrealtime() + 4ull * tacc; while (__builtin_amdgcn_s_memrealtime() < te) __builtin_amdgcn_s_sleep(8); }
#endif
#endif
}

extern "C" void kernel_launch(void* const* d_in, const int* in_sizes, int n_in, void* d_out, int out_size, void* d_ws,
                              size_t ws_size, hipStream_t stream) {
  static int grid_blocks = 0;
  if (grid_blocks == 0) {
    int dev = 0, cus = 0, per_cu = 0;
    hipGetDevice(&dev);
    hipDeviceGetAttribute(&cus, hipDeviceAttributeMultiprocessorCount, dev);
    hipFuncSetAttribute((const void*)mega, hipFuncAttributeMaxDynamicSharedMemorySize, LDS_BYTES);
    hipOccupancyMaxActiveBlocksPerMultiprocessor(&per_cu, (const void*)mega, 256, LDS_BYTES);
    if (per_cu < 1) per_cu = 1;
    if (per_cu > 2) per_cu = 2;
    grid_blocks = cus * per_cu;
    fprintf(stderr, "mega: cus %d per_cu %d grid %d\n", cus, per_cu, grid_blocks);
  }
  P p{};
  const float** ins = (const float**)&p;
  for (int i = 0; i < 33; ++i) ins[i] = (const float*)d_in[i];
  p.XL = (float*)d_out;
  p.ws = (char*)d_ws;
  const size_t off = WS_TOTAL;
  if (off > ws_size || n_in != 33) { fprintf(stderr, "mega: workspace too small (%zu > %zu) or n_in %d\n", off, ws_size, n_in); return; }
  (void)hipMemsetAsync((char*)d_ws + OFF_BAR, 0, BAR_BYTES, stream);
  int pb = 0, pe = NPHASES;
  void* args[] = {&p, &pb, &pe};
  hipError_t e = hipLaunchCooperativeKernel((const void*)mega, dim3(grid_blocks), dim3(256), args, LDS_BYTES, stream);
  if (e != hipSuccess) fprintf(stderr, "mega: cooperative launch failed: %s (grid %d)\n", hipGetErrorString(e), grid_blocks);
}
```

```cpp
#include <hip/hip_runtime.h>
#include <hip/hip_cooperative_groups.h>
#include <cstdio>
#include <cstdint>
namespace cg = cooperative_groups;

typedef _Float16 h16;
typedef _Float16 h16x8 __attribute__((ext_vector_type(8)));
typedef _Float16 h16x4 __attribute__((ext_vector_type(4)));
typedef float f32x16 __attribute__((ext_vector_type(16)));
typedef float f32x4 __attribute__((ext_vector_type(4)));

#define DEVI __device__ __forceinline__
DEVI int threadIdx_x_raw() { return (int)__builtin_amdgcn_workitem_id_x(); }

#define PROBE 0
constexpr int D = 1024, NB = 4, SEQ = 4096, CTX = 256, DEPTH = 4;
constexpr int SB = SEQ + CTX;
constexpr int NR = NB * SB;
constexpr int ZW = 4160;
constexpr int ZMLA = 1568, ZRW = 2240;
constexpr int NIN = 7232;
constexpr int DFF = 4096;
constexpr int LDS_BYTES = 74752;
constexpr int NSCAN_BPC = 2;
constexpr int NSCAN = 64 * NSCAN_BPC;
constexpr int NGLA = 128;
constexpr int TSTEPS = SB + 1;
constexpr int NCHUNK = (TSTEPS + 15) / 16;

constexpr size_t al256(size_t x) { return (x + 255) & ~(size_t)255; }
constexpr size_t OFF_XC = 0;
constexpr size_t OFF_MOD = OFF_XC + al256((size_t)NB * CTX * D * 4);
constexpr size_t OFF_ROPE = OFF_MOD + al256((size_t)DEPTH * 5 * 6144 * 4);
constexpr size_t OFF_INVN = OFF_ROPE + al256((size_t)SEQ * 32 * 4);
constexpr size_t OFF_CTR = OFF_INVN + al256((size_t)NR * 8 * 4);
constexpr size_t OFF_BAR = OFF_CTR + al256(256);
constexpr size_t BAR_BYTES = (size_t)(3584 + 4096 + 4096 + 64) * 4;
constexpr size_t OFF_HLO = OFF_BAR + al256(BAR_BYTES);
constexpr size_t OFF_HHI = OFF_HLO + al256((size_t)(NR / 64) * 1920 * 2);
constexpr size_t OFF_H = OFF_HHI + al256((size_t)(NR / 64) * 1920 * 2);
constexpr size_t OFF_Z = OFF_H + al256((size_t)NR * D * 2);
constexpr size_t OFF_WIN = OFF_Z + al256((size_t)NR * ZW * 2);
constexpr size_t OFF_UQ = OFF_WIN + al256((size_t)NIN * D * 2);
constexpr size_t OFF_UKV = OFF_UQ + al256((size_t)768 * 384 * 2);
constexpr size_t OFF_WB = OFF_UKV + al256((size_t)1024 * 256 * 2);
constexpr size_t OFF_WO = OFF_WB + al256((size_t)3 * D * 512 * 2);
constexpr size_t OFF_WUP = OFF_WO + al256((size_t)D * D * 2);
constexpr size_t OFF_AUP = OFF_WUP + al256((size_t)2 * 512 * 64 * 2);
constexpr size_t OFF_GUP = OFF_AUP + al256((size_t)2 * 512 * 64 * 2);
constexpr size_t OFF_LW = OFF_GUP + al256((size_t)512 * 128 * 2);
constexpr size_t OFF_AA = OFF_LW + al256((size_t)2 * NR * 512 * 2);
constexpr size_t OFF_G = OFF_AA + al256((size_t)2 * NR * 512 * 2);
constexpr size_t OFF_Y2 = OFF_G + al256((size_t)NR * 512 * 2);
constexpr size_t OFF_Q = OFF_Y2 + al256((size_t)2 * NR * 512 * 2);
constexpr size_t OFF_K = OFF_Q + al256((size_t)NR * 768 * 2);
constexpr size_t OFF_VT = OFF_K + al256((size_t)NR * 768 * 2);
constexpr size_t OFF_QIN = OFF_VT + al256((size_t)NR * 512 * 2);
constexpr size_t OFF_KIN = OFF_QIN + al256((size_t)2 * NR * 256 * 2);
constexpr size_t OFF_DEC = OFF_KIN + al256((size_t)2 * NR * 256 * 2);
constexpr size_t OFF_OFB = OFF_DEC + al256((size_t)32 * 68 * 64 * 4);
constexpr size_t WS_TOTAL = OFF_OFB + al256((size_t)2 * NR * 512 * 2);
struct P {
  const float *x, *c, *ctx, *c_ctx, *ada_w, *ada_b, *w_in, *gk_up, *gk_b, *gla_ng, *qn_g, *kvn_g, *w_uq, *w_ukv,
      *mu, *w0, *w_up, *a0, *a_up, *g_up, *k_k, *k_a, *r_k, *rln_g, *rln_b, *w_branch, *w_out, *ln1_g, *ln1_b,
      *w1, *w2, *ln2_g, *ln2_b;
  float* XL;
  char* ws;
  DEVI float* XC() const { return (float*)(ws + OFF_XC); }
  DEVI float* MOD() const { return (float*)(ws + OFF_MOD); }
  DEVI float* ROPE() const { return (float*)(ws + OFF_ROPE); }
  DEVI float* INVN() const { return (float*)(ws + OFF_INVN); }
  DEVI unsigned* CTR() const { return (unsigned*)(ws + OFF_CTR); }
  DEVI unsigned* BAR() const { return (unsigned*)(ws + OFF_BAR); }
  DEVI h16* HLO() const { return (h16*)(ws + OFF_HLO); }
  DEVI h16* HHI() const { return (h16*)(ws + OFF_HHI); }
  DEVI h16* H() const { return (h16*)(ws + OFF_H); }
  DEVI h16* Z() const { return (h16*)(ws + OFF_Z); }
  DEVI h16* WIN() const { return (h16*)(ws + OFF_WIN); }
  DEVI h16* UQ() const { return (h16*)(ws + OFF_UQ); }
  DEVI h16* UKV() const { return (h16*)(ws + OFF_UKV); }
  DEVI h16* WB() const { return (h16*)(ws + OFF_WB); }
  DEVI h16* WO() const { return (h16*)(ws + OFF_WO); }
  DEVI h16* WUP() const { return (h16*)(ws + OFF_WUP); }
  DEVI h16* AUP() const { return (h16*)(ws + OFF_AUP); }
  DEVI h16* GUP() const { return (h16*)(ws + OFF_GUP); }
  DEVI h16* LW() const { return (h16*)(ws + OFF_LW); }
  DEVI h16* AA() const { return (h16*)(ws + OFF_AA); }
  DEVI h16* G() const { return (h16*)(ws + OFF_G); }
  DEVI h16* Y2() const { return (h16*)(ws + OFF_Y2); }
  DEVI h16* Q() const { return (h16*)(ws + OFF_Q); }
  DEVI h16* K() const { return (h16*)(ws + OFF_K); }
  DEVI h16* VT() const { return (h16*)(ws + OFF_VT); }
  DEVI unsigned short* QIN() const { return (unsigned short*)(ws + OFF_QIN); }
  DEVI unsigned short* KIN() const { return (unsigned short*)(ws + OFF_KIN); }
  DEVI float* DEC() const { return (float*)(ws + OFF_DEC); }
  DEVI h16* OFB() const { return (h16*)(ws + OFF_OFB); }
  DEVI h16* W1T() const { return (h16*)(ws + OFF_LW); }
  DEVI h16* W2T() const { return (h16*)(ws + OFF_LW + (size_t)DFF * D * 2); }
  DEVI h16* M() const { return (h16*)(ws + OFF_Q); }
  DEVI h16* YA() const { return (h16*)(ws + OFF_Z + 1056 * 2); }
};

DEVI int tidx() { int t = threadIdx_x_raw(); asm volatile("" : "+v"(t)); return t; }
DEVI float wsum(float v) {
#pragma unroll
  for (int o = 32; o; o >>= 1) v += __shfl_xor(v, o);
  return v;
}
DEVI float sigm(float x) { return 1.f / (1.f + __expf(-x)); }
DEVI unsigned pk2(float a, float b) {
  auto h = __builtin_amdgcn_cvt_pkrtz(a, b);
  return __builtin_bit_cast(unsigned, h);
}
DEVI unsigned pk2n(float a, float b) {
  h16 x = (h16)a, y = (h16)b;
  unsigned short ux = __builtin_bit_cast(unsigned short, x), uy = __builtin_bit_cast(unsigned short, y);
  return (unsigned)ux | ((unsigned)uy << 16);
}
DEVI unsigned f2bf(float f) { unsigned u = __builtin_bit_cast(unsigned, f); u += 0x7fffu + ((u >> 16) & 1u); return u >> 16; }
DEVI float h2f(unsigned short u) { return (float)__builtin_bit_cast(h16, u); }
DEVI void st4h(h16* dst, float a, float b, float c, float d) {
  uint2 u; u.x = pk2n(a, b); u.y = pk2n(c, d);
  *(uint2*)dst = u;
}
DEVI float* xrow(const P& p, int r) {
  int b = r / SB, s = r - b * SB;
  return s < CTX ? p.XC() + (size_t)(b * CTX + s) * D : p.XL + (size_t)(b * SEQ + s - CTX) * D;
}
DEVI int maprow(int dir, int b, int n) {
  if (dir == 0) return b * SB + n;
  return n < CTX ? b * SB + (CTX - 1 - n) : b * SB + (SB + CTX - 1 - n);
}


#define XB_TMO      128
#define XB_XCNT(j)  (256  + 64 * (j))
#define XB_XSUB(j)  (1280 + 64 * (j))
#define XB_XGEN(j)  (2304 + 64 * (j))
#define XB_TOP      3328
#define XB_TOPGEN   3392
#define XCD_BAR_WORDS 3456
#define XB_SPIN_CAP (1u << 22)
#define LAS __attribute__((address_space(3)))
DEVI unsigned xb_ld(unsigned* p) { return __hip_atomic_load(p, __ATOMIC_RELAXED, __HIP_MEMORY_SCOPE_AGENT); }
DEVI unsigned xb_add(unsigned* p, unsigned v) { return __hip_atomic_fetch_add(p, v, __ATOMIC_RELAXED, __HIP_MEMORY_SCOPE_AGENT); }
DEVI unsigned xb_xcc_id() { return (unsigned)__builtin_amdgcn_s_getreg((3 << 11) | 20) & 0xFu; }
#define XB_SPIN(cond, bar) do { unsigned _sp = 0; while (cond) { __builtin_amdgcn_s_sleep(1); \
    if ((++_sp & 255u) == 0u) { if (xb_ld(&(bar)[XB_TMO])) break; if (_sp > XB_SPIN_CAP) { atomicAdd(&(bar)[XB_TMO], 1u); break; } } } } while (0)
struct XcdBarrier { unsigned* bar; unsigned x; volatile LAS unsigned* st; };
DEVI XcdBarrier xcd_barrier_post(unsigned* bar, volatile LAS unsigned* st) {
  XcdBarrier b; b.bar = bar; b.x = xb_xcc_id(); b.st = st;
  if (threadIdx_x_raw() == 0) (void)xb_add(&bar[XB_XCNT(b.x)], 1u);
  return b;
}
DEVI void xcd_barrier_complete(unsigned* bar, unsigned x, unsigned& nloc, unsigned& nx) {
  const unsigned G = gridDim.x;
  unsigned sum, cnt, mine, sp = 0u;
  for (;;) {
    sum = 0u; cnt = 0u; mine = 0u;
#pragma unroll
    for (unsigned j = 0; j < 16; ++j) { const unsigned c = xb_ld(&bar[XB_XCNT(j)]); sum += c; cnt += (c > 0u) ? 1u : 0u; mine = (j == x) ? c : mine; }
    if (sum == G) break;
    __builtin_amdgcn_s_sleep(1);
    if ((++sp & 255u) == 0u) { if (xb_ld(&bar[XB_TMO])) break; if (sp > XB_SPIN_CAP) { atomicAdd(&bar[XB_TMO], 1u); break; } }
  }
  nloc = mine > 0u ? mine : 1u; nx = cnt > 0u ? cnt : 1u;
}
DEVI void xcd_barrier(const XcdBarrier& b) {
  asm volatile("s_waitcnt vmcnt(0)" ::: "memory");
  __syncthreads();
  if (threadIdx_x_raw() == 0) {
    unsigned* bar = b.bar;
    __builtin_amdgcn_s_waitcnt(0);
    unsigned nloc = b.st[0], nx = b.st[1];
    if (nloc == 0u) { xcd_barrier_complete(bar, b.x, nloc, nx); b.st[0] = nloc; b.st[1] = nx; }
    const unsigned old = xb_add(&bar[XB_XSUB(b.x)], 1u);
    const unsigned gen = old / nloc;
    if (old + 1u == (gen + 1u) * nloc) {
      __builtin_amdgcn_fence(__ATOMIC_RELEASE, "agent");
      asm volatile("s_waitcnt vmcnt(0)" ::: "memory");
      const unsigned og = xb_add(&bar[XB_TOP], 1u);
      const unsigned tg = og / nx;
      if (og + 1u == (tg + 1u) * nx) xb_add(&bar[XB_TOPGEN], 1u);
      else XB_SPIN(xb_ld(&bar[XB_TOPGEN]) == tg, bar);
      __builtin_amdgcn_fence(__ATOMIC_ACQUIRE, "agent");
      xb_add(&bar[XB_XGEN(b.x)], 1u);
      asm volatile("s_waitcnt vmcnt(0)" ::: "memory");
    } else {
      XB_SPIN(xb_ld(&bar[XB_XGEN(b.x)]) == gen, bar);
      __builtin_amdgcn_fence(__ATOMIC_ACQUIRE, "agent");
      asm volatile("s_waitcnt vmcnt(0)" ::: "memory");
    }
  }
  __syncthreads();
}

DEVI void phase0(const P& p, char* smem) {
  const int tid = tidx();
  float* sc = (float*)smem;
  float* red = sc + 5 * 1024;
  for (int i = tid; i < 5 * 1024; i += 256) {
    int g = i >> 10, k = i & 1023;
    float v = g < 4 ? p.c[g * D + k] : p.c_ctx[k];
    sc[i] = v * sigm(v);
  }
  __syncthreads();
  for (int job = blockIdx.x; job < DEPTH * 96; job += gridDim.x) {
    int l = job / 96, n0 = (job % 96) * 64;
    int kq = tid >> 6, cc = tid & 63;
    const float* w = p.ada_w + ((size_t)l * D + kq * 256) * 6144 + n0 + cc;
    float a0 = 0, a1 = 0, a2 = 0, a3 = 0, a4 = 0;
#pragma unroll 8
    for (int k = 0; k < 256; ++k) {
      float wv = w[(size_t)k * 6144];
      int kk = kq * 256 + k;
      a0 += sc[kk] * wv; a1 += sc[1024 + kk] * wv; a2 += sc[2048 + kk] * wv; a3 += sc[3072 + kk] * wv; a4 += sc[4096 + kk] * wv;
    }
    red[(kq * 5 + 0) * 64 + cc] = a0; red[(kq * 5 + 1) * 64 + cc] = a1; red[(kq * 5 + 2) * 64 + cc] = a2;
    red[(kq * 5 + 3) * 64 + cc] = a3; red[(kq * 5 + 4) * 64 + cc] = a4;
    __syncthreads();
    for (int i = tid; i < 320; i += 256) {
      int g = i >> 6, c2 = i & 63;
      float s = red[(0 * 5 + g) * 64 + c2] + red[(1 * 5 + g) * 64 + c2] + red[(2 * 5 + g) * 64 + c2] + red[(3 * 5 + g) * 64 + c2];
      p.MOD()[((size_t)l * 5 + g) * 6144 + n0 + c2] = s + p.ada_b[l * 6144 + n0 + c2];
    }
    __syncthreads();
  }
  for (int i = blockIdx.x * 256 + tid; i < SEQ * 16; i += gridDim.x * 256) {
    int s = i >> 4, j = i & 15;
    float pos = (float)(j < 8 ? (s >> 6) : (s & 63));
    float inv = exp2f(-(float)(j & 7) * (13.287712379549449f / 8.f));
    float ang = pos * inv;
    p.ROPE()[s * 32 + j] = cosf(ang);
    p.ROPE()[s * 32 + 16 + j] = sinf(ang);
  }
  if (blockIdx.x == 0 && tid < 64) p.CTR()[tid] = 0;
}

struct CE { const float* src; h16* dst; const float* scale; int K, N; };
DEVI CE get_ce(const P& p, int l, int e) {
  CE c; c.scale = nullptr;
  switch (e) {
    case 0: c.src = p.w_in + (size_t)l * D * NIN; c.dst = p.WIN(); c.K = D; c.N = NIN; break;
    case 1: c.src = p.w_uq + (size_t)l * 384 * 768; c.dst = p.UQ(); c.K = 384; c.N = 768; c.scale = p.qn_g + l * 384; break;
    case 2: c.src = p.w_ukv + (size_t)l * 256 * 1024; c.dst = p.UKV(); c.K = 256; c.N = 1024; c.scale = p.kvn_g + l * 256; break;
    case 3: case 4: case 5: c.src = p.w_branch + ((size_t)l * 3 + (e - 3)) * 512 * D; c.dst = p.WB() + (size_t)(e - 3) * D * 512; c.K = 512; c.N = D; break;
    case 6: c.src = p.w_out + (size_t)l * D * D; c.dst = p.WO(); c.K = D; c.N = D; break;
    case 7: case 8: c.src = p.w_up + ((size_t)l * 2 + (e - 7)) * 64 * 512; c.dst = p.WUP() + (size_t)(e - 7) * 512 * 64; c.K = 64; c.N = 512; break;
    case 9: case 10: c.src = p.a_up + ((size_t)l * 2 + (e - 9)) * 64 * 512; c.dst = p.AUP() + (size_t)(e - 9) * 512 * 64; c.K = 64; c.N = 512; break;
    case 11: c.src = p.g_up + (size_t)l * 128 * 512; c.dst = p.GUP(); c.K = 128; c.N = 512; break;
    case 12: c.src = p.w1 + (size_t)l * D * DFF; c.dst = p.W1T(); c.K = D; c.N = DFF; break;
    default: c.src = p.w2 + (size_t)l * DFF * D; c.dst = p.W2T(); c.K = DFF; c.N = D; break;
  }
  return c;
}
DEVI void conv_tile(const CE& e, int tile, char* smem) {
  float* s = (float*)smem;
  const int tid = tidx();
  int ntn = e.N >> 6;
  int kt = tile / ntn, nt = tile - kt * ntn;
  {
    int r = tid >> 4, c4 = (tid & 15) * 4;
#pragma unroll
    for (int rr = 0; rr < 4; ++rr) {
      int k = r + 16 * rr;
      float4 v = *(const float4*)(e.src + (size_t)(kt * 64 + k) * e.N + nt * 64 + c4);
      float sc = e.scale ? e.scale[kt * 64 + k] : 1.f;
      s[k * 65 + c4 + 0] = v.x * sc; s[k * 65 + c4 + 1] = v.y * sc; s[k * 65 + c4 + 2] = v.z * sc; s[k * 65 + c4 + 3] = v.w * sc;
    }
  }
  __syncthreads();
  {
    int n = tid >> 2, kq = (tid & 3) * 16;
    uint4 u0, u1;
    u0.x = pk2n(s[(kq + 0) * 65 + n], s[(kq + 1) * 65 + n]); u0.y = pk2n(s[(kq + 2) * 65 + n], s[(kq + 3) * 65 + n]);
    u0.z = pk2n(s[(kq + 4) * 65 + n], s[(kq + 5) * 65 + n]); u0.w = pk2n(s[(kq + 6) * 65 + n], s[(kq + 7) * 65 + n]);
    u1.x = pk2n(s[(kq + 8) * 65 + n], s[(kq + 9) * 65 + n]); u1.y = pk2n(s[(kq + 10) * 65 + n], s[(kq + 11) * 65 + n]);
    u1.z = pk2n(s[(kq + 12) * 65 + n], s[(kq + 13) * 65 + n]); u1.w = pk2n(s[(kq + 14) * 65 + n], s[(kq + 15) * 65 + n]);
    h16* d = e.dst + (size_t)(nt * 64 + n) * e.K + kt * 64 + kq;
    *(uint4*)d = u0; *(uint4*)(d + 8) = u1;
  }
  __syncthreads();
}
DEVI void conv_phase(const P& p, int l, int e0, int e1, char* smem) {
  int total = 0;
  for (int e = e0; e < e1; ++e) { CE c = get_ce(p, l, e); total += (c.K >> 6) * (c.N >> 6); }
  for (int t = blockIdx.x; t < total; t += gridDim.x) {
    int tt = t;
    for (int e = e0; e < e1; ++e) {
      CE c = get_ce(p, l, e);
      int nt = (c.K >> 6) * (c.N >> 6);
      if (tt < nt) { conv_tile(c, tt, smem); break; }
      tt -= nt;
    }
  }
}

DEVI void ln_phase(const P& p, int l, int which) {
  const int lane = tidx() & 63;
  const int wid = blockIdx.x * 4 + (tidx() >> 6), nw = gridDim.x * 4;
  for (int r = wid; r < NR; r += nw) {
    int b = r / SB, s = r - b * SB;
    if (which == 2 && s < CTX) continue;
    int g = s < CTX ? 4 : b;
    float* xr = xrow(p, r);
    const float* src = xr;
    if (which == 0 && l == 0) src = s < CTX ? p.ctx + (size_t)(b * CTX + s) * D : p.x + (size_t)(b * SEQ + s - CTX) * D;
    float4 v[4];
#pragma unroll
    for (int i = 0; i < 4; ++i) v[i] = *(const float4*)(src + i * 256 + lane * 4);
    bool do_ln = !(which == 0 && l == 0);
    if (do_ln) {
      const float* gg = which == 1 ? p.ln1_g + l * D : p.ln2_g + (which == 2 ? 3 : l - 1) * D;
      const float* bb = which == 1 ? p.ln1_b + l * D : p.ln2_b + (which == 2 ? 3 : l - 1) * D;
      float sm = 0;
#pragma unroll
      for (int i = 0; i < 4; ++i) sm += v[i].x + v[i].y + v[i].z + v[i].w;
      float mean = wsum(sm) * (1.f / D);
      float sq = 0;
#pragma unroll
      for (int i = 0; i < 4; ++i) {
        v[i].x -= mean; v[i].y -= mean; v[i].z -= mean; v[i].w -= mean;
        sq += v[i].x * v[i].x + v[i].y * v[i].y + v[i].z * v[i].z + v[i].w * v[i].w;
      }
      float rs = rsqrtf(wsum(sq) * (1.f / D) + 1e-5f);
#pragma unroll
      for (int i = 0; i < 4; ++i) {
        float4 g4 = *(const float4*)(gg + i * 256 + lane * 4), b4 = *(const float4*)(bb + i * 256 + lane * 4);
        v[i].x = v[i].x * rs * g4.x + b4.x; v[i].y = v[i].y * rs * g4.y + b4.y;
        v[i].z = v[i].z * rs * g4.z + b4.z; v[i].w = v[i].w * rs * g4.w + b4.w;
      }
    }
#pragma unroll
    for (int i = 0; i < 4; ++i) *(float4*)(xr + i * 256 + lane * 4) = v[i];
    if (which == 2) continue;
    const float* shf = p.MOD() + ((size_t)l * 5 + g) * 6144 + (which == 0 ? 0 : 3) * D;
    const float* scl = shf + D;
    float sm = 0;
#pragma unroll
    for (int i = 0; i < 4; ++i) sm += v[i].x + v[i].y + v[i].z + v[i].w;
    float mean = wsum(sm) * (1.f / D);
    float sq = 0;
#pragma unroll
    for (int i = 0; i < 4; ++i) {
      v[i].x -= mean; v[i].y -= mean; v[i].z -= mean; v[i].w -= mean;
      sq += v[i].x * v[i].x + v[i].y * v[i].y + v[i].z * v[i].z + v[i].w * v[i].w;
    }
    float rs = rsqrtf(wsum(sq) * (1.f / D) + 1e-6f);
    h16* hr = p.H() + (size_t)r * D;
#pragma unroll
    for (int i = 0; i < 4; ++i) {
      float4 s4 = *(const float4*)(shf + i * 256 + lane * 4), c4 = *(const float4*)(scl + i * 256 + lane * 4);
      st4h(hr + i * 256 + lane * 4, v[i].x * rs * (1.f + c4.x) + s4.x, v[i].y * rs * (1.f + c4.y) + s4.y,
           v[i].z * rs * (1.f + c4.z) + s4.z, v[i].w * rs * (1.f + c4.w) + s4.w);
    }
  }
}

constexpr int GLD = 72;
template <bool ROWSQ, int NI = 2>
DEVI void gemm_main(const h16* __restrict__ A, int lda, const h16* __restrict__ Bt, int ldb, int K, int m0, int n0, int nmax,
                    char* smem, f32x16 (&acc)[2][NI], float* rowsq) {
  h16* As = (h16*)smem;
  h16* Bs = As + 2 * 128 * GLD;
  const int tid = tidx(), lane = tid & 63, wv = tid >> 6;
  const int wm = wv >> 1, wn = wv & 1, l31 = lane & 31, hh = lane >> 5;
  const int lrow = tid >> 3, lkc = (tid & 7) * 8;
  uint4 ga[4], gb[2 * NI];
  float sq[4] = {0.f, 0.f, 0.f, 0.f};
  const h16* Ap = A + (size_t)(m0 + lrow) * lda + lkc;
  const h16* Bp = Bt + (size_t)(n0 + lrow) * ldb + lkc;
#pragma unroll
  for (int i = 0; i < 4; ++i) ga[i] = *(const uint4*)(Ap + (size_t)(32 * i) * lda);
#pragma unroll
  for (int i = 0; i < 2 * NI; ++i)
    gb[i] = (n0 + lrow + 32 * i < nmax) ? *(const uint4*)(Bp + (size_t)(32 * i) * ldb) : make_uint4(0, 0, 0, 0);
  const int KT = K >> 6;
#pragma unroll
  for (int i = 0; i < 4; ++i) *(uint4*)(As + (lrow + 32 * i) * GLD + lkc) = ga[i];
#pragma unroll
  for (int i = 0; i < 2 * NI; ++i) *(uint4*)(Bs + (lrow + 32 * i) * GLD + lkc) = gb[i];
  __syncthreads();
  for (int kt = 0; kt < KT; ++kt) {
    const int buf = kt & 1;
    if (ROWSQ) {
#pragma unroll
      for (int i = 0; i < 4; ++i) {
        h16x8 hv = __builtin_bit_cast(h16x8, ga[i]);
#pragma unroll
        for (int j = 0; j < 8; ++j) { float f = (float)hv[j]; sq[i] += f * f; }
      }
    }
    if (kt + 1 < KT) {
#pragma unroll
      for (int i = 0; i < 4; ++i) ga[i] = *(const uint4*)(Ap + (size_t)(32 * i) * lda + (kt + 1) * 64);
#pragma unroll
      for (int i = 0; i < 2 * NI; ++i)
        gb[i] = (n0 + lrow + 32 * i < nmax) ? *(const uint4*)(Bp + (size_t)(32 * i) * ldb + (kt + 1) * 64) : make_uint4(0, 0, 0, 0);
    }
    const h16* as = As + buf * 128 * GLD + (wm * 64 + l31) * GLD + hh * 8;
    const h16* bs = Bs + buf * 128 * GLD + (wn * 32 * NI + l31) * GLD + hh * 8;
#pragma unroll
    for (int ks = 0; ks < 4; ++ks) {
      h16x8 a0 = *(const h16x8*)(as + ks * 16), a1 = *(const h16x8*)(as + 32 * GLD + ks * 16);
#pragma unroll
      for (int ni = 0; ni < NI; ++ni) {
        h16x8 b0 = *(const h16x8*)(bs + ni * 32 * GLD + ks * 16);
        acc[0][ni] = __builtin_amdgcn_mfma_f32_32x32x16_f16(b0, a0, acc[0][ni], 0, 0, 0);
        acc[1][ni] = __builtin_amdgcn_mfma_f32_32x32x16_f16(b0, a1, acc[1][ni], 0, 0, 0);
      }
    }
    if (kt + 1 < KT) {
      h16* ad = As + (buf ^ 1) * 128 * GLD;
      h16* bd = Bs + (buf ^ 1) * 128 * GLD;
#pragma unroll
      for (int i = 0; i < 4; ++i) *(uint4*)(ad + (lrow + 32 * i) * GLD + lkc) = ga[i];
#pragma unroll
      for (int i = 0; i < 2 * NI; ++i) *(uint4*)(bd + (lrow + 32 * i) * GLD + lkc) = gb[i];
    }
    __syncthreads();
  }
  if (ROWSQ) {
#pragma unroll
    for (int i = 0; i < 4; ++i) {
      float s = sq[i];
      s += __shfl_xor(s, 1); s += __shfl_xor(s, 2); s += __shfl_xor(s, 4);
      if ((tid & 7) == 0) rowsq[lrow + 32 * i] = s;
    }
    __syncthreads();
  }
}
template <int NI = 2>
DEVI void gemm_deep(const h16* __restrict__ A, int lda, const h16* __restrict__ Bt, int ldb, int K, int m0, int n0, int nmax,
                    char* smem, f32x16 (&acc)[2][NI]) {
  h16* As = (h16*)smem;
  h16* Bs = As + 2 * 128 * GLD;
  const int tid = tidx(), lane = tid & 63, wv = tid >> 6;
  const int wm = wv >> 1, wn = wv & 1, l31 = lane & 31, hh = lane >> 5;
  const int lrow = tid >> 3, lkc = (tid & 7) * 8;
  uint4 pa0, pa1, pa2, pa3, pb0, pb1, pb2, pb3;
  uint4 qa0, qa1, qa2, qa3, qb0, qb1, qb2, qb3;
  const h16* Ap = A + (size_t)(m0 + lrow) * lda + lkc;
  const int KT = K >> 6;
  const uint4 zz = make_uint4(0, 0, 0, 0);
  const h16* Bq0 = Bt + (size_t)min(n0 + lrow, nmax - 1) * ldb + lkc;
  const h16* Bq1 = Bt + (size_t)min(n0 + lrow + 32, nmax - 1) * ldb + lkc;
  const h16* Bq2 = Bt + (size_t)min(n0 + lrow + 64, nmax - 1) * ldb + lkc;
  const h16* Bq3 = Bt + (size_t)min(n0 + lrow + 96, nmax - 1) * ldb + lkc;
#define GLOAD(S, kt_)                                                                   \
  {                                                                                     \
    const h16* ap_ = Ap + (kt_) * 64;                                                   \
    S##a0 = *(const uint4*)(ap_); S##a1 = *(const uint4*)(ap_ + (size_t)32 * lda);      \
    S##a2 = *(const uint4*)(ap_ + (size_t)64 * lda); S##a3 = *(const uint4*)(ap_ + (size_t)96 * lda); \
    S##b0 = *(const uint4*)(Bq0 + (kt_) * 64); S##b1 = *(const uint4*)(Bq1 + (kt_) * 64); \
    if (NI == 2) { S##b2 = *(const uint4*)(Bq2 + (kt_) * 64); S##b3 = *(const uint4*)(Bq3 + (kt_) * 64); } \
  }
#define LSTORE(S, buf_)                                                                 \
  {                                                                                     \
    h16* ad = As + (buf_) * 128 * GLD + lrow * GLD + lkc;                               \
    h16* bd = Bs + (buf_) * 128 * GLD + lrow * GLD + lkc;                               \
    *(uint4*)(ad) = S##a0; *(uint4*)(ad + 32 * GLD) = S##a1; *(uint4*)(ad + 64 * GLD) = S##a2; *(uint4*)(ad + 96 * GLD) = S##a3; \
    *(uint4*)(bd) = S##b0; *(uint4*)(bd + 32 * GLD) = S##b1;                            \
    if (NI == 2) { *(uint4*)(bd + 64 * GLD) = S##b2; *(uint4*)(bd + 96 * GLD) = S##b3; } \
  }
#define COMPUTE(buf_)                                                                                              \
  {                                                                                                                \
    const h16* as = As + (buf_) * 128 * GLD + (wm * 64 + l31) * GLD + hh * 8;                                      \
    const h16* bs = Bs + (buf_) * 128 * GLD + (wn * 32 * NI + l31) * GLD + hh * 8;                                 \
    _Pragma("unroll") for (int ks = 0; ks < 4; ++ks) {                                                             \
      h16x8 a0 = *(const h16x8*)(as + ks * 16), a1 = *(const h16x8*)(as + 32 * GLD + ks * 16);                     \
      _Pragma("unroll") for (int ni = 0; ni < NI; ++ni) {                                                          \
        h16x8 b0 = *(const h16x8*)(bs + ni * 32 * GLD + ks * 16);                                                  \
        acc[0][ni] = __builtin_amdgcn_mfma_f32_32x32x16_f16(b0, a0, acc[0][ni], 0, 0, 0);                          \
        acc[1][ni] = __builtin_amdgcn_mfma_f32_32x32x16_f16(b0, a1, acc[1][ni], 0, 0, 0);                          \
      }                                                                                                            \
    }                                                                                                              \
  }
  pb2 = zz; pb3 = zz; qb2 = zz; qb3 = zz;
  GLOAD(p, 0);
  GLOAD(q, 1);
  LSTORE(p, 0);
  if (KT > 2) GLOAD(p, 2);
  __syncthreads();
  for (int kt = 0; kt < KT; kt += 2) {
    COMPUTE(0);
    if (kt + 1 < KT) LSTORE(q, 1);
    if (kt + 3 < KT) GLOAD(q, kt + 3);
    __syncthreads();
    if (kt + 1 < KT) {
      COMPUTE(1);
      if (kt + 2 < KT) LSTORE(p, 0);
      if (kt + 4 < KT) GLOAD(p, kt + 4);
      __syncthreads();
    }
  }
#undef GLOAD
#undef LSTORE
#undef COMPUTE
}
DEVI void zero_acc(f32x16 (&acc)[2][2]) {
#pragma unroll
  for (int i = 0; i < 2; ++i)
#pragma unroll
    for (int j = 0; j < 2; ++j)
#pragma unroll
      for (int r = 0; r < 16; ++r) acc[i][j][r] = 0.f;
}
template <class F>
DEVI void epi_quads(const f32x16 (&acc)[2][2], int m0, int n0, F f) {
  const int lane = tidx() & 63, wv = tidx() >> 6;
  const int wm = wv >> 1, wn = wv & 1, l31 = lane & 31, hh = lane >> 5;
#pragma unroll
  for (int mi = 0; mi < 2; ++mi)
#pragma unroll
    for (int ni = 0; ni < 2; ++ni)
#pragma unroll
      for (int g = 0; g < 4; ++g)
        f(m0 + wm * 64 + mi * 32 + l31, n0 + wn * 64 + ni * 32 + 8 * g + 4 * hh, acc[mi][ni][4 * g], acc[mi][ni][4 * g + 1],
          acc[mi][ni][4 * g + 2], acc[mi][ni][4 * g + 3]);
}


template <class T, class F>
DEVI void epi_oct(const f32x16 (&acc)[2][2], int m0, int n0, T tr, F f) {
  const int lane = tidx() & 63, wv = tidx() >> 6;
  const int wm = wv >> 1, wn = wv & 1, l31 = lane & 31, hh = lane >> 5;
#pragma unroll
  for (int mi = 0; mi < 2; ++mi)
#pragma unroll
    for (int ni = 0; ni < 2; ++ni)
#pragma unroll
      for (int j = 0; j < 2; ++j) {
        const int ga = 8 * j, gb = 8 * j + 4;
        const unsigned a0 = pk2n(tr(acc[mi][ni][ga]), tr(acc[mi][ni][ga + 1])), a1 = pk2n(tr(acc[mi][ni][ga + 2]), tr(acc[mi][ni][ga + 3]));
        const unsigned b0 = pk2n(tr(acc[mi][ni][gb]), tr(acc[mi][ni][gb + 1])), b1 = pk2n(tr(acc[mi][ni][gb + 2]), tr(acc[mi][ni][gb + 3]));
        auto r0 = __builtin_amdgcn_permlane32_swap(a0, b0, false, false);
        auto r1 = __builtin_amdgcn_permlane32_swap(a1, b1, false, false);
        f(m0 + wm * 64 + mi * 32 + l31, n0 + wn * 64 + ni * 32 + 16 * j + 8 * hh, make_uint4(r0[0], r1[0], r0[1], r1[1]));
      }
}

DEVI void inproj_phase(const P& p, char* smem) {
  constexpr int MT = NR / 128, NT = (ZW + 127) / 128;
  for (int job = blockIdx.x; job < MT * NT; job += gridDim.x) {
    int nt = job / MT, mt = job - nt * MT;
    f32x16 acc[2][2]; zero_acc(acc);
    gemm_deep<2>(p.H(), D, p.WIN(), D, D, mt * 128, nt * 128, ZW, smem, acc);
    epi_oct(acc, mt * 128, nt * 128, [](float x) { return x; }, [&](int m, int n, uint4 u) {
      if (n < ZW) {
        *(uint4*)(p.Z() + (size_t)m * ZW + n) = u;
        if (n >= ZRW) {
          if ((m & 63) == 0) *(uint4*)(p.HLO() + (size_t)(m >> 6) * 1920 + n - ZRW) = u;
          if ((m & 63) == 63) *(uint4*)(p.HHI() + (size_t)(m >> 6) * 1920 + n - ZRW) = u;
        }
      }
    });
  }
}

DEVI void shift_job(const P& p, int l, int jj, char* smem) {
  const int j = jj >> 3, slab0 = jj & 7;
  h16* raw = (h16*)smem;
  const int tid = tidx(), lane = tid & 63;
  const int r0 = j * 64;
  const int s0 = r0 % SB;
  const bool first = (s0 == 0) || (s0 == CTX);
  const bool last = (s0 + 64 == CTX) || (s0 + 64 == SB);
  for (int slab = slab0; slab <= slab0; ++slab) {
    const int c0 = slab * 256;
    const int ncols = slab == 7 ? 128 : 256;
    const int cpr = ncols >> 3;
    for (int c = tid; c < 66 * cpr; c += 256) {
      int row = c / cpr, ch = (c - row * cpr) * 8;
      uint4 v = make_uint4(0, 0, 0, 0);
      if (row == 0) { if (!first) v = *(const uint4*)(p.HHI() + (size_t)(j - 1) * 1920 + c0 + ch); }
      else if (row == 65) { if (!last) v = *(const uint4*)(p.HLO() + (size_t)(j + 1) * 1920 + c0 + ch); }
      else v = *(const uint4*)(p.Z() + (size_t)(r0 + row - 1) * ZW + ZRW + c0 + ch);
      *(uint4*)(raw + row * 264 + ch) = v;
    }
    __syncthreads();
    if (tid < ncols) {
      const int col = c0 + tid;
      const float mup = p.mu[(size_t)l * 2 * 1920 + col], mun = p.mu[(size_t)l * 2 * 1920 + 1920 + col];
      const bool isk = (col >= 512 && col < 1024);
      const float kkp = isk ? p.k_k[l * 512 + col - 512] : 0.f;
      float prev = (float)raw[tid], cur = (float)raw[264 + tid];
      h16* zc = p.Z() + (size_t)r0 * ZW + ZRW + col;
      for (int t = 0; t < 64; ++t) {
        float nxt = (float)raw[(t + 2) * 264 + tid];
        float o = cur + mup * (prev - cur) + mun * (nxt - cur);
        float ov = o;
        if (col >= 1536 && col < 1664) ov = tanhf(o);
        else if (col >= 1792) ov = sigm(o);
        zc[(size_t)t * ZW] = (h16)ov;
        if (isk) {
          float q = o * kkp;
          float ss = wsum(q * q);
          if (lane == 0) p.INVN()[(size_t)(r0 + t) * 8 + ((col - 512) >> 6)] = rsqrtf(ss + 1e-12f);
        }
        prev = cur; cur = nxt;
      }
    }
    __syncthreads();
  }
}

DEVI void mla_up_job(const P& p, int job, char* smem) {
  constexpr int MT = NR / 128;
  float* rowsq = (float*)(smem + 2 * 2 * 128 * GLD * 2);
  const int tid = tidx();
  f32x16 acc[2][2]; zero_acc(acc);
  if (job < MT * 6) {
    int nt = job / MT, mt = job - nt * MT;
    gemm_main<true>(p.Z() + ZMLA, ZW, p.UQ(), 384, 384, mt * 128, nt * 128, 768, smem, acc, rowsq);
    const int m0 = mt * 128, n0 = nt * 128;
    const int lane = tid & 63, wv = tid >> 6, wm = wv >> 1, wn = wv & 1, l31 = lane & 31, hh = lane >> 5;
    const float qs = 0.10206207261596575f * 1.4426950408889634f;
#pragma unroll
    for (int mi = 0; mi < 2; ++mi) {
      const int ml = wm * 64 + mi * 32 + l31, m = m0 + ml;
      const float sc = rsqrtf(rowsq[ml] * (1.f / 384.f) + 1e-6f) * qs;
      const int sp = m % SB;
      const bool lat = sp >= CTX;
      const float* rp = p.ROPE() + (size_t)(lat ? sp - CTX : 0) * 32;
#pragma unroll
      for (int ni = 0; ni < 2; ++ni) {
        const int nb = n0 + wn * 64 + ni * 32;
        h16* qd = p.Q() + (size_t)m * 768 + nb;
        const bool ropet = (nb % 96) == 64;
        if (ropet && lat) {
#pragma unroll
          for (int g = 0; g < 2; ++g) {
            float o1[4], o2[4];
#pragma unroll
            for (int jj = 0; jj < 4; ++jj) {
              int i = 8 * g + 4 * hh + jj;
              float x1 = acc[mi][ni][4 * g + jj] * sc, x2 = acc[mi][ni][4 * (g + 2) + jj] * sc;
              float cs = rp[i], sn = rp[16 + i];
              o1[jj] = x1 * cs - x2 * sn; o2[jj] = x1 * sn + x2 * cs;
            }
            st4h(qd + 8 * g + 4 * hh, o1[0], o1[1], o1[2], o1[3]);
            st4h(qd + 16 + 8 * g + 4 * hh, o2[0], o2[1], o2[2], o2[3]);
          }
        } else {
#pragma unroll
          for (int g = 0; g < 4; ++g)
            st4h(qd + 8 * g + 4 * hh, acc[mi][ni][4 * g] * sc, acc[mi][ni][4 * g + 1] * sc, acc[mi][ni][4 * g + 2] * sc, acc[mi][ni][4 * g + 3] * sc);
        }
      }
    }
  } else {
    int j2 = job - MT * 6;
    int nt = j2 / MT, mt = j2 - nt * MT;
    gemm_main<true>(p.Z() + ZMLA + 384, ZW, p.UKV(), 256, 256, mt * 128, nt * 128, 1024, smem, acc, rowsq);
    const int m0 = mt * 128;
    epi_quads(acc, m0, 0, [&](int m, int n, float v0, float v1, float v2, float v3) {
      const float sc = rsqrtf(rowsq[m - m0] * (1.f / 256.f) + 1e-6f);
      if (n < 64) st4h(p.K() + (size_t)m * 768 + nt * 96 + n, v0 * sc, v1 * sc, v2 * sc, v3 * sc);
      else {
        int b = m / SB, s = m - b * SB;
        h16* vt = p.VT() + ((size_t)(b * 8 + nt) * 64 + (n - 64)) * SB + s;
        vt[0] = (h16)(v0 * sc); vt[SB] = (h16)(v1 * sc); vt[2 * SB] = (h16)(v2 * sc); vt[3 * SB] = (h16)(v3 * sc);
      }
    });
    {
      int row = tid >> 1, sub = tid & 1;
      int m = m0 + row;
      int sp = m % SB;
      const h16* kr = p.Z() + (size_t)m * ZW + ZMLA + 640 + sub * 8;
      h16x8 x1 = *(const h16x8*)kr, x2 = *(const h16x8*)(kr + 16);
      h16* kd = p.K() + (size_t)m * 768 + nt * 96 + 64 + sub * 8;
      if (sp >= CTX) {
        const float* rp = p.ROPE() + (size_t)(sp - CTX) * 32 + sub * 8;
        h16x8 o1, o2;
#pragma unroll
        for (int i = 0; i < 8; ++i) {
          float a = (float)x1[i], b2 = (float)x2[i], cs = rp[i], sn = rp[16 + i];
          o1[i] = (h16)(a * cs - b2 * sn); o2[i] = (h16)(a * sn + b2 * cs);
        }
        *(h16x8*)kd = o1; *(h16x8*)(kd + 16) = o2;
      } else { *(h16x8*)kd = x1; *(h16x8*)(kd + 16) = x2; }
    }
  }
}

DEVI void lowrank_job(const P& p, int l, int job, char* smem) {
  constexpr int MT = NR / 128;
  int mat = job / (MT * 4), rem = job - mat * MT * 4;
  int nt = rem / MT, mt = rem - nt * MT;
  f32x16 acc[2][2]; zero_acc(acc);
  if (mat < 2) {
    const int dir = mat;
    gemm_main<false>(p.Z() + ZRW + 1536 + dir * 64, ZW, p.WUP() + (size_t)dir * 512 * 64, 64, 64, mt * 128, nt * 128, 512, smem, acc, nullptr);
    const float* w0 = p.w0 + ((size_t)l * 2 + dir) * 512;
    h16* dst = p.LW() + (size_t)dir * NR * 512;
    epi_quads(acc, mt * 128, nt * 128, [&](int m, int n, float v0, float v1, float v2, float v3) {
      float4 b = *(const float4*)(w0 + n);
      const float e = 0.6065306597126334f;
      st4h(dst + (size_t)m * 512 + n, sigm(v0 + b.x) * e, sigm(v1 + b.y) * e, sigm(v2 + b.z) * e, sigm(v3 + b.w) * e);
    });
  } else if (mat < 4) {
    const int dir = mat - 2;
    gemm_main<false>(p.Z() + ZRW + 1664 + dir * 64, ZW, p.AUP() + (size_t)dir * 512 * 64, 64, 64, mt * 128, nt * 128, 512, smem, acc, nullptr);
    const float* a0 = p.a0 + ((size_t)l * 2 + dir) * 512;
    h16* dst = p.AA() + (size_t)dir * NR * 512;
    epi_quads(acc, mt * 128, nt * 128, [&](int m, int n, float v0, float v1, float v2, float v3) {
      float4 b = *(const float4*)(a0 + n);
      st4h(dst + (size_t)m * 512 + n, sigm(v0 + b.x), sigm(v1 + b.y), sigm(v2 + b.z), sigm(v3 + b.w));
    });
  } else {
    gemm_main<false>(p.Z() + ZRW + 1792, ZW, p.GUP(), 128, 128, mt * 128, nt * 128, 512, smem, acc, nullptr);
    epi_quads(acc, mt * 128, nt * 128, [&](int m, int n, float v0, float v1, float v2, float v3) {
      st4h(p.G() + (size_t)m * 512 + n, v0, v1, v2, v3);
    });
  }
}

DEVI void attn_job(const P& p, int job, char* smem) {
  h16* Ks = (h16*)smem;
  h16* Vs = Ks + 2 * 64 * 104;
  const int tid = tidx(), lane = tid & 63, wv = tid >> 6, l31 = lane & 31, hh = lane >> 5;
  int b, h, q0, nk;
  if (job < 1024) { b = job >> 8; h = (job >> 5) & 7; q0 = b * SB + CTX + (job & 31) * 128; nk = SB; }
  else { int j = job - 1024; b = j >> 4; h = (j >> 1) & 7; q0 = b * SB + (j & 1) * 128; nk = CTX; }
  const int NKT = nk >> 6;
  const h16* Kg = p.K() + (size_t)(b * SB) * 768 + h * 96;
  const h16* Vg = p.VT() + (size_t)(b * 8 + h) * 64 * SB;
  h16x8 qf[6];
  {
    const h16* qp = p.Q() + (size_t)(q0 + wv * 32 + l31) * 768 + h * 96 + hh * 8;
#pragma unroll
    for (int ds = 0; ds < 6; ++ds) qf[ds] = *(const h16x8*)(qp + ds * 16);
  }
  uint4 pk0, pk1, pk2_, pv0, pv1, qk0, qk1, qk2_, qv0, qv1;
  int krow[3], kcol[3];
#pragma unroll
  for (int i = 0; i < 3; ++i) { int c = tid + 256 * i; krow[i] = c / 12; kcol[i] = (c - krow[i] * 12) * 8; }
  const int vrow = tid >> 3, vcol = (tid & 7) * 8;
  const h16* kp0 = Kg + (size_t)krow[0] * 768 + kcol[0];
  const h16* kp1 = Kg + (size_t)krow[1] * 768 + kcol[1];
  const h16* kp2 = Kg + (size_t)krow[2] * 768 + kcol[2];
  const h16* vp0 = Vg + (size_t)vrow * SB + vcol;
  const h16* vp1 = Vg + (size_t)(vrow + 32) * SB + vcol;
#define ALOAD(S, kt_) { S##k0 = *(const uint4*)(kp0 + (size_t)(kt_) * 64 * 768); S##k1 = *(const uint4*)(kp1 + (size_t)(kt_) * 64 * 768); \
    S##k2_ = *(const uint4*)(kp2 + (size_t)(kt_) * 64 * 768); S##v0 = *(const uint4*)(vp0 + (kt_) * 64); S##v1 = *(const uint4*)(vp1 + (kt_) * 64); }
#define ASTORE(S, buf_) { h16* kd = Ks + (buf_) * 64 * 104; h16* vd = Vs + (buf_) * 64 * 68; \
    *(uint4*)(kd + krow[0] * 104 + kcol[0]) = S##k0; *(uint4*)(kd + krow[1] * 104 + kcol[1]) = S##k1; *(uint4*)(kd + krow[2] * 104 + kcol[2]) = S##k2_; \
    *(uint2*)(vd + vrow * 68 + vcol) = make_uint2(S##v0.x, S##v0.y); *(uint2*)(vd + vrow * 68 + vcol + 4) = make_uint2(S##v0.z, S##v0.w); \
    *(uint2*)(vd + (vrow + 32) * 68 + vcol) = make_uint2(S##v1.x, S##v1.y); *(uint2*)(vd + (vrow + 32) * 68 + vcol + 4) = make_uint2(S##v1.z, S##v1.w); }
  f32x16 o0, o1;
#pragma unroll
  for (int r = 0; r < 16; ++r) { o0[r] = 0.f; o1[r] = 0.f; }
  float mrun = -1e30f, lsum = 0.f;
  auto compute = [&](int buf) {
    const h16* ks = Ks + buf * 64 * 104 + l31 * 104 + hh * 8;
    f32x16 s0, s1;
#pragma unroll
    for (int r = 0; r < 16; ++r) { s0[r] = 0.f; s1[r] = 0.f; }
#pragma unroll
    for (int ds = 0; ds < 6; ++ds) {
      h16x8 a0 = *(const h16x8*)(ks + ds * 16), a1 = *(const h16x8*)(ks + 32 * 104 + ds * 16);
      s0 = __builtin_amdgcn_mfma_f32_32x32x16_f16(a0, qf[ds], s0, 0, 0, 0);
      s1 = __builtin_amdgcn_mfma_f32_32x32x16_f16(a1, qf[ds], s1, 0, 0, 0);
    }
    float mx = s0[0];
#pragma unroll
    for (int r = 1; r < 16; ++r) mx = fmaxf(mx, s0[r]);
#pragma unroll
    for (int r = 0; r < 16; ++r) mx = fmaxf(mx, s1[r]);
    mx = fmaxf(mx, __shfl_xor(mx, 32));
    const float mnew = fmaxf(mrun, mx);
    const float alpha = __builtin_amdgcn_exp2f(mrun - mnew);
    mrun = mnew;
    float ps = 0.f;
#pragma unroll
    for (int r = 0; r < 16; ++r) { s0[r] = __builtin_amdgcn_exp2f(s0[r] - mnew); ps += s0[r]; }
#pragma unroll
    for (int r = 0; r < 16; ++r) { s1[r] = __builtin_amdgcn_exp2f(s1[r] - mnew); ps += s1[r]; }
    lsum = lsum * alpha + ps;
#pragma unroll
    for (int r = 0; r < 16; ++r) { o0[r] *= alpha; o1[r] *= alpha; }
    const h16* vs = Vs + buf * 64 * 68 + l31 * 68 + 4 * hh;
#pragma unroll
    for (int k2 = 0; k2 < 2; ++k2) {
#pragma unroll
      for (int s2 = 0; s2 < 2; ++s2) {
        uint4 pu;
        if (k2 == 0) { pu.x = pk2(s0[8 * s2], s0[8 * s2 + 1]); pu.y = pk2(s0[8 * s2 + 2], s0[8 * s2 + 3]); pu.z = pk2(s0[8 * s2 + 4], s0[8 * s2 + 5]); pu.w = pk2(s0[8 * s2 + 6], s0[8 * s2 + 7]); }
        else { pu.x = pk2(s1[8 * s2], s1[8 * s2 + 1]); pu.y = pk2(s1[8 * s2 + 2], s1[8 * s2 + 3]); pu.z = pk2(s1[8 * s2 + 4], s1[8 * s2 + 5]); pu.w = pk2(s1[8 * s2 + 6], s1[8 * s2 + 7]); }
        h16x8 pf = __builtin_bit_cast(h16x8, pu);
        const int kb = k2 * 32 + 16 * s2;
        uint2 va = *(const uint2*)(vs + kb), vb = *(const uint2*)(vs + kb + 8);
        uint2 vc = *(const uint2*)(vs + 32 * 68 + kb), vd = *(const uint2*)(vs + 32 * 68 + kb + 8);
        h16x8 vf0 = __builtin_bit_cast(h16x8, make_uint4(va.x, va.y, vb.x, vb.y));
        h16x8 vf1 = __builtin_bit_cast(h16x8, make_uint4(vc.x, vc.y, vd.x, vd.y));
        o0 = __builtin_amdgcn_mfma_f32_32x32x16_f16(vf0, pf, o0, 0, 0, 0);
        o1 = __builtin_amdgcn_mfma_f32_32x32x16_f16(vf1, pf, o1, 0, 0, 0);
      }
    }
  };
  ALOAD(p, 0);
  if (NKT > 1) ALOAD(q, 1);
  ASTORE(p, 0);
  if (NKT > 2) ALOAD(p, 2);
  __syncthreads();
  for (int kt = 0; kt < NKT; kt += 2) {
    compute(0);
    if (kt + 1 < NKT) ASTORE(q, 1);
    if (kt + 3 < NKT) ALOAD(q, kt + 3);
    __syncthreads();
    if (kt + 1 < NKT) {
      compute(1);
      if (kt + 2 < NKT) ASTORE(p, 0);
      if (kt + 4 < NKT) ALOAD(p, kt + 4);
      __syncthreads();
    }
  }
#undef ALOAD
#undef ASTORE
  const float ltot = lsum + __shfl_xor(lsum, 32);
  const float inv = 1.f / ltot;
  h16* yo = p.Z() + (size_t)(q0 + wv * 32 + l31) * ZW + ZMLA + h * 64 + 4 * hh;
#pragma unroll
  for (int g = 0; g < 4; ++g) {
    st4h(yo + 8 * g, o0[4 * g] * inv, o0[4 * g + 1] * inv, o0[4 * g + 2] * inv, o0[4 * g + 3] * inv);
    st4h(yo + 32 + 8 * g, o1[4 * g] * inv, o1[4 * g + 1] * inv, o1[4 * g + 2] * inv, o1[4 * g + 3] * inv);
  }
}

#if PROBE >= 200
__device__ unsigned long long g_tacc[4];
#endif
struct Slot { float w[64]; unsigned bke[64]; float vv[64]; h16 ah[4][64]; int yoff; int pad[3]; };
struct LSet { uint4 lw, a, k, v, r; float inv; int yoff; int vm; };
DEVI void scan_job(const P& p, int l, int job, char* smem, int rank) {
  constexpr int RGB = 4 / NSCAN_BPC;
  constexpr int NLD = (4 - RGB) * 64;
  static_assert(NLD == 128, "loader mapping assumes 128 loader threads");
  Slot* sl = (Slot*)smem;
  h16* ybuf = (h16*)(smem + 2 * 16 * sizeof(Slot));
  const int tid = tidx(), lane = tid & 63, wv = rank ? ((tid >> 6) ^ 2) : (tid >> 6);
  const int chain = job / NSCAN_BPC, part = job - chain * NSCAN_BPC;
  const int dir = chain >> 5, b = (chain >> 3) & 3, h = chain & 7;
  for (int i = tid; i < 32 * 128; i += 256) { int s = i >> 7, e = i & 127; sl[s].ah[2 + (e >> 6)][e & 63] = (h16)0.f; }
  if (wv >= RGB) {
    const int lt = (wv - RGB) * 64 + lane;
    const int st = lt >> 3, ca = lt & 7, c8 = ca * 8;
    const int pp0 = (ca >> 2) * 32 + (2 * (ca & 1)) * 8 + ((ca & 3) >> 1) * 4;
    const int pp1 = pp0 + 8;
    const float4 kkA = *(const float4*)(p.k_k + l * 512 + h * 64 + c8), kkB = *(const float4*)(p.k_k + l * 512 + h * 64 + c8 + 4);
    const float4 kaA = *(const float4*)(p.k_a + l * 512 + h * 64 + c8), kaB = *(const float4*)(p.k_a + l * 512 + h * 64 + c8 + 4);
    const h16* LWd = p.LW() + (size_t)dir * NR * 512 + h * 64 + c8;
    const h16* AAd = p.AA() + (size_t)dir * NR * 512 + h * 64 + c8;
    const h16* Zr = p.Z() + ZRW + h * 64 + c8;
#define LLOAD(ci_, g)                                                                                         \
    {                                                                                                         \
      const int n_ = (ci_) * 16 + st;                                                                         \
      const int rowm_ = maprow(dir, b, min(n_, SB - 1));                                                      \
      const int rowr_ = maprow(dir, b, min(max(n_ - 1, 0), SB - 1));                                          \
      g##_yoff = (n_ >= 1 && n_ <= SB) ? rowr_ * 512 : -1;                                                      \
      g##_vm = (n_ < SB) ? 1 : 0;                                                                               \
      const h16* p0_ = LWd + (size_t)rowm_ * 512; const h16* p1_ = AAd + (size_t)rowm_ * 512;                 \
      const h16* p2_ = Zr + (size_t)rowm_ * ZW + 512; const h16* p3_ = Zr + (size_t)rowm_ * ZW + 1024;        \
      const h16* p4_ = Zr + (size_t)rowr_ * ZW; const float* p5_ = p.INVN() + (size_t)rowm_ * 8 + h;          \
      asm volatile("global_load_dwordx4 %0, %1, off" : "=v"(g##_lw) : "v"(p0_) : "memory");                     \
      asm volatile("global_load_dwordx4 %0, %1, off" : "=v"(g##_a) : "v"(p1_) : "memory");                      \
      asm volatile("global_load_dwordx4 %0, %1, off" : "=v"(g##_k) : "v"(p2_) : "memory");                      \
      asm volatile("global_load_dwordx4 %0, %1, off" : "=v"(g##_v) : "v"(p3_) : "memory");                      \
      asm volatile("global_load_dwordx4 %0, %1, off" : "=v"(g##_r) : "v"(p4_) : "memory");                      \
      asm volatile("global_load_dword %0, %1, off" : "=v"(g##_inv) : "v"(p5_) : "memory");                      \
    }
#define LWAIT(g) asm volatile("s_waitcnt vmcnt(18)" : "+v"(g##_lw), "+v"(g##_a), "+v"(g##_k), "+v"(g##_v), "+v"(g##_r), "+v"(g##_inv) : : "memory")
    auto lstore = [&](uint4 g_lw, uint4 g_a, uint4 g_k, uint4 g_v, uint4 g_r, float g_inv, int g_yoff, int g_vm, int buf) {
      Slot& s = sl[buf * 16 + st];
      const h16x8 lw = __builtin_bit_cast(h16x8, g_lw), a = __builtin_bit_cast(h16x8, g_a), k = __builtin_bit_cast(h16x8, g_k), v = __builtin_bit_cast(h16x8, g_v);
      const float kkp[8] = {kkA.x, kkA.y, kkA.z, kkA.w, kkB.x, kkB.y, kkB.z, kkB.w};
      const float kap[8] = {kaA.x, kaA.y, kaA.z, kaA.w, kaB.x, kaB.y, kaB.z, kaB.w};
      const float vmf = g_vm ? 1.f : 0.f;
      const float inv = g_inv * vmf;
      float w8[8], v8[8], q8[8], r8[8]; unsigned be8[8];
      const h16x8 rh = __builtin_bit_cast(h16x8, g_r);
      const float rvalid = (g_yoff >= 0) ? 1.f : 0.f;
#pragma unroll
      for (int i = 0; i < 8; ++i) w8[i] = __expf(-(float)lw[i] * vmf);
      float P8[8];
#pragma unroll
      for (int i = 0; i < 8; ++i) P8[i] = w8[i];
#pragma unroll
      for (int d = 8; d < 64; d <<= 1) {
#pragma unroll
        for (int i = 0; i < 8; ++i) { const float t = __shfl_up(P8[i], d); if (lane >= d) P8[i] *= t; }
      }
#pragma unroll
      for (int i = 0; i < 8; ++i) {
        const float kf = (float)k[i] * vmf, af = (float)a[i];
        const float kkv = kf * kkp[i] * inv;
        const float rP = __builtin_amdgcn_rcpf(P8[i]);
        const float Pex = P8[i] * __builtin_amdgcn_rcpf(w8[i]);
        be8[i] = pk2n(kkv * af * rP, kf * (1.f + (af - 1.f) * kap[i]) * rP);
        v8[i] = (float)v[i] * vmf;
        q8[i] = kkv * Pex;
        r8[i] = (float)rh[i] * Pex * rvalid;
        w8[i] = P8[i];
      }
      const uint4 rr = make_uint4(pk2n(r8[0], r8[1]), pk2n(r8[2], r8[3]), pk2n(r8[4], r8[5]), pk2n(r8[6], r8[7]));
      *(float4*)(s.w + c8) = make_float4(w8[0], w8[1], w8[2], w8[3]); *(float4*)(s.w + c8 + 4) = make_float4(w8[4], w8[5], w8[6], w8[7]);
      *(uint4*)(s.bke + c8) = make_uint4(be8[0], be8[1], be8[2], be8[3]); *(uint4*)(s.bke + c8 + 4) = make_uint4(be8[4], be8[5], be8[6], be8[7]);
      *(float4*)(s.vv + c8) = make_float4(v8[0], v8[1], v8[2], v8[3]); *(float4*)(s.vv + c8 + 4) = make_float4(v8[4], v8[5], v8[6], v8[7]);
      *(uint2*)(&s.ah[0][pp0]) = make_uint2(pk2n(q8[0], q8[1]), pk2n(q8[2], q8[3]));
      *(uint2*)(&s.ah[0][pp1]) = make_uint2(pk2n(q8[4], q8[5]), pk2n(q8[6], q8[7]));
      *(uint2*)(&s.ah[1][pp0]) = make_uint2(rr.x, rr.y);
      *(uint2*)(&s.ah[1][pp1]) = make_uint2(rr.z, rr.w);
      if (ca == 0) s.yoff = g_yoff;
    };
    typedef unsigned u32x4 __attribute__((ext_vector_type(4)));
    u32x4 R0_lw, R0_a, R0_k, R0_v, R0_r, R1_lw, R1_a, R1_k, R1_v, R1_r, R2_lw, R2_a, R2_k, R2_v, R2_r, R3_lw, R3_a, R3_k, R3_v, R3_r;
    float R0_inv, R1_inv, R2_inv, R3_inv; int R0_yoff, R1_yoff, R2_yoff, R3_yoff, R0_vm, R1_vm, R2_vm, R3_vm;
#define U4(x) make_uint4((x)[0], (x)[1], (x)[2], (x)[3])
#define LST(g, buf_) lstore(U4(g##_lw), U4(g##_a), U4(g##_k), U4(g##_v), U4(g##_r), g##_inv, g##_yoff, g##_vm, buf_)
    asm volatile("s_waitcnt vmcnt(0)" ::: "memory");
    LLOAD(0, R0); LLOAD(1, R1); LLOAD(2, R2); LLOAD(3, R3);
    LWAIT(R0); LST(R0, 0); LLOAD(4, R0);
    __syncthreads();
    h16* yout = p.Y2() + (size_t)dir * NR * 512 + h * 64 + part * (RGB * 16) + ca * 4;
    auto ystore = [&](int cj) {
      const int n = cj * 16 + st;
      if (n >= 1 && n <= SB) {
        const h16* yb = ybuf + ((cj & 1) * 32 + ca * 4) * 24 + st;
        const unsigned short a0 = __builtin_bit_cast(unsigned short, yb[0]), a1 = __builtin_bit_cast(unsigned short, yb[24]);
        const unsigned short a2 = __builtin_bit_cast(unsigned short, yb[48]), a3 = __builtin_bit_cast(unsigned short, yb[72]);
        typedef unsigned u32x2 __attribute__((ext_vector_type(2)));
        u32x2 u; u[0] = (unsigned)a0 | ((unsigned)a1 << 16); u[1] = (unsigned)a2 | ((unsigned)a3 << 16);
        h16* yp = yout + (size_t)maprow(dir, b, n - 1) * 512;
        asm volatile("global_store_dwordx2 %0, %1, off" : : "v"(yp), "v"(u) : "memory");
      }
    };
    for (int ci = 0; ci < NCHUNK; ci += 4) {
      if (ci > 0) ystore(ci - 1);
      LWAIT(R1); if (ci + 1 < NCHUNK) LST(R1, 1); LLOAD(ci + 5, R1);
      __syncthreads();
      if (ci + 1 < NCHUNK) { ystore(ci); LWAIT(R2); if (ci + 2 < NCHUNK) LST(R2, 0); LLOAD(ci + 6, R2); __syncthreads(); }
      if (ci + 2 < NCHUNK) { ystore(ci + 1); LWAIT(R3); if (ci + 3 < NCHUNK) LST(R3, 1); LLOAD(ci + 7, R3); __syncthreads(); }
      if (ci + 3 < NCHUNK) { ystore(ci + 2); LWAIT(R0); if (ci + 4 < NCHUNK) LST(R0, 0); LLOAD(ci + 8, R0); __syncthreads(); }
    }
    ystore(NCHUNK - 1);
    asm volatile("s_waitcnt vmcnt(0)" ::: "memory");
#undef LST
#undef U4
#undef LLOAD
#undef LWAIT
  } else {
    const int c = lane & 15, hq = lane >> 4;
    const int rg = part * RGB + wv;
    const bool h0 = (hq == 0);
    f32x4 ST[4];
#pragma unroll
    for (int t = 0; t < 4; ++t) ST[t] = (f32x4){0.f, 0.f, 0.f, 0.f};
    __builtin_amdgcn_s_setprio(3);
    __syncthreads();
    for (int ci = 0; ci < NCHUNK; ++ci) {
      const int buf = ci & 1;
#if PROBE == 211
      const unsigned long long ct0 = __builtin_amdgcn_s_memrealtime();
#endif
      float yv[16];
      h16x8 rA0[2], rA1[2]; float rvv[2]; unsigned rbe[2][4];
      {
        const Slot& t = sl[buf * 16];
        rA0[0] = *(const h16x8*)(&t.ah[c & 3][8 * hq]); rA1[0] = *(const h16x8*)(&t.ah[c & 3][32 + 8 * hq]);
        rvv[0] = t.vv[rg * 16 + c];
#pragma unroll
        for (int tt = 0; tt < 4; ++tt) rbe[0][tt] = t.bke[16 * tt + c];
      }
#pragma unroll
      for (int s = 0; s < 16; ++s) {
        const int cur = s & 1, nxt = cur ^ 1;
        uint4 sh0, sh1;
        sh0.x = pk2(ST[0][0], ST[0][1]); sh0.y = pk2(ST[0][2], ST[0][3]); sh0.z = pk2(ST[1][0], ST[1][1]); sh0.w = pk2(ST[1][2], ST[1][3]);
        sh1.x = pk2(ST[2][0], ST[2][1]); sh1.y = pk2(ST[2][2], ST[2][3]); sh1.z = pk2(ST[3][0], ST[3][1]); sh1.w = pk2(ST[3][2], ST[3][3]);
        const f32x4 z4 = {0.f, 0.f, 0.f, 0.f};
        f32x4 acc0 = __builtin_amdgcn_mfma_f32_16x16x32_f16(rA0[cur], __builtin_bit_cast(h16x8, sh0), z4, 0, 0, 0);
        f32x4 acc1 = __builtin_amdgcn_mfma_f32_16x16x32_f16(rA1[cur], __builtin_bit_cast(h16x8, sh1), z4, 0, 0, 0);
        f32x4 pe[4];
        if ((s & 7) == 7) {
#pragma unroll
          for (int tt = 0; tt < 4; ++tt) pe[tt] = *(const f32x4*)(sl[buf * 16 + s].w + 16 * tt + 4 * hq);
        }
        if (s + 1 < 16) {
          const Slot& t = sl[buf * 16 + s + 1];
          rA0[nxt] = *(const h16x8*)(&t.ah[c & 3][8 * hq]); rA1[nxt] = *(const h16x8*)(&t.ah[c & 3][32 + 8 * hq]);
          rvv[nxt] = t.vv[rg * 16 + c];
#pragma unroll
          for (int tt = 0; tt < 4; ++tt) rbe[nxt][tt] = t.bke[16 * tt + c];
        }
        __builtin_amdgcn_sched_barrier(0);
        yv[s] = acc0[1] + acc1[1];
        const float sa = -(acc0[0] + acc1[0]);
        const uint4 bu = make_uint4(h0 ? pk2(sa, rvv[cur]) : 0u, 0u, 0u, 0u);
#pragma unroll
        for (int tt = 0; tt < 4; ++tt) {
          const uint4 au = make_uint4(h0 ? rbe[cur][tt] : 0u, 0u, 0u, 0u);
          ST[tt] = __builtin_amdgcn_mfma_f32_16x16x32_f16(__builtin_bit_cast(h16x8, au), __builtin_bit_cast(h16x8, bu), ST[tt], 0, 0, 0);
        }
        if ((s & 7) == 7) {
#pragma unroll
          for (int tt = 0; tt < 4; ++tt) ST[tt] = ST[tt] * pe[tt];
        }
      }
      if (lane < 16) {
        uint4 u0, u1;
        u0.x = pk2n(yv[0], yv[1]); u0.y = pk2n(yv[2], yv[3]); u0.z = pk2n(yv[4], yv[5]); u0.w = pk2n(yv[6], yv[7]);
        u1.x = pk2n(yv[8], yv[9]); u1.y = pk2n(yv[10], yv[11]); u1.z = pk2n(yv[12], yv[13]); u1.w = pk2n(yv[14], yv[15]);
        h16* yr = ybuf + (buf * 32 + wv * 16 + c) * 24;
        *(uint4*)yr = u0; *(uint4*)(yr + 8) = u1;
      }
#if PROBE == 210
      const unsigned long long bt0 = __builtin_amdgcn_s_memrealtime();
#endif
      __syncthreads();
#if PROBE == 210
      if (job == 0 && tid == 0) g_tacc[0] += __builtin_amdgcn_s_memrealtime() - bt0;
#endif
    }
    __builtin_amdgcn_s_setprio(0);
  }
}

DEVI void gla_pre_job(const P& p, int l, int job, char* smem) {
  typedef short bf16x8 __attribute__((ext_vector_type(8)));
  float* lg = (float*)smem;
  float* gku = lg + 64 * 65;
  float* gkb = gku + 1024;
  float* tot = gkb + 64;
  unsigned short* qb = (unsigned short*)(tot + 256);
  unsigned short* kb = qb + 64 * 72;
  h16* vt = (h16*)(kb + 64 * 72);
  const int tid = tidx(), lane = tid & 63, wv = tid >> 6, l31 = lane & 31, hh = lane >> 5;
  const int chain = job / 68, ci = job - chain * 68;
  const int dir = chain >> 4, b = (chain >> 2) & 3, h = chain & 3;
  for (int i = tid; i < 1024; i += 256) gku[i] = p.gk_up[(((size_t)l * 2 + dir) * 16 + (i >> 6)) * 256 + h * 64 + (i & 63)];
  if (tid < 64) gkb[tid] = p.gk_b[((size_t)l * 2 + dir) * 256 + h * 64 + tid];
  const int ri = tid >> 2, dq = tid & 3;
  const int row = maprow(dir, b, ci * 64 + ri);
  const h16* zr = p.Z() + (size_t)row * ZW;
  uint4 q0 = *(const uint4*)(zr + h * 64 + dq * 16), q1 = *(const uint4*)(zr + h * 64 + dq * 16 + 8);
  uint4 k0 = *(const uint4*)(zr + 256 + h * 64 + dq * 16), k1 = *(const uint4*)(zr + 256 + h * 64 + dq * 16 + 8);
  uint4 g0 = *(const uint4*)(zr + 1024 + dir * 16), g1 = *(const uint4*)(zr + 1024 + dir * 16 + 8);
  {
    const h16* zv = zr + 512 + h * 128 + dq * 32;
#pragma unroll
    for (int c = 0; c < 4; ++c) {
      h16x8 vv = *(const h16x8*)(zv + c * 8);
#pragma unroll
      for (int j = 0; j < 8; ++j) vt[(dq * 32 + c * 8 + j) * 72 + ri] = vv[j];
    }
  }
  __syncthreads();
  {
    h16x8 gh0 = __builtin_bit_cast(h16x8, g0), gh1 = __builtin_bit_cast(h16x8, g1);
    float gd[16];
#pragma unroll
    for (int j = 0; j < 8; ++j) { gd[j] = (float)gh0[j]; gd[8 + j] = (float)gh1[j]; }
#pragma unroll 4
    for (int dd = 0; dd < 16; ++dd) {
      const int d = dq * 16 + dd;
      float xx = gkb[d];
#pragma unroll
      for (int r = 0; r < 16; ++r) xx += gd[r] * gku[r * 64 + d];
      float ls = fminf(xx, 0.f) - __logf(1.f + __expf(-fabsf(xx)));
      lg[ri * 65 + d] = ls * (1.f / 16.f);
    }
  }
  __syncthreads();
  {
    const int d = tid & 63, part = tid >> 6;
    float run = 0.f;
#pragma unroll 4
    for (int ii = 0; ii < 16; ++ii) { const int i = part * 16 + ii; run += lg[i * 65 + d]; lg[i * 65 + d] = run; }
    tot[part * 64 + d] = run;
  }
  __syncthreads();
  {
    h16x8 qh0 = __builtin_bit_cast(h16x8, q0), qh1 = __builtin_bit_cast(h16x8, q1), kh0 = __builtin_bit_cast(h16x8, k0), kh1 = __builtin_bit_cast(h16x8, k1);
    const int part = ri >> 4;
    unsigned qp[8], kp[8];
#pragma unroll
    for (int j = 0; j < 8; ++j) {
      unsigned qq[2], kk2[2];
#pragma unroll
      for (int e = 0; e < 2; ++e) {
        const int dd = 2 * j + e, d = dq * 16 + dd;
        float off = 0.f;
        if (part > 0) off += tot[d];
        if (part > 1) off += tot[64 + d];
        if (part > 2) off += tot[128 + d];
        const float bb = lg[ri * 65 + d] + off;
        const float qv = dd < 8 ? (float)qh0[dd & 7] : (float)qh1[dd & 7];
        const float kv = dd < 8 ? (float)kh0[dd & 7] : (float)kh1[dd & 7];
        qq[e] = f2bf(qv * __expf(bb) * 0.125f);
        kk2[e] = f2bf(kv * __expf(-bb));
      }
      qp[j] = qq[0] | (qq[1] << 16); kp[j] = kk2[0] | (kk2[1] << 16);
    }
    const uint4 qa = make_uint4(qp[0], qp[1], qp[2], qp[3]), qc = make_uint4(qp[4], qp[5], qp[6], qp[7]);
    const uint4 ka = make_uint4(kp[0], kp[1], kp[2], kp[3]), kc = make_uint4(kp[4], kp[5], kp[6], kp[7]);
    *(uint4*)(qb + ri * 72 + dq * 16) = qa; *(uint4*)(qb + ri * 72 + dq * 16 + 8) = qc;
    *(uint4*)(kb + ri * 72 + dq * 16) = ka; *(uint4*)(kb + ri * 72 + dq * 16 + 8) = kc;
    unsigned short* qd = p.QIN() + ((size_t)dir * NR + row) * 256 + h * 64 + dq * 16;
    unsigned short* kd = p.KIN() + ((size_t)dir * NR + row) * 256 + h * 64 + dq * 16;
    *(uint4*)qd = qa; *(uint4*)(qd + 8) = qc;
    *(uint4*)kd = ka; *(uint4*)(kd + 8) = kc;
    if (tid < 64) p.DEC()[((size_t)chain * 68 + ci) * 64 + tid] = __expf(tot[tid] + tot[64 + tid] + tot[128 + tid] + tot[192 + tid]);
  }
  __syncthreads();
  const int it = wv & 1, jh = wv >> 1;
  f32x16 o0, o1;
#pragma unroll
  for (int r = 0; r < 16; ++r) { o0[r] = 0.f; o1[r] = 0.f; }
  bf16x8 qf[4];
#pragma unroll
  for (int ks = 0; ks < 4; ++ks) qf[ks] = *(const bf16x8*)(qb + (it * 32 + l31) * 72 + ks * 16 + hh * 8);
#pragma unroll
  for (int st = 0; st < 2; ++st) {
    if (st > it) continue;
    f32x16 at;
#pragma unroll
    for (int r = 0; r < 16; ++r) at[r] = 0.f;
#pragma unroll
    for (int ks = 0; ks < 4; ++ks) {
      bf16x8 kf = *(const bf16x8*)(kb + (st * 32 + l31) * 72 + ks * 16 + hh * 8);
      at = __builtin_amdgcn_mfma_f32_32x32x16_bf16(kf, qf[ks], at, 0, 0, 0);
    }
    if (st == it) {
#pragma unroll
      for (int r = 0; r < 16; ++r) { const int sl = (r & 3) + 8 * (r >> 2) + 4 * hh; if (sl > l31) at[r] = 0.f; }
    }
    const h16* vs = vt + (jh * 64 + l31) * 72 + st * 32 + 4 * hh;
#pragma unroll
    for (int s2 = 0; s2 < 2; ++s2) {
      uint4 pu;
      pu.x = pk2n(at[8 * s2], at[8 * s2 + 1]); pu.y = pk2n(at[8 * s2 + 2], at[8 * s2 + 3]);
      pu.z = pk2n(at[8 * s2 + 4], at[8 * s2 + 5]); pu.w = pk2n(at[8 * s2 + 6], at[8 * s2 + 7]);
      const h16x8 pf = __builtin_bit_cast(h16x8, pu);
      const uint2 va = *(const uint2*)(vs + 16 * s2), vb = *(const uint2*)(vs + 16 * s2 + 8);
      const uint2 vc = *(const uint2*)(vs + 32 * 72 + 16 * s2), vd = *(const uint2*)(vs + 32 * 72 + 16 * s2 + 8);
      o0 = __builtin_amdgcn_mfma_f32_32x32x16_f16(__builtin_bit_cast(h16x8, make_uint4(va.x, va.y, vb.x, vb.y)), pf, o0, 0, 0, 0);
      o1 = __builtin_amdgcn_mfma_f32_32x32x16_f16(__builtin_bit_cast(h16x8, make_uint4(vc.x, vc.y, vd.x, vd.y)), pf, o1, 0, 0, 0);
    }
  }
  {
    const int orow = maprow(dir, b, ci * 64 + it * 32 + l31);
    h16* od = p.OFB() + ((size_t)dir * NR + orow) * 512 + h * 128 + jh * 64 + 4 * hh;
#pragma unroll
    for (int g = 0; g < 4; ++g) {
      st4h(od + 8 * g, o0[4 * g], o0[4 * g + 1], o0[4 * g + 2], o0[4 * g + 3]);
      st4h(od + 32 + 8 * g, o1[4 * g], o1[4 * g + 1], o1[4 * g + 2], o1[4 * g + 3]);
    }
  }
  __syncthreads();
}

DEVI void gla_job(const P& p, int l, int job, char* smem) {
  float* qi = (float*)smem;
  float* ki = qi + 64 * 65;
  float* vs = ki + 64 * 65;
  float* Ss = vs + 64 * 33;
  const int tid = tidx();
  const int dvs = job & 3, chain = job >> 2;
  const int dir = chain >> 4, b = (chain >> 2) & 3, h = chain & 3;
  for (int i = tid; i < 64 * 33; i += 256) Ss[i] = 0.f;
  const int ri = tid >> 2, dq = tid & 3;
  const int t2 = tid >> 3, tj = tid & 7;
  h16* Od = p.OFB() + (size_t)dir * NR * 512 + h * 128 + dvs * 32;
  const unsigned short* Qg = p.QIN() + (size_t)dir * NR * 256 + h * 64 + dq * 16;
  const unsigned short* Kg = p.KIN() + (size_t)dir * NR * 256 + h * 64 + dq * 16;
  const float* Dg = p.DEC() + (size_t)chain * 68 * 64 + 2 * t2;
  uint4 gq0, gq1, gk0, gk1, gv; uint2 goa, gob; float gd0, gd1;
  auto pre = [&](int ci) {
    const int row = maprow(dir, b, ci * 64 + ri);
    gq0 = *(const uint4*)(Qg + (size_t)row * 256); gq1 = *(const uint4*)(Qg + (size_t)row * 256 + 8);
    gk0 = *(const uint4*)(Kg + (size_t)row * 256); gk1 = *(const uint4*)(Kg + (size_t)row * 256 + 8);
    gv = *(const uint4*)(p.Z() + (size_t)row * ZW + 512 + h * 128 + dvs * 32 + dq * 8);
    const int rowa = maprow(dir, b, ci * 64 + 2 * t2), rowb = maprow(dir, b, ci * 64 + 2 * t2 + 1);
    goa = *(const uint2*)(Od + (size_t)rowa * 512 + 4 * tj); gob = *(const uint2*)(Od + (size_t)rowb * 512 + 4 * tj);
    gd0 = Dg[ci * 64]; gd1 = Dg[ci * 64 + 1];
  };
  pre(0);
  __syncthreads();
  for (int ci = 0; ci < SB / 64; ++ci) {
    {
      const unsigned qa[8] = {gq0.x, gq0.y, gq0.z, gq0.w, gq1.x, gq1.y, gq1.z, gq1.w};
      const unsigned ka[8] = {gk0.x, gk0.y, gk0.z, gk0.w, gk1.x, gk1.y, gk1.z, gk1.w};
#pragma unroll
      for (int j = 0; j < 8; ++j) {
        qi[ri * 65 + dq * 16 + 2 * j] = __builtin_bit_cast(float, qa[j] << 16); qi[ri * 65 + dq * 16 + 2 * j + 1] = __builtin_bit_cast(float, qa[j] & 0xffff0000u);
        ki[ri * 65 + dq * 16 + 2 * j] = __builtin_bit_cast(float, ka[j] << 16); ki[ri * 65 + dq * 16 + 2 * j + 1] = __builtin_bit_cast(float, ka[j] & 0xffff0000u);
      }
      h16x8 vh = __builtin_bit_cast(h16x8, gv);
#pragma unroll
      for (int j = 0; j < 8; ++j) vs[ri * 33 + dq * 8 + j] = (float)vh[j];
    }
    const uint2 oia = goa, oib = gob; const float e0 = gd0, e1 = gd1;
    const int rowa = maprow(dir, b, ci * 64 + 2 * t2), rowb = maprow(dir, b, ci * 64 + 2 * t2 + 1);
    if (ci + 1 < SB / 64) pre(ci + 1);
    __syncthreads();
    {
      h16x4 ha = __builtin_bit_cast(h16x4, oia), hb = __builtin_bit_cast(h16x4, oib);
      float a0[4], a1[4];
#pragma unroll
      for (int y = 0; y < 4; ++y) { a0[y] = (float)ha[y]; a1[y] = (float)hb[y]; }
#pragma unroll 4
      for (int d = 0; d < 64; ++d) {
        const float x0 = qi[(2 * t2) * 65 + d], x1 = qi[(2 * t2 + 1) * 65 + d];
#pragma unroll
        for (int y = 0; y < 4; ++y) { const float v = Ss[d * 33 + 4 * tj + y]; a0[y] += x0 * v; a1[y] += x1 * v; }
      }
      st4h(Od + (size_t)rowa * 512 + 4 * tj, a0[0], a0[1], a0[2], a0[3]);
      st4h(Od + (size_t)rowb * 512 + 4 * tj, a1[0], a1[1], a1[2], a1[3]);
    }
    __syncthreads();
    {
      float a0[4], a1[4];
#pragma unroll
      for (int y = 0; y < 4; ++y) { a0[y] = Ss[(2 * t2) * 33 + 4 * tj + y]; a1[y] = Ss[(2 * t2 + 1) * 33 + 4 * tj + y]; }
#pragma unroll 4
      for (int s2 = 0; s2 < 64; ++s2) {
        const float x0 = ki[s2 * 65 + 2 * t2], x1 = ki[s2 * 65 + 2 * t2 + 1];
#pragma unroll
        for (int y = 0; y < 4; ++y) { const float v = vs[s2 * 33 + 4 * tj + y]; a0[y] += x0 * v; a1[y] += x1 * v; }
      }
#pragma unroll
      for (int y = 0; y < 4; ++y) { Ss[(2 * t2) * 33 + 4 * tj + y] = a0[y] * e0; Ss[(2 * t2 + 1) * 33 + 4 * tj + y] = a1[y] * e1; }
    }
    __syncthreads();
  }
}

DEVI void mixer_phase(const P& p, int l, char* smem, int cslot, int mode = 0, int role = -1, int rank = 0) {
  if (role < 0) role = blockIdx.x;
#if PROBE >= 200
  unsigned long long pt0 = __builtin_amdgcn_s_memrealtime();
#endif
  __shared__ int4 sjobv;
  int& sjob = sjobv.x;
  for (int j = role; j < NSCAN + NGLA; j += gridDim.x) {
    if (mode == 1 && j >= NSCAN) break;
    if (mode == 2 && j < NSCAN) continue;
    if (j < NSCAN) {
      scan_job(p, l, j, smem, 0);
    }
    else gla_job(p, l, j - NSCAN, smem);
    __syncthreads();
#if PROBE == 200
    if (role == 0 && tidx() == 0) g_tacc[0] += __builtin_amdgcn_s_memrealtime() - pt0;
#endif
#if PROBE == 201
    if (role == NSCAN && tidx() == 0) g_tacc[0] += __builtin_amdgcn_s_memrealtime() - pt0;
#endif
  }
  if (mode == 1) return;
  const int njobs = (l < DEPTH - 1) ? 1024 + 64 : 1024;
  while (true) {
    if (tidx() == 0) sjob = (int)atomicAdd(p.CTR() + cslot, 1u);
    __syncthreads();
    const int j = sjob;
    __syncthreads();
    if (j >= njobs) break;
    attn_job(p, j, smem);
  }
#if PROBE == 202
  if (role == 300 && tidx() == 0) g_tacc[0] += __builtin_amdgcn_s_memrealtime() - pt0;
#endif
}

DEVI void post_phase(const P& p, int l) {
  const int lane = tidx() & 63;
  const int wid = blockIdx.x * 4 + (tidx() >> 6), nw = gridDim.x * 4;
  const int c8 = lane * 8;
  for (int r = wid; r < NR; r += nw) {
    {
      h16* zr = p.Z() + (size_t)r * ZW + ZRW + c8;
      h16x8 yf = *(const h16x8*)(p.Y2() + (size_t)r * 512 + c8), yb = *(const h16x8*)(p.Y2() + (size_t)(NR + r) * 512 + c8);
      h16x8 rr = *(const h16x8*)zr, kk = *(const h16x8*)(zr + 512), vv = *(const h16x8*)(zr + 1024);
      h16x8 af = *(const h16x8*)(p.AA() + (size_t)r * 512 + c8), ab = *(const h16x8*)(p.AA() + (size_t)(NR + r) * 512 + c8);
      h16x8 gg = *(const h16x8*)(p.G() + (size_t)r * 512 + c8);
      float y[8], sm = 0.f;
#pragma unroll
      for (int i = 0; i < 8; ++i) { y[i] = (float)yf[i] + (float)yb[i]; sm += y[i]; }
      sm += __shfl_xor(sm, 1); sm += __shfl_xor(sm, 2); sm += __shfl_xor(sm, 4);
      const float mean = sm * (1.f / 64.f);
      float sq = 0.f;
#pragma unroll
      for (int i = 0; i < 8; ++i) { y[i] -= mean; sq += y[i] * y[i]; }
      sq += __shfl_xor(sq, 1); sq += __shfl_xor(sq, 2); sq += __shfl_xor(sq, 4);
      const float rs = rsqrtf(sq * (1.f / 64.f) + 64e-5f);
      const float* ka = p.k_a + l * 512 + c8; const float* rk = p.r_k + l * 512 + c8;
      const float* lg = p.rln_g + l * 512 + c8; const float* lb = p.rln_b + l * 512 + c8;
      float bs = 0.f;
#pragma unroll
      for (int i = 0; i < 8; ++i) {
        const float kf = (float)kk[i], kav = ka[i];
        const float ke = kf * (1.f + ((float)af[i] - 1.f) * kav) + kf * (1.f + ((float)ab[i] - 1.f) * kav);
        bs += (float)rr[i] * ke * rk[i];
      }
      bs += __shfl_xor(bs, 1); bs += __shfl_xor(bs, 2); bs += __shfl_xor(bs, 4);
      float o[8];
#pragma unroll
      for (int i = 0; i < 8; ++i) o[i] = (y[i] * rs * lg[i] + lb[i] + bs * (float)vv[i]) * (float)gg[i];
      uint4 u; u.x = pk2n(o[0], o[1]); u.y = pk2n(o[2], o[3]); u.z = pk2n(o[4], o[5]); u.w = pk2n(o[6], o[7]);
      *(uint4*)zr = u;
    }
    {
      h16x8 of = *(const h16x8*)(p.OFB() + (size_t)r * 512 + c8), ob = *(const h16x8*)(p.OFB() + (size_t)(NR + r) * 512 + c8);
      h16x8 og = *(const h16x8*)(p.Z() + (size_t)r * ZW + 1056 + c8);
      float o[8], sq = 0.f;
#pragma unroll
      for (int i = 0; i < 8; ++i) { o[i] = (float)of[i] + (float)ob[i]; sq += o[i] * o[i]; }
      sq += __shfl_xor(sq, 1); sq += __shfl_xor(sq, 2); sq += __shfl_xor(sq, 4); sq += __shfl_xor(sq, 8);
      const float rs = rsqrtf(sq * (1.f / 128.f) + 1e-6f);
      const float* ng = p.gla_ng + l * 128 + (c8 & 127);
#pragma unroll
      for (int i = 0; i < 8; ++i) { const float g = (float)og[i]; o[i] = o[i] * rs * ng[i] * (g * sigm(g)); }
      uint4 u; u.x = pk2n(o[0], o[1]); u.y = pk2n(o[2], o[3]); u.z = pk2n(o[4], o[5]); u.w = pk2n(o[6], o[7]);
      *(uint4*)(p.YA() + (size_t)r * ZW + c8) = u;
    }
  }
}

DEVI void merge_phase(const P& p, char* smem) {
  constexpr int MT = NR / 128, NT = 16;
  const int lane = tidx() & 63, wv = tidx() >> 6;
  const int wm = wv >> 1, wn = wv & 1, l31 = lane & 31, hh = lane >> 5;
  for (int job = blockIdx.x; job < MT * NT; job += gridDim.x) {
    int nt = job / MT, mt = job - nt * MT;
    float out[2][16];
#pragma unroll
    for (int a = 0; a < 2; ++a)
#pragma unroll
      for (int r = 0; r < 16; ++r) out[a][r] = 0.f;
#pragma unroll 1
    for (int br = 0; br < 3; ++br) {
      const h16* Y = br == 0 ? p.YA() : (br == 1 ? p.Z() + ZMLA : p.Z() + ZRW);
      const int ldy = ZW;
      f32x16 acc[2][1];
#pragma unroll
      for (int a = 0; a < 2; ++a)
#pragma unroll
        for (int r = 0; r < 16; ++r) acc[a][0][r] = 0.f;
      gemm_deep<1>(Y, ldy, p.WB() + (size_t)br * D * 512, 512, 512, mt * 128, nt * 64, D, smem, acc);
      float u[2][16];
#pragma unroll
      for (int a = 0; a < 2; ++a)
#pragma unroll
        for (int r = 0; r < 16; ++r) { u[a][r] = acc[a][0][r]; acc[a][0][r] = 0.f; }
      gemm_deep<1>(p.H(), D, p.WIN() + (size_t)(ZW + br * D) * D, D, D, mt * 128, nt * 64, D, smem, acc);
#pragma unroll
      for (int a = 0; a < 2; ++a)
#pragma unroll
        for (int r = 0; r < 16; ++r) out[a][r] += sigm(acc[a][0][r]) * u[a][r];
    }
#pragma unroll
    for (int a = 0; a < 2; ++a)
#pragma unroll
      for (int g = 0; g < 4; ++g)
        st4h(p.M() + (size_t)(mt * 128 + wm * 64 + a * 32 + l31) * D + nt * 64 + wn * 32 + 8 * g + 4 * hh, out[a][4 * g], out[a][4 * g + 1],
             out[a][4 * g + 2], out[a][4 * g + 3]);
  }
}

DEVI void resid_gemm_phase(const P& p, int l, const h16* A, int K, const h16* Bt, int gate_idx, char* smem) {
  constexpr int MT = NR / 128, NT = 8, T = MT * NT;
  const float alpha = 1.6817928305074290f;
  auto epi = [&](int m, int n, float v0, float v1, float v2, float v3) {
    int b = m / SB, s = m - b * SB;
    int g = s < CTX ? 4 : b;
    float4 gt = *(const float4*)(p.MOD() + ((size_t)l * 5 + g) * 6144 + gate_idx * D + n);
    float* xp = xrow(p, m) + n;
    float4 xv = *(float4*)xp;
    xv.x = alpha * xv.x + gt.x * v0; xv.y = alpha * xv.y + gt.y * v1; xv.z = alpha * xv.z + gt.z * v2; xv.w = alpha * xv.w + gt.w * v3;
    *(float4*)xp = xv;
  };
  const int G = gridDim.x, R = T / G, rem = T - R * G;
  const bool split_tail = (2 * rem <= G);
  const int nfull = split_tail ? R * G : T;
  for (int job = blockIdx.x; job < nfull; job += G) {
    int nt = job / MT, mt = job - nt * MT;
    f32x16 acc[2][2]; zero_acc(acc);
    gemm_deep<2>(A, K, Bt, K, K, mt * 128, nt * 128, D, smem, acc);
    epi_quads(acc, mt * 128, nt * 128, epi);
  }
  if (split_tail && (int)blockIdx.x < 2 * rem) {
    const int job = nfull + (blockIdx.x >> 1), half = blockIdx.x & 1;
    int nt = job / MT, mt = job - nt * MT;
    f32x16 acc[2][1];
#pragma unroll
    for (int a2 = 0; a2 < 2; ++a2)
#pragma unroll
      for (int r = 0; r < 16; ++r) acc[a2][0][r] = 0.f;
    const int n0 = nt * 128 + half * 64;
    gemm_deep<1>(A, K, Bt, K, K, mt * 128, n0, D, smem, acc);
    const int lane = tidx() & 63, wv = tidx() >> 6, wm = wv >> 1, wn = wv & 1, l31 = lane & 31, hh = lane >> 5;
#pragma unroll
    for (int a2 = 0; a2 < 2; ++a2)
#pragma unroll
      for (int g = 0; g < 4; ++g)
        epi(mt * 128 + wm * 64 + a2 * 32 + l31, n0 + wn * 32 + 8 * g + 4 * hh, acc[a2][0][4 * g], acc[a2][0][4 * g + 1], acc[a2][0][4 * g + 2], acc[a2][0][4 * g + 3]);
  }
}
DEVI void mlp1_phase(const P& p, char* smem) {
  constexpr int MT = NR / 128, NT = DFF / 128;
  h16* HID = p.Z();
  for (int job = blockIdx.x; job < MT * NT; job += gridDim.x) {
    int nt = job / MT, mt = job - nt * MT;
    f32x16 acc[2][2]; zero_acc(acc);
    gemm_deep<2>(p.H(), D, p.W1T(), D, D, mt * 128, nt * 128, DFF, smem, acc);
    epi_oct(acc, mt * 128, nt * 128, [](float x) { x = fmaxf(x, 0.f); return x * x; }, [&](int m, int n, uint4 u) {
      *(uint4*)(HID + (size_t)m * DFF + n) = u;
    });
  }
}

constexpr int PH_PER_LAYER = 11;
constexpr int NPHASES = 1 + DEPTH * PH_PER_LAYER + 1;

DEVI void run_phase(const P& p, int ph, char* smem, int role, int rank) {
  if (ph == 0) { phase0(p, smem); return; }
  if (ph == NPHASES - 1) { ln_phase(p, DEPTH, 2); return; }
  const int l = (ph - 1) / PH_PER_LAYER, k = (ph - 1) - l * PH_PER_LAYER;
  switch (k) {
    case 0: ln_phase(p, l, 0); conv_phase(p, l, 0, 12, smem); break;
    case 1: inproj_phase(p, smem);
#if PROBE == 2
      inproj_phase(p, smem);
#endif
      break;
    case 2: {
      constexpr int NPRE = 32 * 68, NSH = (NR / 64) * 8, NUP = (NR / 128) * 14;
      for (int j = blockIdx.x; j < NPRE + NSH + NUP; j += gridDim.x) {
        if (j < NPRE) gla_pre_job(p, l, j, smem);
        else if (j < NPRE + NSH) shift_job(p, l, j - NPRE, smem);
        else mla_up_job(p, j - NPRE - NSH, smem);
        __syncthreads();
      }
    } break;
    case 3: {
      constexpr int NLR = 5 * 4 * (NR / 128);
      for (int j = blockIdx.x; j < NLR; j += gridDim.x) { lowrank_job(p, l, j, smem); __syncthreads(); }
    } break;
    case 4: mixer_phase(p, l, smem, l, 0, role, rank);
#if PROBE == 1
      mixer_phase(p, l, smem, 8 + l);
#endif
      break;
    case 5: post_phase(p, l); break;
    case 6: merge_phase(p, smem); conv_phase(p, l, 12, 14, smem); break;
    case 7: resid_gemm_phase(p, l, p.M(), D, p.WO(), 2, smem); break;
    case 8: ln_phase(p, l, 1); break;
    case 9: mlp1_phase(p, smem);
#if PROBE == 2
      mlp1_phase(p, smem);
#endif
      break;
    default: resid_gemm_phase(p, l, p.Z(), DFF, p.W2T(), 5, smem); break;
  }
}

__global__ void __launch_bounds__(256, 2) mega(P p, int pb, int pe) {
  extern __shared__ __attribute__((aligned(16))) char smem[];
  cg::grid_group grid = cg::this_grid();
  __shared__ uint4 xb_words;
  if (threadIdx_x_raw() == 0) xb_words = make_uint4(0u, 0u, 0u, 0u);
  __syncthreads();
  XcdBarrier xb = xcd_barrier_post(p.BAR(), (volatile LAS unsigned*)&xb_words);
  __shared__ int4 rolev;
  unsigned* cut = p.BAR() + 3584;
  if (threadIdx_x_raw() == 0) {
    const unsigned key = (xb_xcc_id() << 8) | ((unsigned)__builtin_amdgcn_s_getreg((7 << 11) | (8 << 6) | 4) & 0xffu);
    const unsigned rank = xb_add(cut + key, 1u);
    if (rank == 0u) { const unsigned ord = xb_add(cut + 8192, 1u); __hip_atomic_store(cut + 4096 + key, ord, __ATOMIC_RELAXED, __HIP_MEMORY_SCOPE_AGENT); }
    if (rank >= 2u) xb_add(cut + 8193, 1u);
    rolev = make_int4((int)blockIdx.x, 0, (int)key, (int)rank);
  }
  __syncthreads();
#if PROBE >= 100
  unsigned long long tacc = 0;
#endif
#if PROBE >= 200
  if (blockIdx.x == 0 && threadIdx_x_raw() == 0) g_tacc[0] = 0;
#endif
  for (int ph = pb; ph < pe; ++ph) {
    if (ph > pb) {
      if (ph == pb + 1) {
        grid.sync();
        if (threadIdx_x_raw() == 0) {
          const unsigned key = (unsigned)rolev.z, rank = (unsigned)rolev.w;
          const unsigned ord = xb_ld(cut + 4096 + key), ncu = xb_ld(cut + 8192), bad = xb_ld(cut + 8193);
          if (bad == 0u && 2u * ncu == gridDim.x && rank < 2u && ncu >= 256u) {
            if (ord < 128u) rolev.x = rank == 0u ? (int)ord : (int)(256u + ord);
            else if (ord < 192u) rolev.x = (int)(128u + 2u * (ord - 128u) + rank);
            else rolev.x = (int)(384u + 2u * (ord - 192u) + rank);
            rolev.y = 1;
          }
        }
        __syncthreads();
      } else xcd_barrier(xb);
    }
#if PROBE == 6
    if (ph >= 1 && ph < NPHASES - 1 && ((ph - 1) % PH_PER_LAYER) == 4) {
      const int l = (ph - 1) / PH_PER_LAYER;
      mixer_phase(p, l, smem, l, 1);
      xcd_barrier(xb);
      mixer_phase(p, l, smem, l, 1);
      xcd_barrier(xb);
      mixer_phase(p, l, smem, l, 2);
      continue;
    }
#endif
#if PROBE >= 100
    const bool tph = (ph >= 1 && ph < NPHASES - 1 && ((ph - 1) % PH_PER_LAYER) == (PROBE - 100));
    unsigned long long t0 = 0;
    if (tph && blockIdx.x == 0) t0 = __builtin_amdgcn_s_memrealtime();
#endif
    run_phase(p, ph, smem, rolev.x, rolev.y);
#if PROBE >= 100
    if (tph) { xcd_barrier(xb); if (blockIdx.x == 0) tacc += __builtin_amdgcn_s_memrealtime() - t0; }
#endif
  }
#if PROBE >= 100
#if PROBE == 300
  if (blockIdx.x == 0) { const unsigned long long te = __builtin_amdgcn_s_memrealtime() + (rolev.w == 1000 ? 300000ull : (rolev.w == 2001 ? 600000ull : 900000ull)); while (__builtin_amdgcn_s_memrealtime() < te) __builtin_amdgcn_s_sleep(8); }
#elif PROBE >= 200
  {
    __syncthreads();
    const unsigned long long ta = g_tacc[0];
    if (ta) { const unsigned long long te = __builtin_amdgcn_s_memrealtime() + 4ull * ta; while (__builtin_amdgcn_s_memrealtime() < te) __builtin_amdgcn_s_sleep(8); }
  }
#else
  if (blockIdx.x == 0) { const unsigned long long te = __builtin_amdgcn_s_memrealtime() + 4ull * tacc; while (__builtin_amdgcn_s_memrealtime() < te) __builtin_amdgcn_s_sleep(8); }
#endif
#endif
}

extern "C" void kernel_launch(void* const* d_in, const int* in_sizes, int n_in, void* d_out, int out_size, void* d_ws,
                              size_t ws_size, hipStream_t stream) {
  static int grid_blocks = 0;
  if (grid_blocks == 0) {
    int dev = 0, cus = 0, per_cu = 0;
    hipGetDevice(&dev);
    hipDeviceGetAttribute(&cus, hipDeviceAttributeMultiprocessorCount, dev);
    hipFuncSetAttribute((const void*)mega, hipFuncAttributeMaxDynamicSharedMemorySize, LDS_BYTES);
    hipOccupancyMaxActiveBlocksPerMultiprocessor(&per_cu, (const void*)mega, 256, LDS_BYTES);
    if (per_cu < 1) per_cu = 1;
    if (per_cu > 2) per_cu = 2;
    grid_blocks = cus * per_cu;
    fprintf(stderr, "mega: cus %d per_cu %d grid %d\n", cus, per_cu, grid_blocks);
  }
  P p{};
  const float** ins = (const float**)&p;
  for (int i = 0; i < 33; ++i) ins[i] = (const float*)d_in[i];
  p.XL = (float*)d_out;
  p.ws = (char*)d_ws;
  const size_t off = WS_TOTAL;
  if (off > ws_size || n_in != 33) { fprintf(stderr, "mega: workspace too small (%zu > %zu) or n_in %d\n", off, ws_size, n_in); return; }
  (void)hipMemsetAsync((char*)d_ws + OFF_BAR, 0, BAR_BYTES, stream);
  int pb = 0, pe = NPHASES;
  void* args[] = {&p, &pb, &pe};
  hipError_t e = hipLaunchCooperativeKernel((const void*)mega, dim3(grid_blocks), dim3(256), args, LDS_BYTES, stream);
  if (e != hipSuccess) fprintf(stderr, "mega: cooperative launch failed: %s (grid %d)\n", hipGetErrorString(e), grid_blocks);
}
```

```cpp
#include <hip/hip_runtime.h>
#include <hip/hip_cooperative_groups.h>
#include <cstdio>
#include <cstdint>
namespace cg = cooperative_groups;

typedef _Float16 h16;
typedef _Float16 h16x8 __attribute__((ext_vector_type(8)));
typedef _Float16 h16x4 __attribute__((ext_vector_type(4)));
typedef float f32x16 __attribute__((ext_vector_type(16)));
typedef float f32x4 __attribute__((ext_vector_type(4)));

#define DEVI __device__ __forceinline__
DEVI int threadIdx_x_raw() { return (int)__builtin_amdgcn_workitem_id_x(); }

#define PROBE 0
constexpr int D = 1024, NB = 4, SEQ = 4096, CTX = 256, DEPTH = 4;
constexpr int SB = SEQ + CTX;
constexpr int NR = NB * SB;
constexpr int ZW = 4160;
constexpr int ZMLA = 1568, ZRW = 2240;
constexpr int NIN = 7232;
constexpr int DFF = 4096;
constexpr int LDS_BYTES = 74752;
constexpr int NSCAN_BPC = 2;
constexpr int NSCAN = 64 * NSCAN_BPC;
constexpr int NGLA = 128;
constexpr int TSTEPS = SB + 1;
constexpr int NCHUNK = (TSTEPS + 15) / 16;

constexpr size_t al256(size_t x) { return (x + 255) & ~(size_t)255; }
constexpr size_t OFF_XC = 0;
constexpr size_t OFF_MOD = OFF_XC + al256((size_t)NB * CTX * D * 4);
constexpr size_t OFF_ROPE = OFF_MOD + al256((size_t)DEPTH * 5 * 6144 * 4);
constexpr size_t OFF_INVN = OFF_ROPE + al256((size_t)SEQ * 32 * 4);
constexpr size_t OFF_CTR = OFF_INVN + al256((size_t)NR * 8 * 4);
constexpr size_t OFF_BAR = OFF_CTR + al256(256);
constexpr size_t BAR_BYTES = (size_t)(3584 + 4096 + 4096 + 64) * 4;
constexpr size_t OFF_HLO = OFF_BAR + al256(BAR_BYTES);
constexpr size_t OFF_HHI = OFF_HLO + al256((size_t)(NR / 64) * 1920 * 2);
constexpr size_t OFF_H = OFF_HHI + al256((size_t)(NR / 64) * 1920 * 2);
constexpr size_t OFF_Z = OFF_H + al256((size_t)NR * D * 2);
constexpr size_t OFF_WIN = OFF_Z + al256((size_t)NR * ZW * 2);
constexpr size_t OFF_UQ = OFF_WIN + al256((size_t)NIN * D * 2);
constexpr size_t OFF_UKV = OFF_UQ + al256((size_t)768 * 384 * 2);
constexpr size_t OFF_WB = OFF_UKV + al256((size_t)1024 * 256 * 2);
constexpr size_t OFF_WO = OFF_WB + al256((size_t)3 * D * 512 * 2);
constexpr size_t OFF_WUP = OFF_WO + al256((size_t)D * D * 2);
constexpr size_t OFF_AUP = OFF_WUP + al256((size_t)2 * 512 * 64 * 2);
constexpr size_t OFF_GUP = OFF_AUP + al256((size_t)2 * 512 * 64 * 2);
constexpr size_t OFF_LW = OFF_GUP + al256((size_t)512 * 128 * 2);
constexpr size_t OFF_AA = OFF_LW + al256((size_t)2 * NR * 512 * 2);
constexpr size_t OFF_G = OFF_AA + al256((size_t)2 * NR * 512 * 2);
constexpr size_t OFF_Y2 = OFF_G + al256((size_t)NR * 512 * 2);
constexpr size_t OFF_Q = OFF_Y2 + al256((size_t)2 * NR * 512 * 2);
constexpr size_t OFF_K = OFF_Q + al256((size_t)NR * 768 * 2);
constexpr size_t OFF_VT = OFF_K + al256((size_t)NR * 768 * 2);
constexpr size_t OFF_QIN = OFF_VT + al256((size_t)NR * 512 * 2);
constexpr size_t OFF_KIN = OFF_QIN + al256((size_t)2 * NR * 256 * 2);
constexpr size_t OFF_DEC = OFF_KIN + al256((size_t)2 * NR * 256 * 2);
constexpr size_t OFF_OFB = OFF_DEC + al256((size_t)32 * 68 * 64 * 4);
constexpr size_t WS_TOTAL = OFF_OFB + al256((size_t)2 * NR * 512 * 2);
struct P {
  const float *x, *c, *ctx, *c_ctx, *ada_w, *ada_b, *w_in, *gk_up, *gk_b, *gla_ng, *qn_g, *kvn_g, *w_uq, *w_ukv,
      *mu, *w0, *w_up, *a0, *a_up, *g_up, *k_k, *k_a, *r_k, *rln_g, *rln_b, *w_branch, *w_out, *ln1_g, *ln1_b,
      *w1, *w2, *ln2_g, *ln2_b;
  float* XL;
  char* ws;
  DEVI float* XC() const { return (float*)(ws + OFF_XC); }
  DEVI float* MOD() const { return (float*)(ws + OFF_MOD); }
  DEVI float* ROPE() const { return (float*)(ws + OFF_ROPE); }
  DEVI float* INVN() const { return (float*)(ws + OFF_INVN); }
  DEVI unsigned* CTR() const { return (unsigned*)(ws + OFF_CTR); }
  DEVI unsigned* BAR() const { return (unsigned*)(ws + OFF_BAR); }
  DEVI h16* HLO() const { return (h16*)(ws + OFF_HLO); }
  DEVI h16* HHI() const { return (h16*)(ws + OFF_HHI); }
  DEVI h16* H() const { return (h16*)(ws + OFF_H); }
  DEVI h16* Z() const { return (h16*)(ws + OFF_Z); }
  DEVI h16* WIN() const { return (h16*)(ws + OFF_WIN); }
  DEVI h16* UQ() const { return (h16*)(ws + OFF_UQ); }
  DEVI h16* UKV() const { return (h16*)(ws + OFF_UKV); }
  DEVI h16* WB() const { return (h16*)(ws + OFF_WB); }
  DEVI h16* WO() const { return (h16*)(ws + OFF_WO); }
  DEVI h16* WUP() const { return (h16*)(ws + OFF_WUP); }
  DEVI h16* AUP() const { return (h16*)(ws + OFF_AUP); }
  DEVI h16* GUP() const { return (h16*)(ws + OFF_GUP); }
  DEVI h16* LW() const { return (h16*)(ws + OFF_LW); }
  DEVI h16* AA() const { return (h16*)(ws + OFF_AA); }
  DEVI h16* G() const { return (h16*)(ws + OFF_G); }
  DEVI h16* Y2() const { return (h16*)(ws + OFF_Y2); }
  DEVI h16* Q() const { return (h16*)(ws + OFF_Q); }
  DEVI h16* K() const { return (h16*)(ws + OFF_K); }
  DEVI h16* VT() const { return (h16*)(ws + OFF_VT); }
  DEVI unsigned short* QIN() const { return (unsigned short*)(ws + OFF_QIN); }
  DEVI unsigned short* KIN() const { return (unsigned short*)(ws + OFF_KIN); }
  DEVI float* DEC() const { return (float*)(ws + OFF_DEC); }
  DEVI h16* OFB() const { return (h16*)(ws + OFF_OFB); }
  DEVI h16* W1T() const { return (h16*)(ws + OFF_LW); }
  DEVI h16* W2T() const { return (h16*)(ws + OFF_LW + (size_t)DFF * D * 2); }
  DEVI h16* M() const { return (h16*)(ws + OFF_Q); }
  DEVI h16* YA() const { return (h16*)(ws + OFF_Z + 1056 * 2); }
};

DEVI int tidx() { int t = threadIdx_x_raw(); asm volatile("" : "+v"(t)); return t; }
DEVI float wsum(float v) {
#pragma unroll
  for (int o = 32; o; o >>= 1) v += __shfl_xor(v, o);
  return v;
}
DEVI float sigm(float x) { return 1.f / (1.f + __expf(-x)); }
DEVI unsigned pk2(float a, float b) {
  auto h = __builtin_amdgcn_cvt_pkrtz(a, b);
  return __builtin_bit_cast(unsigned, h);
}
DEVI unsigned pk2n(float a, float b) {
  h16 x = (h16)a, y = (h16)b;
  unsigned short ux = __builtin_bit_cast(unsigned short, x), uy = __builtin_bit_cast(unsigned short, y);
  return (unsigned)ux | ((unsigned)uy << 16);
}
DEVI unsigned f2bf(float f) { unsigned u = __builtin_bit_cast(unsigned, f); u += 0x7fffu + ((u >> 16) & 1u); return u >> 16; }
DEVI float h2f(unsigned short u) { return (float)__builtin_bit_cast(h16, u); }
DEVI void st4h(h16* dst, float a, float b, float c, float d) {
  uint2 u; u.x = pk2n(a, b); u.y = pk2n(c, d);
  *(uint2*)dst = u;
}
DEVI float* xrow(const P& p, int r) {
  int b = r / SB, s = r - b * SB;
  return s < CTX ? p.XC() + (size_t)(b * CTX + s) * D : p.XL + (size_t)(b * SEQ + s - CTX) * D;
}
DEVI int maprow(int dir, int b, int n) {
  if (dir == 0) return b * SB + n;
  return n < CTX ? b * SB + (CTX - 1 - n) : b * SB + (SB + CTX - 1 - n);
}


#define XB_TMO      128
#define XB_XCNT(j)  (256  + 64 * (j))
#define XB_XSUB(j)  (1280 + 64 * (j))
#define XB_XGEN(j)  (2304 + 64 * (j))
#define XB_TOP      3328
#define XB_TOPGEN   3392
#define XCD_BAR_WORDS 3456
#define XB_SPIN_CAP (1u << 22)
#define LAS __attribute__((address_space(3)))
DEVI unsigned xb_ld(unsigned* p) { return __hip_atomic_load(p, __ATOMIC_RELAXED, __HIP_MEMORY_SCOPE_AGENT); }
DEVI unsigned xb_add(unsigned* p, unsigned v) { return __hip_atomic_fetch_add(p, v, __ATOMIC_RELAXED, __HIP_MEMORY_SCOPE_AGENT); }
DEVI unsigned xb_xcc_id() { return (unsigned)__builtin_amdgcn_s_getreg((3 << 11) | 20) & 0xFu; }
#define XB_SPIN(cond, bar) do { unsigned _sp = 0; while (cond) { __builtin_amdgcn_s_sleep(1); \
    if ((++_sp & 255u) == 0u) { if (xb_ld(&(bar)[XB_TMO])) break; if (_sp > XB_SPIN_CAP) { atomicAdd(&(bar)[XB_TMO], 1u); break; } } } } while (0)
struct XcdBarrier { unsigned* bar; unsigned x; volatile LAS unsigned* st; };
DEVI XcdBarrier xcd_barrier_post(unsigned* bar, volatile LAS unsigned* st) {
  XcdBarrier b; b.bar = bar; b.x = xb_xcc_id(); b.st = st;
  if (threadIdx_x_raw() == 0) (void)xb_add(&bar[XB_XCNT(b.x)], 1u);
  return b;
}
DEVI void xcd_barrier_complete(unsigned* bar, unsigned x, unsigned& nloc, unsigned& nx) {
  const unsigned G = gridDim.x;
  unsigned sum, cnt, mine, sp = 0u;
  for (;;) {
    sum = 0u; cnt = 0u; mine = 0u;
#pragma unroll
    for (unsigned j = 0; j < 16; ++j) { const unsigned c = xb_ld(&bar[XB_XCNT(j)]); sum += c; cnt += (c > 0u) ? 1u : 0u; mine = (j == x) ? c : mine; }
    if (sum == G) break;
    __builtin_amdgcn_s_sleep(1);
    if ((++sp & 255u) == 0u) { if (xb_ld(&bar[XB_TMO])) break; if (sp > XB_SPIN_CAP) { atomicAdd(&bar[XB_TMO], 1u); break; } }
  }
  nloc = mine > 0u ? mine : 1u; nx = cnt > 0u ? cnt : 1u;
}
DEVI void xcd_barrier(const XcdBarrier& b) {
  asm volatile("s_waitcnt vmcnt(0)" ::: "memory");
  __syncthreads();
  if (threadIdx_x_raw() == 0) {
    unsigned* bar = b.bar;
    __builtin_amdgcn_s_waitcnt(0);
    unsigned nloc = b.st[0], nx = b.st[1];
    if (nloc == 0u) { xcd_barrier_complete(bar, b.x, nloc, nx); b.st[0] = nloc; b.st[1] = nx; }
    const unsigned old = xb_add(&bar[XB_XSUB(b.x)], 1u);
    const unsigned gen = old / nloc;
    if (old + 1u == (gen + 1u) * nloc) {
      __builtin_amdgcn_fence(__ATOMIC_RELEASE, "agent");
      asm volatile("s_waitcnt vmcnt(0)" ::: "memory");
      const unsigned og = xb_add(&bar[XB_TOP], 1u);
      const unsigned tg = og / nx;
      if (og + 1u == (tg + 1u) * nx) xb_add(&bar[XB_TOPGEN], 1u);
      else XB_SPIN(xb_ld(&bar[XB_TOPGEN]) == tg, bar);
      __builtin_amdgcn_fence(__ATOMIC_ACQUIRE, "agent");
      xb_add(&bar[XB_XGEN(b.x)], 1u);
      asm volatile("s_waitcnt vmcnt(0)" ::: "memory");
    } else {
      XB_SPIN(xb_ld(&bar[XB_XGEN(b.x)]) == gen, bar);
      __builtin_amdgcn_fence(__ATOMIC_ACQUIRE, "agent");
      asm volatile("s_waitcnt vmcnt(0)" ::: "memory");
    }
  }
  __syncthreads();
}

DEVI void phase0(const P& p, char* smem) {
  const int tid = tidx();
  float* sc = (float*)smem;
  float* red = sc + 5 * 1024;
  for (int i = tid; i < 5 * 1024; i += 256) {
    int g = i >> 10, k = i & 1023;
    float v = g < 4 ? p.c[g * D + k] : p.c_ctx[k];
    sc[i] = v * sigm(v);
  }
  __syncthreads();
  for (int job = blockIdx.x; job < DEPTH * 96; job += gridDim.x) {
    int l = job / 96, n0 = (job % 96) * 64;
    int kq = tid >> 6, cc = tid & 63;
    const float* w = p.ada_w + ((size_t)l * D + kq * 256) * 6144 + n0 + cc;
    float a0 = 0, a1 = 0, a2 = 0, a3 = 0, a4 = 0;
#pragma unroll 8
    for (int k = 0; k < 256; ++k) {
      float wv = w[(size_t)k * 6144];
      int kk = kq * 256 + k;
      a0 += sc[kk] * wv; a1 += sc[1024 + kk] * wv; a2 += sc[2048 + kk] * wv; a3 += sc[3072 + kk] * wv; a4 += sc[4096 + kk] * wv;
    }
    red[(kq * 5 + 0) * 64 + cc] = a0; red[(kq * 5 + 1) * 64 + cc] = a1; red[(kq * 5 + 2) * 64 + cc] = a2;
    red[(kq * 5 + 3) * 64 + cc] = a3; red[(kq * 5 + 4) * 64 + cc] = a4;
    __syncthreads();
    for (int i = tid; i < 320; i += 256) {
      int g = i >> 6, c2 = i & 63;
      float s = red[(0 * 5 + g) * 64 + c2] + red[(1 * 5 + g) * 64 + c2] + red[(2 * 5 + g) * 64 + c2] + red[(3 * 5 + g) * 64 + c2];
      p.MOD()[((size_t)l * 5 + g) * 6144 + n0 + c2] = s + p.ada_b[l * 6144 + n0 + c2];
    }
    __syncthreads();
  }
  for (int i = blockIdx.x * 256 + tid; i < SEQ * 16; i += gridDim.x * 256) {
    int s = i >> 4, j = i & 15;
    float pos = (float)(j < 8 ? (s >> 6) : (s & 63));
    float inv = exp2f(-(float)(j & 7) * (13.287712379549449f / 8.f));
    float ang = pos * inv;
    p.ROPE()[s * 32 + j] = cosf(ang);
    p.ROPE()[s * 32 + 16 + j] = sinf(ang);
  }
  if (blockIdx.x == 0 && tid < 64) p.CTR()[tid] = 0;
}

struct CE { const float* src; h16* dst; const float* scale; int K, N; };
DEVI CE get_ce(const P& p, int l, int e) {
  CE c; c.scale = nullptr;
  switch (e) {
    case 0: c.src = p.w_in + (size_t)l * D * NIN; c.dst = p.WIN(); c.K = D; c.N = NIN; break;
    case 1: c.src = p.w_uq + (size_t)l * 384 * 768; c.dst = p.UQ(); c.K = 384; c.N = 768; c.scale = p.qn_g + l * 384; break;
    case 2: c.src = p.w_ukv + (size_t)l * 256 * 1024; c.dst = p.UKV(); c.K = 256; c.N = 1024; c.scale = p.kvn_g + l * 256; break;
    case 3: case 4: case 5: c.src = p.w_branch + ((size_t)l * 3 + (e - 3)) * 512 * D; c.dst = p.WB() + (size_t)(e - 3) * D * 512; c.K = 512; c.N = D; break;
    case 6: c.src = p.w_out + (size_t)l * D * D; c.dst = p.WO(); c.K = D; c.N = D; break;
    case 7: case 8: c.src = p.w_up + ((size_t)l * 2 + (e - 7)) * 64 * 512; c.dst = p.WUP() + (size_t)(e - 7) * 512 * 64; c.K = 64; c.N = 512; break;
    case 9: case 10: c.src = p.a_up + ((size_t)l * 2 + (e - 9)) * 64 * 512; c.dst = p.AUP() + (size_t)(e - 9) * 512 * 64; c.K = 64; c.N = 512; break;
    case 11: c.src = p.g_up + (size_t)l * 128 * 512; c.dst = p.GUP(); c.K = 128; c.N = 512; break;
    case 12: c.src = p.w1 + (size_t)l * D * DFF; c.dst = p.W1T(); c.K = D; c.N = DFF; break;
    default: c.src = p.w2 + (size_t)l * DFF * D; c.dst = p.W2T(); c.K = DFF; c.N = D; break;
  }
  return c;
}
DEVI void conv_tile(const CE& e, int tile, char* smem) {
  float* s = (float*)smem;
  const int tid = tidx();
  int ntn = e.N >> 6;
  int kt = tile / ntn, nt = tile - kt * ntn;
  {
    int r = tid >> 4, c4 = (tid & 15) * 4;
#pragma unroll
    for (int rr = 0; rr < 4; ++rr) {
      int k = r + 16 * rr;
      float4 v = *(const float4*)(e.src + (size_t)(kt * 64 + k) * e.N + nt * 64 + c4);
      float sc = e.scale ? e.scale[kt * 64 + k] : 1.f;
      s[k * 65 + c4 + 0] = v.x * sc; s[k * 65 + c4 + 1] = v.y * sc; s[k * 65 + c4 + 2] = v.z * sc; s[k * 65 + c4 + 3] = v.w * sc;
    }
  }
  __syncthreads();
  {
    int n = tid >> 2, kq = (tid & 3) * 16;
    uint4 u0, u1;
    u0.x = pk2n(s[(kq + 0) * 65 + n], s[(kq + 1) * 65 + n]); u0.y = pk2n(s[(kq + 2) * 65 + n], s[(kq + 3) * 65 + n]);
    u0.z = pk2n(s[(kq + 4) * 65 + n], s[(kq + 5) * 65 + n]); u0.w = pk2n(s[(kq + 6) * 65 + n], s[(kq + 7) * 65 + n]);
    u1.x = pk2n(s[(kq + 8) * 65 + n], s[(kq + 9) * 65 + n]); u1.y = pk2n(s[(kq + 10) * 65 + n], s[(kq + 11) * 65 + n]);
    u1.z = pk2n(s[(kq + 12) * 65 + n], s[(kq + 13) * 65 + n]); u1.w = pk2n(s[(kq + 14) * 65 + n], s[(kq + 15) * 65 + n]);
    h16* d = e.dst + (size_t)(nt * 64 + n) * e.K + kt * 64 + kq;
    *(uint4*)d = u0; *(uint4*)(d + 8) = u1;
  }
  __syncthreads();
}
DEVI void conv_phase(const P& p, int l, int e0, int e1, char* smem) {
  int total = 0;
  for (int e = e0; e < e1; ++e) { CE c = get_ce(p, l, e); total += (c.K >> 6) * (c.N >> 6); }
  for (int t = blockIdx.x; t < total; t += gridDim.x) {
    int tt = t;
    for (int e = e0; e < e1; ++e) {
      CE c = get_ce(p, l, e);
      int nt = (c.K >> 6) * (c.N >> 6);
      if (tt < nt) { conv_tile(c, tt, smem); break; }
      tt -= nt;
    }
  }
}

DEVI void ln_phase(const P& p, int l, int which) {
  const int lane = tidx() & 63;
  const int wid = blockIdx.x * 4 + (tidx() >> 6), nw = gridDim.x * 4;
  for (int r = wid; r < NR; r += nw) {
    int b = r / SB, s = r - b * SB;
    if (which == 2 && s < CTX) continue;
    int g = s < CTX ? 4 : b;
    float* xr = xrow(p, r);
    const float* src = xr;
    if (which == 0 && l == 0) src = s < CTX ? p.ctx + (size_t)(b * CTX + s) * D : p.x + (size_t)(b * SEQ + s - CTX) * D;
    float4 v[4];
#pragma unroll
    for (int i = 0; i < 4; ++i) v[i] = *(const float4*)(src + i * 256 + lane * 4);
    bool do_ln = !(which == 0 && l == 0);
    if (do_ln) {
      const float* gg = which == 1 ? p.ln1_g + l * D : p.ln2_g + (which == 2 ? 3 : l - 1) * D;
      const float* bb = which == 1 ? p.ln1_b + l * D : p.ln2_b + (which == 2 ? 3 : l - 1) * D;
      float sm = 0;
#pragma unroll
      for (int i = 0; i < 4; ++i) sm += v[i].x + v[i].y + v[i].z + v[i].w;
      float mean = wsum(sm) * (1.f / D);
      float sq = 0;
#pragma unroll
      for (int i = 0; i < 4; ++i) {
        v[i].x -= mean; v[i].y -= mean; v[i].z -= mean; v[i].w -= mean;
        sq += v[i].x * v[i].x + v[i].y * v[i].y + v[i].z * v[i].z + v[i].w * v[i].w;
      }
      float rs = rsqrtf(wsum(sq) * (1.f / D) + 1e-5f);
#pragma unroll
      for (int i = 0; i < 4; ++i) {
        float4 g4 = *(const float4*)(gg + i * 256 + lane * 4), b4 = *(const float4*)(bb + i * 256 + lane * 4);
        v[i].x = v[i].x * rs * g4.x + b4.x; v[i].y = v[i].y * rs * g4.y + b4.y;
        v[i].z = v[i].z * rs * g4.z + b4.z; v[i].w = v[i].w * rs * g4.w + b4.w;
      }
    }
#pragma unroll
    for (int i = 0; i < 4; ++i) *(float4*)(xr + i * 256 + lane * 4) = v[i];
    if (which == 2) continue;
    const float* shf = p.MOD() + ((size_t)l * 5 + g) * 6144 + (which == 0 ? 0 : 3) * D;
    const float* scl = shf + D;
    float sm = 0;
#pragma unroll
    for (int i = 0; i < 4; ++i) sm += v[i].x + v[i].y + v[i].z + v[i].w;
    float mean = wsum(sm) * (1.f / D);
    float sq = 0;
#pragma unroll
    for (int i = 0; i < 4; ++i) {
      v[i].x -= mean; v[i].y -= mean; v[i].z -= mean; v[i].w -= mean;
      sq += v[i].x * v[i].x + v[i].y * v[i].y + v[i].z * v[i].z + v[i].w * v[i].w;
    }
    float rs = rsqrtf(wsum(sq) * (1.f / D) + 1e-6f);
    h16* hr = p.H() + (size_t)r * D;
#pragma unroll
    for (int i = 0; i < 4; ++i) {
      float4 s4 = *(const float4*)(shf + i * 256 + lane * 4), c4 = *(const float4*)(scl + i * 256 + lane * 4);
      st4h(hr + i * 256 + lane * 4, v[i].x * rs * (1.f + c4.x) + s4.x, v[i].y * rs * (1.f + c4.y) + s4.y,
           v[i].z * rs * (1.f + c4.z) + s4.z, v[i].w * rs * (1.f + c4.w) + s4.w);
    }
  }
}

constexpr int GLD = 72;
template <bool ROWSQ, int NI = 2>
DEVI void gemm_main(const h16* __restrict__ A, int lda, const h16* __restrict__ Bt, int ldb, int K, int m0, int n0, int nmax,
                    char* smem, f32x16 (&acc)[2][NI], float* rowsq) {
  h16* As = (h16*)smem;
  h16* Bs = As + 2 * 128 * GLD;
  const int tid = tidx(), lane = tid & 63, wv = tid >> 6;
  const int wm = wv >> 1, wn = wv & 1, l31 = lane & 31, hh = lane >> 5;
  const int lrow = tid >> 3, lkc = (tid & 7) * 8;
  uint4 ga[4], gb[2 * NI];
  float sq[4] = {0.f, 0.f, 0.f, 0.f};
  const h16* Ap = A + (size_t)(m0 + lrow) * lda + lkc;
  const h16* Bp = Bt + (size_t)(n0 + lrow) * ldb + lkc;
#pragma unroll
  for (int i = 0; i < 4; ++i) ga[i] = *(const uint4*)(Ap + (size_t)(32 * i) * lda);
#pragma unroll
  for (int i = 0; i < 2 * NI; ++i)
    gb[i] = (n0 + lrow + 32 * i < nmax) ? *(const uint4*)(Bp + (size_t)(32 * i) * ldb) : make_uint4(0, 0, 0, 0);
  const int KT = K >> 6;
#pragma unroll
  for (int i = 0; i < 4; ++i) *(uint4*)(As + (lrow + 32 * i) * GLD + lkc) = ga[i];
#pragma unroll
  for (int i = 0; i < 2 * NI; ++i) *(uint4*)(Bs + (lrow + 32 * i) * GLD + lkc) = gb[i];
  __syncthreads();
  for (int kt = 0; kt < KT; ++kt) {
    const int buf = kt & 1;
    if (ROWSQ) {
#pragma unroll
      for (int i = 0; i < 4; ++i) {
        h16x8 hv = __builtin_bit_cast(h16x8, ga[i]);
#pragma unroll
        for (int j = 0; j < 8; ++j) { float f = (float)hv[j]; sq[i] += f * f; }
      }
    }
    if (kt + 1 < KT) {
#pragma unroll
      for (int i = 0; i < 4; ++i) ga[i] = *(const uint4*)(Ap + (size_t)(32 * i) * lda + (kt + 1) * 64);
#pragma unroll
      for (int i = 0; i < 2 * NI; ++i)
        gb[i] = (n0 + lrow + 32 * i < nmax) ? *(const uint4*)(Bp + (size_t)(32 * i) * ldb + (kt + 1) * 64) : make_uint4(0, 0, 0, 0);
    }
    const h16* as = As + buf * 128 * GLD + (wm * 64 + l31) * GLD + hh * 8;
    const h16* bs = Bs + buf * 128 * GLD + (wn * 32 * NI + l31) * GLD + hh * 8;
#pragma unroll
    for (int ks = 0; ks < 4; ++ks) {
      h16x8 a0 = *(const h16x8*)(as + ks * 16), a1 = *(const h16x8*)(as + 32 * GLD + ks * 16);
#pragma unroll
      for (int ni = 0; ni < NI; ++ni) {
        h16x8 b0 = *(const h16x8*)(bs + ni * 32 * GLD + ks * 16);
        acc[0][ni] = __builtin_amdgcn_mfma_f32_32x32x16_f16(b0, a0, acc[0][ni], 0, 0, 0);
        acc[1][ni] = __builtin_amdgcn_mfma_f32_32x32x16_f16(b0, a1, acc[1][ni], 0, 0, 0);
      }
    }
    if (kt + 1 < KT) {
      h16* ad = As + (buf ^ 1) * 128 * GLD;
      h16* bd = Bs + (buf ^ 1) * 128 * GLD;
#pragma unroll
      for (int i = 0; i < 4; ++i) *(uint4*)(ad + (lrow + 32 * i) * GLD + lkc) = ga[i];
#pragma unroll
      for (int i = 0; i < 2 * NI; ++i) *(uint4*)(bd + (lrow + 32 * i) * GLD + lkc) = gb[i];
    }
    __syncthreads();
  }
  if (ROWSQ) {
#pragma unroll
    for (int i = 0; i < 4; ++i) {
      float s = sq[i];
      s += __shfl_xor(s, 1); s += __shfl_xor(s, 2); s += __shfl_xor(s, 4);
      if ((tid & 7) == 0) rowsq[lrow + 32 * i] = s;
    }
    __syncthreads();
  }
}
template <int NI = 2>
DEVI void gemm_deep(const h16* __restrict__ A, int lda, const h16* __restrict__ Bt, int ldb, int K, int m0, int n0, int nmax,
                    char* smem, f32x16 (&acc)[2][NI]) {
  h16* As = (h16*)smem;
  h16* Bs = As + 2 * 128 * GLD;
  const int tid = tidx(), lane = tid & 63, wv = tid >> 6;
  const int wm = wv >> 1, wn = wv & 1, l31 = lane & 31, hh = lane >> 5;
  const int lrow = tid >> 3, lkc = (tid & 7) * 8;
  uint4 pa0, pa1, pa2, pa3, pb0, pb1, pb2, pb3;
  uint4 qa0, qa1, qa2, qa3, qb0, qb1, qb2, qb3;
  const h16* Ap = A + (size_t)(m0 + lrow) * lda + lkc;
  const int KT = K >> 6;
  const uint4 zz = make_uint4(0, 0, 0, 0);
  const h16* Bq0 = Bt + (size_t)min(n0 + lrow, nmax - 1) * ldb + lkc;
  const h16* Bq1 = Bt + (size_t)min(n0 + lrow + 32, nmax - 1) * ldb + lkc;
  const h16* Bq2 = Bt + (size_t)min(n0 + lrow + 64, nmax - 1) * ldb + lkc;
  const h16* Bq3 = Bt + (size_t)min(n0 + lrow + 96, nmax - 1) * ldb + lkc;
#define GLOAD(S, kt_)                                                                   \
  {                                                                                     \
    const h16* ap_ = Ap + (kt_) * 64;                                                   \
    S##a0 = *(const uint4*)(ap_); S##a1 = *(const uint4*)(ap_ + (size_t)32 * lda);      \
    S##a2 = *(const uint4*)(ap_ + (size_t)64 * lda); S##a3 = *(const uint4*)(ap_ + (size_t)96 * lda); \
    S##b0 = *(const uint4*)(Bq0 + (kt_) * 64); S##b1 = *(const uint4*)(Bq1 + (kt_) * 64); \
    if (NI == 2) { S##b2 = *(const uint4*)(Bq2 + (kt_) * 64); S##b3 = *(const uint4*)(Bq3 + (kt_) * 64); } \
  }
#define LSTORE(S, buf_)                                                                 \
  {                                                                                     \
    h16* ad = As + (buf_) * 128 * GLD + lrow * GLD + lkc;                               \
    h16* bd = Bs + (buf_) * 128 * GLD + lrow * GLD + lkc;                               \
    *(uint4*)(ad) = S##a0; *(uint4*)(ad + 32 * GLD) = S##a1; *(uint4*)(ad + 64 * GLD) = S##a2; *(uint4*)(ad + 96 * GLD) = S##a3; \
    *(uint4*)(bd) = S##b0; *(uint4*)(bd + 32 * GLD) = S##b1;                            \
    if (NI == 2) { *(uint4*)(bd + 64 * GLD) = S##b2; *(uint4*)(bd + 96 * GLD) = S##b3; } \
  }
#define COMPUTE(buf_)                                                                                              \
  {                                                                                                                \
    const h16* as = As + (buf_) * 128 * GLD + (wm * 64 + l31) * GLD + hh * 8;                                      \
    const h16* bs = Bs + (buf_) * 128 * GLD + (wn * 32 * NI + l31) * GLD + hh * 8;                                 \
    _Pragma("unroll") for (int ks = 0; ks < 4; ++ks) {                                                             \
      h16x8 a0 = *(const h16x8*)(as + ks * 16), a1 = *(const h16x8*)(as + 32 * GLD + ks * 16);                     \
      _Pragma("unroll") for (int ni = 0; ni < NI; ++ni) {                                                          \
        h16x8 b0 = *(const h16x8*)(bs + ni * 32 * GLD + ks * 16);                                                  \
        acc[0][ni] = __builtin_amdgcn_mfma_f32_32x32x16_f16(b0, a0, acc[0][ni], 0, 0, 0);                          \
        acc[1][ni] = __builtin_amdgcn_mfma_f32_32x32x16_f16(b0, a1, acc[1][ni], 0, 0, 0);                          \
      }                                                                                                            \
    }                                                                                                              \
  }
  pb2 = zz; pb3 = zz; qb2 = zz; qb3 = zz;
  GLOAD(p, 0);
  GLOAD(q, 1);
  LSTORE(p, 0);
  if (KT > 2) GLOAD(p, 2);
  __syncthreads();
  for (int kt = 0; kt < KT; kt += 2) {
    COMPUTE(0);
    if (kt + 1 < KT) LSTORE(q, 1);
    if (kt + 3 < KT) GLOAD(q, kt + 3);
    __syncthreads();
    if (kt + 1 < KT) {
      COMPUTE(1);
      if (kt + 2 < KT) LSTORE(p, 0);
      if (kt + 4 < KT) GLOAD(p, kt + 4);
      __syncthreads();
    }
  }
#undef GLOAD
#undef LSTORE
#undef COMPUTE
}
DEVI void zero_acc(f32x16 (&acc)[2][2]) {
#pragma unroll
  for (int i = 0; i < 2; ++i)
#pragma unroll
    for (int j = 0; j < 2; ++j)
#pragma unroll
      for (int r = 0; r < 16; ++r) acc[i][j][r] = 0.f;
}
template <class F>
DEVI void epi_quads(const f32x16 (&acc)[2][2], int m0, int n0, F f) {
  const int lane = tidx() & 63, wv = tidx() >> 6;
  const int wm = wv >> 1, wn = wv & 1, l31 = lane & 31, hh = lane >> 5;
#pragma unroll
  for (int mi = 0; mi < 2; ++mi)
#pragma unroll
    for (int ni = 0; ni < 2; ++ni)
#pragma unroll
      for (int g = 0; g < 4; ++g)
        f(m0 + wm * 64 + mi * 32 + l31, n0 + wn * 64 + ni * 32 + 8 * g + 4 * hh, acc[mi][ni][4 * g], acc[mi][ni][4 * g + 1],
          acc[mi][ni][4 * g + 2], acc[mi][ni][4 * g + 3]);
}


template <class T, class F>
DEVI void epi_oct(const f32x16 (&acc)[2][2], int m0, int n0, T tr, F f) {
  const int lane = tidx() & 63, wv = tidx() >> 6;
  const int wm = wv >> 1, wn = wv & 1, l31 = lane & 31, hh = lane >> 5;
#pragma unroll
  for (int mi = 0; mi < 2; ++mi)
#pragma unroll
    for (int ni = 0; ni < 2; ++ni)
#pragma unroll
      for (int j = 0; j < 2; ++j) {
        const int ga = 8 * j, gb = 8 * j + 4;
        const int ca = n0 + wn * 64 + ni * 32 + 16 * j + 4 * hh, cb = ca + 8;
        const unsigned a0 = pk2n(tr(acc[mi][ni][ga], ca), tr(acc[mi][ni][ga + 1], ca + 1)), a1 = pk2n(tr(acc[mi][ni][ga + 2], ca + 2), tr(acc[mi][ni][ga + 3], ca + 3));
        const unsigned b0 = pk2n(tr(acc[mi][ni][gb], cb), tr(acc[mi][ni][gb + 1], cb + 1)), b1 = pk2n(tr(acc[mi][ni][gb + 2], cb + 2), tr(acc[mi][ni][gb + 3], cb + 3));
        auto r0 = __builtin_amdgcn_permlane32_swap(a0, b0, false, false);
        auto r1 = __builtin_amdgcn_permlane32_swap(a1, b1, false, false);
        f(m0 + wm * 64 + mi * 32 + l31, n0 + wn * 64 + ni * 32 + 16 * j + 8 * hh, make_uint4(r0[0], r1[0], r0[1], r1[1]));
      }
}

DEVI void inproj_phase(const P& p, char* smem) {
  constexpr int MT = NR / 128, NT = (ZW + 127) / 128;
  for (int job = blockIdx.x; job < MT * NT; job += gridDim.x) {
    int nt = job / MT, mt = job - nt * MT;
    f32x16 acc[2][2]; zero_acc(acc);
    gemm_deep<2>(p.H(), D, p.WIN(), D, D, mt * 128, nt * 128, ZW, smem, acc);
    epi_oct(acc, mt * 128, nt * 128, [](float x, int) { return x; }, [&](int m, int n, uint4 u) {
      if (n < ZW) {
        *(uint4*)(p.Z() + (size_t)m * ZW + n) = u;
        if (n >= ZRW) {
          if ((m & 63) == 0) *(uint4*)(p.HLO() + (size_t)(m >> 6) * 1920 + n - ZRW) = u;
          if ((m & 63) == 63) *(uint4*)(p.HHI() + (size_t)(m >> 6) * 1920 + n - ZRW) = u;
        }
      }
    });
  }
}

DEVI void shift_job(const P& p, int l, int jj, char* smem) {
  const int j = jj >> 3, slab0 = jj & 7;
  h16* raw = (h16*)smem;
  const int tid = tidx(), lane = tid & 63;
  const int r0 = j * 64;
  const int s0 = r0 % SB;
  const bool first = (s0 == 0) || (s0 == CTX);
  const bool last = (s0 + 64 == CTX) || (s0 + 64 == SB);
  for (int slab = slab0; slab <= slab0; ++slab) {
    const int c0 = slab * 256;
    const int ncols = slab == 7 ? 128 : 256;
    const int cpr = ncols >> 3;
    for (int c = tid; c < 66 * cpr; c += 256) {
      int row = c / cpr, ch = (c - row * cpr) * 8;
      uint4 v = make_uint4(0, 0, 0, 0);
      if (row == 0) { if (!first) v = *(const uint4*)(p.HHI() + (size_t)(j - 1) * 1920 + c0 + ch); }
      else if (row == 65) { if (!last) v = *(const uint4*)(p.HLO() + (size_t)(j + 1) * 1920 + c0 + ch); }
      else v = *(const uint4*)(p.Z() + (size_t)(r0 + row - 1) * ZW + ZRW + c0 + ch);
      *(uint4*)(raw + row * 264 + ch) = v;
    }
    __syncthreads();
    if (tid < ncols) {
      const int col = c0 + tid;
      const float mup = p.mu[(size_t)l * 2 * 1920 + col], mun = p.mu[(size_t)l * 2 * 1920 + 1920 + col];
      const bool isk = (col >= 512 && col < 1024);
      const float kkp = isk ? p.k_k[l * 512 + col - 512] : 0.f;
      float prev = (float)raw[tid], cur = (float)raw[264 + tid];
      h16* zc = p.Z() + (size_t)r0 * ZW + ZRW + col;
      for (int t = 0; t < 64; ++t) {
        float nxt = (float)raw[(t + 2) * 264 + tid];
        float o = cur + mup * (prev - cur) + mun * (nxt - cur);
        float ov = o;
        if (col >= 1536 && col < 1664) ov = tanhf(o);
        else if (col >= 1792) ov = sigm(o);
        zc[(size_t)t * ZW] = (h16)ov;
        if (isk) {
          float q = o * kkp;
          float ss = wsum(q * q);
          if (lane == 0) p.INVN()[(size_t)(r0 + t) * 8 + ((col - 512) >> 6)] = rsqrtf(ss + 1e-12f);
        }
        prev = cur; cur = nxt;
      }
    }
    __syncthreads();
  }
}

DEVI void mla_up_job(const P& p, int job, char* smem) {
  constexpr int MT = NR / 128;
  float* rowsq = (float*)(smem + 2 * 2 * 128 * GLD * 2);
  const int tid = tidx();
  f32x16 acc[2][2]; zero_acc(acc);
  if (job < MT * 6) {
    int nt = job / MT, mt = job - nt * MT;
    gemm_main<true>(p.Z() + ZMLA, ZW, p.UQ(), 384, 384, mt * 128, nt * 128, 768, smem, acc, rowsq);
    const int m0 = mt * 128, n0 = nt * 128;
    const int lane = tid & 63, wv = tid >> 6, wm = wv >> 1, wn = wv & 1, l31 = lane & 31, hh = lane >> 5;
    const float qs = 0.10206207261596575f * 1.4426950408889634f;
#pragma unroll
    for (int mi = 0; mi < 2; ++mi) {
      const int ml = wm * 64 + mi * 32 + l31, m = m0 + ml;
      const float sc = rsqrtf(rowsq[ml] * (1.f / 384.f) + 1e-6f) * qs;
      const int sp = m % SB;
      const bool lat = sp >= CTX;
      const float* rp = p.ROPE() + (size_t)(lat ? sp - CTX : 0) * 32;
#pragma unroll
      for (int ni = 0; ni < 2; ++ni) {
        const int nb = n0 + wn * 64 + ni * 32;
        h16* qd = p.Q() + (size_t)m * 768 + nb;
        const bool ropet = (nb % 96) == 64;
        if (ropet && lat) {
#pragma unroll
          for (int g = 0; g < 2; ++g) {
            float o1[4], o2[4];
#pragma unroll
            for (int jj = 0; jj < 4; ++jj) {
              int i = 8 * g + 4 * hh + jj;
              float x1 = acc[mi][ni][4 * g + jj] * sc, x2 = acc[mi][ni][4 * (g + 2) + jj] * sc;
              float cs = rp[i], sn = rp[16 + i];
              o1[jj] = x1 * cs - x2 * sn; o2[jj] = x1 * sn + x2 * cs;
            }
            st4h(qd + 8 * g + 4 * hh, o1[0], o1[1], o1[2], o1[3]);
            st4h(qd + 16 + 8 * g + 4 * hh, o2[0], o2[1], o2[2], o2[3]);
          }
        } else {
#pragma unroll
          for (int g = 0; g < 4; ++g)
            st4h(qd + 8 * g + 4 * hh, acc[mi][ni][4 * g] * sc, acc[mi][ni][4 * g + 1] * sc, acc[mi][ni][4 * g + 2] * sc, acc[mi][ni][4 * g + 3] * sc);
        }
      }
    }
  } else {
    int j2 = job - MT * 6;
    int nt = j2 / MT, mt = j2 - nt * MT;
    gemm_main<true>(p.Z() + ZMLA + 384, ZW, p.UKV(), 256, 256, mt * 128, nt * 128, 1024, smem, acc, rowsq);
    const int m0 = mt * 128;
    epi_quads(acc, m0, 0, [&](int m, int n, float v0, float v1, float v2, float v3) {
      const float sc = rsqrtf(rowsq[m - m0] * (1.f / 256.f) + 1e-6f);
      if (n < 64) st4h(p.K() + (size_t)m * 768 + nt * 96 + n, v0 * sc, v1 * sc, v2 * sc, v3 * sc);
      else {
        int b = m / SB, s = m - b * SB;
        h16* vt = p.VT() + ((size_t)(b * 8 + nt) * 64 + (n - 64)) * SB + s;
        vt[0] = (h16)(v0 * sc); vt[SB] = (h16)(v1 * sc); vt[2 * SB] = (h16)(v2 * sc); vt[3 * SB] = (h16)(v3 * sc);
      }
    });
    {
      int row = tid >> 1, sub = tid & 1;
      int m = m0 + row;
      int sp = m % SB;
      const h16* kr = p.Z() + (size_t)m * ZW + ZMLA + 640 + sub * 8;
      h16x8 x1 = *(const h16x8*)kr, x2 = *(const h16x8*)(kr + 16);
      h16* kd = p.K() + (size_t)m * 768 + nt * 96 + 64 + sub * 8;
      if (sp >= CTX) {
        const float* rp = p.ROPE() + (size_t)(sp - CTX) * 32 + sub * 8;
        h16x8 o1, o2;
#pragma unroll
        for (int i = 0; i < 8; ++i) {
          float a = (float)x1[i], b2 = (float)x2[i], cs = rp[i], sn = rp[16 + i];
          o1[i] = (h16)(a * cs - b2 * sn); o2[i] = (h16)(a * sn + b2 * cs);
        }
        *(h16x8*)kd = o1; *(h16x8*)(kd + 16) = o2;
      } else { *(h16x8*)kd = x1; *(h16x8*)(kd + 16) = x2; }
    }
  }
}

DEVI void lowrank_job(const P& p, int l, int job, char* smem) {
  constexpr int MT = NR / 128;
  int mat = job / (MT * 4), rem = job - mat * MT * 4;
  int nt = rem / MT, mt = rem - nt * MT;
  f32x16 acc[2][2]; zero_acc(acc);
  if (mat < 2) {
    const int dir = mat;
    gemm_main<false>(p.Z() + ZRW + 1536 + dir * 64, ZW, p.WUP() + (size_t)dir * 512 * 64, 64, 64, mt * 128, nt * 128, 512, smem, acc, nullptr);
    const float* w0 = p.w0 + ((size_t)l * 2 + dir) * 512;
    h16* dst = p.LW() + (size_t)dir * NR * 512;
    epi_oct(acc, mt * 128, nt * 128, [&](float x, int n) { return sigm(x + w0[n]) * 0.6065306597126334f; },
            [&](int m, int n, uint4 u) { *(uint4*)(dst + (size_t)m * 512 + n) = u; });
  } else if (mat < 4) {
    const int dir = mat - 2;
    gemm_main<false>(p.Z() + ZRW + 1664 + dir * 64, ZW, p.AUP() + (size_t)dir * 512 * 64, 64, 64, mt * 128, nt * 128, 512, smem, acc, nullptr);
    const float* a0 = p.a0 + ((size_t)l * 2 + dir) * 512;
    h16* dst = p.AA() + (size_t)dir * NR * 512;
    epi_oct(acc, mt * 128, nt * 128, [&](float x, int n) { return sigm(x + a0[n]); },
            [&](int m, int n, uint4 u) { *(uint4*)(dst + (size_t)m * 512 + n) = u; });
  } else {
    gemm_main<false>(p.Z() + ZRW + 1792, ZW, p.GUP(), 128, 128, mt * 128, nt * 128, 512, smem, acc, nullptr);
    epi_oct(acc, mt * 128, nt * 128, [](float x, int) { return x; },
            [&](int m, int n, uint4 u) { *(uint4*)(p.G() + (size_t)m * 512 + n) = u; });
  }
}

DEVI void attn_job(const P& p, int job, char* smem) {
  h16* Ks = (h16*)smem;
  h16* Vs = Ks + 2 * 64 * 104;
  const int tid = tidx(), lane = tid & 63, wv = tid >> 6, l31 = lane & 31, hh = lane >> 5;
  int b, h, q0, nk;
  if (job < 1024) { b = job >> 8; h = (job >> 5) & 7; q0 = b * SB + CTX + (job & 31) * 128; nk = SB; }
  else { int j = job - 1024; b = j >> 4; h = (j >> 1) & 7; q0 = b * SB + (j & 1) * 128; nk = CTX; }
  const int NKT = nk >> 6;
  const h16* Kg = p.K() + (size_t)(b * SB) * 768 + h * 96;
  const h16* Vg = p.VT() + (size_t)(b * 8 + h) * 64 * SB;
  h16x8 qf[6];
  {
    const h16* qp = p.Q() + (size_t)(q0 + wv * 32 + l31) * 768 + h * 96 + hh * 8;
#pragma unroll
    for (int ds = 0; ds < 6; ++ds) qf[ds] = *(const h16x8*)(qp + ds * 16);
  }
  uint4 pk0, pk1, pk2_, pv0, pv1, qk0, qk1, qk2_, qv0, qv1;
  int krow[3], kcol[3];
#pragma unroll
  for (int i = 0; i < 3; ++i) { int c = tid + 256 * i; krow[i] = c / 12; kcol[i] = (c - krow[i] * 12) * 8; }
  const int vrow = tid >> 3, vcol = (tid & 7) * 8;
  const h16* kp0 = Kg + (size_t)krow[0] * 768 + kcol[0];
  const h16* kp1 = Kg + (size_t)krow[1] * 768 + kcol[1];
  const h16* kp2 = Kg + (size_t)krow[2] * 768 + kcol[2];
  const h16* vp0 = Vg + (size_t)vrow * SB + vcol;
  const h16* vp1 = Vg + (size_t)(vrow + 32) * SB + vcol;
#define ALOAD(S, kt_) { S##k0 = *(const uint4*)(kp0 + (size_t)(kt_) * 64 * 768); S##k1 = *(const uint4*)(kp1 + (size_t)(kt_) * 64 * 768); \
    S##k2_ = *(const uint4*)(kp2 + (size_t)(kt_) * 64 * 768); S##v0 = *(const uint4*)(vp0 + (kt_) * 64); S##v1 = *(const uint4*)(vp1 + (kt_) * 64); }
#define ASTORE(S, buf_) { h16* kd = Ks + (buf_) * 64 * 104; h16* vd = Vs + (buf_) * 64 * 68; \
    *(uint4*)(kd + krow[0] * 104 + kcol[0]) = S##k0; *(uint4*)(kd + krow[1] * 104 + kcol[1]) = S##k1; *(uint4*)(kd + krow[2] * 104 + kcol[2]) = S##k2_; \
    *(uint2*)(vd + vrow * 68 + vcol) = make_uint2(S##v0.x, S##v0.y); *(uint2*)(vd + vrow * 68 + vcol + 4) = make_uint2(S##v0.z, S##v0.w); \
    *(uint2*)(vd + (vrow + 32) * 68 + vcol) = make_uint2(S##v1.x, S##v1.y); *(uint2*)(vd + (vrow + 32) * 68 + vcol + 4) = make_uint2(S##v1.z, S##v1.w); }
  f32x16 o0, o1;
#pragma unroll
  for (int r = 0; r < 16; ++r) { o0[r] = 0.f; o1[r] = 0.f; }
  float mrun = -1e30f, lsum = 0.f;
  auto compute = [&](int buf) {
    const h16* ks = Ks + buf * 64 * 104 + l31 * 104 + hh * 8;
    f32x16 s0, s1;
#pragma unroll
    for (int r = 0; r < 16; ++r) { s0[r] = 0.f; s1[r] = 0.f; }
#pragma unroll
    for (int ds = 0; ds < 6; ++ds) {
      h16x8 a0 = *(const h16x8*)(ks + ds * 16), a1 = *(const h16x8*)(ks + 32 * 104 + ds * 16);
      s0 = __builtin_amdgcn_mfma_f32_32x32x16_f16(a0, qf[ds], s0, 0, 0, 0);
      s1 = __builtin_amdgcn_mfma_f32_32x32x16_f16(a1, qf[ds], s1, 0, 0, 0);
    }
    float mx = s0[0];
#pragma unroll
    for (int r = 1; r < 16; ++r) mx = fmaxf(mx, s0[r]);
#pragma unroll
    for (int r = 0; r < 16; ++r) mx = fmaxf(mx, s1[r]);
    mx = fmaxf(mx, __shfl_xor(mx, 32));
    const float mnew = fmaxf(mrun, mx);
    const float alpha = __builtin_amdgcn_exp2f(mrun - mnew);
    mrun = mnew;
    float ps = 0.f;
#pragma unroll
    for (int r = 0; r < 16; ++r) { s0[r] = __builtin_amdgcn_exp2f(s0[r] - mnew); ps += s0[r]; }
#pragma unroll
    for (int r = 0; r < 16; ++r) { s1[r] = __builtin_amdgcn_exp2f(s1[r] - mnew); ps += s1[r]; }
    lsum = lsum * alpha + ps;
#pragma unroll
    for (int r = 0; r < 16; ++r) { o0[r] *= alpha; o1[r] *= alpha; }
    const h16* vs = Vs + buf * 64 * 68 + l31 * 68 + 4 * hh;
#pragma unroll
    for (int k2 = 0; k2 < 2; ++k2) {
#pragma unroll
      for (int s2 = 0; s2 < 2; ++s2) {
        uint4 pu;
        if (k2 == 0) { pu.x = pk2(s0[8 * s2], s0[8 * s2 + 1]); pu.y = pk2(s0[8 * s2 + 2], s0[8 * s2 + 3]); pu.z = pk2(s0[8 * s2 + 4], s0[8 * s2 + 5]); pu.w = pk2(s0[8 * s2 + 6], s0[8 * s2 + 7]); }
        else { pu.x = pk2(s1[8 * s2], s1[8 * s2 + 1]); pu.y = pk2(s1[8 * s2 + 2], s1[8 * s2 + 3]); pu.z = pk2(s1[8 * s2 + 4], s1[8 * s2 + 5]); pu.w = pk2(s1[8 * s2 + 6], s1[8 * s2 + 7]); }
        h16x8 pf = __builtin_bit_cast(h16x8, pu);
        const int kb = k2 * 32 + 16 * s2;
        uint2 va = *(const uint2*)(vs + kb), vb = *(const uint2*)(vs + kb + 8);
        uint2 vc = *(const uint2*)(vs + 32 * 68 + kb), vd = *(const uint2*)(vs + 32 * 68 + kb + 8);
        h16x8 vf0 = __builtin_bit_cast(h16x8, make_uint4(va.x, va.y, vb.x, vb.y));
        h16x8 vf1 = __builtin_bit_cast(h16x8, make_uint4(vc.x, vc.y, vd.x, vd.y));
        o0 = __builtin_amdgcn_mfma_f32_32x32x16_f16(vf0, pf, o0, 0, 0, 0);
        o1 = __builtin_amdgcn_mfma_f32_32x32x16_f16(vf1, pf, o1, 0, 0, 0);
      }
    }
  };
  ALOAD(p, 0);
  if (NKT > 1) ALOAD(q, 1);
  ASTORE(p, 0);
  if (NKT > 2) ALOAD(p, 2);
  __syncthreads();
  for (int kt = 0; kt < NKT; kt += 2) {
    compute(0);
    if (kt + 1 < NKT) ASTORE(q, 1);
    if (kt + 3 < NKT) ALOAD(q, kt + 3);
    __syncthreads();
    if (kt + 1 < NKT) {
      compute(1);
      if (kt + 2 < NKT) ASTORE(p, 0);
      if (kt + 4 < NKT) ALOAD(p, kt + 4);
      __syncthreads();
    }
  }
#undef ALOAD
#undef ASTORE
  const float ltot = lsum + __shfl_xor(lsum, 32);
  const float inv = 1.f / ltot;
  h16* yo = p.Z() + (size_t)(q0 + wv * 32 + l31) * ZW + ZMLA + h * 64 + 4 * hh;
#pragma unroll
  for (int g = 0; g < 4; ++g) {
    st4h(yo + 8 * g, o0[4 * g] * inv, o0[4 * g + 1] * inv, o0[4 * g + 2] * inv, o0[4 * g + 3] * inv);
    st4h(yo + 32 + 8 * g, o1[4 * g] * inv, o1[4 * g + 1] * inv, o1[4 * g + 2] * inv, o1[4 * g + 3] * inv);
  }
}

#if PROBE >= 200
__device__ unsigned long long g_tacc[4];
#endif
struct Slot { float w[64]; unsigned bke[64]; float vv[64]; h16 ah[4][64]; int yoff; int pad[3]; };
struct LSet { uint4 lw, a, k, v, r; float inv; int yoff; int vm; };
DEVI void scan_job(const P& p, int l, int job, char* smem, int rank) {
  constexpr int RGB = 4 / NSCAN_BPC;
  constexpr int NLD = (4 - RGB) * 64;
  static_assert(NLD == 128, "loader mapping assumes 128 loader threads");
  Slot* sl = (Slot*)smem;
  h16* ybuf = (h16*)(smem + 2 * 16 * sizeof(Slot));
  const int tid = tidx(), lane = tid & 63, wv = rank ? ((tid >> 6) ^ 2) : (tid >> 6);
  const int chain = job / NSCAN_BPC, part = job - chain * NSCAN_BPC;
  const int dir = chain >> 5, b = (chain >> 3) & 3, h = chain & 7;
  for (int i = tid; i < 32 * 128; i += 256) { int s = i >> 7, e = i & 127; sl[s].ah[2 + (e >> 6)][e & 63] = (h16)0.f; }
  if (wv >= RGB) {
    const int lt = (wv - RGB) * 64 + lane;
    const int st = lt >> 3, ca = lt & 7, c8 = ca * 8;
    const int pp0 = (ca >> 2) * 32 + (2 * (ca & 1)) * 8 + ((ca & 3) >> 1) * 4;
    const int pp1 = pp0 + 8;
    const float4 kkA = *(const float4*)(p.k_k + l * 512 + h * 64 + c8), kkB = *(const float4*)(p.k_k + l * 512 + h * 64 + c8 + 4);
    const float4 kaA = *(const float4*)(p.k_a + l * 512 + h * 64 + c8), kaB = *(const float4*)(p.k_a + l * 512 + h * 64 + c8 + 4);
    const h16* LWd = p.LW() + (size_t)dir * NR * 512 + h * 64 + c8;
    const h16* AAd = p.AA() + (size_t)dir * NR * 512 + h * 64 + c8;
    const h16* Zr = p.Z() + ZRW + h * 64 + c8;
#define LLOAD(ci_, g)                                                                                         \
    {                                                                                                         \
      const int n_ = (ci_) * 16 + st;                                                                         \
      const int rowm_ = maprow(dir, b, min(n_, SB - 1));                                                      \
      const int rowr_ = maprow(dir, b, min(max(n_ - 1, 0), SB - 1));                                          \
      g##_yoff = (n_ >= 1 && n_ <= SB) ? rowr_ * 512 : -1;                                                      \
      g##_vm = (n_ < SB) ? 1 : 0;                                                                               \
      const h16* p0_ = LWd + (size_t)rowm_ * 512; const h16* p1_ = AAd + (size_t)rowm_ * 512;                 \
      const h16* p2_ = Zr + (size_t)rowm_ * ZW + 512; const h16* p3_ = Zr + (size_t)rowm_ * ZW + 1024;        \
      const h16* p4_ = Zr + (size_t)rowr_ * ZW; const float* p5_ = p.INVN() + (size_t)rowm_ * 8 + h;          \
      asm volatile("global_load_dwordx4 %0, %1, off" : "=v"(g##_lw) : "v"(p0_) : "memory");                     \
      asm volatile("global_load_dwordx4 %0, %1, off" : "=v"(g##_a) : "v"(p1_) : "memory");                      \
      asm volatile("global_load_dwordx4 %0, %1, off" : "=v"(g##_k) : "v"(p2_) : "memory");                      \
      asm volatile("global_load_dwordx4 %0, %1, off" : "=v"(g##_v) : "v"(p3_) : "memory");                      \
      asm volatile("global_load_dwordx4 %0, %1, off" : "=v"(g##_r) : "v"(p4_) : "memory");                      \
      asm volatile("global_load_dword %0, %1, off" : "=v"(g##_inv) : "v"(p5_) : "memory");                      \
    }
#define LWAIT(g) asm volatile("s_waitcnt vmcnt(18)" : "+v"(g##_lw), "+v"(g##_a), "+v"(g##_k), "+v"(g##_v), "+v"(g##_r), "+v"(g##_inv) : : "memory")
    auto lstore = [&](uint4 g_lw, uint4 g_a, uint4 g_k, uint4 g_v, uint4 g_r, float g_inv, int g_yoff, int g_vm, int buf) {
      Slot& s = sl[buf * 16 + st];
      const h16x8 lw = __builtin_bit_cast(h16x8, g_lw), a = __builtin_bit_cast(h16x8, g_a), k = __builtin_bit_cast(h16x8, g_k), v = __builtin_bit_cast(h16x8, g_v);
      const float kkp[8] = {kkA.x, kkA.y, kkA.z, kkA.w, kkB.x, kkB.y, kkB.z, kkB.w};
      const float kap[8] = {kaA.x, kaA.y, kaA.z, kaA.w, kaB.x, kaB.y, kaB.z, kaB.w};
      const float vmf = g_vm ? 1.f : 0.f;
      const float inv = g_inv * vmf;
      float w8[8], v8[8], q8[8], r8[8]; unsigned be8[8];
      const h16x8 rh = __builtin_bit_cast(h16x8, g_r);
      const float rvalid = (g_yoff >= 0) ? 1.f : 0.f;
#pragma unroll
      for (int i = 0; i < 8; ++i) w8[i] = __expf(-(float)lw[i] * vmf);
      float P8[8];
#pragma unroll
      for (int i = 0; i < 8; ++i) P8[i] = w8[i];
#pragma unroll
      for (int d = 8; d < 64; d <<= 1) {
#pragma unroll
        for (int i = 0; i < 8; ++i) { const float t = __shfl_up(P8[i], d); if (lane >= d) P8[i] *= t; }
      }
#pragma unroll
      for (int i = 0; i < 8; ++i) {
        const float kf = (float)k[i] * vmf, af = (float)a[i];
        const float kkv = kf * kkp[i] * inv;
        const float rP = __builtin_amdgcn_rcpf(P8[i]);
        const float Pex = P8[i] * __builtin_amdgcn_rcpf(w8[i]);
        be8[i] = pk2n(kkv * af * rP, kf * (1.f + (af - 1.f) * kap[i]) * rP);
        v8[i] = (float)v[i] * vmf;
        q8[i] = kkv * Pex;
        r8[i] = (float)rh[i] * Pex * rvalid;
        w8[i] = P8[i];
      }
      const uint4 rr = make_uint4(pk2n(r8[0], r8[1]), pk2n(r8[2], r8[3]), pk2n(r8[4], r8[5]), pk2n(r8[6], r8[7]));
      *(float4*)(s.w + c8) = make_float4(w8[0], w8[1], w8[2], w8[3]); *(float4*)(s.w + c8 + 4) = make_float4(w8[4], w8[5], w8[6], w8[7]);
      *(uint4*)(s.bke + c8) = make_uint4(be8[0], be8[1], be8[2], be8[3]); *(uint4*)(s.bke + c8 + 4) = make_uint4(be8[4], be8[5], be8[6], be8[7]);
      *(float4*)(s.vv + c8) = make_float4(v8[0], v8[1], v8[2], v8[3]); *(float4*)(s.vv + c8 + 4) = make_float4(v8[4], v8[5], v8[6], v8[7]);
      *(uint2*)(&s.ah[0][pp0]) = make_uint2(pk2n(q8[0], q8[1]), pk2n(q8[2], q8[3]));
      *(uint2*)(&s.ah[0][pp1]) = make_uint2(pk2n(q8[4], q8[5]), pk2n(q8[6], q8[7]));
      *(uint2*)(&s.ah[1][pp0]) = make_uint2(rr.x, rr.y);
      *(uint2*)(&s.ah[1][pp1]) = make_uint2(rr.z, rr.w);
      if (ca == 0) s.yoff = g_yoff;
    };
    typedef unsigned u32x4 __attribute__((ext_vector_type(4)));
    u32x4 R0_lw, R0_a, R0_k, R0_v, R0_r, R1_lw, R1_a, R1_k, R1_v, R1_r, R2_lw, R2_a, R2_k, R2_v, R2_r, R3_lw, R3_a, R3_k, R3_v, R3_r;
    float R0_inv, R1_inv, R2_inv, R3_inv; int R0_yoff, R1_yoff, R2_yoff, R3_yoff, R0_vm, R1_vm, R2_vm, R3_vm;
#define U4(x) make_uint4((x)[0], (x)[1], (x)[2], (x)[3])
#define LST(g, buf_) lstore(U4(g##_lw), U4(g##_a), U4(g##_k), U4(g##_v), U4(g##_r), g##_inv, g##_yoff, g##_vm, buf_)
    asm volatile("s_waitcnt vmcnt(0)" ::: "memory");
    LLOAD(0, R0); LLOAD(1, R1); LLOAD(2, R2); LLOAD(3, R3);
    LWAIT(R0); LST(R0, 0); LLOAD(4, R0);
    __syncthreads();
    h16* yout = p.Y2() + (size_t)dir * NR * 512 + h * 64 + part * (RGB * 16) + ca * 4;
    auto ystore = [&](int cj) {
      const int n = cj * 16 + st;
      if (n >= 1 && n <= SB) {
        const h16* yb = ybuf + ((cj & 1) * 32 + ca * 4) * 24 + st;
        const unsigned short a0 = __builtin_bit_cast(unsigned short, yb[0]), a1 = __builtin_bit_cast(unsigned short, yb[24]);
        const unsigned short a2 = __builtin_bit_cast(unsigned short, yb[48]), a3 = __builtin_bit_cast(unsigned short, yb[72]);
        typedef unsigned u32x2 __attribute__((ext_vector_type(2)));
        u32x2 u; u[0] = (unsigned)a0 | ((unsigned)a1 << 16); u[1] = (unsigned)a2 | ((unsigned)a3 << 16);
        h16* yp = yout + (size_t)maprow(dir, b, n - 1) * 512;
        asm volatile("global_store_dwordx2 %0, %1, off" : : "v"(yp), "v"(u) : "memory");
      }
    };
    for (int ci = 0; ci < NCHUNK; ci += 4) {
      if (ci > 0) ystore(ci - 1);
      LWAIT(R1); if (ci + 1 < NCHUNK) LST(R1, 1); LLOAD(ci + 5, R1);
      __syncthreads();
      if (ci + 1 < NCHUNK) { ystore(ci); LWAIT(R2); if (ci + 2 < NCHUNK) LST(R2, 0); LLOAD(ci + 6, R2); __syncthreads(); }
      if (ci + 2 < NCHUNK) { ystore(ci + 1); LWAIT(R3); if (ci + 3 < NCHUNK) LST(R3, 1); LLOAD(ci + 7, R3); __syncthreads(); }
      if (ci + 3 < NCHUNK) { ystore(ci + 2); LWAIT(R0); if (ci + 4 < NCHUNK) LST(R0, 0); LLOAD(ci + 8, R0); __syncthreads(); }
    }
    ystore(NCHUNK - 1);
    asm volatile("s_waitcnt vmcnt(0)" ::: "memory");
#undef LST
#undef U4
#undef LLOAD
#undef LWAIT
  } else {
    const int c = lane & 15, hq = lane >> 4;
    const int rg = part * RGB + wv;
    const bool h0 = (hq == 0);
    f32x4 ST[4];
#pragma unroll
    for (int t = 0; t < 4; ++t) ST[t] = (f32x4){0.f, 0.f, 0.f, 0.f};
    __builtin_amdgcn_s_setprio(3);
    __syncthreads();
    for (int ci = 0; ci < NCHUNK; ++ci) {
      const int buf = ci & 1;
#if PROBE == 211
      const unsigned long long ct0 = __builtin_amdgcn_s_memrealtime();
#endif
      float yv[16];
      h16x8 rA0[2], rA1[2]; float rvv[2]; unsigned rbe[2][4];
      {
        const Slot& t = sl[buf * 16];
        rA0[0] = *(const h16x8*)(&t.ah[c & 3][8 * hq]); rA1[0] = *(const h16x8*)(&t.ah[c & 3][32 + 8 * hq]);
        rvv[0] = t.vv[rg * 16 + c];
#pragma unroll
        for (int tt = 0; tt < 4; ++tt) rbe[0][tt] = t.bke[16 * tt + c];
      }
#pragma unroll
      for (int s = 0; s < 16; ++s) {
        const int cur = s & 1, nxt = cur ^ 1;
        uint4 sh0, sh1;
        sh0.x = pk2(ST[0][0], ST[0][1]); sh0.y = pk2(ST[0][2], ST[0][3]); sh0.z = pk2(ST[1][0], ST[1][1]); sh0.w = pk2(ST[1][2], ST[1][3]);
        sh1.x = pk2(ST[2][0], ST[2][1]); sh1.y = pk2(ST[2][2], ST[2][3]); sh1.z = pk2(ST[3][0], ST[3][1]); sh1.w = pk2(ST[3][2], ST[3][3]);
        const f32x4 z4 = {0.f, 0.f, 0.f, 0.f};
        f32x4 acc0 = __builtin_amdgcn_mfma_f32_16x16x32_f16(rA0[cur], __builtin_bit_cast(h16x8, sh0), z4, 0, 0, 0);
        f32x4 acc1 = __builtin_amdgcn_mfma_f32_16x16x32_f16(rA1[cur], __builtin_bit_cast(h16x8, sh1), z4, 0, 0, 0);
        f32x4 pe[4];
        if ((s & 7) == 7) {
#pragma unroll
          for (int tt = 0; tt < 4; ++tt) pe[tt] = *(const f32x4*)(sl[buf * 16 + s].w + 16 * tt + 4 * hq);
        }
        if (s + 1 < 16) {
          const Slot& t = sl[buf * 16 + s + 1];
          rA0[nxt] = *(const h16x8*)(&t.ah[c & 3][8 * hq]); rA1[nxt] = *(const h16x8*)(&t.ah[c & 3][32 + 8 * hq]);
          rvv[nxt] = t.vv[rg * 16 + c];
#pragma unroll
          for (int tt = 0; tt < 4; ++tt) rbe[nxt][tt] = t.bke[16 * tt + c];
        }
        __builtin_amdgcn_sched_barrier(0);
        yv[s] = acc0[1] + acc1[1];
        const float sa = -(acc0[0] + acc1[0]);
        const uint4 bu = make_uint4(h0 ? pk2(sa, rvv[cur]) : 0u, 0u, 0u, 0u);
#pragma unroll
        for (int tt = 0; tt < 4; ++tt) {
          const uint4 au = make_uint4(h0 ? rbe[cur][tt] : 0u, 0u, 0u, 0u);
          ST[tt] = __builtin_amdgcn_mfma_f32_16x16x32_f16(__builtin_bit_cast(h16x8, au), __builtin_bit_cast(h16x8, bu), ST[tt], 0, 0, 0);
        }
        if ((s & 7) == 7) {
#pragma unroll
          for (int tt = 0; tt < 4; ++tt) ST[tt] = ST[tt] * pe[tt];
        }
      }
      if (lane < 16) {
        uint4 u0, u1;
        u0.x = pk2n(yv[0], yv[1]); u0.y = pk2n(yv[2], yv[3]); u0.z = pk2n(yv[4], yv[5]); u0.w = pk2n(yv[6], yv[7]);
        u1.x = pk2n(yv[8], yv[9]); u1.y = pk2n(yv[10], yv[11]); u1.z = pk2n(yv[12], yv[13]); u1.w = pk2n(yv[14], yv[15]);
        h16* yr = ybuf + (buf * 32 + wv * 16 + c) * 24;
        *(uint4*)yr = u0; *(uint4*)(yr + 8) = u1;
      }
#if PROBE == 210
      const unsigned long long bt0 = __builtin_amdgcn_s_memrealtime();
#endif
      __syncthreads();
#if PROBE == 210
      if (job == 0 && tid == 0) g_tacc[0] += __builtin_amdgcn_s_memrealtime() - bt0;
#endif
    }
    __builtin_amdgcn_s_setprio(0);
  }
}

DEVI void gla_pre_job(const P& p, int l, int job, char* smem) {
  typedef short bf16x8 __attribute__((ext_vector_type(8)));
  float* lg = (float*)smem;
  float* gku = lg + 64 * 65;
  float* gkb = gku + 1024;
  float* tot = gkb + 64;
  unsigned short* qb = (unsigned short*)(tot + 256);
  unsigned short* kb = qb + 64 * 72;
  h16* vt = (h16*)(kb + 64 * 72);
  const int tid = tidx(), lane = tid & 63, wv = tid >> 6, l31 = lane & 31, hh = lane >> 5;
  const int chain = job / 68, ci = job - chain * 68;
  const int dir = chain >> 4, b = (chain >> 2) & 3, h = chain & 3;
  for (int i = tid; i < 1024; i += 256) gku[i] = p.gk_up[(((size_t)l * 2 + dir) * 16 + (i >> 6)) * 256 + h * 64 + (i & 63)];
  if (tid < 64) gkb[tid] = p.gk_b[((size_t)l * 2 + dir) * 256 + h * 64 + tid];
  const int ri = tid >> 2, dq = tid & 3;
  const int row = maprow(dir, b, ci * 64 + ri);
  const h16* zr = p.Z() + (size_t)row * ZW;
  uint4 q0 = *(const uint4*)(zr + h * 64 + dq * 16), q1 = *(const uint4*)(zr + h * 64 + dq * 16 + 8);
  uint4 k0 = *(const uint4*)(zr + 256 + h * 64 + dq * 16), k1 = *(const uint4*)(zr + 256 + h * 64 + dq * 16 + 8);
  uint4 g0 = *(const uint4*)(zr + 1024 + dir * 16), g1 = *(const uint4*)(zr + 1024 + dir * 16 + 8);
  {
    const h16* zv = zr + 512 + h * 128 + dq * 32;
#pragma unroll
    for (int c = 0; c < 4; ++c) {
      h16x8 vv = *(const h16x8*)(zv + c * 8);
#pragma unroll
      for (int j = 0; j < 8; ++j) vt[(dq * 32 + c * 8 + j) * 72 + ri] = vv[j];
    }
  }
  __syncthreads();
  {
    h16x8 gh0 = __builtin_bit_cast(h16x8, g0), gh1 = __builtin_bit_cast(h16x8, g1);
    float gd[16];
#pragma unroll
    for (int j = 0; j < 8; ++j) { gd[j] = (float)gh0[j]; gd[8 + j] = (float)gh1[j]; }
#pragma unroll 4
    for (int dd = 0; dd < 16; ++dd) {
      const int d = dq * 16 + dd;
      float xx = gkb[d];
#pragma unroll
      for (int r = 0; r < 16; ++r) xx += gd[r] * gku[r * 64 + d];
      float ls = fminf(xx, 0.f) - __logf(1.f + __expf(-fabsf(xx)));
      lg[ri * 65 + d] = ls * (1.f / 16.f);
    }
  }
  __syncthreads();
  {
    const int d = tid & 63, part = tid >> 6;
    float run = 0.f;
#pragma unroll 4
    for (int ii = 0; ii < 16; ++ii) { const int i = part * 16 + ii; run += lg[i * 65 + d]; lg[i * 65 + d] = run; }
    tot[part * 64 + d] = run;
  }
  __syncthreads();
  {
    h16x8 qh0 = __builtin_bit_cast(h16x8, q0), qh1 = __builtin_bit_cast(h16x8, q1), kh0 = __builtin_bit_cast(h16x8, k0), kh1 = __builtin_bit_cast(h16x8, k1);
    const int part = ri >> 4;
    unsigned qp[8], kp[8];
#pragma unroll
    for (int j = 0; j < 8; ++j) {
      unsigned qq[2], kk2[2];
#pragma unroll
      for (int e = 0; e < 2; ++e) {
        const int dd = 2 * j + e, d = dq * 16 + dd;
        float off = 0.f;
        if (part > 0) off += tot[d];
        if (part > 1) off += tot[64 + d];
        if (part > 2) off += tot[128 + d];
        const float bb = lg[ri * 65 + d] + off;
        const float qv = dd < 8 ? (float)qh0[dd & 7] : (float)qh1[dd & 7];
        const float kv = dd < 8 ? (float)kh0[dd & 7] : (float)kh1[dd & 7];
        qq[e] = f2bf(qv * __expf(bb) * 0.125f);
        kk2[e] = f2bf(kv * __expf(-bb));
      }
      qp[j] = qq[0] | (qq[1] << 16); kp[j] = kk2[0] | (kk2[1] << 16);
    }
    const uint4 qa = make_uint4(qp[0], qp[1], qp[2], qp[3]), qc = make_uint4(qp[4], qp[5], qp[6], qp[7]);
    const uint4 ka = make_uint4(kp[0], kp[1], kp[2], kp[3]), kc = make_uint4(kp[4], kp[5], kp[6], kp[7]);
    *(uint4*)(qb + ri * 72 + dq * 16) = qa; *(uint4*)(qb + ri * 72 + dq * 16 + 8) = qc;
    *(uint4*)(kb + ri * 72 + dq * 16) = ka; *(uint4*)(kb + ri * 72 + dq * 16 + 8) = kc;
    unsigned short* qd = p.QIN() + ((size_t)dir * NR + row) * 256 + h * 64 + dq * 16;
    unsigned short* kd = p.KIN() + ((size_t)dir * NR + row) * 256 + h * 64 + dq * 16;
    *(uint4*)qd = qa; *(uint4*)(qd + 8) = qc;
    *(uint4*)kd = ka; *(uint4*)(kd + 8) = kc;
    if (tid < 64) p.DEC()[((size_t)chain * 68 + ci) * 64 + tid] = __expf(tot[tid] + tot[64 + tid] + tot[128 + tid] + tot[192 + tid]);
  }
  __syncthreads();
  const int it = wv & 1, jh = wv >> 1;
  f32x16 o0, o1;
#pragma unroll
  for (int r = 0; r < 16; ++r) { o0[r] = 0.f; o1[r] = 0.f; }
  bf16x8 qf[4];
#pragma unroll
  for (int ks = 0; ks < 4; ++ks) qf[ks] = *(const bf16x8*)(qb + (it * 32 + l31) * 72 + ks * 16 + hh * 8);
#pragma unroll
  for (int st = 0; st < 2; ++st) {
    if (st > it) continue;
    f32x16 at;
#pragma unroll
    for (int r = 0; r < 16; ++r) at[r] = 0.f;
#pragma unroll
    for (int ks = 0; ks < 4; ++ks) {
      bf16x8 kf = *(const bf16x8*)(kb + (st * 32 + l31) * 72 + ks * 16 + hh * 8);
      at = __builtin_amdgcn_mfma_f32_32x32x16_bf16(kf, qf[ks], at, 0, 0, 0);
    }
    if (st == it) {
#pragma unroll
      for (int r = 0; r < 16; ++r) { const int sl = (r & 3) + 8 * (r >> 2) + 4 * hh; if (sl > l31) at[r] = 0.f; }
    }
    const h16* vs = vt + (jh * 64 + l31) * 72 + st * 32 + 4 * hh;
#pragma unroll
    for (int s2 = 0; s2 < 2; ++s2) {
      uint4 pu;
      pu.x = pk2n(at[8 * s2], at[8 * s2 + 1]); pu.y = pk2n(at[8 * s2 + 2], at[8 * s2 + 3]);
      pu.z = pk2n(at[8 * s2 + 4], at[8 * s2 + 5]); pu.w = pk2n(at[8 * s2 + 6], at[8 * s2 + 7]);
      const h16x8 pf = __builtin_bit_cast(h16x8, pu);
      const uint2 va = *(const uint2*)(vs + 16 * s2), vb = *(const uint2*)(vs + 16 * s2 + 8);
      const uint2 vc = *(const uint2*)(vs + 32 * 72 + 16 * s2), vd = *(const uint2*)(vs + 32 * 72 + 16 * s2 + 8);
      o0 = __builtin_amdgcn_mfma_f32_32x32x16_f16(__builtin_bit_cast(h16x8, make_uint4(va.x, va.y, vb.x, vb.y)), pf, o0, 0, 0, 0);
      o1 = __builtin_amdgcn_mfma_f32_32x32x16_f16(__builtin_bit_cast(h16x8, make_uint4(vc.x, vc.y, vd.x, vd.y)), pf, o1, 0, 0, 0);
    }
  }
  {
    const int orow = maprow(dir, b, ci * 64 + it * 32 + l31);
    h16* od = p.OFB() + ((size_t)dir * NR + orow) * 512 + h * 128 + jh * 64 + 4 * hh;
#pragma unroll
    for (int g = 0; g < 4; ++g) {
      st4h(od + 8 * g, o0[4 * g], o0[4 * g + 1], o0[4 * g + 2], o0[4 * g + 3]);
      st4h(od + 32 + 8 * g, o1[4 * g], o1[4 * g + 1], o1[4 * g + 2], o1[4 * g + 3]);
    }
  }
  __syncthreads();
}

DEVI void gla_job(const P& p, int l, int job, char* smem) {
  float* qi = (float*)smem;
  float* ki = qi + 64 * 65;
  float* vs = ki + 64 * 65;
  float* Ss = vs + 64 * 33;
  const int tid = tidx();
  const int dvs = job & 3, chain = job >> 2;
  const int dir = chain >> 4, b = (chain >> 2) & 3, h = chain & 3;
  for (int i = tid; i < 64 * 33; i += 256) Ss[i] = 0.f;
  const int ri = tid >> 2, dq = tid & 3;
  const int t2 = tid >> 3, tj = tid & 7;
  h16* Od = p.OFB() + (size_t)dir * NR * 512 + h * 128 + dvs * 32;
  const unsigned short* Qg = p.QIN() + (size_t)dir * NR * 256 + h * 64 + dq * 16;
  const unsigned short* Kg = p.KIN() + (size_t)dir * NR * 256 + h * 64 + dq * 16;
  const float* Dg = p.DEC() + (size_t)chain * 68 * 64 + 2 * t2;
  uint4 gq0, gq1, gk0, gk1, gv; uint2 goa, gob; float gd0, gd1;
  auto pre = [&](int ci) {
    const int row = maprow(dir, b, ci * 64 + ri);
    gq0 = *(const uint4*)(Qg + (size_t)row * 256); gq1 = *(const uint4*)(Qg + (size_t)row * 256 + 8);
    gk0 = *(const uint4*)(Kg + (size_t)row * 256); gk1 = *(const uint4*)(Kg + (size_t)row * 256 + 8);
    gv = *(const uint4*)(p.Z() + (size_t)row * ZW + 512 + h * 128 + dvs * 32 + dq * 8);
    const int rowa = maprow(dir, b, ci * 64 + 2 * t2), rowb = maprow(dir, b, ci * 64 + 2 * t2 + 1);
    goa = *(const uint2*)(Od + (size_t)rowa * 512 + 4 * tj); gob = *(const uint2*)(Od + (size_t)rowb * 512 + 4 * tj);
    gd0 = Dg[ci * 64]; gd1 = Dg[ci * 64 + 1];
  };
  pre(0);
  __syncthreads();
  for (int ci = 0; ci < SB / 64; ++ci) {
    {
      const unsigned qa[8] = {gq0.x, gq0.y, gq0.z, gq0.w, gq1.x, gq1.y, gq1.z, gq1.w};
      const unsigned ka[8] = {gk0.x, gk0.y, gk0.z, gk0.w, gk1.x, gk1.y, gk1.z, gk1.w};
#pragma unroll
      for (int j = 0; j < 8; ++j) {
        qi[ri * 65 + dq * 16 + 2 * j] = __builtin_bit_cast(float, qa[j] << 16); qi[ri * 65 + dq * 16 + 2 * j + 1] = __builtin_bit_cast(float, qa[j] & 0xffff0000u);
        ki[ri * 65 + dq * 16 + 2 * j] = __builtin_bit_cast(float, ka[j] << 16); ki[ri * 65 + dq * 16 + 2 * j + 1] = __builtin_bit_cast(float, ka[j] & 0xffff0000u);
      }
      h16x8 vh = __builtin_bit_cast(h16x8, gv);
#pragma unroll
      for (int j = 0; j < 8; ++j) vs[ri * 33 + dq * 8 + j] = (float)vh[j];
    }
    const uint2 oia = goa, oib = gob; const float e0 = gd0, e1 = gd1;
    const int rowa = maprow(dir, b, ci * 64 + 2 * t2), rowb = maprow(dir, b, ci * 64 + 2 * t2 + 1);
    if (ci + 1 < SB / 64) pre(ci + 1);
    __syncthreads();
    {
      h16x4 ha = __builtin_bit_cast(h16x4, oia), hb = __builtin_bit_cast(h16x4, oib);
      float a0[4], a1[4];
#pragma unroll
      for (int y = 0; y < 4; ++y) { a0[y] = (float)ha[y]; a1[y] = (float)hb[y]; }
#pragma unroll 4
      for (int d = 0; d < 64; ++d) {
        const float x0 = qi[(2 * t2) * 65 + d], x1 = qi[(2 * t2 + 1) * 65 + d];
#pragma unroll
        for (int y = 0; y < 4; ++y) { const float v = Ss[d * 33 + 4 * tj + y]; a0[y] += x0 * v; a1[y] += x1 * v; }
      }
      st4h(Od + (size_t)rowa * 512 + 4 * tj, a0[0], a0[1], a0[2], a0[3]);
      st4h(Od + (size_t)rowb * 512 + 4 * tj, a1[0], a1[1], a1[2], a1[3]);
    }
    __syncthreads();
    {
      float a0[4], a1[4];
#pragma unroll
      for (int y = 0; y < 4; ++y) { a0[y] = Ss[(2 * t2) * 33 + 4 * tj + y]; a1[y] = Ss[(2 * t2 + 1) * 33 + 4 * tj + y]; }
#pragma unroll 4
      for (int s2 = 0; s2 < 64; ++s2) {
        const float x0 = ki[s2 * 65 + 2 * t2], x1 = ki[s2 * 65 + 2 * t2 + 1];
#pragma unroll
        for (int y = 0; y < 4; ++y) { const float v = vs[s2 * 33 + 4 * tj + y]; a0[y] += x0 * v; a1[y] += x1 * v; }
      }
#pragma unroll
      for (int y = 0; y < 4; ++y) { Ss[(2 * t2) * 33 + 4 * tj + y] = a0[y] * e0; Ss[(2 * t2 + 1) * 33 + 4 * tj + y] = a1[y] * e1; }
    }
    __syncthreads();
  }
}

DEVI void mixer_phase(const P& p, int l, char* smem, int cslot, int mode = 0, int role = -1, int rank = 0) {
  if (role < 0) role = blockIdx.x;
#if PROBE >= 200
  unsigned long long pt0 = __builtin_amdgcn_s_memrealtime();
#endif
  __shared__ int4 sjobv;
  int& sjob = sjobv.x;
  for (int j = role; j < NSCAN + NGLA; j += gridDim.x) {
    if (mode == 1 && j >= NSCAN) break;
    if (mode == 2 && j < NSCAN) continue;
    if (j < NSCAN) {
      scan_job(p, l, j, smem, 0);
    }
    else gla_job(p, l, j - NSCAN, smem);
    __syncthreads();
#if PROBE == 200
    if (role == 0 && tidx() == 0) g_tacc[0] += __builtin_amdgcn_s_memrealtime() - pt0;
#endif
#if PROBE == 201
    if (role == NSCAN && tidx() == 0) g_tacc[0] += __builtin_amdgcn_s_memrealtime() - pt0;
#endif
  }
  if (mode == 1) return;
  const int njobs = (l < DEPTH - 1) ? 1024 + 64 : 1024;
  while (true) {
    if (tidx() == 0) sjob = (int)atomicAdd(p.CTR() + cslot, 1u);
    __syncthreads();
    const int j = sjob;
    __syncthreads();
    if (j >= njobs) break;
    attn_job(p, j, smem);
  }
#if PROBE == 202
  if (role == 300 && tidx() == 0) g_tacc[0] += __builtin_amdgcn_s_memrealtime() - pt0;
#endif
}

DEVI void post_phase(const P& p, int l) {
  const int lane = tidx() & 63;
  const int wid = blockIdx.x * 4 + (tidx() >> 6), nw = gridDim.x * 4;
  const int c8 = lane * 8;
  for (int r = wid; r < NR; r += nw) {
    {
      h16* zr = p.Z() + (size_t)r * ZW + ZRW + c8;
      h16x8 yf = *(const h16x8*)(p.Y2() + (size_t)r * 512 + c8), yb = *(const h16x8*)(p.Y2() + (size_t)(NR + r) * 512 + c8);
      h16x8 rr = *(const h16x8*)zr, kk = *(const h16x8*)(zr + 512), vv = *(const h16x8*)(zr + 1024);
      h16x8 af = *(const h16x8*)(p.AA() + (size_t)r * 512 + c8), ab = *(const h16x8*)(p.AA() + (size_t)(NR + r) * 512 + c8);
      h16x8 gg = *(const h16x8*)(p.G() + (size_t)r * 512 + c8);
      float y[8], sm = 0.f;
#pragma unroll
      for (int i = 0; i < 8; ++i) { y[i] = (float)yf[i] + (float)yb[i]; sm += y[i]; }
      sm += __shfl_xor(sm, 1); sm += __shfl_xor(sm, 2); sm += __shfl_xor(sm, 4);
      const float mean = sm * (1.f / 64.f);
      float sq = 0.f;
#pragma unroll
      for (int i = 0; i < 8; ++i) { y[i] -= mean; sq += y[i] * y[i]; }
      sq += __shfl_xor(sq, 1); sq += __shfl_xor(sq, 2); sq += __shfl_xor(sq, 4);
      const float rs = rsqrtf(sq * (1.f / 64.f) + 64e-5f);
      const float* ka = p.k_a + l * 512 + c8; const float* rk = p.r_k + l * 512 + c8;
      const float* lg = p.rln_g + l * 512 + c8; const float* lb = p.rln_b + l * 512 + c8;
      float bs = 0.f;
#pragma unroll
      for (int i = 0; i < 8; ++i) {
        const float kf = (float)kk[i], kav = ka[i];
        const float ke = kf * (1.f + ((float)af[i] - 1.f) * kav) + kf * (1.f + ((float)ab[i] - 1.f) * kav);
        bs += (float)rr[i] * ke * rk[i];
      }
      bs += __shfl_xor(bs, 1); bs += __shfl_xor(bs, 2); bs += __shfl_xor(bs, 4);
      float o[8];
#pragma unroll
      for (int i = 0; i < 8; ++i) o[i] = (y[i] * rs * lg[i] + lb[i] + bs * (float)vv[i]) * (float)gg[i];
      uint4 u; u.x = pk2n(o[0], o[1]); u.y = pk2n(o[2], o[3]); u.z = pk2n(o[4], o[5]); u.w = pk2n(o[6], o[7]);
      *(uint4*)zr = u;
    }
    {
      h16x8 of = *(const h16x8*)(p.OFB() + (size_t)r * 512 + c8), ob = *(const h16x8*)(p.OFB() + (size_t)(NR + r) * 512 + c8);
      h16x8 og = *(const h16x8*)(p.Z() + (size_t)r * ZW + 1056 + c8);
      float o[8], sq = 0.f;
#pragma unroll
      for (int i = 0; i < 8; ++i) { o[i] = (float)of[i] + (float)ob[i]; sq += o[i] * o[i]; }
      sq += __shfl_xor(sq, 1); sq += __shfl_xor(sq, 2); sq += __shfl_xor(sq, 4); sq += __shfl_xor(sq, 8);
      const float rs = rsqrtf(sq * (1.f / 128.f) + 1e-6f);
      const float* ng = p.gla_ng + l * 128 + (c8 & 127);
#pragma unroll
      for (int i = 0; i < 8; ++i) { const float g = (float)og[i]; o[i] = o[i] * rs * ng[i] * (g * sigm(g)); }
      uint4 u; u.x = pk2n(o[0], o[1]); u.y = pk2n(o[2], o[3]); u.z = pk2n(o[4], o[5]); u.w = pk2n(o[6], o[7]);
      *(uint4*)(p.YA() + (size_t)r * ZW + c8) = u;
    }
  }
}

DEVI void merge_phase(const P& p, char* smem) {
  constexpr int MT = NR / 128, NT = 16;
  const int lane = tidx() & 63, wv = tidx() >> 6;
  const int wm = wv >> 1, wn = wv & 1, l31 = lane & 31, hh = lane >> 5;
  for (int job = blockIdx.x; job < MT * NT; job += gridDim.x) {
    int nt = job / MT, mt = job - nt * MT;
    float out[2][16];
#pragma unroll
    for (int a = 0; a < 2; ++a)
#pragma unroll
      for (int r = 0; r < 16; ++r) out[a][r] = 0.f;
#pragma unroll 1
    for (int br = 0; br < 3; ++br) {
      const h16* Y = br == 0 ? p.YA() : (br == 1 ? p.Z() + ZMLA : p.Z() + ZRW);
      const int ldy = ZW;
      f32x16 acc[2][1];
#pragma unroll
      for (int a = 0; a < 2; ++a)
#pragma unroll
        for (int r = 0; r < 16; ++r) acc[a][0][r] = 0.f;
      gemm_deep<1>(Y, ldy, p.WB() + (size_t)br * D * 512, 512, 512, mt * 128, nt * 64, D, smem, acc);
      float u[2][16];
#pragma unroll
      for (int a = 0; a < 2; ++a)
#pragma unroll
        for (int r = 0; r < 16; ++r) { u[a][r] = acc[a][0][r]; acc[a][0][r] = 0.f; }
      gemm_deep<1>(p.H(), D, p.WIN() + (size_t)(ZW + br * D) * D, D, D, mt * 128, nt * 64, D, smem, acc);
#pragma unroll
      for (int a = 0; a < 2; ++a)
#pragma unroll
        for (int r = 0; r < 16; ++r) out[a][r] += sigm(acc[a][0][r]) * u[a][r];
    }
#pragma unroll
    for (int a = 0; a < 2; ++a)
#pragma unroll
      for (int g = 0; g < 4; ++g)
        st4h(p.M() + (size_t)(mt * 128 + wm * 64 + a * 32 + l31) * D + nt * 64 + wn * 32 + 8 * g + 4 * hh, out[a][4 * g], out[a][4 * g + 1],
             out[a][4 * g + 2], out[a][4 * g + 3]);
  }
}

DEVI void resid_gemm_phase(const P& p, int l, const h16* A, int K, const h16* Bt, int gate_idx, char* smem) {
  constexpr int MT = NR / 128, NT = 8, T = MT * NT;
  const float alpha = 1.6817928305074290f;
  auto epi = [&](int m, int n, float v0, float v1, float v2, float v3) {
    int b = m / SB, s = m - b * SB;
    int g = s < CTX ? 4 : b;
    float4 gt = *(const float4*)(p.MOD() + ((size_t)l * 5 + g) * 6144 + gate_idx * D + n);
    float* xp = xrow(p, m) + n;
    float4 xv = *(float4*)xp;
    xv.x = alpha * xv.x + gt.x * v0; xv.y = alpha * xv.y + gt.y * v1; xv.z = alpha * xv.z + gt.z * v2; xv.w = alpha * xv.w + gt.w * v3;
    *(float4*)xp = xv;
  };
  const int G = gridDim.x, R = T / G, rem = T - R * G;
  const bool split_tail = (2 * rem <= G);
  const int nfull = split_tail ? R * G : T;
  for (int job = blockIdx.x; job < nfull; job += G) {
    int nt = job / MT, mt = job - nt * MT;
    f32x16 acc[2][2]; zero_acc(acc);
    gemm_deep<2>(A, K, Bt, K, K, mt * 128, nt * 128, D, smem, acc);
    epi_quads(acc, mt * 128, nt * 128, epi);
  }
  if (split_tail && (int)blockIdx.x < 2 * rem) {
    const int job = nfull + (blockIdx.x >> 1), half = blockIdx.x & 1;
    int nt = job / MT, mt = job - nt * MT;
    f32x16 acc[2][1];
#pragma unroll
    for (int a2 = 0; a2 < 2; ++a2)
#pragma unroll
      for (int r = 0; r < 16; ++r) acc[a2][0][r] = 0.f;
    const int n0 = nt * 128 + half * 64;
    gemm_deep<1>(A, K, Bt, K, K, mt * 128, n0, D, smem, acc);
    const int lane = tidx() & 63, wv = tidx() >> 6, wm = wv >> 1, wn = wv & 1, l31 = lane & 31, hh = lane >> 5;
#pragma unroll
    for (int a2 = 0; a2 < 2; ++a2)
#pragma unroll
      for (int g = 0; g < 4; ++g)
        epi(mt * 128 + wm * 64 + a2 * 32 + l31, n0 + wn * 32 + 8 * g + 4 * hh, acc[a2][0][4 * g], acc[a2][0][4 * g + 1], acc[a2][0][4 * g + 2], acc[a2][0][4 * g + 3]);
  }
}
DEVI void mlp1_phase(const P& p, char* smem) {
  constexpr int MT = NR / 128, NT = DFF / 128;
  h16* HID = p.Z();
  for (int job = blockIdx.x; job < MT * NT; job += gridDim.x) {
    int nt = job / MT, mt = job - nt * MT;
    f32x16 acc[2][2]; zero_acc(acc);
    gemm_deep<2>(p.H(), D, p.W1T(), D, D, mt * 128, nt * 128, DFF, smem, acc);
    epi_oct(acc, mt * 128, nt * 128, [](float x, int) { x = fmaxf(x, 0.f); return x * x; }, [&](int m, int n, uint4 u) {
      *(uint4*)(HID + (size_t)m * DFF + n) = u;
    });
  }
}

constexpr int PH_PER_LAYER = 11;
constexpr int NPHASES = 1 + DEPTH * PH_PER_LAYER + 1;

DEVI void run_phase(const P& p, int ph, char* smem, int role, int rank) {
  if (ph == 0) { phase0(p, smem); return; }
  if (ph == NPHASES - 1) { ln_phase(p, DEPTH, 2); return; }
  const int l = (ph - 1) / PH_PER_LAYER, k = (ph - 1) - l * PH_PER_LAYER;
  switch (k) {
    case 0: ln_phase(p, l, 0); conv_phase(p, l, 0, 12, smem); break;
    case 1: inproj_phase(p, smem);
#if PROBE == 2
      inproj_phase(p, smem);
#endif
      break;
    case 2: {
      constexpr int NPRE = 32 * 68, NSH = (NR / 64) * 8, NUP = (NR / 128) * 14;
      for (int j = blockIdx.x; j < NPRE + NSH + NUP; j += gridDim.x) {
        if (j < NPRE) gla_pre_job(p, l, j, smem);
        else if (j < NPRE + NSH) shift_job(p, l, j - NPRE, smem);
        else mla_up_job(p, j - NPRE - NSH, smem);
        __syncthreads();
      }
    } break;
    case 3: {
      constexpr int NLR = 5 * 4 * (NR / 128);
      for (int j = blockIdx.x; j < NLR; j += gridDim.x) { lowrank_job(p, l, j, smem); __syncthreads(); }
    } break;
    case 4: mixer_phase(p, l, smem, l, 0, role, rank);
#if PROBE == 1
      mixer_phase(p, l, smem, 8 + l);
#endif
      break;
    case 5: post_phase(p, l); break;
    case 6: merge_phase(p, smem); conv_phase(p, l, 12, 14, smem); break;
    case 7: resid_gemm_phase(p, l, p.M(), D, p.WO(), 2, smem); break;
    case 8: ln_phase(p, l, 1); break;
    case 9: mlp1_phase(p, smem);
#if PROBE == 2
      mlp1_phase(p, smem);
#endif
      break;
    default: resid_gemm_phase(p, l, p.Z(), DFF, p.W2T(), 5, smem); break;
  }
}

__global__ void __launch_bounds__(256, 2) mega(P p, int pb, int pe) {
  extern __shared__ __attribute__((aligned(16))) char smem[];
  cg::grid_group grid = cg::this_grid();
  __shared__ uint4 xb_words;
  if (threadIdx_x_raw() == 0) xb_words = make_uint4(0u, 0u, 0u, 0u);
  __syncthreads();
  XcdBarrier xb = xcd_barrier_post(p.BAR(), (volatile LAS unsigned*)&xb_words);
  __shared__ int4 rolev;
  unsigned* cut = p.BAR() + 3584;
  if (threadIdx_x_raw() == 0) {
    const unsigned key = (xb_xcc_id() << 8) | ((unsigned)__builtin_amdgcn_s_getreg((7 << 11) | (8 << 6) | 4) & 0xffu);
    const unsigned rank = xb_add(cut + key, 1u);
    if (rank == 0u) { const unsigned ord = xb_add(cut + 8192, 1u); __hip_atomic_store(cut + 4096 + key, ord, __ATOMIC_RELAXED, __HIP_MEMORY_SCOPE_AGENT); }
    if (rank >= 2u) xb_add(cut + 8193, 1u);
    rolev = make_int4((int)blockIdx.x, 0, (int)key, (int)rank);
  }
  __syncthreads();
#if PROBE >= 100
  unsigned long long tacc = 0;
#endif
#if PROBE >= 200
  if (blockIdx.x == 0 && threadIdx_x_raw() == 0) g_tacc[0] = 0;
#endif
  for (int ph = pb; ph < pe; ++ph) {
    if (ph > pb) {
      if (ph == pb + 1) {
        grid.sync();
        if (threadIdx_x_raw() == 0) {
          const unsigned key = (unsigned)rolev.z, rank = (unsigned)rolev.w;
          const unsigned ord = xb_ld(cut + 4096 + key), ncu = xb_ld(cut + 8192), bad = xb_ld(cut + 8193);
          if (bad == 0u && 2u * ncu == gridDim.x && rank < 2u && ncu >= 256u) {
            if (ord < 128u) rolev.x = rank == 0u ? (int)ord : (int)(256u + ord);
            else if (ord < 192u) rolev.x = (int)(128u + 2u * (ord - 128u) + rank);
            else rolev.x = (int)(384u + 2u * (ord - 192u) + rank);
            rolev.y = 1;
          }
        }
        __syncthreads();
      } else xcd_barrier(xb);
    }
#if PROBE == 6
    if (ph >= 1 && ph < NPHASES - 1 && ((ph - 1) % PH_PER_LAYER) == 4) {
      const int l = (ph - 1) / PH_PER_LAYER;
      mixer_phase(p, l, smem, l, 1);
      xcd_barrier(xb);
      mixer_phase(p, l, smem, l, 1);
      xcd_barrier(xb);
      mixer_phase(p, l, smem, l, 2);
      continue;
    }
#endif
#if PROBE >= 100
    const bool tph = (ph >= 1 && ph < NPHASES - 1 && ((ph - 1) % PH_PER_LAYER) == (PROBE - 100));
    unsigned long long t0 = 0;
    if (tph && blockIdx.x == 0) t0 = __builtin_amdgcn_s_memrealtime();
#endif
    run_phase(p, ph, smem, rolev.x, rolev.y);
#if PROBE >= 100
    if (tph) { xcd_barrier(xb); if (blockIdx.x == 0) tacc += __builtin_amdgcn_s_memrealtime() - t0; }
#endif
  }
#if PROBE >= 100
#if PROBE == 300
  if (blockIdx.x == 0) { const unsigned long long te = __builtin_amdgcn_s_memrealtime() + (rolev.w == 1000 ? 300000ull : (rolev.w == 2001 ? 600000ull : 900000ull)); while (__builtin_amdgcn_s_memrealtime() < te) __builtin_amdgcn_s_sleep(8); }
#elif PROBE >= 200
  {
    __syncthreads();
    const unsigned long long ta = g_tacc[0];
    if (ta) { const unsigned long long te = __builtin_amdgcn_s_memrealtime() + 4ull * ta; while (__builtin_amdgcn_s_memrealtime() < te) __builtin_amdgcn_s_sleep(8); }
  }
#else
  if (blockIdx.x == 0) { const unsigned long long te = __builtin_amdgcn_s_memrealtime() + 4ull * tacc; while (__builtin_amdgcn_s_memrealtime() < te) __builtin_amdgcn_s_sleep(8); }
#endif
#endif
}

extern "C" void kernel_launch(void* const* d_in, const int* in_sizes, int n_in, void* d_out, int out_size, void* d_ws,
                              size_t ws_size, hipStream_t stream) {
  static int grid_blocks = 0;
  if (grid_blocks == 0) {
    int dev = 0, cus = 0, per_cu = 0;
    hipGetDevice(&dev);
    hipDeviceGetAttribute(&cus, hipDeviceAttributeMultiprocessorCount, dev);
    hipFuncSetAttribute((const void*)mega, hipFuncAttributeMaxDynamicSharedMemorySize, LDS_BYTES);
    hipOccupancyMaxActiveBlocksPerMultiprocessor(&per_cu, (const void*)mega, 256, LDS_BYTES);
    if (per_cu < 1) per_cu = 1;
    if (per_cu > 2) per_cu = 2;
    grid_blocks = cus * per_cu;
    fprintf(stderr, "mega: cus %d per_cu %d grid %d\n", cus, per_cu, grid_blocks);
  }
  P p{};
  const float** ins = (const float**)&p;
  for (int i = 0; i < 33; ++i) ins[i] = (const float*)d_in[i];
  p.XL = (float*)d_out;
  p.ws = (char*)d_ws;
  const size_t off = WS_TOTAL;
  if (off > ws_size || n_in != 33) { fprintf(stderr, "mega: workspace too small (%zu > %zu) or n_in %d\n", off, ws_size, n_in); return; }
  (void)hipMemsetAsync((char*)d_ws + OFF_BAR, 0, BAR_BYTES, stream);
  int pb = 0, pe = NPHASES;
  void* args[] = {&p, &pb, &pe};
  hipError_t e = hipLaunchCooperativeKernel((const void*)mega, dim3(grid_blocks), dim3(256), args, LDS_BYTES, stream);
  if (e != hipSuccess) fprintf(stderr, "mega: cooperative launch failed: %s (grid %d)\n", hipGetErrorString(e), grid_blocks);
}
```
